# Optimizing an MI355X kernel written in HIP

```python
import math
import jax, jax.numpy as jnp
from jax import lax
import numpy as np

D_MODEL = 4096
BATCH = 2
SEQ = 4096
DEPTH = 1
DEC_BATCH = 1
DEC_SEQ = 16384
PAST_LEN = 128

N_HEADS = 16
HEAD_DIM = 64
V_HEAD_DIM = 2 * HEAD_DIM
QK_WIDTH = N_HEADS * 2 * HEAD_DIM
ATTN_WIDTH = N_HEADS * V_HEAD_DIM
ROT_DIM = HEAD_DIM // 4
ROPE_THETA = 500000.0
Q_BLOCK = 128
RNN_WIDTH = 2048
RNN_BLOCKS = 16
RNN_BLOCK_W = RNN_WIDTH // RNN_BLOCKS
CONV_WIDTH = 4
RG_C = 8.0
N_BRANCH = 2
IN_WIDTH = 2 * QK_WIDTH + ATTN_WIDTH + 2 * RNN_WIDTH + N_BRANCH * D_MODEL
D_FF = 11008
EPS = 1e-6

kernel_name = "hybrid_diffattn_rglru_macaron_encoder"


def _lambda_init(layer_idx):
    return 0.8 - 0.6 * math.exp(-0.3 * layer_idx)


def _rms_norm(x, g):
    xf = x.astype(jnp.float32)
    y = xf * lax.rsqrt(jnp.mean(xf * xf, axis=-1, keepdims=True) + EPS)
    return (y * g.astype(jnp.float32)).astype(x.dtype)


def _swiglu(x, w_in, w_out):
    gate, up = jnp.split(x @ w_in, 2, axis=-1)
    return (jax.nn.silu(gate) * up) @ w_out


def _partial_rope(x, pos):
    inv_freq = ROPE_THETA ** (-jnp.arange(0, ROT_DIM, 2, dtype=jnp.float32) / ROT_DIM)
    ang = pos.astype(jnp.float32)[:, None] * inv_freq[None, :]
    cos = jnp.cos(ang)[:, None, None, :].astype(x.dtype)
    sin = jnp.sin(ang)[:, None, None, :].astype(x.dtype)
    xr, xp = x[..., :ROT_DIM], x[..., ROT_DIM:]
    x1, x2 = jnp.split(xr, 2, axis=-1)
    rot = jnp.concatenate([x1 * cos - x2 * sin, x2 * cos + x1 * sin], axis=-1)
    return jnp.concatenate([rot, xp], axis=-1)


def _diff_attention(q, k, v, lam):
    B, S = q.shape[0], q.shape[1]
    nb = S // Q_BLOCK
    q = q * (HEAD_DIM ** -0.5)
    qb = q.reshape(B, nb, Q_BLOCK, N_HEADS, 2, HEAD_DIM).swapaxes(0, 1)

    def block(qi):
        s = jnp.einsum('bqhmd,bkhmd->bhmqk', qi, k).astype(jnp.float32)
        p = jax.nn.softmax(s, axis=-1)
        w = p[:, :, 0] - lam * p[:, :, 1]
        return jnp.einsum('bhqk,bkhe->bqhe', w.astype(v.dtype), v)

    o = lax.map(block, qb)
    return o.swapaxes(0, 1).reshape(B, S, N_HEADS, V_HEAD_DIM)


def _centred_dwconv(x, w, b):
    C = x.shape[-1]
    y = lax.conv_general_dilated(x, w[:, None, :].astype(x.dtype), window_strides=(1,),
                                 padding=[(CONV_WIDTH // 2, CONV_WIDTH - 1 - CONV_WIDTH // 2)],
                                 dimension_numbers=('NWC', 'WIO', 'NWC'),
                                 feature_group_count=C)
    return y + b.astype(x.dtype)


def _rglru_dir(xf, wa, ba, wx, bx, lam, reverse):
    B, S, _ = xf.shape
    xb = xf.reshape(B, S, RNN_BLOCKS, RNN_BLOCK_W)
    r = jax.nn.sigmoid(jnp.einsum('bsnc,ncd->bsnd', xb, wa.astype(jnp.float32)) + ba.astype(jnp.float32)).reshape(B, S, RNN_WIDTH)
    i = jax.nn.sigmoid(jnp.einsum('bsnc,ncd->bsnd', xb, wx.astype(jnp.float32)) + bx.astype(jnp.float32)).reshape(B, S, RNN_WIDTH)
    log_a = -RG_C * r * jax.nn.softplus(-lam.astype(jnp.float32))
    a = jnp.exp(log_a)
    u = jnp.sqrt(-jnp.expm1(2.0 * log_a)) * (i * xf)

    def combine(e1, e2):
        a1, b1 = e1
        a2, b2 = e2
        return a1 * a2, a2 * b1 + b2

    _, h = lax.associative_scan(combine, (a, u), axis=1, reverse=reverse)
    return h


def _layer(x, l, ffn1_norm, ffn1_w_in, ffn1_w_out, mix_norm, w_in, lambda_q1, lambda_k1,
           lambda_q2, lambda_k2, subln_gain, conv_w, conv_b, rg_wa, rg_ba, rg_wx, rg_bx,
           rg_lambda, w_attn_proj, w_rnn_proj, w_out, ffn2_norm, ffn2_w_in, ffn2_w_out):
    B, S, _ = x.shape
    lam_init = _lambda_init(l)
    x = x + 0.5 * _swiglu(_rms_norm(x, ffn1_norm[l]), ffn1_w_in[l], ffn1_w_out[l])

    h = _rms_norm(x, mix_norm[l])
    proj = h @ w_in[l]
    c1 = QK_WIDTH
    c2 = c1 + QK_WIDTH
    c3 = c2 + ATTN_WIDTH
    c4 = c3 + RNN_WIDTH
    c5 = c4 + RNN_WIDTH
    q, k, v, rx, ry, gates = jnp.split(proj, [c1, c2, c3, c4, c5], axis=-1)

    pos = jnp.arange(S)
    q = _partial_rope(q.reshape(B, S, N_HEADS, 2, HEAD_DIM), pos)
    k = _partial_rope(k.reshape(B, S, N_HEADS, 2, HEAD_DIM), pos)
    v = v.reshape(B, S, N_HEADS, V_HEAD_DIM)
    f32 = jnp.float32
    lam = (jnp.exp(jnp.sum(lambda_q1[l].astype(f32) * lambda_k1[l].astype(f32)))
           - jnp.exp(jnp.sum(lambda_q2[l].astype(f32) * lambda_k2[l].astype(f32))) + lam_init)
    o = _diff_attention(q, k, v, lam)
    o = _rms_norm(o, subln_gain[l]) * (1.0 - lam_init)
    branch_a = o.reshape(B, S, ATTN_WIDTH) @ w_attn_proj[l]

    xc = _centred_dwconv(rx, conv_w[l], conv_b[l]).astype(f32)
    hf = _rglru_dir(xc, rg_wa[l, 0], rg_ba[l, 0], rg_wx[l, 0], rg_bx[l, 0], rg_lambda[l, 0], False)
    hb = _rglru_dir(xc, rg_wa[l, 1], rg_ba[l, 1], rg_wx[l, 1], rg_bx[l, 1], rg_lambda[l, 1], True)
    rr = ((hf + hb) * jax.nn.gelu(ry.astype(f32))).astype(x.dtype)
    branch_r = rr @ w_rnn_proj[l]

    g = jax.nn.sigmoid(gates.reshape(B, S, N_BRANCH, D_MODEL))
    merged = g[:, :, 0] * branch_a + g[:, :, 1] * branch_r
    x = x + merged @ w_out[l]

    x = x + 0.5 * _swiglu(_rms_norm(x, ffn2_norm[l]), ffn2_w_in[l], ffn2_w_out[l])
    return x


def setup_inputs(seed: int = 0) -> dict:
    key = jax.random.key(seed)
    ks = jax.random.split(key, 32)
    f32 = jnp.float32

    def nrm(k, shape, fan_in):
        return jax.random.normal(k, shape, f32) * (fan_in ** -0.5)

    def gain(k, shape):
        return 1.0 + 0.01 * jax.random.normal(k, shape, f32)

    a0 = jax.random.uniform(ks[20], (DEPTH, 2, RNN_WIDTH), f32, 0.9, 0.999)
    return {
        "x_prompt": jax.random.normal(ks[0], (BATCH, SEQ, D_MODEL), f32),
        "x_sample": jax.random.normal(ks[1], (DEC_BATCH, DEC_SEQ, D_MODEL), f32),
        "ffn1_norm": gain(ks[2], (DEPTH, D_MODEL)),
        "ffn1_w_in": nrm(ks[3], (DEPTH, D_MODEL, 2 * D_FF), D_MODEL),
        "ffn1_w_out": nrm(ks[4], (DEPTH, D_FF, D_MODEL), D_FF),
        "mix_norm": gain(ks[5], (DEPTH, D_MODEL)),
        "w_in": nrm(ks[6], (DEPTH, D_MODEL, IN_WIDTH), D_MODEL),
        "lambda_q1": 0.1 * jax.random.normal(ks[7], (DEPTH, HEAD_DIM), f32),
        "lambda_k1": 0.1 * jax.random.normal(ks[8], (DEPTH, HEAD_DIM), f32),
        "lambda_q2": 0.1 * jax.random.normal(ks[9], (DEPTH, HEAD_DIM), f32),
        "lambda_k2": 0.1 * jax.random.normal(ks[10], (DEPTH, HEAD_DIM), f32),
        "subln_gain": gain(ks[11], (DEPTH, V_HEAD_DIM)),
        "conv_w": nrm(ks[12], (DEPTH, CONV_WIDTH, RNN_WIDTH), CONV_WIDTH),
        "conv_b": 0.01 * jax.random.normal(ks[13], (DEPTH, RNN_WIDTH), f32),
        "rg_wa": nrm(ks[14], (DEPTH, 2, RNN_BLOCKS, RNN_BLOCK_W, RNN_BLOCK_W), RNN_BLOCK_W),
        "rg_ba": 0.01 * jax.random.normal(ks[15], (DEPTH, 2, RNN_BLOCKS, RNN_BLOCK_W), f32),
        "rg_wx": nrm(ks[16], (DEPTH, 2, RNN_BLOCKS, RNN_BLOCK_W, RNN_BLOCK_W), RNN_BLOCK_W),
        "rg_bx": 0.01 * jax.random.normal(ks[17], (DEPTH, 2, RNN_BLOCKS, RNN_BLOCK_W), f32),
        "rg_lambda": jnp.log(a0) - jnp.log1p(-a0),
        "w_attn_proj": nrm(ks[18], (DEPTH, ATTN_WIDTH, D_MODEL), ATTN_WIDTH),
        "w_rnn_proj": nrm(ks[19], (DEPTH, RNN_WIDTH, D_MODEL), RNN_WIDTH),
        "w_out": nrm(ks[21], (DEPTH, D_MODEL, D_MODEL), D_MODEL),
        "ffn2_norm": gain(ks[22], (DEPTH, D_MODEL)),
        "ffn2_w_in": nrm(ks[23], (DEPTH, D_MODEL, 2 * D_FF), D_MODEL),
        "ffn2_w_out": nrm(ks[24], (DEPTH, D_FF, D_MODEL), D_FF),
        "final_norm": gain(ks[25], (D_MODEL,)),
    }


def _trunk(x, ffn1_norm, ffn1_w_in, ffn1_w_out, mix_norm, w_in, lambda_q1, lambda_k1,
           lambda_q2, lambda_k2, subln_gain, conv_w, conv_b, rg_wa, rg_ba, rg_wx, rg_bx,
           rg_lambda, w_attn_proj, w_rnn_proj, w_out, ffn2_norm, ffn2_w_in, ffn2_w_out, final_norm):
    for l in range(DEPTH):
        x = _layer(x, l, ffn1_norm, ffn1_w_in, ffn1_w_out, mix_norm, w_in, lambda_q1, lambda_k1,
                   lambda_q2, lambda_k2, subln_gain, conv_w, conv_b, rg_wa, rg_ba, rg_wx, rg_bx,
                   rg_lambda, w_attn_proj, w_rnn_proj, w_out, ffn2_norm, ffn2_w_in, ffn2_w_out)
    return _rms_norm(x, final_norm)


def reference(x_prompt, x_sample, ffn1_norm, ffn1_w_in, ffn1_w_out, mix_norm, w_in, lambda_q1,
              lambda_k1, lambda_q2, lambda_k2, subln_gain, conv_w, conv_b, rg_wa, rg_ba, rg_wx,
              rg_bx, rg_lambda, w_attn_proj, w_rnn_proj, w_out, ffn2_norm, ffn2_w_in, ffn2_w_out,
              final_norm):
    y_prompt = _trunk(x_prompt, ffn1_norm, ffn1_w_in, ffn1_w_out, mix_norm, w_in, lambda_q1,
                      lambda_k1, lambda_q2, lambda_k2, subln_gain, conv_w, conv_b, rg_wa, rg_ba,
                      rg_wx, rg_bx, rg_lambda, w_attn_proj, w_rnn_proj, w_out, ffn2_norm,
                      ffn2_w_in, ffn2_w_out, final_norm)
    y_sample = _trunk(x_sample, ffn1_norm, ffn1_w_in, ffn1_w_out, mix_norm, w_in, lambda_q1,
                      lambda_k1, lambda_q2, lambda_k2, subln_gain, conv_w, conv_b, rg_wa, rg_ba,
                      rg_wx, rg_bx, rg_lambda, w_attn_proj, w_rnn_proj, w_out, ffn2_norm,
                      ffn2_w_in, ffn2_w_out, final_norm)
    return (y_prompt, y_sample)
```

```cpp
#include <hip/hip_runtime.h>
#include <hip/hip_bf16.h>
#include <cstdio>
#include <cstdint>
#include <cmath>
namespace pg8 {
#define PG8_LAS __attribute__((address_space(3)))
typedef unsigned short bf16_t;
typedef short bf16x8 __attribute__((ext_vector_type(8)));
typedef float f32x4 __attribute__((ext_vector_type(4)));
typedef unsigned u32x4 __attribute__((ext_vector_type(4)));
constexpr int BM = 256, BK = 64, HALF = 128, HTB = HALF * BK * 2  , STAGE_BYTES = 8 * HTB, NXCD = 8, WGM = 8;

__host__ __device__ __forceinline__ int lds_byte(int r, int c) { const int st = (r >> 4) * 2 + (c >> 5), rr = r & 15, cc = c & 31, ob = rr * 64 + cc * 2; return st * 1024 + (ob ^ (((ob >> 9) & 1) << 5)); }
__host__ __device__ __forceinline__ void stage_rc(int b, int& R, int& C) { const int st = b / 1024, sb = b % 1024, swz = sb ^ (((sb >> 9) & 1) << 5); R = (st >> 1) * 16 + swz / 64; C = (st & 1) * 32 + (swz % 64) / 2; }
__host__ __device__ __forceinline__ int perm32(int rho) { const int n = rho >> 4, i = rho & 15; return 8 * (i >> 2) + 4 * n + (i & 3); }

struct Unit { int pm, pn; };
struct Gemm { const bf16_t* A; const bf16_t* Bt; int M, N, K; };

struct StaticOrder {
    int nM, nN, nwg, G, c;
    __host__ __device__ void init(int M, int N, int G_, int c_) { nM = M / BM; nN = N / BM; nwg = nM * nN; G = G_; c = c_; }
    __host__ __device__ bool next(int i, Unit& u) const {
        const long L = (long)i * G + c; if (L >= nwg) return false;
        int wgid = (int)L; { const int q = nwg / NXCD, r = nwg % NXCD, xcd = wgid % NXCD, off = wgid / NXCD; wgid = (xcd < r ? xcd * (q + 1) : r * (q + 1) + (xcd - r) * q) + off; }
        const int nig = WGM * nN, gid = wgid / nig, fm = gid * WGM, gsz = (nM - fm) < WGM ? (nM - fm) : WGM;
        u.pm = fm + ((wgid % nig) % gsz); u.pn = (wgid % nig) / gsz; return true;
    }
    __device__ __forceinline__ void a_ready(const Unit&) const {}
    __device__ __forceinline__ void done(const Unit&) const {}
};

__device__ __forceinline__ unsigned cvt_pk_bf16(float lo, float hi) { unsigned r; asm volatile("v_cvt_pk_bf16_f32 %0, %1, %2" : "=v"(r) : "v"(lo), "v"(hi)); return r; }
typedef float f32x2 __attribute__((ext_vector_type(2)));
__device__ __forceinline__ float sigm(float x) { return __builtin_amdgcn_rcpf(1.f + __builtin_amdgcn_exp2f(-1.4426950408889634f * x)); }
__device__ __forceinline__ float bf_lo(unsigned w) { return __uint_as_float(w << 16); }
__device__ __forceinline__ float bf_hi(unsigned w) { return __uint_as_float(w & 0xffff0000u); }
struct EpiSwiGLU {
    static constexpr bool PERM = true, AFTER_DRAIN = false;
    bf16_t* O; int ldc;
    __device__ __forceinline__ void operator()(const f32x4 (&acc)[2][2][4][2], const Unit& u, int wr, int wc, int fr, int fq) const {
        const int row0 = u.pm * BM + wr * 64 + fr, col0 = u.pn * HALF + wc * 32 + 8 * fq;
#pragma unroll
        for (int ai = 0; ai < 2; ++ai)
#pragma unroll
            for (int m = 0; m < 4; ++m) {
                bf16_t* rowp = O + (size_t)(row0 + ai * HALF + m * 16) * ldc + col0;
                float r[8];
#pragma unroll
                for (int n = 0; n < 2; ++n)
#pragma unroll
                    for (int j = 0; j < 4; ++j) { const float g = acc[ai][0][m][n][j], up = acc[ai][1][m][n][j]; r[4 * n + j] = g * sigm(g) * up; }
                u32x4 w; w.x = cvt_pk_bf16(r[0], r[1]); w.y = cvt_pk_bf16(r[2], r[3]); w.z = cvt_pk_bf16(r[4], r[5]); w.w = cvt_pk_bf16(r[6], r[7]);
                *(u32x4*)rowp = w;
            }
    }
};
struct EpiResid {
    static constexpr bool PERM = false, AFTER_DRAIN = false;
    const float* res0; const float* res1; int split_row; float* out; int ldc; float alpha;
    __device__ __forceinline__ void operator()(const f32x4 (&acc)[2][2][4][2], const Unit& u, int wr, int wc, int fr, int fq) const {
        const int rowt = u.pm * BM; const float* rb = rowt < split_row ? res0 + (size_t)rowt * ldc : res1 + (size_t)(rowt - split_row) * ldc;
        float* ob = out + (size_t)rowt * ldc;
        const int col0 = u.pn * BM + wc * 32 + 4 * fq;
#pragma unroll
        for (int ai = 0; ai < 2; ++ai)
#pragma unroll
            for (int m = 0; m < 4; ++m) { const size_t off = (size_t)(ai * HALF + wr * 64 + m * 16 + fr) * ldc + col0;
                f32x4 rv[2][2];
#pragma unroll
                for (int bj = 0; bj < 2; ++bj)
#pragma unroll
                    for (int n = 0; n < 2; ++n) rv[bj][n] = *(const f32x4*)(rb + off + bj * HALF + n * 16);
#pragma unroll
                for (int bj = 0; bj < 2; ++bj)
#pragma unroll
                    for (int n = 0; n < 2; ++n) *(f32x4*)(ob + off + bj * HALF + n * 16) = rv[bj][n] + acc[ai][bj][m][n] * alpha;
                if (m & 1) asm volatile("" ::: "memory"); }
    }
};
struct EpiProj {
    static constexpr bool PERM = true, AFTER_DRAIN = false;
    bf16_t* QKV; bf16_t* RXY; bf16_t* G; const float* rope;
    __device__ __forceinline__ void operator()(const f32x4 (&acc)[2][2][4][2], const Unit& u, int wr, int wc, int fr, int fq) const {
        const int colt = u.pn * BM, rowt = u.pm * BM;
        bf16_t* base; int ldc, cb;
        if (colt < 6144) { base = QKV; ldc = 6144; cb = colt; } else if (colt < 10240) { base = RXY; ldc = 4096; cb = colt - 6144; } else { base = G; ldc = 8192; cb = colt - 10240; }
        const bool rot = (colt < 4096) && ((wc & 1) == 0);
        const int pos0 = rowt - (rowt < 4096 ? 0 : (rowt < 8192 ? 4096 : 8192));
        const int col0 = cb + wc * 32 + 8 * fq;
        const float sgn = fq == 0 ? -1.f : 1.f;
#pragma unroll
        for (int ai = 0; ai < 2; ++ai)
#pragma unroll
            for (int m = 0; m < 4; ++m) {
                const int rl = ai * HALF + wr * 64 + m * 16 + fr;
                bf16_t* rowp = base + (size_t)(rowt + rl) * ldc + col0;
                f32x4 cs[4];
                if (rot && fq < 2) { const f32x4* tp = (const f32x4*)(rope + (size_t)(pos0 + rl) * 16);
#pragma unroll
                    for (int q = 0; q < 4; ++q) cs[q] = tp[q]; }
#pragma unroll
                for (int bj = 0; bj < 2; ++bj) {
                    f32x4 v0 = acc[ai][bj][m][0], v1 = acc[ai][bj][m][1];
                    if (rot) {
                        f32x4 p0, p1;
#pragma unroll
                        for (int j = 0; j < 4; ++j) { p0[j] = __shfl_xor(v0[j], 16); p1[j] = __shfl_xor(v1[j], 16); }
                        if (fq < 2) {
                            v0[0] = v0[0] * cs[0][0] + sgn * p0[0] * cs[0][1]; v0[1] = v0[1] * cs[0][2] + sgn * p0[1] * cs[0][3];
                            v0[2] = v0[2] * cs[1][0] + sgn * p0[2] * cs[1][1]; v0[3] = v0[3] * cs[1][2] + sgn * p0[3] * cs[1][3];
                            v1[0] = v1[0] * cs[2][0] + sgn * p1[0] * cs[2][1]; v1[1] = v1[1] * cs[2][2] + sgn * p1[1] * cs[2][3];
                            v1[2] = v1[2] * cs[3][0] + sgn * p1[2] * cs[3][1]; v1[3] = v1[3] * cs[3][2] + sgn * p1[3] * cs[3][3];
                        }
                    }
                    u32x4 w; w.x = cvt_pk_bf16(v0[0], v0[1]); w.y = cvt_pk_bf16(v0[2], v0[3]); w.z = cvt_pk_bf16(v1[0], v1[1]); w.w = cvt_pk_bf16(v1[2], v1[3]);
                    *(u32x4*)(rowp + bj * HALF) = w;
                }
            }
    }
};
template <bool ADD> struct EpiGate {
    static constexpr bool PERM = true, AFTER_DRAIN = false;
    bf16_t* O; const bf16_t* Gt; int goff;
    __device__ __forceinline__ void operator()(const f32x4 (&acc)[2][2][4][2], const Unit& u, int wr, int wc, int fr, int fq) const {
        const int row0 = u.pm * BM + wr * 64 + fr, col0 = u.pn * BM + wc * 32 + 8 * fq;
#pragma unroll
        for (int ai = 0; ai < 2; ++ai)
#pragma unroll
            for (int m = 0; m < 4; ++m) { const size_t row = (size_t)(row0 + ai * HALF + m * 16);
                u32x4 gv[2], ov[2];
#pragma unroll
                for (int bj = 0; bj < 2; ++bj) { gv[bj] = *(const u32x4*)(Gt + row * 8192 + goff + col0 + bj * HALF); if (ADD) ov[bj] = *(const u32x4*)(O + row * 4096 + col0 + bj * HALF); }
#pragma unroll
                for (int bj = 0; bj < 2; ++bj) { const f32x4 a0 = acc[ai][bj][m][0], a1 = acc[ai][bj][m][1]; float r[8];
                    r[0] = sigm(bf_lo(gv[bj].x)) * a0[0]; r[1] = sigm(bf_hi(gv[bj].x)) * a0[1]; r[2] = sigm(bf_lo(gv[bj].y)) * a0[2]; r[3] = sigm(bf_hi(gv[bj].y)) * a0[3];
                    r[4] = sigm(bf_lo(gv[bj].z)) * a1[0]; r[5] = sigm(bf_hi(gv[bj].z)) * a1[1]; r[6] = sigm(bf_lo(gv[bj].w)) * a1[2]; r[7] = sigm(bf_hi(gv[bj].w)) * a1[3];
                    if (ADD) { r[0] += bf_lo(ov[bj].x); r[1] += bf_hi(ov[bj].x); r[2] += bf_lo(ov[bj].y); r[3] += bf_hi(ov[bj].y); r[4] += bf_lo(ov[bj].z); r[5] += bf_hi(ov[bj].z); r[6] += bf_lo(ov[bj].w); r[7] += bf_hi(ov[bj].w); }
                    u32x4 w; w.x = cvt_pk_bf16(r[0], r[1]); w.y = cvt_pk_bf16(r[2], r[3]); w.z = cvt_pk_bf16(r[4], r[5]); w.w = cvt_pk_bf16(r[6], r[7]);
                    *(u32x4*)(O + row * 4096 + col0 + bj * HALF) = w; }
            }
    }
};

template <class Epi, class Sched, bool ALIGN_EPI = false, bool SP2 = false>
__device__ __forceinline__ void gemm_phase(PG8_LAS unsigned char* lds, const Gemm g, const Sched& S, const Epi& E) {
    const int tid = threadIdx.x, wid = __builtin_amdgcn_readfirstlane(tid >> 6), lane = tid & 63, wr = wid >> 2, wc = wid & 3, fr = lane & 15, fq = lane >> 4;
    const int K = g.K, nt = K / BK;
    unsigned voffA[2], voffB[2];
#pragma unroll
    for (int i = 0; i < 2; ++i) { int R, C; stage_rc(tid * 16 + i * 8192, R, C); const int Rb = Epi::PERM ? ((R & ~31) + perm32(R & 31)) : R;
        voffA[i] = (unsigned)(R * K + C) * 2u; voffB[i] = (unsigned)(Rb * K + C) * 2u; }
    const size_t kstep = (size_t)(BK * 2);
    const size_t hstep = (size_t)HALF * K * 2;
    const size_t tstep = 2 * hstep;
    const unsigned ldsw = (unsigned)wid * 1024u;
    const int aoff = lds_byte(wr * 64 + fr, fq * 8), boff = lds_byte(wc * 32 + fr, fq * 8);
#define PG8_SA(b, h) (((b) * 2 + (h)) * HTB)
#define PG8_SB(b, h) ((4 + (b) * 2 + (h)) * HTB)
#define PG8_STAGE(bufoff, gbase, voff) do { _Pragma("unroll") for (int _i = 0; _i < 2; ++_i) \
        __builtin_amdgcn_global_load_lds((const unsigned*)((const char*)(gbase) + (voff)[_i]), (PG8_LAS unsigned*)(lds + (bufoff) + ldsw + _i * 8192), 16, 0, 0); } while (0)
#define PG8_LDA(dst, b, h) do { _Pragma("unroll") for (int m = 0; m < 4; ++m) _Pragma("unroll") for (int k = 0; k < 2; ++k) dst[m][k] = *(const PG8_LAS bf16x8*)(lds + PG8_SA(b, h) + aoff + m * 2048 + k * 1024); } while (0)
#define PG8_LDB(dst, b, h) do { _Pragma("unroll") for (int n = 0; n < 2; ++n) _Pragma("unroll") for (int k = 0; k < 2; ++k) dst[n][k] = *(const PG8_LAS bf16x8*)(lds + PG8_SB(b, h) + boff + n * 2048 + k * 1024); } while (0)
#define PG8_MMA(ai, bj, At, Bt) do { __builtin_amdgcn_s_setprio(1); _Pragma("unroll") for (int m = 0; m < 4; ++m) _Pragma("unroll") for (int n = 0; n < 2; ++n) _Pragma("unroll") for (int k = 0; k < 2; ++k) \
        acc[ai][bj][m][n] = __builtin_amdgcn_mfma_f32_16x16x32_bf16(Bt[n][k], At[m][k], acc[ai][bj][m][n], 0, 0, 0); __builtin_amdgcn_s_setprio(0); } while (0)
#define PG8_WAIT_V(n) asm volatile("s_waitcnt vmcnt(" #n ")" ::: "memory")
#define PG8_WAIT_L(n) asm volatile("s_waitcnt lgkmcnt(" #n ")" ::: "memory")
#define PG8_BAR __builtin_amdgcn_s_barrier()
#define PG8_SCHED __builtin_amdgcn_sched_barrier(0)
    Unit cur, nxt; int ui = 0;
    if (!S.next(0, cur)) return;
    f32x4 acc[2][2][4][2];
#pragma unroll
    for (int a = 0; a < 2; ++a)
#pragma unroll
        for (int b = 0; b < 2; ++b)
#pragma unroll
            for (int m = 0; m < 4; ++m)
#pragma unroll
                for (int n = 0; n < 2; ++n) acc[a][b][m][n] = (f32x4){0.f, 0.f, 0.f, 0.f};
    bf16x8 At[4][2], B0[2][2], B1[2][2];
    const char* cA = (const char*)g.A + (size_t)cur.pm * tstep; const char* cB = (const char*)g.Bt + (size_t)cur.pn * tstep;
    S.a_ready(cur);
    if constexpr (SP2) {
        PG8_STAGE(PG8_SB(0, 0), cB, voffB); PG8_STAGE(PG8_SB(0, 1), cB + hstep, voffB); PG8_STAGE(PG8_SA(0, 0), cA, voffA); PG8_STAGE(PG8_SA(0, 1), cA + hstep, voffA);
        if (wr == 1) PG8_BAR;
        PG8_WAIT_V(2); PG8_BAR;
        PG8_STAGE(PG8_SB(1, 0), cB + kstep, voffB); PG8_STAGE(PG8_SA(1, 0), cA + kstep, voffA); PG8_STAGE(PG8_SB(1, 1), cB + hstep + kstep, voffB);
        PG8_WAIT_V(6); PG8_BAR;
    } else {
        PG8_STAGE(PG8_SB(0, 0), cB, voffB); PG8_STAGE(PG8_SA(0, 0), cA, voffA); PG8_STAGE(PG8_SB(0, 1), cB + hstep, voffB); PG8_STAGE(PG8_SA(0, 1), cA + hstep, voffA);
        if (wr == 1) PG8_BAR;
        PG8_WAIT_V(4); PG8_BAR;
        PG8_STAGE(PG8_SB(1, 0), cB + kstep, voffB); PG8_STAGE(PG8_SA(1, 0), cA + kstep, voffA); PG8_STAGE(PG8_SB(1, 1), cB + hstep + kstep, voffB);
        PG8_WAIT_V(6); PG8_BAR;
    }
    for (;;) {
        const bool has_next = S.next(ui + 1, nxt);
        const char* nA = has_next ? (const char*)g.A + (size_t)nxt.pm * tstep : cA; const char* nB = has_next ? (const char*)g.Bt + (size_t)nxt.pn * tstep : cB;
        for (int t = 0; t < nt; t += 2) {
            const bool last = (t == nt - 2);
            const char* a1 = cA + (size_t)(t + 1) * kstep;
            const char* a2 = last ? nA : cA + (size_t)(t + 2) * kstep; const char* b2 = last ? nB : cB + (size_t)(t + 2) * kstep;
            const char* a3 = a2 + kstep; const char* b3 = b2 + kstep;
            if (last && has_next) S.a_ready(nxt);
            if constexpr (SP2) {
            PG8_LDB(B0, 0, 0); PG8_LDB(B1, 0, 1); PG8_SCHED; PG8_LDA(At, 0, 0); PG8_STAGE(PG8_SA(1, 1), a1 + hstep, voffA);
            PG8_WAIT_V(8); PG8_WAIT_L(0); PG8_BAR; PG8_MMA(0, 0, At, B0); PG8_MMA(0, 1, At, B1); PG8_BAR; PG8_SCHED;
            PG8_LDA(At, 0, 1); PG8_STAGE(PG8_SB(0, 0), b2, voffB); PG8_STAGE(PG8_SB(0, 1), b2 + hstep, voffB); PG8_STAGE(PG8_SA(0, 0), a2, voffA);
            PG8_WAIT_V(8); PG8_WAIT_L(0); PG8_BAR; PG8_MMA(1, 0, At, B0); PG8_MMA(1, 1, At, B1); PG8_BAR; PG8_SCHED;
            PG8_LDB(B0, 1, 0); PG8_LDB(B1, 1, 1); PG8_SCHED; PG8_LDA(At, 1, 0); PG8_STAGE(PG8_SA(0, 1), a2 + hstep, voffA);
            PG8_WAIT_V(8); PG8_WAIT_L(0); PG8_BAR; PG8_MMA(0, 0, At, B0); PG8_MMA(0, 1, At, B1); PG8_BAR; PG8_SCHED;
            PG8_LDA(At, 1, 1); PG8_STAGE(PG8_SB(1, 0), b3, voffB); PG8_STAGE(PG8_SB(1, 1), b3 + hstep, voffB); PG8_STAGE(PG8_SA(1, 0), a3, voffA);
            PG8_WAIT_V(8); PG8_WAIT_L(0); PG8_BAR; PG8_MMA(1, 0, At, B0); PG8_MMA(1, 1, At, B1); PG8_BAR; PG8_SCHED;
            } else {
            PG8_LDB(B0, 0, 0); PG8_SCHED; PG8_LDA(At, 0, 0); PG8_STAGE(PG8_SA(1, 1), a1 + hstep, voffA);
            PG8_WAIT_L(8); PG8_BAR; PG8_WAIT_L(0); PG8_MMA(0, 0, At, B0); PG8_BAR; PG8_SCHED;
            PG8_LDB(B1, 0, 1); PG8_STAGE(PG8_SB(0, 0), b2, voffB);
            PG8_BAR; PG8_WAIT_L(0); PG8_MMA(0, 1, At, B1); PG8_BAR;
            PG8_LDA(At, 0, 1); PG8_STAGE(PG8_SA(0, 0), a2, voffA);
            PG8_BAR; PG8_WAIT_L(0); PG8_MMA(1, 0, At, B0); PG8_BAR; PG8_SCHED;
            PG8_STAGE(PG8_SB(0, 1), b2 + hstep, voffB);
            PG8_WAIT_V(6); PG8_BAR; PG8_MMA(1, 1, At, B1); PG8_BAR;
            PG8_LDB(B0, 1, 0); PG8_SCHED; PG8_LDA(At, 1, 0); PG8_STAGE(PG8_SA(0, 1), a2 + hstep, voffA);
            PG8_WAIT_L(8); PG8_BAR; PG8_WAIT_L(0); PG8_MMA(0, 0, At, B0); PG8_BAR; PG8_SCHED;
            PG8_LDB(B1, 1, 1); PG8_STAGE(PG8_SB(1, 0), b3, voffB);
            PG8_BAR; PG8_WAIT_L(0); PG8_MMA(0, 1, At, B1); PG8_BAR;
            PG8_LDA(At, 1, 1); PG8_STAGE(PG8_SA(1, 0), a3, voffA);
            PG8_BAR; PG8_WAIT_L(0); PG8_MMA(1, 0, At, B0); PG8_BAR; PG8_SCHED;
            PG8_STAGE(PG8_SB(1, 1), b3 + hstep, voffB);
            PG8_WAIT_V(6); PG8_BAR; PG8_MMA(1, 1, At, B1); PG8_BAR;
            }
        }
        if constexpr (ALIGN_EPI) { if (wr == 0) PG8_BAR; }
        if constexpr (!Epi::AFTER_DRAIN) { E(acc, cur, wr, wc, fr, fq); S.done(cur); }
        if (!has_next) break;
#pragma unroll
        for (int a = 0; a < 2; ++a)
#pragma unroll
            for (int b = 0; b < 2; ++b)
#pragma unroll
                for (int m = 0; m < 4; ++m)
#pragma unroll
                    for (int n = 0; n < 2; ++n) acc[a][b][m][n] = (f32x4){0.f, 0.f, 0.f, 0.f};
        cur = nxt; cA = nA; cB = nB; ++ui;
        if constexpr (ALIGN_EPI) { if (wr == 1) PG8_BAR; }
    }
    PG8_WAIT_V(0);
    if constexpr (!ALIGN_EPI) { if (wr == 0) PG8_BAR; }
    PG8_BAR;
    if constexpr (Epi::AFTER_DRAIN) { E.fused(acc, cur, wr, wc, fr, fq, lds, wid, lane); S.done(cur); }
#undef PG8_SA
#undef PG8_SB
#undef PG8_STAGE
#undef PG8_LDA
#undef PG8_LDB
#undef PG8_MMA
#undef PG8_WAIT_V
#undef PG8_WAIT_L
#undef PG8_BAR
#undef PG8_SCHED
}
}
namespace att {
typedef unsigned short bf16;
using bf16x8 = __attribute__((ext_vector_type(8))) short;
using s16x4  = __attribute__((ext_vector_type(4))) short;
using f32x16 = __attribute__((ext_vector_type(16))) float;
using u32x4  = __attribute__((ext_vector_type(4))) unsigned;
constexpr int NW = 8, QBLK = 32, KVBLK = 64, LDQ = 6144;
constexpr float SCALE = 0.125f;
constexpr float THR = 8.f;
constexpr int SHM_V = KVBLK * 128 * 2, SHM_K = KVBLK * 64 * 2;
constexpr int LDS_V = 0, LDS_K = 2 * SHM_V, LDS_WS = 2 * SHM_V + 2 * SHM_K, LDS_BYTES = LDS_WS + NW * 64 * 4;
#define KSWZ64(row, colB) ((row) * 128 + ((colB) ^ ((((row) >> 1) & 7) << 4)))
#define SBAR() __builtin_amdgcn_sched_barrier(0)
__device__ __forceinline__ int crow(int r, int hi) { return (r & 3) + 8 * (r >> 2) + 4 * hi; }
__device__ __forceinline__ unsigned cvtpk(float lo, float hi) { unsigned r; asm volatile("v_cvt_pk_bf16_f32 %0, %1, %2" : "=v"(r) : "v"(lo), "v"(hi)); return r; }

__device__ __forceinline__ void partialSM(f32x16& p0, f32x16& p1, float& m_reg, float& mn, float& alpha) {
  constexpr float C = SCALE * 1.4426950408889634f;
  float pmax = p0[0];
#pragma unroll
  for (int r = 1; r < 16; ++r) pmax = fmaxf(pmax, p0[r]);
#pragma unroll
  for (int r = 0; r < 16; ++r) pmax = fmaxf(pmax, p1[r]);
  { auto rr = __builtin_amdgcn_permlane32_swap(__float_as_uint(pmax), __float_as_uint(pmax), false, false);
    pmax = fmaxf(__uint_as_float(rr[0]), __uint_as_float(rr[1])); }
  if (__builtin_expect(__all(pmax - m_reg <= THR / SCALE), 1)) { mn = m_reg; alpha = 1.f; }
  else { mn = fmaxf(m_reg, pmax); alpha = __builtin_amdgcn_exp2f((m_reg - mn) * C); m_reg = mn; }
  float mnC = -mn * C;
#pragma unroll
  for (int r = 0; r < 16; ++r) p0[r] = fmaf(p0[r], C, mnC);
#pragma unroll
  for (int r = 0; r < 16; ++r) p1[r] = fmaf(p1[r], C, mnC);
#pragma unroll
  for (int r = 0; r < 16; ++r) p0[r] = __builtin_amdgcn_exp2f(p0[r]);
}
__device__ __forceinline__ void finishSM(f32x16& p0, f32x16& p1, float alpha, float& l_reg, bf16x8& pa0, bf16x8& pa1, bf16x8& pa2, bf16x8& pa3) {
#pragma unroll
  for (int r = 0; r < 16; ++r) p1[r] = __builtin_amdgcn_exp2f(p1[r]);
  float ps = 0;
#pragma unroll
  for (int r = 0; r < 16; ++r) ps += p0[r];
#pragma unroll
  for (int r = 0; r < 16; ++r) ps += p1[r];
  { auto rr = __builtin_amdgcn_permlane32_swap(__float_as_uint(ps), __float_as_uint(ps), false, false);
    ps = __uint_as_float(rr[0]) + __uint_as_float(rr[1]); }
  l_reg = l_reg * alpha + ps;
#define PK4(P, BASE, OUT) do { unsigned a0 = cvtpk(P[BASE + 0], P[BASE + 1]), a1 = cvtpk(P[BASE + 2], P[BASE + 3]);   \
    unsigned b0 = cvtpk(P[BASE + 4], P[BASE + 5]), b1 = cvtpk(P[BASE + 6], P[BASE + 7]);                              \
    auto r0 = __builtin_amdgcn_permlane32_swap(a0, b0, false, false); auto r1 = __builtin_amdgcn_permlane32_swap(a1, b1, false, false); \
    u32x4 w = {r0[0], r1[0], r0[1], r1[1]}; OUT = *reinterpret_cast<bf16x8*>(&w); } while (0)
  PK4(p0, 0, pa0); PK4(p0, 8, pa1); PK4(p1, 0, pa2); PK4(p1, 8, pa3);
#undef PK4
}
__device__ __forceinline__ void qkt(f32x16& p0, f32x16& p1, const char* Ks, const bf16x8* qr, int r32, int hi) {
  p0 = f32x16{}; p1 = f32x16{};
#pragma unroll
  for (int d0 = 0; d0 < 4; ++d0) { const int cb = (d0 * 16 + hi * 8) * 2;
    bf16x8 b0 = *reinterpret_cast<const bf16x8*>(Ks + KSWZ64(r32, cb));
    bf16x8 b1 = *reinterpret_cast<const bf16x8*>(Ks + KSWZ64(32 + r32, cb));
    p0 = __builtin_amdgcn_mfma_f32_32x32x16_bf16(b0, qr[d0], p0, 0, 0, 0);
    p1 = __builtin_amdgcn_mfma_f32_32x32x16_bf16(b1, qr[d0], p1, 0, 0, 0); }
}
__device__ __forceinline__ int v_st(int k, int c) { const int kk = (k & ~0xC) | ((k & 4) << 1) | ((k & 8) >> 1); return ((kk >> 3) * 4 + (c >> 5)) * 512 + ((kk & 7) * 32 + (c & 31)) * 2; }
__device__ __forceinline__ int v_rd_base(int lane) { return ((lane & 3) << 3) | (((lane >> 2) & 3) << 6) | (((lane >> 4) & 1) << 5) | (((lane >> 5) & 1) << 8); }
constexpr int v_rd_off(int d0, int ks, int half) { return d0 * 512 + ks * 4096 + half * 2048; }
template <int OFF> __device__ __forceinline__ s16x4 tr_read(int vb) {
  s16x4 r; asm volatile("ds_read_b64_tr_b16 %0, %1 offset:%2" : "=&v"(r) : "v"(vb), "i"(OFF) : "memory"); return r;
}
template <int D0> __device__ __forceinline__ void pv_one(f32x16& od, int vb, bf16x8 pa0, bf16x8 pa1, bf16x8 pa2, bf16x8 pa3) {
  const s16x4 l0 = tr_read<v_rd_off(D0, 0, 0)>(vb), h0 = tr_read<v_rd_off(D0, 0, 1)>(vb), l1 = tr_read<v_rd_off(D0, 1, 0)>(vb), h1 = tr_read<v_rd_off(D0, 1, 1)>(vb);
  const s16x4 l2 = tr_read<v_rd_off(D0, 2, 0)>(vb), h2 = tr_read<v_rd_off(D0, 2, 1)>(vb), l3 = tr_read<v_rd_off(D0, 3, 0)>(vb), h3 = tr_read<v_rd_off(D0, 3, 1)>(vb);
  asm volatile("s_waitcnt lgkmcnt(0)" ::: "memory"); SBAR();
#define PK(L, H) (bf16x8){L[0], L[1], L[2], L[3], H[0], H[1], H[2], H[3]}
  od = __builtin_amdgcn_mfma_f32_32x32x16_bf16(pa0, PK(l0, h0), od, 0, 0, 0);
  od = __builtin_amdgcn_mfma_f32_32x32x16_bf16(pa1, PK(l1, h1), od, 0, 0, 0);
  od = __builtin_amdgcn_mfma_f32_32x32x16_bf16(pa2, PK(l2, h2), od, 0, 0, 0);
  od = __builtin_amdgcn_mfma_f32_32x32x16_bf16(pa3, PK(l3, h3), od, 0, 0, 0);
#undef PK
}
__device__ __forceinline__ void pv_d0(f32x16* o, int vb, bf16x8 pa0, bf16x8 pa1, bf16x8 pa2, bf16x8 pa3) {
  pv_one<0>(o[0], vb, pa0, pa1, pa2, pa3); pv_one<1>(o[1], vb, pa0, pa1, pa2, pa3); pv_one<2>(o[2], vb, pa0, pa1, pa2, pa3); pv_one<3>(o[3], vb, pa0, pa1, pa2, pa3);
}

__device__ __forceinline__ bf16x8 bload(__amdgpu_buffer_rsrc_t rs, unsigned voff, unsigned soff) { return __builtin_bit_cast(bf16x8, __builtin_amdgcn_raw_buffer_load_b128(rs, voff, soff, 0)); }
__device__ __forceinline__ void attn_map_body(__amdgpu_buffer_rsrc_t rs, unsigned qo, unsigned ko, unsigned vo, int seq, char* lds, f32x16 (&o)[4], float& l_out) {
  const int tid = threadIdx.x, wid = tid >> 6, lane = tid & 63, r32 = lane & 31, hi = lane >> 5;
  char* V_lds = lds + LDS_V; char* K_lds = lds + LDS_K;
  float* ws = (float*)(lds + LDS_WS) + wid * 64; float* al_l = ws + 32;
  float m_reg = -1e30f, l_reg = 0; bf16x8 qr[4];
#pragma unroll
  for (int d = 0; d < 4; ++d) o[d] = f32x16{};
  const unsigned qvo = (unsigned)(((wid * QBLK + r32) * LDQ + hi * 8) * 2);
#pragma unroll
  for (int d0 = 0; d0 < 4; ++d0) qr[d0] = bload(rs, qvo + d0 * 32, qo);
  const int sr = tid >> 4, sc = (tid & 15) * 8, vst0 = v_st(sr, sc), vst1 = v_st(32 + sr, sc);
  const int kr = tid >> 3, kc = (tid & 7) * 8, kst = KSWZ64(kr, kc * 2);
  const int vb0 = (int)(uintptr_t)V_lds + v_rd_base(lane);
  struct { bf16x8 vs0, vs1, ks0; } sr_[2];
  const unsigned vvo = (unsigned)((sr * LDQ + sc) * 2), kvo = (unsigned)((kr * LDQ + kc) * 2);
#define SLOAD(i, k0) do { const unsigned so_ = (unsigned)(k0) * (LDQ * 2); sr_[i].vs0 = bload(rs, vvo, vo + so_); sr_[i].vs1 = bload(rs, vvo, vo + so_ + 32 * LDQ * 2); \
    sr_[i].ks0 = bload(rs, kvo, ko + so_); } while (0)
#define SWRITE(b, i) do { *(bf16x8*)(V_lds + (b) * SHM_V + vst0) = sr_[i].vs0; *(bf16x8*)(V_lds + (b) * SHM_V + vst1) = sr_[i].vs1; \
    *(bf16x8*)(K_lds + (b) * SHM_K + kst) = sr_[i].ks0; } while (0)
#define SWAIT() asm volatile("s_waitcnt vmcnt(3)" ::: "memory")
#define RESC(a) do { if (__any((a) < 1.f)) { if (hi == 0) al_l[r32] = (a); asm volatile("s_waitcnt lgkmcnt(0)" ::: "memory"); \
    _Pragma("unroll") for (int d = 0; d < 4; ++d) _Pragma("unroll") for (int r = 0; r < 16; ++r) o[d][r] *= al_l[crow(r, hi)]; } } while (0)
  f32x16 pA0, pA1, pB0, pB1; float mnA, mnB, alA, alB; bf16x8 pa0, pa1, pa2, pa3; const int NT = seq / KVBLK;
  constexpr int SE = 0, SO = 1;
  SLOAD(SE, 0); asm volatile("s_waitcnt vmcnt(0)" ::: "memory"); SWRITE(0, SE); __syncthreads();
  qkt(pA0, pA1, K_lds, qr, r32, hi); partialSM(pA0, pA1, m_reg, mnA, alA);
  SLOAD(SO, KVBLK); if (2 < NT) SLOAD(SE, 2 * KVBLK);
  SWAIT(); SWRITE(1, SO); __syncthreads();
  for (int j = 1; j + 1 < NT; j += 2) {
    SBAR(); qkt(pB0, pB1, K_lds + SHM_K, qr, r32, hi);
    finishSM(pA0, pA1, alA, l_reg, pa0, pa1, pa2, pa3); SBAR();
    SLOAD(SO, (j + 2) * KVBLK); SBAR();
    pv_d0(o, vb0, pa0, pa1, pa2, pa3); partialSM(pB0, pB1, m_reg, mnB, alB);
    __syncthreads(); SWAIT(); SWRITE(0, SE);
    RESC(alB); __syncthreads();
    SBAR(); qkt(pA0, pA1, K_lds, qr, r32, hi);
    finishSM(pB0, pB1, alB, l_reg, pa0, pa1, pa2, pa3); SBAR();
    if (j + 3 < NT) SLOAD(SE, (j + 3) * KVBLK); SBAR();
    pv_d0(o, vb0 + SHM_V, pa0, pa1, pa2, pa3); partialSM(pA0, pA1, m_reg, mnA, alA);
    __syncthreads(); SWAIT(); SWRITE(1, SO);
    RESC(alA); __syncthreads();
  }
  SBAR(); qkt(pB0, pB1, K_lds + SHM_K, qr, r32, hi);
  finishSM(pA0, pA1, alA, l_reg, pa0, pa1, pa2, pa3); SBAR();
  pv_d0(o, vb0, pa0, pa1, pa2, pa3); partialSM(pB0, pB1, m_reg, mnB, alB);
  __syncthreads(); RESC(alB);
  finishSM(pB0, pB1, alB, l_reg, pa0, pa1, pa2, pa3); SBAR();
  pv_d0(o, vb0 + SHM_V, pa0, pa1, pa2, pa3);
  l_out = l_reg;
#undef SLOAD
#undef SWRITE
#undef SWAIT
#undef RESC
}
#undef SBAR
}

#define GAS __attribute__((address_space(1)))
#define LAS __attribute__((address_space(3)))
typedef unsigned short bf16;
typedef unsigned v4u __attribute__((ext_vector_type(4)));
typedef float f32x4 __attribute__((ext_vector_type(4)));
typedef short bf16x8 __attribute__((ext_vector_type(8)));
typedef GAS unsigned gu32;
typedef GAS unsigned long long gu64;
#define RLX_AGENT __ATOMIC_RELAXED, __HIP_MEMORY_SCOPE_AGENT
#define LDS_WAIT() asm volatile("s_waitcnt lgkmcnt(0)" ::: "memory")
#define VM_WAIT() asm volatile("s_waitcnt vmcnt(0)" ::: "memory")
__device__ __forceinline__ unsigned long long rt() { return __builtin_amdgcn_s_memrealtime(); }
__device__ __forceinline__ unsigned f2bf(float f) { unsigned u = __builtin_bit_cast(unsigned, f); return (u + 0x7fffu + ((u >> 16) & 1u)) >> 16; }
__device__ __forceinline__ unsigned pk2(float lo, float hi) { return f2bf(lo) | (f2bf(hi) << 16); }
#define XB_TMO      128
#define XB_XCNT(j)  (256  + 64 * (j))
#define XB_XSUB(j)  (1280 + 64 * (j))
#define XB_XGEN(j)  (2304 + 64 * (j))
#define XB_TOP      3328
#define XB_TOPGEN   3392
#define XCD_BAR_WORDS 3456
#define XB_SPIN_CAP (1u << 18)

__device__ __forceinline__ unsigned xb_ld(unsigned* p)              { return __hip_atomic_load(p, __ATOMIC_RELAXED, __HIP_MEMORY_SCOPE_AGENT); }
__device__ __forceinline__ unsigned xb_add(unsigned* p, unsigned v) { return __hip_atomic_fetch_add(p, v, __ATOMIC_RELAXED, __HIP_MEMORY_SCOPE_AGENT); }
__device__ __forceinline__ unsigned xb_xcc_id() { return (unsigned)__builtin_amdgcn_s_getreg((3 << 11) | 20) & 0xFu; }
#define XB_SPIN(cond, bar) do { unsigned _sp = 0; while (cond) { __builtin_amdgcn_s_sleep(1); \
    if ((++_sp & 255u) == 0u) { if (xb_ld(&(bar)[XB_TMO])) break; if (_sp > XB_SPIN_CAP) { atomicAdd(&(bar)[XB_TMO], 1u); break; } } } } while (0)

struct XcdBarrier {
    unsigned* bar; unsigned x;
    volatile LAS unsigned* st;
};

__device__ __forceinline__ XcdBarrier xcd_barrier_post(unsigned* bar, volatile LAS unsigned* st) {
    XcdBarrier b; b.bar = bar; b.x = xb_xcc_id(); b.st = st;
    if (threadIdx.x == 0) (void)xb_add(&bar[XB_XCNT(b.x)], 1u);
    return b;
}
__device__ __forceinline__ void xcd_barrier_complete(unsigned* bar, unsigned x, unsigned& nloc, unsigned& nx) {
    const unsigned G = gridDim.x * gridDim.y * gridDim.z;
    unsigned sum, cnt, mine, sp = 0u;
    for (;;) {
        sum = 0u; cnt = 0u; mine = 0u;
#pragma unroll
        for (unsigned j = 0; j < 16; ++j) { const unsigned c = xb_ld(&bar[XB_XCNT(j)]); sum += c; cnt += (c > 0u) ? 1u : 0u; mine = (j == x) ? c : mine; }
        if (sum == G) break;
        __builtin_amdgcn_s_sleep(1);
        if ((++sp & 255u) == 0u) { if (xb_ld(&bar[XB_TMO])) break; if (sp > XB_SPIN_CAP) { atomicAdd(&bar[XB_TMO], 1u); break; } }
    }
    nloc = mine > 0u ? mine : 1u; nx = cnt > 0u ? cnt : 1u;
}

__device__ __forceinline__ void xcd_barrier(const XcdBarrier& b) {
    asm volatile("s_waitcnt vmcnt(0)" ::: "memory");
    __syncthreads();
    if (threadIdx.x == 0) {
        unsigned* bar = b.bar;
        __builtin_amdgcn_s_waitcnt(0);
        unsigned nloc = b.st[0], nx = b.st[1];
        if (nloc == 0u) { xcd_barrier_complete(bar, b.x, nloc, nx); b.st[0] = nloc; b.st[1] = nx; }
        const unsigned old = xb_add(&bar[XB_XSUB(b.x)], 1u);
        const unsigned gen = old / nloc;
        if (old + 1u == (gen + 1u) * nloc) {
            __builtin_amdgcn_fence(__ATOMIC_RELEASE, "agent");
            asm volatile("s_waitcnt vmcnt(0)" ::: "memory");
            const unsigned og = xb_add(&bar[XB_TOP], 1u);
            const unsigned tg = og / nx;
            if (og + 1u == (tg + 1u) * nx) xb_add(&bar[XB_TOPGEN], 1u);
            else XB_SPIN(xb_ld(&bar[XB_TOPGEN]) == tg, bar);
            __builtin_amdgcn_fence(__ATOMIC_ACQUIRE, "agent");
            xb_add(&bar[XB_XGEN(b.x)], 1u);
            asm volatile("s_waitcnt vmcnt(0)" ::: "memory");
        } else {
            XB_SPIN(xb_ld(&bar[XB_XGEN(b.x)]) == gen, bar);
            __builtin_amdgcn_fence(__ATOMIC_ACQUIRE, "agent");
            asm volatile("s_waitcnt vmcnt(0)" ::: "memory");
        }
    }
    __syncthreads();
}
constexpr int NWAVES = 8;
constexpr int TT = 24576, DM = 4096, DFF = 11008, NIN = 18432;
constexpr int NH = 16, AW = 2048, RW = 2048;
constexpr int NCHUNK = TT / 64;
constexpr float EPS = 1e-6f;
constexpr int NPHASE = 15;
#ifndef MK_PER_PHASE
#define MK_PER_PHASE 0
#endif

constexpr size_t MiB = 1u << 20;
constexpr size_t WS_CTL = 0, CTL_ZERO_BYTES = 1 * MiB;
constexpr size_t WS_ROPE = 1 * MiB;
constexpr size_t WS_RGW = 2 * MiB;
constexpr size_t WS_AGG = 4 * MiB;
constexpr size_t WS_CARRY = 16 * MiB;
constexpr size_t WS_ASCR = 22 * MiB;
constexpr size_t WS_WFI = 54 * MiB, WS_WFO = 226 * MiB;
constexpr size_t WS_WIN = 312 * MiB, WS_WA = 456 * MiB, WS_WR = 472 * MiB, WS_WO = 488 * MiB;
constexpr size_t WS_H = 520 * MiB;
constexpr size_t WS_BIG = 712 * MiB;
constexpr size_t WS_QKV = WS_BIG, WS_RXY = WS_BIG + 288 * MiB, WS_G = WS_BIG + 480 * MiB, WS_END = WS_BIG + 864 * MiB;
static_assert(WS_WFO + (size_t)DM * DFF * 2 <= WS_WIN && WS_WFI + (size_t)2 * DFF * DM * 2 <= WS_WFO && WS_WO + (size_t)DM * DM * 2 <= WS_H && WS_H + (size_t)TT * DM * 2 <= WS_BIG, "ws map");
static_assert(WS_QKV + (size_t)TT * 6144 * 2 <= WS_RXY && WS_RXY + (size_t)TT * 4096 * 2 <= WS_G && WS_G + (size_t)TT * 8192 * 2 <= WS_END && WS_BIG + (size_t)TT * DFF * 2 <= WS_END, "ws map 2");
constexpr int CW_BAR = 4096;

constexpr int RING_OFF = 0, RING_BYTES = 131072;
constexpr int LDSCTL_OFF = RING_BYTES, MISC_OFF = LDSCTL_OFF + 320;
constexpr int LDS_BYTES = 147456;

struct Frame {
    LAS unsigned char* lds;
    volatile LAS unsigned* MISC;
    int tid, lane, wave;
    int vcu, G;
};
__device__ __forceinline__ float wave_sum(float v) {
#pragma unroll
    for (int o = 1; o < 64; o <<= 1) v += __shfl_xor(v, o);
    return v;
}
__device__ __forceinline__ int seq_start(int row) { return row < 4096 ? 0 : (row < 8192 ? 4096 : 8192); }
__device__ __forceinline__ int seq_end(int row) { return row < 4096 ? 4096 : (row < 8192 ? 8192 : TT); }

__device__ __forceinline__ void transpose_item(const float* __restrict__ W, int K, int N, bf16* WT, int k0, int n0, int drow0, LAS float* scr, int lane) {
#pragma unroll
    for (int i = 0; i < 32; ++i) { const int kk = 2 * i + (lane >> 5); scr[kk * 33 + (lane & 31)] = W[(size_t)(k0 + kk) * N + n0 + (lane & 31)]; }
    LDS_WAIT(); asm volatile("" ::: "memory");
    const int c = lane & 7;
#pragma unroll
    for (int j = 0; j < 4; ++j) { const int n = (lane >> 3) + 8 * j; const LAS float* s = scr + (8 * c) * 33 + n;
        v4u o; o.x = pk2(s[0 * 33], s[1 * 33]); o.y = pk2(s[2 * 33], s[3 * 33]); o.z = pk2(s[4 * 33], s[5 * 33]); o.w = pk2(s[6 * 33], s[7 * 33]);
        *(GAS v4u*)(WT + (size_t)(drow0 + n) * K + k0 + 8 * c) = o; }
    LDS_WAIT(); asm volatile("" ::: "memory");
}
__device__ __forceinline__ int ffn_in_row(int n) { return n < DFF ? (n >> 7) * 256 + (n & 127) : ((n - DFF) >> 7) * 256 + 128 + ((n - DFF) & 127); }
__device__ __forceinline__ void transpose_matrix_item(const float* W, int K, int N, bf16* WT, int mode, LAS float* scr, int item, int lane) {
    const int nblk = N / 32, kb = item / nblk, nb = item % nblk, n0 = 32 * nb;
    transpose_item(W, K, N, WT, 64 * kb, n0, mode ? ffn_in_row(n0) : n0, scr, lane);
}
__device__ __forceinline__ void rms_row_to_bf16(const float* xrow, const float* g, bf16* orow, int lane) {
    const GAS f32x4* xr = (const GAS f32x4*)xrow + lane; const GAS f32x4* gr = (const GAS f32x4*)g + lane;
    f32x4 v[16]; float s = 0.f;
#pragma unroll
    for (int j = 0; j < 16; ++j) { v[j] = xr[64 * j]; s += (v[j].x * v[j].x + v[j].y * v[j].y) + (v[j].z * v[j].z + v[j].w * v[j].w); }
    const float rstd = 1.f / sqrtf(wave_sum(s) * (1.f / DM) + EPS);
    GAS unsigned long long* o8 = (GAS unsigned long long*)orow + lane;
#pragma unroll
    for (int j = 0; j < 16; ++j) { const f32x4 gg = gr[64 * j];
        o8[64 * j] = (unsigned long long)pk2(v[j].x * rstd * gg.x, v[j].y * rstd * gg.y) | ((unsigned long long)pk2(v[j].z * rstd * gg.z, v[j].w * rstd * gg.w) << 32); }
}
__device__ __forceinline__ void rms_row_f32_inplace(float* xrow, const float* g, int lane) {
    GAS f32x4* xr = (GAS f32x4*)xrow + lane; const GAS f32x4* gr = (const GAS f32x4*)g + lane;
    f32x4 v[16]; float s = 0.f;
#pragma unroll
    for (int j = 0; j < 16; ++j) { v[j] = xr[64 * j]; s += (v[j].x * v[j].x + v[j].y * v[j].y) + (v[j].z * v[j].z + v[j].w * v[j].w); }
    const float rstd = 1.f / sqrtf(wave_sum(s) * (1.f / DM) + EPS);
#pragma unroll
    for (int j = 0; j < 16; ++j) { const f32x4 gg = gr[64 * j]; xr[64 * j] = v[j] * rstd * gg; }
}
__device__ __forceinline__ void rms_phase(Frame& F, const float* xa, const float* xb, const float* g, bf16* H) {
    const int gw = F.vcu * NWAVES + F.wave, NGW = F.G * NWAVES;
    for (int m = gw; m < TT; m += NGW) { const float* xr = m < 8192 ? xa + (size_t)m * DM : xb + (size_t)(m - 8192) * DM; rms_row_to_bf16(xr, g, H + (size_t)m * DM, F.lane); }
}

constexpr int RL_XB = 0, RL_XF = 17408, RL_YB = 51200, RL_CW = 68608;
template <bool REV> __device__ __forceinline__ void rl_scan(const float (&a)[4][4], const float (&u)[4][4], float cin, float (&h)[4][4], float& Atot, float& Hfin, int lane) {
    const int fq = lane >> 4, fr = lane & 15;
    const int src1 = (REV ? lane + 16 : lane - 16) & 63, src2 = (REV ? lane + 32 : lane - 32) & 63, srct = REV ? fr : fr + 48;
    const bool v1 = REV ? fq <= 2 : fq >= 1, v2 = REV ? fq <= 1 : fq >= 2;
    float C = cin; Atot = 1.f;
#pragma unroll
    for (int mtt = 0; mtt < 4; ++mtt) { const int mt = REV ? 3 - mtt : mtt;
        float P[4], Hl[4];
        if (!REV) { P[0] = a[mt][0]; Hl[0] = u[mt][0];
#pragma unroll
            for (int i = 1; i < 4; ++i) { P[i] = a[mt][i] * P[i - 1]; Hl[i] = a[mt][i] * Hl[i - 1] + u[mt][i]; } }
        else { P[3] = a[mt][3]; Hl[3] = u[mt][3];
#pragma unroll
            for (int i = 2; i >= 0; --i) { P[i] = a[mt][i] * P[i + 1]; Hl[i] = a[mt][i] * Hl[i + 1] + u[mt][i]; } }
        float As = REV ? P[0] : P[3], Hs = REV ? Hl[0] : Hl[3];
        { const float Ap = __shfl(As, src1), Hp = __shfl(Hs, src1); if (v1) { Hs = As * Hp + Hs; As = As * Ap; } }
        { const float Ap = __shfl(As, src2), Hp = __shfl(Hs, src2); if (v2) { Hs = As * Hp + Hs; As = As * Ap; } }
        float Ae = __shfl(As, src1), He = __shfl(Hs, src1); if (!v1) { Ae = 1.f; He = 0.f; }
        const float At = __shfl(As, srct), Ht = __shfl(Hs, srct);
        const float E = Ae * C + He;
#pragma unroll
        for (int i = 0; i < 4; ++i) h[mt][i] = P[i] * E + Hl[i];
        C = At * C + Ht; Atot *= At; }
    Hfin = C;
}
__device__ __forceinline__ float gelu_tanh(float x) {
    const float z = 0.7978845608028654f * (x + 0.044715f * x * x * x);
    const float e = __builtin_amdgcn_exp2f(2.f * 1.4426950408889634f * z);
    const float th = 1.f - 2.f * __builtin_amdgcn_rcpf(e + 1.f);
    return 0.5f * x * (1.f + th);
}
template <bool FINAL>
__device__ __forceinline__ void rglru_phase(Frame& F, const bf16* RXY, const bf16* RGW, const float* conv_w, const float* conv_b, const float* rg_ba, const float* rg_bx,
                                            const float* rg_lambda, float* AGG, const float* CARRY, bf16* RR) {
    typedef short bf16x8 __attribute__((ext_vector_type(8)));
    const int tid = F.tid, lane = F.lane, w = F.wave, fr = lane & 15, fq = lane >> 4;
    const int n = F.vcu & 15, cl = 16 * w + fr, cg = n * 128 + cl;
    LAS unsigned char* L = F.lds + RING_OFF;
    LAS float* CW = (LAS float*)(L + RL_CW);
    for (int i = tid; i < 640; i += NWAVES * 64) CW[i] = i < 512 ? conv_w[(i >> 7) * RW + n * 128 + (i & 127)] : conv_b[n * 128 + (i - 512)];
    bf16x8 Bf[4][4]; float bias[4], sp[2];
#pragma unroll
    for (int g = 0; g < 4; ++g) {
#pragma unroll
        for (int ks = 0; ks < 4; ++ks) Bf[g][ks] = *(const bf16x8*)(RGW + ((size_t)(g * 16 + n) * 128 + cl) * 128 + 32 * ks + 8 * fq);
        bias[g] = (g & 1) ? rg_bx[((g >> 1) * 16 + n) * 128 + cl] : rg_ba[((g >> 1) * 16 + n) * 128 + cl]; }
#pragma unroll
    for (int d = 0; d < 2; ++d) sp[d] = log1pf(__expf(-rg_lambda[d * RW + cg]));
    __syncthreads();
    const int t = tid >> 3, c16 = (tid & 7) * 16;
    for (int ci = F.vcu >> 4; ci < NCHUNK; ci += F.G >> 4) {
        const int row0 = ci * 64, s0 = seq_start(row0), s1 = seq_end(row0);
        { float xa[16];
#pragma unroll
          for (int k = 0; k < 16; ++k) xa[k] = CW[512 + c16 + k];
#pragma unroll
          for (int j = 0; j < 4; ++j) { const int rr = row0 + t + j - 2;
              if (rr >= s0 && rr < s1) { const v4u* p = (const v4u*)(RXY + (size_t)rr * 4096 + n * 128 + c16); const v4u q0 = p[0], q1 = p[1];
                  const unsigned ww[8] = {q0.x, q0.y, q0.z, q0.w, q1.x, q1.y, q1.z, q1.w};
#pragma unroll
                  for (int k = 0; k < 8; ++k) { xa[2 * k] += CW[j * 128 + c16 + 2 * k] * pg8::bf_lo(ww[k]); xa[2 * k + 1] += CW[j * 128 + c16 + 2 * k + 1] * pg8::bf_hi(ww[k]); } } }
          LAS f32x4* xf = (LAS f32x4*)(L + RL_XF + t * 528 + c16 * 4);
#pragma unroll
          for (int k = 0; k < 4; ++k) xf[k] = (f32x4){xa[4 * k], xa[4 * k + 1], xa[4 * k + 2], xa[4 * k + 3]};
          LAS v4u* xb = (LAS v4u*)(L + RL_XB + t * 272 + c16 * 2);
          xb[0] = (v4u){pk2(xa[0], xa[1]), pk2(xa[2], xa[3]), pk2(xa[4], xa[5]), pk2(xa[6], xa[7])};
          xb[1] = (v4u){pk2(xa[8], xa[9]), pk2(xa[10], xa[11]), pk2(xa[12], xa[13]), pk2(xa[14], xa[15])};
          if (FINAL) { const v4u* p = (const v4u*)(RXY + (size_t)(row0 + t) * 4096 + 2048 + n * 128 + c16); LAS v4u* yb = (LAS v4u*)(L + RL_YB + t * 272 + c16 * 2); yb[0] = p[0]; yb[1] = p[1]; } }
        __syncthreads();
        float hsum[4][4];
#pragma unroll
        for (int d = 0; d < 2; ++d) {
            float a[4][4], u[4][4];
#pragma unroll
            for (int mt = 0; mt < 4; ++mt) {
                f32x4 ca = (f32x4){bias[2 * d], bias[2 * d], bias[2 * d], bias[2 * d]}, cx = (f32x4){bias[2 * d + 1], bias[2 * d + 1], bias[2 * d + 1], bias[2 * d + 1]};
#pragma unroll
                for (int ks = 0; ks < 4; ++ks) { const bf16x8 af = *(const LAS bf16x8*)(L + RL_XB + (16 * mt + fr) * 272 + (32 * ks + 8 * fq) * 2);
                    ca = __builtin_amdgcn_mfma_f32_16x16x32_bf16(af, Bf[2 * d][ks], ca, 0, 0, 0); cx = __builtin_amdgcn_mfma_f32_16x16x32_bf16(af, Bf[2 * d + 1][ks], cx, 0, 0, 0); }
#pragma unroll
                for (int i = 0; i < 4; ++i) { const float ra = pg8::sigm(ca[i]), ia = pg8::sigm(cx[i]); const float la = -8.f * ra * sp[d];
                    const float xv = *(const LAS float*)(L + RL_XF + (16 * mt + 4 * fq + i) * 528 + cl * 4);
                    a[mt][i] = __expf(la); u[mt][i] = sqrtf(-expm1f(2.f * la)) * (ia * xv); } }
            float h[4][4], Atot, Hfin;
            const float cin = FINAL ? CARRY[(size_t)(ci * 2 + d) * RW + cg] : 0.f;
            if (d == 0) rl_scan<false>(a, u, cin, h, Atot, Hfin, lane); else rl_scan<true>(a, u, cin, h, Atot, Hfin, lane);
            if (FINAL) {
#pragma unroll
                for (int mt = 0; mt < 4; ++mt)
#pragma unroll
                    for (int i = 0; i < 4; ++i) hsum[mt][i] = d == 0 ? h[mt][i] : hsum[mt][i] + h[mt][i]; }
            else if (fq == 0) { float2 ah; ah.x = Atot; ah.y = Hfin; *(float2*)(AGG + ((size_t)(ci * 2 + d) * RW + cg) * 2) = ah; }
        }
        if (FINAL) {
#pragma unroll
            for (int mt = 0; mt < 4; ++mt)
#pragma unroll
                for (int i = 0; i < 4; ++i) { LAS unsigned short* yp = (LAS unsigned short*)(L + RL_YB + (16 * mt + 4 * fq + i) * 272 + cl * 2);
                    const float y = __uint_as_float((unsigned)(*yp) << 16); *yp = (unsigned short)f2bf(hsum[mt][i] * gelu_tanh(y)); }
            __syncthreads();
            { const LAS v4u* yb = (const LAS v4u*)(L + RL_YB + t * 272 + c16 * 2); v4u* op = (v4u*)(RR + (size_t)(row0 + t) * RW + n * 128 + c16); op[0] = yb[0]; op[1] = yb[1]; }
        }
        __syncthreads();
    }
}
__device__ __forceinline__ void carry_phase(Frame& F, const float* AGG, float* CARRY) {
    const int gt = F.vcu * (NWAVES * 64) + F.tid;
    if (gt >= 3 * 2 * RW) return;
    const int s = gt / (2 * RW), d = (gt / RW) & 1, c = gt % RW;
    const int c0 = s == 0 ? 0 : (s == 1 ? 64 : 128), c1 = s == 0 ? 64 : (s == 1 ? 128 : NCHUNK);
    float carry = 0.f;
    for (int b = 0; b < c1 - c0; b += 8) {
        float2 ah[8];
#pragma unroll
        for (int k = 0; k < 8; ++k) { const int ch = d == 0 ? c0 + b + k : c1 - 1 - b - k; ah[k] = *(const float2*)(AGG + ((size_t)(ch * 2 + d) * RW + c) * 2); }
#pragma unroll
        for (int k = 0; k < 8; ++k) { const int ch = d == 0 ? c0 + b + k : c1 - 1 - b - k; CARRY[(size_t)(ch * 2 + d) * RW + c] = carry; carry = ah[k].x * carry + ah[k].y; }
    }
}

struct Args { const float* in[26]; float* out; unsigned char* ws; int ph_lo, ph_hi; };
__device__ __forceinline__ double rope_rev(int j) {
    return j == 0 ? 0.15915494309189535 : j == 1 ? 0.03086376340470123 : j == 2 ? 0.005985185712713705 : j == 3 ? 0.001160663641240061 :
           j == 4 ? 0.00022507907903927653 : j == 5 ? 4.364795279280289e-05 : j == 6 ? 8.464330808241401e-06 : 1.6414262627950345e-06;
}
__global__ void __launch_bounds__(NWAVES * 64, 2) mk_fwd(Args args) {
    extern __shared__ __attribute__((aligned(16))) unsigned char lds[];
    Frame F;
    F.lds = (LAS unsigned char*)lds;
    F.MISC = (volatile LAS unsigned*)(F.lds + MISC_OFF);
    F.tid = threadIdx.x; F.lane = F.tid & 63; F.wave = __builtin_amdgcn_readfirstlane(F.tid >> 6);
    F.G = gridDim.x; { const int bx = blockIdx.x; F.vcu = (F.G % 8 == 0) ? (bx % 8) * (F.G / 8) + bx / 8 : bx; }
    unsigned char* ws = args.ws;
    gu32* ctl = (gu32*)(ws + WS_CTL);
    const float* x_prompt = args.in[0]; const float* x_sample = args.in[1];
    const float* ffn1_norm = args.in[2]; const float* ffn1_w_in = args.in[3]; const float* ffn1_w_out = args.in[4];
    const float* mix_norm = args.in[5]; const float* w_in = args.in[6];
    const float* lq1 = args.in[7]; const float* lk1 = args.in[8]; const float* lq2 = args.in[9]; const float* lk2 = args.in[10];
    const float* subln_gain = args.in[11]; const float* conv_w = args.in[12]; const float* conv_b = args.in[13];
    const float* rg_wa = args.in[14]; const float* rg_ba = args.in[15]; const float* rg_wx = args.in[16]; const float* rg_bx = args.in[17]; const float* rg_lambda = args.in[18];
    const float* w_attn = args.in[19]; const float* w_rnn = args.in[20]; const float* w_out = args.in[21];
    const float* ffn2_norm = args.in[22]; const float* ffn2_w_in = args.in[23]; const float* ffn2_w_out = args.in[24]; const float* final_norm = args.in[25];
    float* out = args.out;
    float* ROPE = (float*)(ws + WS_ROPE); bf16* RGW = (bf16*)(ws + WS_RGW); float* AGG = (float*)(ws + WS_AGG); float* CARRY = (float*)(ws + WS_CARRY);
    bf16* WFI = (bf16*)(ws + WS_WFI); bf16* WFO = (bf16*)(ws + WS_WFO); bf16* WIN = (bf16*)(ws + WS_WIN); bf16* WA = (bf16*)(ws + WS_WA); bf16* WR = (bf16*)(ws + WS_WR); bf16* WO = (bf16*)(ws + WS_WO);
    bf16* H = (bf16*)(ws + WS_H); bf16* OB = H; bf16* RR = H + (size_t)TT * AW;
    bf16* MID = (bf16*)(ws + WS_BIG); bf16* QKV = (bf16*)(ws + WS_QKV); bf16* RXY = (bf16*)(ws + WS_RXY); bf16* GT = (bf16*)(ws + WS_G); bf16* MG = QKV;

    for (int u = F.tid; u < (LDS_BYTES - LDSCTL_OFF) / 4; u += NWAVES * 64) ((LAS unsigned*)(F.lds + LDSCTL_OFF))[u] = 0u;
    __syncthreads();
    XcdBarrier bar; bar.bar = (unsigned*)(ctl + CW_BAR); bar.x = 0; bar.st = nullptr;
    if (!MK_PER_PHASE) bar = xcd_barrier_post((unsigned*)(ctl + CW_BAR), F.MISC + 8);
#define GRID_BAR() do { xcd_barrier(bar); } while (0)
    const int lo = args.ph_lo, hi = args.ph_hi;
#ifndef PH_MASK
#define PH_MASK 0x7fff
#endif
#define IN(k) (((PH_MASK >> (k)) & 1) && lo <= (k) && (k) < hi)
#define BOTH(k) (IN(k) && IN((k) + 1))
    const int gw = F.vcu * NWAVES + F.wave, NGW = F.G * NWAVES;
    LAS float* scr = (LAS float*)(F.lds + RING_OFF + F.wave * 16384);

    if (IN(0)) {
        constexpr int I_FI = (DM / 64) * (2 * DFF / 32), I_FO = (DFF / 64) * (DM / 32), I_IN = (DM / 64) * (NIN / 32), I_A = (AW / 64) * (DM / 32), I_O = (DM / 64) * (DM / 32), I_RG = 512;
        constexpr int NITEMS = I_FI + I_FO + I_IN + 2 * I_A + I_O + I_RG;
        for (int it = gw; it < NITEMS; it += NGW) {
            int r = it;
            if (r < I_FI) { transpose_matrix_item(ffn1_w_in, DM, 2 * DFF, WFI, 1, scr, r, F.lane); continue; } r -= I_FI;
            if (r < I_FO) { transpose_matrix_item(ffn1_w_out, DFF, DM, WFO, 0, scr, r, F.lane); continue; } r -= I_FO;
            if (r < I_IN) { transpose_matrix_item(w_in, DM, NIN, WIN, 0, scr, r, F.lane); continue; } r -= I_IN;
            if (r < I_A) { transpose_matrix_item(w_attn, AW, DM, WA, 0, scr, r, F.lane); continue; } r -= I_A;
            if (r < I_A) { transpose_matrix_item(w_rnn, RW, DM, WR, 0, scr, r, F.lane); continue; } r -= I_A;
            if (r < I_O) { transpose_matrix_item(w_out, DM, DM, WO, 0, scr, r, F.lane); continue; } r -= I_O;
            { const int blk = r >> 3, sub = r & 7, gate = blk >> 5, b = blk & 31, dir = b >> 4, n = b & 15;
              const float* W = (gate ? rg_wx : rg_wa) + (size_t)b * 16384; bf16* WT = RGW + (size_t)((dir * 2 + gate) * 16 + n) * 16384;
              transpose_item(W, 128, 128, WT, 64 * (sub >> 2), 32 * (sub & 3), 32 * (sub & 3), scr, F.lane); }
        }
        for (int idx = gw * 64 + F.lane; idx < 16384 * 8; idx += NGW * 64) { const int pos = idx >> 3, j = idx & 7;
            double rev = (double)pos * rope_rev(j); rev -= __builtin_floor(rev); const float rf = (float)rev;
            float2 cs; cs.x = __builtin_amdgcn_cosf(rf); cs.y = __builtin_amdgcn_sinf(rf); *(float2*)(ROPE + 2 * (size_t)idx) = cs; }
        rms_phase(F, x_prompt, x_sample, ffn1_norm, H);
        if (BOTH(0)) GRID_BAR();
    }
    if (IN(1)) {
        pg8::Gemm g{H, WFI, TT, 2 * DFF, DM}; pg8::StaticOrder S; S.init(TT, 2 * DFF, F.G, (int)blockIdx.x);
        pg8::EpiSwiGLU E{MID, DFF};
        pg8::gemm_phase<pg8::EpiSwiGLU, pg8::StaticOrder, true, true>(F.lds + RING_OFF, g, S, E);
        if (BOTH(1)) GRID_BAR();
    }
    if (IN(2)) {
        pg8::Gemm g{MID, WFO, TT, DM, DFF}; pg8::StaticOrder S; S.init(TT, DM, F.G, (int)blockIdx.x);
        pg8::EpiResid E{x_prompt, x_sample, 8192, out, DM, 0.5f};
        pg8::gemm_phase<pg8::EpiResid, pg8::StaticOrder, true, true>(F.lds + RING_OFF, g, S, E);
        if (BOTH(2)) GRID_BAR();
    }
    if (IN(3)) {
        rms_phase(F, out, out + (size_t)8192 * DM, mix_norm, H);
        constexpr int I_FI = (DM / 64) * (2 * DFF / 32), I_FO = (DFF / 64) * (DM / 32);
        for (int it = gw; it < I_FI + I_FO; it += NGW) {
            if (it < I_FI) transpose_matrix_item(ffn2_w_in, DM, 2 * DFF, WFI, 1, scr, it, F.lane);
            else transpose_matrix_item(ffn2_w_out, DFF, DM, WFO, 0, scr, it - I_FI, F.lane);
        }
        if (BOTH(3)) GRID_BAR();
    }
    if (IN(4)) {
        pg8::Gemm g{H, WIN, TT, NIN, DM}; pg8::StaticOrder S; S.init(TT, NIN, F.G, (int)blockIdx.x);
        pg8::EpiProj E{QKV, RXY, GT, ROPE};
        pg8::gemm_phase<pg8::EpiProj, pg8::StaticOrder, true, true>(F.lds + RING_OFF, g, S, E);
        if (BOTH(4)) GRID_BAR();
    }
    if (IN(5)) {
        rglru_phase<false>(F, RXY, RGW, conv_w, conv_b, rg_ba, rg_bx, rg_lambda, AGG, CARRY, RR);
        if (BOTH(5)) GRID_BAR();
    }
    if (IN(6)) {
        carry_phase(F, AGG, CARRY);
        const float lam = __expf(wave_sum(lq1[F.lane] * lk1[F.lane])) - __expf(wave_sum(lq2[F.lane] * lk2[F.lane])) + 0.2f;
        const int lane = F.lane, r32 = lane & 31, hi = lane >> 5, wid = F.wave;
        char* alds = (char*)lds + RING_OFF;
        const __amdgpu_buffer_rsrc_t qkv_rs = __builtin_amdgcn_make_buffer_rsrc((void*)QKV, 0, (int)((size_t)TT * 6144 * 2), 0x00020000);
        float* li_l = (float*)(alds + att::LDS_WS) + wid * 64;
        for (int L = F.vcu; L < 1536; L += F.G) {
            int h, qb, row0, seqlen;
            if (L < 1024) { const int i = L >> 8, xcd = (L & 255) >> 5, loc = L & 31; h = 2 * xcd + (i >> 1); qb = 32 * (i & 1) + loc; row0 = 8192; seqlen = 16384; }
            else { const int Lp = L - 1024, j = Lp >> 8, xcd = (Lp & 255) >> 5, loc = Lp & 31, pair = 4 * xcd + 2 * j + (loc >> 4); qb = loc & 15; h = pair & 15; row0 = (pair >> 4) * 4096; seqlen = 4096; }
            for (int m = 0; m < 2; ++m) {
                const unsigned qo = (unsigned)(((row0 + qb * 256) * 6144 + h * 128 + m * 64) * 2);
                const unsigned ko = (unsigned)((row0 * 6144 + 2048 + h * 128 + m * 64) * 2);
                const unsigned vo = (unsigned)((row0 * 6144 + 4096 + h * 128) * 2);
                att::f32x16 o[4]; float l;
                att::attn_map_body(qkv_rs, qo, ko, vo, seqlen, alds, o, l);
                if (hi == 0) li_l[r32] = l;
                asm volatile("s_waitcnt lgkmcnt(0)" ::: "memory");
                float rli[16];
#pragma unroll
                for (int r = 0; r < 16; ++r) rli[r] = __builtin_amdgcn_rcpf(li_l[att::crow(r, hi)]);
                float* swl = (float*)(ws + WS_ASCR) + (size_t)blockIdx.x * (256 * 128) + (size_t)(wid * 32 + 4 * hi) * 128 + r32; asm volatile("" : "+v"(swl));
                if (m == 0) {
#pragma unroll
                    for (int r = 0; r < 16; ++r)
#pragma unroll
                        for (int d0 = 0; d0 < 4; ++d0) swl[((r & 3) + 8 * (r >> 2)) * 128 + d0 * 32] = o[d0][r] * rli[r];
                    asm volatile("s_waitcnt vmcnt(0)" ::: "memory");
                } else {
                    bf16* owl = OB + (size_t)(row0 + qb * 256 + wid * 32 + 4 * hi) * AW + h * 128 + r32; asm volatile("" : "+v"(owl));
                    float gain[4];
#pragma unroll
                    for (int d0 = 0; d0 < 4; ++d0) gain[d0] = subln_gain[d0 * 32 + r32] * 0.8f;
#pragma unroll
                    for (int r = 0; r < 16; ++r) { const int rb = (r & 3) + 8 * (r >> 2); float ss = 0.f; float v[4];
#pragma unroll
                        for (int d0 = 0; d0 < 4; ++d0) { v[d0] = swl[rb * 128 + d0 * 32] - lam * (o[d0][r] * rli[r]); ss += v[d0] * v[d0]; }
                        ss += __shfl_xor(ss, 1); ss += __shfl_xor(ss, 2); ss += __shfl_xor(ss, 4); ss += __shfl_xor(ss, 8); ss += __shfl_xor(ss, 16);
                        const float rs = 1.f / sqrtf(ss * (1.f / 128.f) + EPS);
#pragma unroll
                        for (int d0 = 0; d0 < 4; ++d0) owl[(size_t)rb * AW + d0 * 32] = (bf16)f2bf(v[d0] * rs * gain[d0]); }
                }
                __syncthreads();
            }
        }
        if (BOTH(6)) GRID_BAR();
    }
    if (IN(7)) {
        rglru_phase<true>(F, RXY, RGW, conv_w, conv_b, rg_ba, rg_bx, rg_lambda, AGG, CARRY, RR);
        if (BOTH(7)) GRID_BAR();
    }
    if (IN(8)) {
        pg8::Gemm g{OB, WA, TT, DM, AW}; pg8::StaticOrder S; S.init(TT, DM, F.G, (int)blockIdx.x);
        pg8::EpiGate<false> E{MG, GT, 0};
        pg8::gemm_phase<pg8::EpiGate<false>, pg8::StaticOrder, true, true>(F.lds + RING_OFF, g, S, E);
        if (BOTH(8)) GRID_BAR();
    }
    if (IN(9)) {
        pg8::Gemm g{RR, WR, TT, DM, RW}; pg8::StaticOrder S; S.init(TT, DM, F.G, (int)blockIdx.x);
        pg8::EpiGate<true> E{MG, GT, 4096};
        pg8::gemm_phase<pg8::EpiGate<true>, pg8::StaticOrder, true, true>(F.lds + RING_OFF, g, S, E);
        if (BOTH(9)) GRID_BAR();
    }
    if (IN(10)) {
        pg8::Gemm g{MG, WO, TT, DM, DM}; pg8::StaticOrder S; S.init(TT, DM, F.G, (int)blockIdx.x);
        pg8::EpiResid E{out, out, TT, out, DM, 1.0f};
        pg8::gemm_phase<pg8::EpiResid, pg8::StaticOrder, true, true>(F.lds + RING_OFF, g, S, E);
        if (BOTH(10)) GRID_BAR();
    }
    if (IN(11)) {
        rms_phase(F, out, out + (size_t)8192 * DM, ffn2_norm, H);
        if (BOTH(11)) GRID_BAR();
    }
    if (IN(12)) {
        pg8::Gemm g{H, WFI, TT, 2 * DFF, DM}; pg8::StaticOrder S; S.init(TT, 2 * DFF, F.G, (int)blockIdx.x);
        pg8::EpiSwiGLU E{MID, DFF};
        pg8::gemm_phase<pg8::EpiSwiGLU, pg8::StaticOrder, true, true>(F.lds + RING_OFF, g, S, E);
        if (BOTH(12)) GRID_BAR();
    }
    if (IN(13)) {
        pg8::Gemm g{MID, WFO, TT, DM, DFF}; pg8::StaticOrder S; S.init(TT, DM, F.G, (int)blockIdx.x);
        pg8::EpiResid E{out, out, TT, out, DM, 0.5f};
        pg8::gemm_phase<pg8::EpiResid, pg8::StaticOrder, true, true>(F.lds + RING_OFF, g, S, E);
        if (BOTH(13)) GRID_BAR();
    }
    if (IN(14)) {
        for (int m = gw; m < TT; m += NGW) rms_row_f32_inplace(out + (size_t)m * DM, final_norm, F.lane);
    }
#undef IN
#undef BOTH
#undef GRID_BAR
}

extern "C" void kernel_launch(void* const* d_in, const int* in_sizes, int n_in, void* d_out, int out_size, void* d_ws, size_t ws_size, hipStream_t stream) {
    static int grid = 0;
    if (grid == 0) {
        if (n_in != 26 || in_sizes[0] != 8192 * DM || in_sizes[1] != 16384 * DM || out_size != TT * DM || ws_size < WS_END) {
            fprintf(stderr, "kernel_launch: shape mismatch (n_in %d, out %d, ws %zu, need %zu); nothing launched\n", n_in, out_size, ws_size, (size_t)WS_END); grid = -1; return; }
        int dev = 0, cus = 0;
        if (hipGetDevice(&dev) != hipSuccess || hipDeviceGetAttribute(&cus, hipDeviceAttributeMultiprocessorCount, dev) != hipSuccess) { grid = -1; return; }
        if (hipFuncSetAttribute((const void*)mk_fwd, hipFuncAttributeMaxDynamicSharedMemorySize, LDS_BYTES) != hipSuccess) { fprintf(stderr, "kernel_launch: hipFuncSetAttribute failed\n"); grid = -1; return; }
        (void)hipGetLastError();
        grid = cus > 256 ? 256 : cus - (cus % 16);
        if (grid < 16) { grid = -1; return; }
    }
    if (grid < 0) return;
    if (hipMemsetAsync((char*)d_ws + WS_CTL, 0, CTL_ZERO_BYTES, stream) != hipSuccess) return;
    Args a{};
    for (int i = 0; i < 26; ++i) a.in[i] = (const float*)d_in[i];
    a.out = (float*)d_out; a.ws = (unsigned char*)d_ws;
#if MK_PER_PHASE
    for (int k = 0; k < NPHASE; ++k) { a.ph_lo = k; a.ph_hi = k + 1; hipLaunchKernelGGL(mk_fwd, dim3(grid), dim3(NWAVES * 64), LDS_BYTES, stream, a); }
#else
    a.ph_lo = 0; a.ph_hi = NPHASE;
    hipLaunchKernelGGL(mk_fwd, dim3(grid), dim3(NWAVES * 64), LDS_BYTES, stream, a);
#endif
    const hipError_t le = hipPeekAtLastError();
    if (le != hipSuccess) fprintf(stderr, "kernel_launch: launch failed: %s\n", hipGetErrorName(le));
}
```

```cpp
#include <hip/hip_runtime.h>
#include <hip/hip_bf16.h>
#include <cstdio>
#include <cstdint>
#include <cmath>
namespace pg8 {
#define PG8_LAS __attribute__((address_space(3)))
typedef unsigned short bf16_t;
typedef short bf16x8 __attribute__((ext_vector_type(8)));
typedef float f32x4 __attribute__((ext_vector_type(4)));
typedef unsigned u32x4 __attribute__((ext_vector_type(4)));
constexpr int BM = 256, BK = 64, HALF = 128, HTB = HALF * BK * 2  , STAGE_BYTES = 8 * HTB, NXCD = 8, WGM = 8;

__host__ __device__ __forceinline__ int lds_byte(int r, int c) { const int st = (r >> 4) * 2 + (c >> 5), rr = r & 15, cc = c & 31, ob = rr * 64 + cc * 2; return st * 1024 + (ob ^ (((ob >> 9) & 1) << 5)); }
__host__ __device__ __forceinline__ void stage_rc(int b, int& R, int& C) { const int st = b / 1024, sb = b % 1024, swz = sb ^ (((sb >> 9) & 1) << 5); R = (st >> 1) * 16 + swz / 64; C = (st & 1) * 32 + (swz % 64) / 2; }
__host__ __device__ __forceinline__ int perm32(int rho) { const int n = rho >> 4, i = rho & 15; return 8 * (i >> 2) + 4 * n + (i & 3); }
__host__ __device__ __forceinline__ int inv_perm32(int w) { return 16 * ((w >> 2) & 1) + 4 * (w >> 3) + (w & 3); }
__host__ __device__ __forceinline__ size_t blk_off(int row, int col, int KT) { return ((size_t)((row >> 8) * KT + (col >> 6)) * 2 + ((row >> 7) & 1)) * 16384 + (size_t)lds_byte(row & 127, col & 63); }
__host__ __device__ __forceinline__ size_t blk_off_b(int w, int col, int KT, bool perm) { const int w128 = w & 127, R = perm ? (w128 & ~31) + inv_perm32(w128 & 31) : w128;
    return ((size_t)((w >> 8) * KT + (col >> 6)) * 2 + ((w >> 7) & 1)) * 16384 + (size_t)lds_byte(R, col & 63); }

struct Unit { int pm, pn; };
struct Gemm { const bf16_t* A; const bf16_t* Bt; int M, N, K, lda, ldb; };

#ifndef SERPENTINE
#define SERPENTINE 1
#endif
struct StaticOrder {
    int rev = 0;
    int csplit = 0;
    int nM, nN, nwg, G, c, wgm, serp = SERPENTINE;
    __host__ __device__ void init(int M, int N, int G_, int c_, int wgm_ = WGM) { nM = M / BM; nN = N / BM; nwg = nM * nN; G = G_; c = c_; wgm = wgm_; }
    __host__ __device__ bool next(int i, Unit& u) const {
        const long L = (long)i * G + c; if (L >= nwg) return false;
        if (csplit && nwg % NXCD == 0 && nM % 16 == 0 && nN % 2 == 0) { const int xcd = (int)(L % NXCD), off = (int)(L / NXCD), cpg = nN / 2, rnd = off / (4 * cpg), in = off % (4 * cpg);
            u.pm = (xcd >> 1) * (nM / 4) + rnd * 4 + (in & 3); u.pn = (xcd & 1) * cpg + (in >> 2); if (rev) u.pm = nM - 1 - u.pm; return true; }
        int wgid = (int)L; { const int q = nwg / NXCD, r = nwg % NXCD, xcd = wgid % NXCD, off = wgid / NXCD; wgid = (xcd < r ? xcd * (q + 1) : r * (q + 1) + (xcd - r) * q) + off; }
        const int nig = wgm * nN, gid = wgid / nig, fm = gid * wgm, gsz = (nM - fm) < wgm ? (nM - fm) : wgm;
        u.pm = fm + ((wgid % nig) % gsz); u.pn = (wgid % nig) / gsz;
        if (serp && (nwg / NXCD) % nig == 0 && nwg % NXCD == 0 && (((wgid % (nwg / NXCD)) / nig) & 1)) u.pn = nN - 1 - u.pn;
        if (rev) u.pm = nM - 1 - u.pm;
        return true;
    }
    __device__ __forceinline__ void a_ready(const Unit&) const {}
    __device__ __forceinline__ void done(const Unit&) const {}
};

__device__ __forceinline__ unsigned cvt_pk_bf16(float lo, float hi) { unsigned r; asm volatile("v_cvt_pk_bf16_f32 %0, %1, %2" : "=v"(r) : "v"(lo), "v"(hi)); return r; }
typedef float f32x2 __attribute__((ext_vector_type(2)));
__device__ __forceinline__ float sigm(float x) { return __builtin_amdgcn_rcpf(1.f + __builtin_amdgcn_exp2f(-1.4426950408889634f * x)); }
__device__ __forceinline__ float bf_lo(unsigned w) { return __uint_as_float(w << 16); }
__device__ __forceinline__ float bf_hi(unsigned w) { return __uint_as_float(w & 0xffff0000u); }
#ifndef OUT_NT
#define OUT_NT 0
#endif
struct EpiSwiGLU {
    static constexpr bool PERM = true, AFTER_DRAIN = false;
    bf16_t* O; int KT; const float* rstd;
    __device__ __forceinline__ void operator()(const f32x4 (&acc)[2][2][4][2], const Unit& u, int wr, int wc, int fr, int fq) const {
        const int row0 = u.pm * BM + wr * 64 + fr, col0 = u.pn * HALF + wc * 32 + 8 * fq;
        float rs8[2][4];
#pragma unroll
        for (int ai = 0; ai < 2; ++ai)
#pragma unroll
            for (int m = 0; m < 4; ++m) rs8[ai][m] = rstd ? rstd[row0 + ai * HALF + m * 16] : 1.f;
        asm volatile("" ::: "memory");
#pragma unroll
        for (int ai = 0; ai < 2; ++ai)
#pragma unroll
            for (int m = 0; m < 4; ++m) {
                bf16_t* rowp = (bf16_t*)((unsigned char*)O + blk_off(row0 + ai * HALF + m * 16, col0, KT));
                float r[8]; const float rs = rs8[ai][m];
#pragma unroll
                for (int n = 0; n < 2; ++n)
#pragma unroll
                    for (int j = 0; j < 4; ++j) { const float g = acc[ai][0][m][n][j] * rs, up = acc[ai][1][m][n][j] * rs; r[4 * n + j] = g * sigm(g) * up; }
                u32x4 w; w.x = cvt_pk_bf16(r[0], r[1]); w.y = cvt_pk_bf16(r[2], r[3]); w.z = cvt_pk_bf16(r[4], r[5]); w.w = cvt_pk_bf16(r[6], r[7]);
                if (OUT_NT) __builtin_nontemporal_store(w, (u32x4*)rowp); else *(u32x4*)rowp = w;
            }
    }
};
template <bool RB16, bool OB16> struct EpiResidT {
#ifndef RESID_PERM
#define RESID_PERM 1
#endif
    static constexpr bool PERM = RESID_PERM != 0, AFTER_DRAIN = false;
    const void* res0; const void* res1; int split_row; void* out; int ldc; float alpha; float* ssq;
    __device__ __forceinline__ void operator()(const f32x4 (&acc)[2][2][4][2], const Unit& u, int wr, int wc, int fr, int fq) const {
        typedef unsigned u32x2v __attribute__((ext_vector_type(2)));
        const int rowt = u.pm * BM;
        const float* rbf = RB16 ? nullptr : (rowt < split_row ? (const float*)res0 + (size_t)rowt * ldc : (const float*)res1 + (size_t)(rowt - split_row) * ldc);
        float* obf = OB16 ? nullptr : (float*)out + (size_t)rowt * ldc;
#if RESID_PERM
        const int col0 = u.pn * BM + wc * 32 + 8 * fq;
#pragma unroll
        for (int ai = 0; ai < 2; ++ai) {
            f32x4 rv[4][2][2]; u32x4 rw[4][2];
#pragma unroll
            for (int m = 0; m < 4; ++m) { const int rl = ai * HALF + wr * 64 + m * 16 + fr; const size_t off = (size_t)rl * ldc + col0;
#pragma unroll
                for (int bj = 0; bj < 2; ++bj) {
                    if (RB16) rw[m][bj] = *(const u32x4*)((const unsigned char*)res0 + blk_off(rowt + rl, col0 + bj * HALF, 64));
                    else { rv[m][bj][0] = *(const f32x4*)(rbf + off + bj * HALF); rv[m][bj][1] = *(const f32x4*)(rbf + off + bj * HALF + 4); } } }
#pragma unroll
            for (int m = 0; m < 4; ++m) { const int rl = ai * HALF + wr * 64 + m * 16 + fr; const size_t off = (size_t)rl * ldc + col0; float sq = 0.f;
#pragma unroll
                for (int bj = 0; bj < 2; ++bj) {
                    if (RB16) { const u32x4 w = rw[m][bj]; rv[m][bj][0] = (f32x4){bf_lo(w.x), bf_hi(w.x), bf_lo(w.y), bf_hi(w.y)}; rv[m][bj][1] = (f32x4){bf_lo(w.z), bf_hi(w.z), bf_lo(w.w), bf_hi(w.w)}; }
                    const f32x4 v0 = rv[m][bj][0] + acc[ai][bj][m][0] * alpha, v1 = rv[m][bj][1] + acc[ai][bj][m][1] * alpha;
                    sq += ((v0[0] * v0[0] + v0[1] * v0[1]) + (v0[2] * v0[2] + v0[3] * v0[3])) + ((v1[0] * v1[0] + v1[1] * v1[1]) + (v1[2] * v1[2] + v1[3] * v1[3]));
                    if (OB16) { u32x4 w; w.x = cvt_pk_bf16(v0[0], v0[1]); w.y = cvt_pk_bf16(v0[2], v0[3]); w.z = cvt_pk_bf16(v1[0], v1[1]); w.w = cvt_pk_bf16(v1[2], v1[3]);
                        *(u32x4*)((unsigned char*)out + blk_off(rowt + rl, col0 + bj * HALF, 64)) = w; }
                    else { *(f32x4*)(obf + off + bj * HALF) = v0; *(f32x4*)(obf + off + bj * HALF + 4) = v1; } }
                if (ssq) { sq += __shfl_xor(sq, 16); sq += __shfl_xor(sq, 32); if (fq == 0) ssq[(size_t)(rowt + rl) * 64 + u.pn * 4 + wc] = sq; } }
            asm volatile("" ::: "memory"); }
#else
        const int col0 = u.pn * BM + wc * 32 + 4 * fq;
#pragma unroll
        for (int ai = 0; ai < 2; ++ai) {
            f32x4 rv[4][2][2];
#pragma unroll
            for (int m = 0; m < 4; ++m) { const int rl = ai * HALF + wr * 64 + m * 16 + fr; const size_t off = (size_t)rl * ldc + col0;
#pragma unroll
                for (int bj = 0; bj < 2; ++bj)
#pragma unroll
                    for (int n = 0; n < 2; ++n) {
                        if (RB16) { const u32x2v w = *(const u32x2v*)((const unsigned char*)res0 + blk_off(rowt + rl, col0 + bj * HALF + n * 16, 64)); rv[m][bj][n] = (f32x4){bf_lo(w.x), bf_hi(w.x), bf_lo(w.y), bf_hi(w.y)}; }
                        else rv[m][bj][n] = *(const f32x4*)(rbf + off + bj * HALF + n * 16); } }
#pragma unroll
            for (int m = 0; m < 4; ++m) { const int rl = ai * HALF + wr * 64 + m * 16 + fr; const size_t off = (size_t)rl * ldc + col0; float sq = 0.f;
#pragma unroll
                for (int bj = 0; bj < 2; ++bj)
#pragma unroll
                    for (int n = 0; n < 2; ++n) { const f32x4 val = rv[m][bj][n] + acc[ai][bj][m][n] * alpha;
                        sq += (val[0] * val[0] + val[1] * val[1]) + (val[2] * val[2] + val[3] * val[3]);
                        if (OB16) { u32x2v w; w.x = cvt_pk_bf16(val[0], val[1]); w.y = cvt_pk_bf16(val[2], val[3]); *(u32x2v*)((unsigned char*)out + blk_off(rowt + rl, col0 + bj * HALF + n * 16, 64)) = w; }
                        else *(f32x4*)(obf + off + bj * HALF + n * 16) = val; }
                if (ssq) { sq += __shfl_xor(sq, 16); sq += __shfl_xor(sq, 32); if (fq == 0) ssq[(size_t)(rowt + rl) * 64 + u.pn * 4 + wc] = sq; } }
            asm volatile("" ::: "memory"); }
#endif
    }
};
constexpr size_t QKV_KOFF = (size_t)24576 * 2048 * 2, QKV_VOFF = 2 * QKV_KOFF;
__host__ __device__ __forceinline__ int kimg(int r64, int d) { return r64 * 128 + ((d * 2) ^ (((r64 >> 1) & 7) << 4)); }
__host__ __device__ __forceinline__ int vimg(int k, int c) { const int kk = k;     return ((kk >> 3) * 4 + (c >> 5)) * 512 + ((kk & 7) * 32 + (c & 31)) * 2; }
struct EpiPlainBf16 {
    static constexpr bool PERM = false, AFTER_DRAIN = false;
    bf16_t* O; float alpha;
    __device__ __forceinline__ void operator()(const f32x4 (&acc)[2][2][4][2], const Unit& u, int wr, int wc, int fr, int fq) const {
        const int col0 = u.pn * BM + wc * 32 + 4 * fq;
#pragma unroll
        for (int ai = 0; ai < 2; ++ai)
#pragma unroll
            for (int m = 0; m < 4; ++m) { const size_t off = (size_t)(u.pm * BM + ai * HALF + wr * 64 + m * 16 + fr) * 4096 + col0;
#pragma unroll
                for (int bj = 0; bj < 2; ++bj)
#pragma unroll
                    for (int n = 0; n < 2; ++n) { const f32x4 v = acc[ai][bj][m][n] * alpha; unsigned long long w = (unsigned long long)cvt_pk_bf16(v[0], v[1]) | ((unsigned long long)cvt_pk_bf16(v[2], v[3]) << 32);
                        *(unsigned long long*)(O + off + bj * HALF + n * 16) = w; } }
    }
};
struct EpiProj {
    static constexpr bool PERM = true, AFTER_DRAIN = false;
    bf16_t* QKV; bf16_t* RXY; bf16_t* G; const float* rope; const float* rstd;
    __device__ __forceinline__ void operator()(const f32x4 (&acc)[2][2][4][2], const Unit& u, int wr, int wc, int fr, int fq) const {
        const int colt = u.pn * BM, rowt = u.pm * BM;
        bf16_t* base; int ldc, cb;
        if (colt < 6144) { base = QKV; ldc = 6144; cb = colt; } else if (colt < 10240) { base = RXY; ldc = 4096; cb = colt - 6144; } else { base = G; ldc = 8192; cb = colt - 10240; }
        const bool rot = (colt < 4096) && ((wc & 1) == 0);
        const int pos0 = rowt - (rowt < 4096 ? 0 : (rowt < 8192 ? 4096 : 8192));
        const int col0 = cb + wc * 32 + 8 * fq;
        const float sgn = fq == 0 ? -1.f : 1.f;
        const float qs = colt < 2048 ? 0.125f * 1.4426950408889634f : 1.f;
        float rs8[8];
#pragma unroll
        for (int it = 0; it < 8; ++it) rs8[it] = rstd[rowt + (it >> 2) * HALF + wr * 64 + (it & 3) * 16 + fr];
        asm volatile("" ::: "memory");
        if (rot) body<true>(acc, rs8, base, ldc, colt, rowt, pos0, col0, sgn, qs, wr, fr, fq);
        else body<false>(acc, rs8, base, ldc, colt, rowt, pos0, col0, sgn, qs, wr, fr, fq);
    }
    template <bool ROT>
    __device__ __forceinline__ void body(const f32x4 (&acc)[2][2][4][2], const float (&rs8)[8], bf16_t* base, int ldc, int colt, int rowt, int pos0, int col0, float sgn, float qs, int wr, int fr, int fq) const {
        f32x4 cs[2][4];
        if (ROT) { const f32x4* tp = (const f32x4*)(rope + (size_t)(pos0 + wr * 64 + fr) * 16);
#pragma unroll
            for (int q = 0; q < 4; ++q) cs[0][q] = tp[q]; }
#pragma unroll
        for (int it = 0; it < 8; ++it) { const int ai = it >> 2, m = it & 3;
                const int rl = ai * HALF + wr * 64 + m * 16 + fr;
                const int row = rowt + rl; const float rs = rs8[it];
                if (ROT && it + 1 < 8) { const int rn = ((it + 1) >> 2) * HALF + wr * 64 + ((it + 1) & 3) * 16 + fr; const f32x4* tp = (const f32x4*)(rope + (size_t)(pos0 + rn) * 16);
#pragma unroll
                    for (int q = 0; q < 4; ++q) cs[(it + 1) & 1][q] = tp[q];
                    asm volatile("" ::: "memory"); }
#pragma unroll
                for (int bj = 0; bj < 2; ++bj) {
                    f32x4 v0 = acc[ai][bj][m][0] * (qs * rs), v1 = acc[ai][bj][m][1] * (qs * rs);
                    if (ROT) { const f32x4 (&c)[4] = cs[it & 1];
                        f32x4 p0, p1;
#pragma unroll
                        for (int j = 0; j < 4; ++j) { p0[j] = __shfl_xor(v0[j], 16); p1[j] = __shfl_xor(v1[j], 16); }
                        if (fq < 2) {
                            v0[0] = v0[0] * c[0][0] + sgn * p0[0] * c[0][1]; v0[1] = v0[1] * c[0][2] + sgn * p0[1] * c[0][3];
                            v0[2] = v0[2] * c[1][0] + sgn * p0[2] * c[1][1]; v0[3] = v0[3] * c[1][2] + sgn * p0[3] * c[1][3];
                            v1[0] = v1[0] * c[2][0] + sgn * p1[0] * c[2][1]; v1[1] = v1[1] * c[2][2] + sgn * p1[1] * c[2][3];
                            v1[2] = v1[2] * c[3][0] + sgn * p1[2] * c[3][1]; v1[3] = v1[3] * c[3][2] + sgn * p1[3] * c[3][3];
                        }
                    }
                    u32x4 w; w.x = cvt_pk_bf16(v0[0], v0[1]); w.y = cvt_pk_bf16(v0[2], v0[3]); w.z = cvt_pk_bf16(v1[0], v1[1]); w.w = cvt_pk_bf16(v1[2], v1[3]);
                    const int col = col0 + bj * HALF;
                    unsigned char* dp;
                    if (colt >= 6144) dp = (unsigned char*)(base + (size_t)row * ldc + col);
                    else if (colt < 2048) dp = (unsigned char*)(QKV + (size_t)row * 2048 + col);
                    else if (colt < 4096) { const int c2 = col - 2048; dp = (unsigned char*)QKV + QKV_KOFF + (size_t)((((row >> 6) * 16 + (c2 >> 7)) * 2 + ((c2 >> 6) & 1))) * 8192 + kimg(row & 63, c2 & 63); }
                    else { const int c2 = col - 4096; dp = (unsigned char*)QKV + QKV_VOFF + (size_t)((row >> 6) * 16 + (c2 >> 7)) * 16384 + vimg(row & 63, c2 & 127); }
                    if (OUT_NT) __builtin_nontemporal_store(w, (u32x4*)dp); else *(u32x4*)dp = w;
                }
            }
    }
};
template <bool ADD> struct EpiGate {
    static constexpr bool PERM = true, AFTER_DRAIN = false;
    bf16_t* O; const bf16_t* Gt; int goff; int KT;
    __device__ __forceinline__ void operator()(const f32x4 (&acc)[2][2][4][2], const Unit& u, int wr, int wc, int fr, int fq) const {
        const int row0 = u.pm * BM + wr * 64 + fr, col0 = u.pn * BM + wc * 32 + 8 * fq;
#pragma unroll
        for (int ai = 0; ai < 2; ++ai) {
            u32x4 gv[4][2], ov[4][2];
#pragma unroll
            for (int m = 0; m < 4; ++m) { const size_t row = (size_t)(row0 + ai * HALF + m * 16);
#pragma unroll
                for (int bj = 0; bj < 2; ++bj) { gv[m][bj] = *(const u32x4*)(Gt + row * 8192 + goff + col0 + bj * HALF); if (ADD) ov[m][bj] = *(const u32x4*)((const unsigned char*)O + blk_off((int)row, col0 + bj * HALF, KT)); } }
            asm volatile("" ::: "memory");
#pragma unroll
            for (int m = 0; m < 4; ++m) { const size_t row = (size_t)(row0 + ai * HALF + m * 16);
#pragma unroll
                for (int bj = 0; bj < 2; ++bj) { const f32x4 a0 = acc[ai][bj][m][0], a1 = acc[ai][bj][m][1]; float r[8]; const u32x4 g = gv[m][bj];
                    r[0] = sigm(bf_lo(g.x)) * a0[0]; r[1] = sigm(bf_hi(g.x)) * a0[1]; r[2] = sigm(bf_lo(g.y)) * a0[2]; r[3] = sigm(bf_hi(g.y)) * a0[3];
                    r[4] = sigm(bf_lo(g.z)) * a1[0]; r[5] = sigm(bf_hi(g.z)) * a1[1]; r[6] = sigm(bf_lo(g.w)) * a1[2]; r[7] = sigm(bf_hi(g.w)) * a1[3];
                    if (ADD) { const u32x4 o = ov[m][bj]; r[0] += bf_lo(o.x); r[1] += bf_hi(o.x); r[2] += bf_lo(o.y); r[3] += bf_hi(o.y); r[4] += bf_lo(o.z); r[5] += bf_hi(o.z); r[6] += bf_lo(o.w); r[7] += bf_hi(o.w); }
                    u32x4 w; w.x = cvt_pk_bf16(r[0], r[1]); w.y = cvt_pk_bf16(r[2], r[3]); w.z = cvt_pk_bf16(r[4], r[5]); w.w = cvt_pk_bf16(r[6], r[7]);
                    *(u32x4*)((unsigned char*)O + blk_off((int)row, col0 + bj * HALF, KT)) = w; } }
            asm volatile("" ::: "memory"); }
    }
};

struct EpiGatePair {
    static constexpr bool PERM = true, AFTER_DRAIN = false;
    bf16_t* O; const bf16_t* Gt; int KT;
    __device__ __forceinline__ void operator()(const f32x4 (&acc)[2][2][4][2], const Unit& u, int wr, int wc, int fr, int fq) const {
        if (u.pm < 96) { EpiGate<false> e{O, Gt, 0, KT}; e(acc, u, wr, wc, fr, fq); }
        else { Unit v; v.pm = u.pm - 96; v.pn = u.pn - 16; EpiGate<true> e{O, Gt, 4096, KT}; e(acc, v, wr, wc, fr, fq); }
    }
};
struct PairOrder {
    StaticOrder S;
    __device__ __forceinline__ bool next(int i, Unit& u) const { if (!S.next(i >> 1, u)) return false; if (i & 1) { u.pm += 96; u.pn += 16; } return true; }
    __device__ __forceinline__ void a_ready(const Unit&) const {}
    __device__ __forceinline__ void done(const Unit&) const {}
};

template <class Epi, class Sched, bool ALIGN_EPI = false, bool SP2 = false>
__device__ __forceinline__ void gemm_phase(PG8_LAS unsigned char* lds, const Gemm g, const Sched& S, const Epi& E) {
    const int tid = threadIdx.x, wid = __builtin_amdgcn_readfirstlane(tid >> 6), lane = tid & 63, wr = wid >> 2, wc = wid & 3, fr = lane & 15, fq = lane >> 4;
    const int K = g.K, nt = K / BK;
    unsigned voffA[2], voffB[2];
#pragma unroll
    for (int i = 0; i < 2; ++i) { voffA[i] = (unsigned)(tid * 16 + i * 8192); voffB[i] = voffA[i]; }
    const size_t kstep = 32768;
    const size_t hstepA = 16384, hstepB = 16384;
    const size_t tstepA = (size_t)nt * 32768, tstepB = tstepA;
    const unsigned ldsw = (unsigned)wid * 1024u;
    const int aoff = lds_byte(wr * 64 + fr, fq * 8), boff = lds_byte(wc * 32 + fr, fq * 8);
#define PG8_SA(b, h) (((b) * 2 + (h)) * HTB)
#define PG8_SB(b, h) ((4 + (b) * 2 + (h)) * HTB)
#define PG8_STAGE(bufoff, gbase, voff) do { _Pragma("unroll") for (int _i = 0; _i < 2; ++_i) \
        __builtin_amdgcn_global_load_lds((const unsigned*)((const char*)(gbase) + (voff)[_i]), (PG8_LAS unsigned*)(lds + (bufoff) + ldsw + _i * 8192), 16, 0, 0); } while (0)
#ifndef GEMM_B_AUX
#define GEMM_B_AUX 0
#endif
#define PG8_STAGEB(bufoff, gbase, voff) do { _Pragma("unroll") for (int _i = 0; _i < 2; ++_i) \
        __builtin_amdgcn_global_load_lds((const unsigned*)((const char*)(gbase) + (voff)[_i]), (PG8_LAS unsigned*)(lds + (bufoff) + ldsw + _i * 8192), 16, 0, GEMM_B_AUX); } while (0)
#define PG8_LDA(dst, b, h) do { _Pragma("unroll") for (int m = 0; m < 4; ++m) _Pragma("unroll") for (int k = 0; k < 2; ++k) dst[m][k] = *(const PG8_LAS bf16x8*)(lds + PG8_SA(b, h) + aoff + m * 2048 + k * 1024); } while (0)
#define PG8_LDB(dst, b, h) do { _Pragma("unroll") for (int n = 0; n < 2; ++n) _Pragma("unroll") for (int k = 0; k < 2; ++k) dst[n][k] = *(const PG8_LAS bf16x8*)(lds + PG8_SB(b, h) + boff + n * 2048 + k * 1024); } while (0)
#define PG8_MMA(ai, bj, At, Bt) do { __builtin_amdgcn_s_setprio(1); _Pragma("unroll") for (int m = 0; m < 4; ++m) _Pragma("unroll") for (int n = 0; n < 2; ++n) _Pragma("unroll") for (int k = 0; k < 2; ++k) \
        acc[ai][bj][m][n] = __builtin_amdgcn_mfma_f32_16x16x32_bf16(Bt[n][k], At[m][k], acc[ai][bj][m][n], 0, 0, 0); __builtin_amdgcn_s_setprio(0); } while (0)
#define PG8_WAIT_V(n) asm volatile("s_waitcnt vmcnt(" #n ")" ::: "memory")
#define PG8_WAIT_L(n) asm volatile("s_waitcnt lgkmcnt(" #n ")" ::: "memory")
#define PG8_BAR __builtin_amdgcn_s_barrier()
#define PG8_SCHED __builtin_amdgcn_sched_barrier(0)
    Unit cur, nxt; int ui = 0;
    if (!S.next(0, cur)) return;
    f32x4 acc[2][2][4][2];
#pragma unroll
    for (int a = 0; a < 2; ++a)
#pragma unroll
        for (int b = 0; b < 2; ++b)
#pragma unroll
            for (int m = 0; m < 4; ++m)
#pragma unroll
                for (int n = 0; n < 2; ++n) acc[a][b][m][n] = (f32x4){0.f, 0.f, 0.f, 0.f};
    bf16x8 At[4][2], B0[2][2], B1[2][2];
    const char* cA = (const char*)g.A + (size_t)cur.pm * tstepA; const char* cB = (const char*)g.Bt + (size_t)cur.pn * tstepB;
    S.a_ready(cur);
    if constexpr (SP2) {
        PG8_STAGEB(PG8_SB(0, 0), cB, voffB); PG8_STAGEB(PG8_SB(0, 1), cB + hstepB, voffB); PG8_STAGE(PG8_SA(0, 0), cA, voffA); PG8_STAGE(PG8_SA(0, 1), cA + hstepA, voffA);
        if (wr == 1) PG8_BAR;
        PG8_WAIT_V(2); PG8_BAR;
        PG8_STAGEB(PG8_SB(1, 0), cB + kstep, voffB); PG8_STAGE(PG8_SA(1, 0), cA + kstep, voffA); PG8_STAGEB(PG8_SB(1, 1), cB + hstepB + kstep, voffB);
        PG8_WAIT_V(6); PG8_BAR;
    } else {
        PG8_STAGEB(PG8_SB(0, 0), cB, voffB); PG8_STAGE(PG8_SA(0, 0), cA, voffA); PG8_STAGEB(PG8_SB(0, 1), cB + hstepB, voffB); PG8_STAGE(PG8_SA(0, 1), cA + hstepA, voffA);
        if (wr == 1) PG8_BAR;
        PG8_WAIT_V(4); PG8_BAR;
        PG8_STAGEB(PG8_SB(1, 0), cB + kstep, voffB); PG8_STAGE(PG8_SA(1, 0), cA + kstep, voffA); PG8_STAGEB(PG8_SB(1, 1), cB + hstepB + kstep, voffB);
        PG8_WAIT_V(6); PG8_BAR;
    }
    for (;;) {
        const bool has_next = S.next(ui + 1, nxt);
        const char* nA = has_next ? (const char*)g.A + (size_t)nxt.pm * tstepA : cA; const char* nB = has_next ? (const char*)g.Bt + (size_t)nxt.pn * tstepB : cB;
        for (int t = 0; t < nt; t += 2) {
            const bool last = (t == nt - 2);
            const char* a1 = cA + (size_t)(t + 1) * kstep;
            const char* a2 = last ? nA : cA + (size_t)(t + 2) * kstep; const char* b2 = last ? nB : cB + (size_t)(t + 2) * kstep;
            const char* a3 = a2 + kstep; const char* b3 = b2 + kstep;
            if (last && has_next) S.a_ready(nxt);
            if constexpr (SP2) {
            PG8_LDB(B0, 0, 0); PG8_LDB(B1, 0, 1); PG8_SCHED; PG8_LDA(At, 0, 0); PG8_STAGE(PG8_SA(1, 1), a1 + hstepA, voffA);
            PG8_WAIT_V(8); PG8_WAIT_L(0); PG8_BAR; PG8_MMA(0, 0, At, B0); PG8_MMA(0, 1, At, B1); PG8_BAR; PG8_SCHED;
            PG8_LDA(At, 0, 1); PG8_STAGEB(PG8_SB(0, 0), b2, voffB); PG8_STAGEB(PG8_SB(0, 1), b2 + hstepB, voffB); PG8_STAGE(PG8_SA(0, 0), a2, voffA);
            PG8_WAIT_V(8); PG8_WAIT_L(0); PG8_BAR; PG8_MMA(1, 0, At, B0); PG8_MMA(1, 1, At, B1); PG8_BAR; PG8_SCHED;
            PG8_LDB(B0, 1, 0); PG8_LDB(B1, 1, 1); PG8_SCHED; PG8_LDA(At, 1, 0); PG8_STAGE(PG8_SA(0, 1), a2 + hstepA, voffA);
            PG8_WAIT_V(8); PG8_WAIT_L(0); PG8_BAR; PG8_MMA(0, 0, At, B0); PG8_MMA(0, 1, At, B1); PG8_BAR; PG8_SCHED;
            PG8_LDA(At, 1, 1); PG8_STAGEB(PG8_SB(1, 0), b3, voffB); PG8_STAGEB(PG8_SB(1, 1), b3 + hstepB, voffB); PG8_STAGE(PG8_SA(1, 0), a3, voffA);
            PG8_WAIT_V(8); PG8_WAIT_L(0); PG8_BAR; PG8_MMA(1, 0, At, B0); PG8_MMA(1, 1, At, B1); PG8_BAR; PG8_SCHED;
            } else {
            PG8_LDB(B0, 0, 0); PG8_SCHED; PG8_LDA(At, 0, 0); PG8_STAGE(PG8_SA(1, 1), a1 + hstepA, voffA);
            PG8_WAIT_L(8); PG8_BAR; PG8_WAIT_L(0); PG8_MMA(0, 0, At, B0); PG8_BAR; PG8_SCHED;
            PG8_LDB(B1, 0, 1); PG8_STAGEB(PG8_SB(0, 0), b2, voffB);
            PG8_BAR; PG8_WAIT_L(0); PG8_MMA(0, 1, At, B1); PG8_BAR;
            PG8_LDA(At, 0, 1); PG8_STAGE(PG8_SA(0, 0), a2, voffA);
            PG8_BAR; PG8_WAIT_L(0); PG8_MMA(1, 0, At, B0); PG8_BAR; PG8_SCHED;
            PG8_STAGEB(PG8_SB(0, 1), b2 + hstepB, voffB);
            PG8_WAIT_V(6); PG8_BAR; PG8_MMA(1, 1, At, B1); PG8_BAR;
            PG8_LDB(B0, 1, 0); PG8_SCHED; PG8_LDA(At, 1, 0); PG8_STAGE(PG8_SA(0, 1), a2 + hstepA, voffA);
            PG8_WAIT_L(8); PG8_BAR; PG8_WAIT_L(0); PG8_MMA(0, 0, At, B0); PG8_BAR; PG8_SCHED;
            PG8_LDB(B1, 1, 1); PG8_STAGEB(PG8_SB(1, 0), b3, voffB);
            PG8_BAR; PG8_WAIT_L(0); PG8_MMA(0, 1, At, B1); PG8_BAR;
            PG8_LDA(At, 1, 1); PG8_STAGE(PG8_SA(1, 0), a3, voffA);
            PG8_BAR; PG8_WAIT_L(0); PG8_MMA(1, 0, At, B0); PG8_BAR; PG8_SCHED;
            PG8_STAGEB(PG8_SB(1, 1), b3 + hstepB, voffB);
            PG8_WAIT_V(6); PG8_BAR; PG8_MMA(1, 1, At, B1); PG8_BAR;
            }
        }
        if constexpr (ALIGN_EPI) { if (wr == 0) PG8_BAR; }
        if constexpr (!Epi::AFTER_DRAIN) { E(acc, cur, wr, wc, fr, fq); S.done(cur); }
        if (!has_next) break;
#pragma unroll
        for (int a = 0; a < 2; ++a)
#pragma unroll
            for (int b = 0; b < 2; ++b)
#pragma unroll
                for (int m = 0; m < 4; ++m)
#pragma unroll
                    for (int n = 0; n < 2; ++n) acc[a][b][m][n] = (f32x4){0.f, 0.f, 0.f, 0.f};
        cur = nxt; cA = nA; cB = nB; ++ui;
        if constexpr (ALIGN_EPI) { if (wr == 1) PG8_BAR; }
    }
    PG8_WAIT_V(0);
    if constexpr (!ALIGN_EPI) { if (wr == 0) PG8_BAR; }
    PG8_BAR;
    if constexpr (Epi::AFTER_DRAIN) { E.fused(acc, cur, wr, wc, fr, fq, lds, wid, lane); S.done(cur); }
#undef PG8_SA
#undef PG8_SB
#undef PG8_STAGE
#undef PG8_STAGEB
#undef PG8_LDA
#undef PG8_LDB
#undef PG8_MMA
#undef PG8_WAIT_V
#undef PG8_WAIT_L
#undef PG8_BAR
#undef PG8_SCHED
}
}
#ifndef ATT_SETPRIO
#define ATT_SETPRIO 0
#endif
namespace att {
typedef unsigned short bf16;
using bf16x8 = __attribute__((ext_vector_type(8))) short;
using s16x4  = __attribute__((ext_vector_type(4))) short;
using f32x16 = __attribute__((ext_vector_type(16))) float;
using u32x4  = __attribute__((ext_vector_type(4))) unsigned;
constexpr int NW = 8, QBLK = 32, KVBLK = 64, LDQ = 6144;
constexpr float SCALE = 0.125f;
constexpr float THR = 8.f;
constexpr int SHM_V = KVBLK * 128 * 2, SHM_K = KVBLK * 64 * 2;
constexpr int LDS_K = 0, LDS_V = 3 * SHM_K, LDS_WS = 3 * SHM_K + 4 * SHM_V, LDS_BYTES = LDS_WS + NW * 64 * 4;
#define KSWZ64(row, colB) ((row) * 128 + ((colB) ^ ((((row) >> 1) & 7) << 4)))
#define SBAR() __builtin_amdgcn_sched_barrier(0)
__device__ __forceinline__ int crow(int r, int hi) { return (r & 3) + 8 * (r >> 2) + 4 * hi; }
__device__ __forceinline__ unsigned cvtpk(float lo, float hi) { unsigned r; asm volatile("v_cvt_pk_bf16_f32 %0, %1, %2" : "=v"(r) : "v"(lo), "v"(hi)); return r; }

template <bool FIRST>
__device__ __forceinline__ void partialSM(f32x16& p0, f32x16& p1, float& mhat, f32x16& negm, float& alpha) {
  constexpr float THRL = THR * 1.4426950408889634f;
  float pmax = p0[0];
#pragma unroll
  for (int r = 1; r < 16; ++r) pmax = fmaxf(pmax, p0[r]);
#pragma unroll
  for (int r = 0; r < 16; ++r) pmax = fmaxf(pmax, p1[r]);
  { auto rr = __builtin_amdgcn_permlane32_swap(__float_as_uint(pmax), __float_as_uint(pmax), false, false);
    pmax = fmaxf(__uint_as_float(rr[0]), __uint_as_float(rr[1])); }
  if (!FIRST && __builtin_expect(__all(pmax <= THRL), 1)) { alpha = 1.f; }
  else { const float dl = FIRST ? pmax : fmaxf(pmax, 0.f); mhat += dl; alpha = FIRST ? 1.f : __builtin_amdgcn_exp2f(-dl);
#pragma unroll
    for (int r = 0; r < 16; ++r) { p0[r] -= dl; p1[r] -= dl; }
#pragma unroll
    for (int r = 0; r < 16; ++r) negm[r] = -mhat; }
#pragma unroll
  for (int r = 0; r < 16; ++r) p0[r] = __builtin_amdgcn_exp2f(p0[r]);
}
__device__ __forceinline__ void finishSM(f32x16& p0, f32x16& p1, float alpha, float& l_reg, bf16x8& pa0, bf16x8& pa1, bf16x8& pa2, bf16x8& pa3) {
#pragma unroll
  for (int r = 0; r < 16; ++r) p1[r] = __builtin_amdgcn_exp2f(p1[r]);
  float ps = 0;
#pragma unroll
  for (int r = 0; r < 16; ++r) ps += p0[r];
#pragma unroll
  for (int r = 0; r < 16; ++r) ps += p1[r];
  { auto rr = __builtin_amdgcn_permlane32_swap(__float_as_uint(ps), __float_as_uint(ps), false, false);
    ps = __uint_as_float(rr[0]) + __uint_as_float(rr[1]); }
  l_reg = l_reg * alpha + ps;
#define PK8(P, BASE, OUT) do { u32x4 w = {cvtpk(P[BASE + 0], P[BASE + 1]), cvtpk(P[BASE + 2], P[BASE + 3]), cvtpk(P[BASE + 4], P[BASE + 5]), cvtpk(P[BASE + 6], P[BASE + 7])}; \
    OUT = *reinterpret_cast<bf16x8*>(&w); } while (0)
  PK8(p0, 0, pa0); PK8(p0, 8, pa1); PK8(p1, 0, pa2); PK8(p1, 8, pa3);
#undef PK8
}
__device__ __forceinline__ void qkt(f32x16& p0, f32x16& p1, const char* Ks, const bf16x8* qr, const f32x16& negm, int r32, int hi) {
#pragma unroll
  for (int d0 = 0; d0 < 4; ++d0) { const int cb = (d0 * 16 + hi * 8) * 2;
    bf16x8 b0 = *reinterpret_cast<const bf16x8*>(Ks + KSWZ64(r32, cb));
    bf16x8 b1 = *reinterpret_cast<const bf16x8*>(Ks + KSWZ64(32 + r32, cb));
    if (d0 == 0) { p0 = __builtin_amdgcn_mfma_f32_32x32x16_bf16(b0, qr[0], negm, 0, 0, 0); p1 = __builtin_amdgcn_mfma_f32_32x32x16_bf16(b1, qr[0], negm, 0, 0, 0); }
    else { p0 = __builtin_amdgcn_mfma_f32_32x32x16_bf16(b0, qr[d0], p0, 0, 0, 0); p1 = __builtin_amdgcn_mfma_f32_32x32x16_bf16(b1, qr[d0], p1, 0, 0, 0); } }
}
__device__ __forceinline__ int v_st(int k, int c) { const int kk = (k & ~0xC) | ((k & 4) << 1) | ((k & 8) >> 1); return ((kk >> 3) * 4 + (c >> 5)) * 512 + ((kk & 7) * 32 + (c & 31)) * 2; }
__device__ __forceinline__ int v_rd_base(int lane) { return ((lane & 3) << 3) | (((lane >> 2) & 3) << 6) | (((lane >> 4) & 1) << 5) | (((lane >> 5) & 1) << 8); }
constexpr int v_rd_off(int d0, int ks, int half) { return d0 * 512 + ks * 4096 + half * 2048; }
template <int OFF> __device__ __forceinline__ s16x4 tr_read(int vb) {
  s16x4 r; asm volatile("ds_read_b64_tr_b16 %0, %1 offset:%2" : "=&v"(r) : "v"(vb), "i"(OFF) : "memory"); return r;
}
template <int D0> __device__ __forceinline__ void pv_one(f32x16& od, int vb, bf16x8 pa0, bf16x8 pa1, bf16x8 pa2, bf16x8 pa3) {
  const s16x4 l0 = tr_read<v_rd_off(D0, 0, 0)>(vb), h0 = tr_read<v_rd_off(D0, 0, 1)>(vb), l1 = tr_read<v_rd_off(D0, 1, 0)>(vb), h1 = tr_read<v_rd_off(D0, 1, 1)>(vb);
  const s16x4 l2 = tr_read<v_rd_off(D0, 2, 0)>(vb), h2 = tr_read<v_rd_off(D0, 2, 1)>(vb), l3 = tr_read<v_rd_off(D0, 3, 0)>(vb), h3 = tr_read<v_rd_off(D0, 3, 1)>(vb);
  asm volatile("s_waitcnt lgkmcnt(0)" ::: "memory"); SBAR();
#define PK(L, H) (bf16x8){L[0], L[1], L[2], L[3], H[0], H[1], H[2], H[3]}
#if ATT_SETPRIO
  __builtin_amdgcn_s_setprio(1);
#endif
  od = __builtin_amdgcn_mfma_f32_32x32x16_bf16(pa0, PK(l0, h0), od, 0, 0, 0);
  od = __builtin_amdgcn_mfma_f32_32x32x16_bf16(pa1, PK(l1, h1), od, 0, 0, 0);
  od = __builtin_amdgcn_mfma_f32_32x32x16_bf16(pa2, PK(l2, h2), od, 0, 0, 0);
  od = __builtin_amdgcn_mfma_f32_32x32x16_bf16(pa3, PK(l3, h3), od, 0, 0, 0);
#if ATT_SETPRIO
  __builtin_amdgcn_s_setprio(0);
#endif
#undef PK
}
__device__ __forceinline__ void pv_d0(f32x16* o, int vb, bf16x8 pa0, bf16x8 pa1, bf16x8 pa2, bf16x8 pa3) {
  pv_one<0>(o[0], vb, pa0, pa1, pa2, pa3); pv_one<1>(o[1], vb, pa0, pa1, pa2, pa3); pv_one<2>(o[2], vb, pa0, pa1, pa2, pa3); pv_one<3>(o[3], vb, pa0, pa1, pa2, pa3);
}

__device__ __forceinline__ bf16x8 bload(__amdgpu_buffer_rsrc_t rs, unsigned voff, unsigned soff) { return __builtin_bit_cast(bf16x8, __builtin_amdgcn_raw_buffer_load_b128(rs, voff, soff, 0)); }
__device__ __forceinline__ void glds16s(const char* sbase, unsigned voff, unsigned lds_dst) { unsigned keep;
  asm volatile("s_mov_b32 %0, m0\n\ts_mov_b32 m0, %3\n\ts_nop 0\n\tglobal_load_lds_dwordx4 %1, %2\n\ts_mov_b32 m0, %0" : "=&s"(keep) : "v"(voff), "s"(sbase), "s"(lds_dst) : "memory"); }
#define WAIT_BAR(N) asm volatile("s_waitcnt vmcnt(" #N ") lgkmcnt(0)\n\ts_barrier" ::: "memory")
template <bool FAST>
__device__ __forceinline__ void attn_map_body(__amdgpu_buffer_rsrc_t rs, unsigned qo, const char* kbase, const char* vbase, int seq, char* lds, f32x16 (&o)[4], float& l_out) {
  const int tid = threadIdx.x, wid = __builtin_amdgcn_readfirstlane(tid >> 6), lane = tid & 63, r32 = lane & 31, hi = lane >> 5;
  char* V_lds = lds + LDS_V; char* K_lds = lds + LDS_K;
  float* ws = (float*)(lds + LDS_WS) + wid * 64; float* al_l = ws + 32;
  float mhat = 0.f, l_reg = 0; bf16x8 qr[4]; f32x16 negm = f32x16{};
#pragma unroll
  for (int d = 0; d < 4; ++d) o[d] = f32x16{};
  const unsigned qvo = (unsigned)(((wid * QBLK + r32) * 2048 + hi * 8) * 2);
#pragma unroll
  for (int d0 = 0; d0 < 4; ++d0) qr[d0] = bload(rs, qvo + d0 * 32, qo);
  const unsigned lds0 = (unsigned)(uintptr_t)lds;
  const unsigned kvo = (unsigned)(wid * 1024 + lane * 16);
  unsigned vvo[2];
#pragma unroll
  for (int i = 0; i < 2; ++i) vvo[i] = (unsigned)((wid + 8 * i) * 1024 + lane * 16);
  const unsigned kdst = lds0 + LDS_K + wid * 1024, vdst = lds0 + LDS_V + wid * 1024;
#define DMA_K(t, slot) glds16s(kbase + (size_t)(t) * 262144, kvo, (unsigned)__builtin_amdgcn_readfirstlane((int)(kdst + (slot) * SHM_K)))
#define DMA_V(t, slot) do { const char* vb_ = vbase + (size_t)(t) * 262144; const unsigned vd_ = (unsigned)__builtin_amdgcn_readfirstlane((int)(vdst + (slot) * SHM_V)); \
    glds16s(vb_, vvo[0], vd_); glds16s(vb_, vvo[1], vd_ + 8192); } while (0)
  const int vb0 = (int)(uintptr_t)V_lds + v_rd_base(lane);
#define RESC(a) do { if (__any((a) < 1.f)) { if (hi == 0) al_l[r32] = (a); asm volatile("s_waitcnt lgkmcnt(0)" ::: "memory"); \
    _Pragma("unroll") for (int d = 0; d < 4; ++d) _Pragma("unroll") for (int r = 0; r < 16; ++r) o[d][r] *= al_l[crow(r, hi)]; } } while (0)
  f32x16 pA0, pA1, pB0, pB1; float alA, alB; bf16x8 pa0, pa1, pa2, pa3; const int NT = seq / KVBLK;
  int k3 = 0;
#define K3NEXT() do { k3 = (k3 == 2) ? 0 : k3 + 1; } while (0)
#define SM_STEP(PX0, PX1, alX) do { if (FAST) { alX = 1.f; _Pragma("unroll") for (int r_ = 0; r_ < 16; ++r_) PX0[r_] = __builtin_amdgcn_exp2f(PX0[r_]); } \
    else { partialSM<false>(PX0, PX1, mhat, negm, alX); RESC(alX); } } while (0)
#define A_PART(PX0, PX1, PY0, PY1, alY, j, GK, GV, FIN) do { \
    if (GK) DMA_K((j) + 2, (k3 == 0 ? 2 : k3 - 1)); if (GV) DMA_V((j) + 1, ((j) + 1) & 3); \
    SBAR(); qkt(PX0, PX1, K_lds + k3 * SHM_K, qr, negm, r32, hi); \
    if (FIN) finishSM(PY0, PY1, alY, l_reg, pa0, pa1, pa2, pa3); SBAR(); } while (0)
#ifndef ATT_EXP_IN_PV
#define ATT_EXP_IN_PV 1
#endif
#define B_PART(PX0, PX1, alX, j) do { \
    if (FAST && ATT_EXP_IN_PV) { const int vb_ = vb0 + (((j) + 3) & 3) * SHM_V; alX = 1.f; \
        pv_one<0>(o[0], vb_, pa0, pa1, pa2, pa3); _Pragma("unroll") for (int r_ = 0; r_ < 4; ++r_) PX0[r_] = __builtin_amdgcn_exp2f(PX0[r_]); \
        pv_one<1>(o[1], vb_, pa0, pa1, pa2, pa3); _Pragma("unroll") for (int r_ = 4; r_ < 8; ++r_) PX0[r_] = __builtin_amdgcn_exp2f(PX0[r_]); \
        pv_one<2>(o[2], vb_, pa0, pa1, pa2, pa3); _Pragma("unroll") for (int r_ = 8; r_ < 12; ++r_) PX0[r_] = __builtin_amdgcn_exp2f(PX0[r_]); \
        pv_one<3>(o[3], vb_, pa0, pa1, pa2, pa3); _Pragma("unroll") for (int r_ = 12; r_ < 16; ++r_) PX0[r_] = __builtin_amdgcn_exp2f(PX0[r_]); } \
    else { pv_d0(o, vb0 + (((j) + 3) & 3) * SHM_V, pa0, pa1, pa2, pa3); SM_STEP(PX0, PX1, alX); } } while (0)
#ifndef ATT_LATE_SPLIT
#define ATT_LATE_SPLIT 0
#endif
#define B1_PART(j) do { const int vb_ = vb0 + (((j) + 3) & 3) * SHM_V; if (ATT_LATE_SPLIT) { pv_one<0>(o[0], vb_, pa0, pa1, pa2, pa3); pv_one<1>(o[1], vb_, pa0, pa1, pa2, pa3); } } while (0)
#define B2_PART(PX0, PX1, alX, j) do { const int vb_ = vb0 + (((j) + 3) & 3) * SHM_V; \
    if (ATT_LATE_SPLIT) { pv_one<2>(o[2], vb_, pa0, pa1, pa2, pa3); pv_one<3>(o[3], vb_, pa0, pa1, pa2, pa3); } else pv_d0(o, vb_, pa0, pa1, pa2, pa3); \
    SM_STEP(PX0, PX1, alX); } while (0)
  DMA_K(0, 0); DMA_V(0, 0); DMA_K(1, 1);
  WAIT_BAR(0);
  int j = 1;
  if (wid < 4) {
    A_PART(pA0, pA1, pB0, pB1, alB, 0, true, true, false); partialSM<true>(pA0, pA1, mhat, negm, alA); WAIT_BAR(3); K3NEXT();
    for (; j + 3 < NT; j += 2) {
      A_PART(pB0, pB1, pA0, pA1, alA, j, true, true, true); B_PART(pB0, pB1, alB, j); WAIT_BAR(3); K3NEXT();
      A_PART(pA0, pA1, pB0, pB1, alB, j + 1, true, true, true); B_PART(pA0, pA1, alA, j + 1); WAIT_BAR(3); K3NEXT();
    }
    A_PART(pB0, pB1, pA0, pA1, alA, j, true, true, true); B_PART(pB0, pB1, alB, j); WAIT_BAR(3); K3NEXT();
    A_PART(pA0, pA1, pB0, pB1, alB, j + 1, false, true, true); B_PART(pA0, pA1, alA, j + 1); WAIT_BAR(2); K3NEXT();
    A_PART(pB0, pB1, pA0, pA1, alA, j + 2, false, false, true); B_PART(pB0, pB1, alB, j + 2); WAIT_BAR(0); K3NEXT();
  } else {
    A_PART(pA0, pA1, pB0, pB1, alB, 0, true, true, false); WAIT_BAR(3); K3NEXT();
    partialSM<true>(pA0, pA1, mhat, negm, alA);
    for (; j + 3 < NT; j += 2) {
      A_PART(pB0, pB1, pA0, pA1, alA, j, true, true, true); B1_PART(j); WAIT_BAR(3); K3NEXT(); B2_PART(pB0, pB1, alB, j);
      A_PART(pA0, pA1, pB0, pB1, alB, j + 1, true, true, true); B1_PART(j + 1); WAIT_BAR(3); K3NEXT(); B2_PART(pA0, pA1, alA, j + 1);
    }
    A_PART(pB0, pB1, pA0, pA1, alA, j, true, true, true); B1_PART(j); WAIT_BAR(3); K3NEXT(); B2_PART(pB0, pB1, alB, j);
    A_PART(pA0, pA1, pB0, pB1, alB, j + 1, false, true, true); B1_PART(j + 1); WAIT_BAR(2); K3NEXT(); B2_PART(pA0, pA1, alA, j + 1);
    A_PART(pB0, pB1, pA0, pA1, alA, j + 2, false, false, true); B1_PART(j + 2); WAIT_BAR(0); K3NEXT(); B2_PART(pB0, pB1, alB, j + 2);
  }
  finishSM(pB0, pB1, alB, l_reg, pa0, pa1, pa2, pa3); SBAR();
  pv_d0(o, vb0 + ((NT - 1) & 3) * SHM_V, pa0, pa1, pa2, pa3);
  WAIT_BAR(0);
  l_out = l_reg;
#undef A_PART
#undef SM_STEP
#undef B_PART
#undef B1_PART
#undef B2_PART
#undef K3NEXT
#undef DMA_K
#undef DMA_V
#undef RESC
}
#undef WAIT_BAR
#undef SBAR
}

#define GAS __attribute__((address_space(1)))
#define LAS __attribute__((address_space(3)))
typedef unsigned short bf16;
typedef unsigned v4u __attribute__((ext_vector_type(4)));
typedef float f32x4 __attribute__((ext_vector_type(4)));
typedef short bf16x8 __attribute__((ext_vector_type(8)));
typedef GAS unsigned gu32;
typedef GAS unsigned long long gu64;
#define RLX_AGENT __ATOMIC_RELAXED, __HIP_MEMORY_SCOPE_AGENT
#define LDS_WAIT() asm volatile("s_waitcnt lgkmcnt(0)" ::: "memory")
#define VM_WAIT() asm volatile("s_waitcnt vmcnt(0)" ::: "memory")
__device__ __forceinline__ unsigned long long rt() { return __builtin_amdgcn_s_memrealtime(); }
__device__ __forceinline__ unsigned f2bf(float f) { unsigned u = __builtin_bit_cast(unsigned, f); return (u + 0x7fffu + ((u >> 16) & 1u)) >> 16; }
__device__ __forceinline__ unsigned pk2(float lo, float hi) { return f2bf(lo) | (f2bf(hi) << 16); }
#define XB_TMO      128
#define XB_XCNT(j)  (256  + 64 * (j))
#define XB_XSUB(j)  (1280 + 64 * (j))
#define XB_XGEN(j)  (2304 + 64 * (j))
#define XB_TOP      3328
#define XB_TOPGEN   3392
#define XCD_BAR_WORDS 3456
#define XB_SPIN_CAP (1u << 18)

__device__ __forceinline__ unsigned xb_ld(unsigned* p)              { return __hip_atomic_load(p, __ATOMIC_RELAXED, __HIP_MEMORY_SCOPE_AGENT); }
__device__ __forceinline__ unsigned xb_add(unsigned* p, unsigned v) { return __hip_atomic_fetch_add(p, v, __ATOMIC_RELAXED, __HIP_MEMORY_SCOPE_AGENT); }
__device__ __forceinline__ unsigned xb_xcc_id() { return (unsigned)__builtin_amdgcn_s_getreg((3 << 11) | 20) & 0xFu; }
#define XB_SPIN(cond, bar) do { unsigned _sp = 0; while (cond) { __builtin_amdgcn_s_sleep(1); \
    if ((++_sp & 255u) == 0u) { if (xb_ld(&(bar)[XB_TMO])) break; if (_sp > XB_SPIN_CAP) { atomicAdd(&(bar)[XB_TMO], 1u); break; } } } } while (0)

struct XcdBarrier {
    unsigned* bar; unsigned x;
    volatile LAS unsigned* st;
};

__device__ __forceinline__ XcdBarrier xcd_barrier_post(unsigned* bar, volatile LAS unsigned* st) {
    XcdBarrier b; b.bar = bar; b.x = xb_xcc_id(); b.st = st;
    if (threadIdx.x == 0) (void)xb_add(&bar[XB_XCNT(b.x)], 1u);
    return b;
}
__device__ __forceinline__ void xcd_barrier_complete(unsigned* bar, unsigned x, unsigned& nloc, unsigned& nx) {
    const unsigned G = gridDim.x * gridDim.y * gridDim.z;
    unsigned sum, cnt, mine, sp = 0u;
    for (;;) {
        sum = 0u; cnt = 0u; mine = 0u;
#pragma unroll
        for (unsigned j = 0; j < 16; ++j) { const unsigned c = xb_ld(&bar[XB_XCNT(j)]); sum += c; cnt += (c > 0u) ? 1u : 0u; mine = (j == x) ? c : mine; }
        if (sum == G) break;
        __builtin_amdgcn_s_sleep(1);
        if ((++sp & 255u) == 0u) { if (xb_ld(&bar[XB_TMO])) break; if (sp > XB_SPIN_CAP) { atomicAdd(&bar[XB_TMO], 1u); break; } }
    }
    nloc = mine > 0u ? mine : 1u; nx = cnt > 0u ? cnt : 1u;
}

__device__ __forceinline__ void xcd_barrier(const XcdBarrier& b) {
    asm volatile("s_waitcnt vmcnt(0)" ::: "memory");
    __syncthreads();
    if (threadIdx.x == 0) {
        unsigned* bar = b.bar;
        __builtin_amdgcn_s_waitcnt(0);
        unsigned nloc = b.st[0], nx = b.st[1];
        if (nloc == 0u) { xcd_barrier_complete(bar, b.x, nloc, nx); b.st[0] = nloc; b.st[1] = nx; }
        const unsigned old = xb_add(&bar[XB_XSUB(b.x)], 1u);
        const unsigned gen = old / nloc;
        if (old + 1u == (gen + 1u) * nloc) {
            __builtin_amdgcn_fence(__ATOMIC_RELEASE, "agent");
            asm volatile("s_waitcnt vmcnt(0)" ::: "memory");
            const unsigned og = xb_add(&bar[XB_TOP], 1u);
            const unsigned tg = og / nx;
            if (og + 1u == (tg + 1u) * nx) xb_add(&bar[XB_TOPGEN], 1u);
            else XB_SPIN(xb_ld(&bar[XB_TOPGEN]) == tg, bar);
            __builtin_amdgcn_fence(__ATOMIC_ACQUIRE, "agent");
            xb_add(&bar[XB_XGEN(b.x)], 1u);
            asm volatile("s_waitcnt vmcnt(0)" ::: "memory");
        } else {
            XB_SPIN(xb_ld(&bar[XB_XGEN(b.x)]) == gen, bar);
            __builtin_amdgcn_fence(__ATOMIC_ACQUIRE, "agent");
            asm volatile("s_waitcnt vmcnt(0)" ::: "memory");
        }
    }
    __syncthreads();
}
constexpr int NWAVES = 8;
constexpr int TT = 24576, DM = 4096, DFF = 11008, NIN = 18432;
constexpr int NH = 16, AW = 2048, RW = 2048;
constexpr int NCHUNK = TT / 64;
constexpr float EPS = 1e-6f;
constexpr int NPHASE = 15;
#ifndef MK_PER_PHASE
#define MK_PER_PHASE 0
#endif

constexpr size_t MiB = 1u << 20;
constexpr size_t WS_CTL = 0, CTL_ZERO_BYTES = 1 * MiB;
constexpr size_t WS_ROPE = 1 * MiB;
constexpr size_t WS_RGW = 2 * MiB;
constexpr size_t WS_AGG = 4 * MiB;
constexpr size_t WS_CARRY = 16 * MiB;
constexpr size_t WS_ASCR = 22 * MiB;
constexpr int PADE = 128, LDH = DM + PADE, LDMID = DFF + PADE, LDO = AW + PADE;
constexpr size_t WS_WFI = 54 * MiB, WS_WFO = 232 * MiB;
constexpr size_t WS_WIN = 319 * MiB, WS_WA = 468 * MiB, WS_WR = WS_WA + (size_t)DM * AW * 2  , WS_WO = 502 * MiB;
constexpr size_t WS_H = 535 * MiB;
constexpr size_t WS_RR = WS_H + (size_t)TT * AW * 2;
constexpr size_t WS_BIG = 739 * MiB;
constexpr size_t WS_QKV = WS_BIG, WS_RXY = WS_BIG + 288 * MiB, WS_G = WS_BIG + 480 * MiB, WS_XR = WS_BIG + 864 * MiB, WS_END = WS_XR + 192 * MiB;
static_assert(WS_WFI + (size_t)2 * DFF * LDH * 2 <= WS_WFO && WS_WFO + (size_t)DM * LDMID * 2 <= WS_WIN && WS_WIN + (size_t)NIN * LDH * 2 <= WS_WA && WS_WA + (size_t)DM * AW * 2 <= WS_WR &&
              WS_WR + (size_t)DM * RW * 2 <= WS_WO && WS_WO + (size_t)DM * LDH * 2 <= WS_H && WS_H + (size_t)TT * LDH * 2 <= WS_BIG && WS_H + (size_t)TT * AW * 2 <= WS_RR && WS_RR + (size_t)TT * RW * 2 <= WS_BIG, "ws map");
static_assert(WS_QKV + (size_t)TT * 6144 * 2 <= WS_RXY && WS_RXY + (size_t)TT * 4096 * 2 <= WS_G && WS_G + (size_t)TT * 8192 * 2 <= WS_END && WS_BIG + (size_t)TT * LDMID * 2 <= WS_END && (size_t)TT * LDH * 2 <= 288 * MiB, "ws map 2");
constexpr int CW_BAR = 4096;
constexpr size_t WS_SSQ = WS_ASCR;
constexpr size_t WS_RSTD = WS_CTL + 512 * 1024;

constexpr int RING_OFF = 0, RING_BYTES = 131072;
constexpr int LDSCTL_OFF = RING_BYTES, MISC_OFF = LDSCTL_OFF + 320;
constexpr int LDS_BYTES = 147456;

struct Frame {
    LAS unsigned char* lds;
    volatile LAS unsigned* MISC;
    int tid, lane, wave;
    int vcu, G;
};
__device__ __forceinline__ float wave_sum(float v) {
#pragma unroll
    for (int o = 1; o < 64; o <<= 1) v += __shfl_xor(v, o);
    return v;
}
__device__ __forceinline__ int seq_start(int row) { return row < 4096 ? 0 : (row < 8192 ? 4096 : 8192); }
__device__ __forceinline__ int seq_end(int row) { return row < 4096 ? 4096 : (row < 8192 ? 8192 : TT); }

struct TItem { const float* src; bf16* WT; const float* gk; int N, drow0, k0, KT, mode; };
__device__ __forceinline__ void titem_load(const TItem& d, float (&v)[32]) {
#pragma unroll
    for (int i = 0; i < 32; ++i) v[i] = d.src[(size_t)(2 * i) * d.N];
}
__device__ __forceinline__ void titem_finish(const TItem& d, const float (&v)[32], LAS float* scr, int lane) {
#pragma unroll
    for (int i = 0; i < 32; ++i) scr[(2 * i + (lane >> 5)) * 33 + (lane & 31)] = v[i];
    LDS_WAIT(); asm volatile("" ::: "memory");
    const int c = lane & 7;
    f32x4 g0 = (f32x4){1.f, 1.f, 1.f, 1.f}, g1 = g0;
    if (d.gk) { g0 = *(const GAS f32x4*)(d.gk + d.k0 + 8 * c); g1 = *(const GAS f32x4*)(d.gk + d.k0 + 8 * c + 4); }
#pragma unroll
    for (int j = 0; j < 4; ++j) { const int n = (lane >> 3) + 8 * j; const LAS float* s = scr + (8 * c) * 33 + n;
        v4u o; o.x = pk2(s[0 * 33] * g0.x, s[1 * 33] * g0.y); o.y = pk2(s[2 * 33] * g0.z, s[3 * 33] * g0.w); o.z = pk2(s[4 * 33] * g1.x, s[5 * 33] * g1.y); o.w = pk2(s[6 * 33] * g1.z, s[7 * 33] * g1.w);
        GAS v4u* dp = d.mode == 0 ? (GAS v4u*)(d.WT + (size_t)(d.drow0 + n) * d.KT + d.k0 + 8 * c)
                                  : (GAS v4u*)((unsigned char*)d.WT + pg8::blk_off_b(d.drow0 + n, d.k0 + 8 * c, d.KT, d.mode == 2));
        *dp = o; }
    LDS_WAIT(); asm volatile("" ::: "memory");
}
__device__ __forceinline__ int ffn_in_row(int n) { return n < DFF ? (n >> 7) * 256 + (n & 127) : ((n - DFF) >> 7) * 256 + 128 + ((n - DFF) & 127); }
__device__ __forceinline__ TItem titem_matrix(const float* W, int K, int N, bf16* WT, int KT, int mode, int ffn, int item, int lane, const float* gk = nullptr) {
    const int nblk = N / 32, kb = item / nblk, nb = item % nblk, n0 = 32 * nb, k0 = 64 * kb;
    TItem d; d.src = W + (size_t)(k0 + (lane >> 5)) * N + n0 + (lane & 31); d.WT = WT; d.gk = gk; d.N = N; d.drow0 = ffn ? ffn_in_row(n0) : n0; d.k0 = k0; d.KT = KT; d.mode = mode; return d;
}
__device__ __forceinline__ void rms_row_to_bf16(const float* xrow, const float* g, bf16* Hb, int m, int lane) {
    const GAS f32x4* xr = (const GAS f32x4*)xrow + lane; const GAS f32x4* gr = (const GAS f32x4*)g + lane;
    f32x4 v[16]; float s = 0.f;
#pragma unroll
    for (int j = 0; j < 16; ++j) { v[j] = xr[64 * j]; s += (v[j].x * v[j].x + v[j].y * v[j].y) + (v[j].z * v[j].z + v[j].w * v[j].w); }
    const float rstd = 1.f / sqrtf(wave_sum(s) * (1.f / DM) + EPS);
#pragma unroll
    for (int j = 0; j < 16; ++j) { const f32x4 gg = gr[64 * j];
        *(GAS unsigned long long*)((unsigned char*)Hb + pg8::blk_off(m, 4 * lane + 256 * j, DM / 64)) =
            (unsigned long long)pk2(v[j].x * rstd * gg.x, v[j].y * rstd * gg.y) | ((unsigned long long)pk2(v[j].z * rstd * gg.z, v[j].w * rstd * gg.w) << 32); }
}
__device__ __forceinline__ void rms_row_bf16_to_bf16(const bf16* xrow, const float* g, bf16* Hb, int m, int lane) {
    const GAS v4u* xr = (const GAS v4u*)xrow + lane;
    v4u v[8]; float s = 0.f;
#pragma unroll
    for (int j = 0; j < 8; ++j) { v[j] = xr[64 * j]; const unsigned w[4] = {v[j].x, v[j].y, v[j].z, v[j].w};
#pragma unroll
        for (int k = 0; k < 4; ++k) { const float a = pg8::bf_lo(w[k]), b = pg8::bf_hi(w[k]); s += a * a + b * b; } }
    const float rstd = 1.f / sqrtf(wave_sum(s) * (1.f / DM) + EPS);
#pragma unroll
    for (int j = 0; j < 8; ++j) { const int col = 8 * lane + 512 * j; const f32x4 g0 = *(const GAS f32x4*)(g + col), g1 = *(const GAS f32x4*)(g + col + 4);
        v4u o; o.x = pk2(pg8::bf_lo(v[j].x) * rstd * g0.x, pg8::bf_hi(v[j].x) * rstd * g0.y); o.y = pk2(pg8::bf_lo(v[j].y) * rstd * g0.z, pg8::bf_hi(v[j].y) * rstd * g0.w);
        o.z = pk2(pg8::bf_lo(v[j].z) * rstd * g1.x, pg8::bf_hi(v[j].z) * rstd * g1.y); o.w = pk2(pg8::bf_lo(v[j].w) * rstd * g1.z, pg8::bf_hi(v[j].w) * rstd * g1.w);
        *(GAS v4u*)((unsigned char*)Hb + pg8::blk_off(m, col, DM / 64)) = o; }
}
__device__ __forceinline__ void rms_row_f32_inplace(float* xrow, const float* g, int lane) {
    GAS f32x4* xr = (GAS f32x4*)xrow + lane; const GAS f32x4* gr = (const GAS f32x4*)g + lane;
    f32x4 v[16]; float s = 0.f;
#pragma unroll
    for (int j = 0; j < 16; ++j) { v[j] = xr[64 * j]; s += (v[j].x * v[j].x + v[j].y * v[j].y) + (v[j].z * v[j].z + v[j].w * v[j].w); }
    const float rstd = 1.f / sqrtf(wave_sum(s) * (1.f / DM) + EPS);
#pragma unroll
    for (int j = 0; j < 16; ++j) { const f32x4 gg = gr[64 * j]; xr[64 * j] = v[j] * rstd * gg; }
}
__device__ __forceinline__ int recent_first_row(int it) { const int pp = it >> 8, s = pp >> 5, idx = pp & 31; return ((12 * (idx >> 2) + 4 * (2 - s) + (idx & 3)) << 8) + (it & 255); }
__device__ __forceinline__ void rms_row_bf16_to_f32(const bf16* Xb, int m, const float* g, float* orow, int lane) {
    v4u v[8]; float s = 0.f;
#pragma unroll
    for (int j = 0; j < 8; ++j) { v[j] = *(const GAS v4u*)((const unsigned char*)Xb + pg8::blk_off(m, 8 * lane + 512 * j, DM / 64)); const unsigned w[4] = {v[j].x, v[j].y, v[j].z, v[j].w};
#pragma unroll
        for (int k = 0; k < 4; ++k) { const float a = pg8::bf_lo(w[k]), b = pg8::bf_hi(w[k]); s += a * a + b * b; } }
    const float rstd = 1.f / sqrtf(wave_sum(s) * (1.f / DM) + EPS);
#pragma unroll
    for (int j = 0; j < 8; ++j) { const int col = 8 * lane + 512 * j; const f32x4 g0 = *(const GAS f32x4*)(g + col), g1 = *(const GAS f32x4*)(g + col + 4);
        *(GAS f32x4*)(orow + col) = (f32x4){pg8::bf_lo(v[j].x) * rstd * g0.x, pg8::bf_hi(v[j].x) * rstd * g0.y, pg8::bf_lo(v[j].y) * rstd * g0.z, pg8::bf_hi(v[j].y) * rstd * g0.w};
        *(GAS f32x4*)(orow + col + 4) = (f32x4){pg8::bf_lo(v[j].z) * rstd * g1.x, pg8::bf_hi(v[j].z) * rstd * g1.y, pg8::bf_lo(v[j].w) * rstd * g1.z, pg8::bf_hi(v[j].w) * rstd * g1.w}; }
}
__device__ __forceinline__ void rstd_phase(Frame& F, const float* ssq, float* rstd) {
    for (int m = F.vcu * (NWAVES * 64) + F.tid; m < TT; m += F.G * NWAVES * 64) { const GAS f32x4* p = (const GAS f32x4*)(ssq + (size_t)m * 64); float s = 0.f;
#pragma unroll
        for (int j = 0; j < 16; ++j) { const f32x4 v = p[j]; s += (v.x + v.y) + (v.z + v.w); }
        rstd[m] = 1.f / sqrtf(s * (1.f / DM) + EPS); }
}
__device__ __forceinline__ void rms_phase(Frame& F, const float* xa, const float* xb, const float* g, bf16* H) {
    const int gw = F.vcu * NWAVES + F.wave, NGW = F.G * NWAVES;
    for (int it = gw; it < TT; it += NGW) { const int m = recent_first_row(it); const float* xr = m < 8192 ? xa + (size_t)m * DM : xb + (size_t)(m - 8192) * DM; rms_row_to_bf16(xr, g, H, m, F.lane); }
}

constexpr int RL_XB = 0, RL_XF = 17408, RL_CW = 51200, RL_RAW = 53760, RL_RAWB = 33792;
static_assert(RL_RAW + 2 * RL_RAWB <= RING_BYTES, "rglru LDS");
template <bool REV> __device__ __forceinline__ void rl_scan(const float (&a)[4][4], const float (&u)[4][4], float cin, float (&h)[4][4], float& Atot, float& Hfin, int lane) {
    const int fq = lane >> 4, fr = lane & 15;
    const int src1 = (REV ? lane + 16 : lane - 16) & 63, src2 = (REV ? lane + 32 : lane - 32) & 63, srct = REV ? fr : fr + 48;
    const bool v1 = REV ? fq <= 2 : fq >= 1, v2 = REV ? fq <= 1 : fq >= 2;
    float C = cin; Atot = 1.f;
#pragma unroll
    for (int mtt = 0; mtt < 4; ++mtt) { const int mt = REV ? 3 - mtt : mtt;
        float P[4], Hl[4];
        if (!REV) { P[0] = a[mt][0]; Hl[0] = u[mt][0];
#pragma unroll
            for (int i = 1; i < 4; ++i) { P[i] = a[mt][i] * P[i - 1]; Hl[i] = a[mt][i] * Hl[i - 1] + u[mt][i]; } }
        else { P[3] = a[mt][3]; Hl[3] = u[mt][3];
#pragma unroll
            for (int i = 2; i >= 0; --i) { P[i] = a[mt][i] * P[i + 1]; Hl[i] = a[mt][i] * Hl[i + 1] + u[mt][i]; } }
        float As = REV ? P[0] : P[3], Hs = REV ? Hl[0] : Hl[3];
        { const float Ap = __shfl(As, src1), Hp = __shfl(Hs, src1); if (v1) { Hs = As * Hp + Hs; As = As * Ap; } }
        { const float Ap = __shfl(As, src2), Hp = __shfl(Hs, src2); if (v2) { Hs = As * Hp + Hs; As = As * Ap; } }
        float Ae = __shfl(As, src1), He = __shfl(Hs, src1); if (!v1) { Ae = 1.f; He = 0.f; }
        const float At = __shfl(As, srct), Ht = __shfl(Hs, srct);
        const float E = Ae * C + He;
#pragma unroll
        for (int i = 0; i < 4; ++i) h[mt][i] = P[i] * E + Hl[i];
        C = At * C + Ht; Atot *= At; }
    Hfin = C;
}
__device__ __forceinline__ float gelu_tanh(float x) {
    const float z = 0.7978845608028654f * (x + 0.044715f * x * x * x);
    const float e = __builtin_amdgcn_exp2f(2.f * 1.4426950408889634f * z);
    const float th = 1.f - 2.f * __builtin_amdgcn_rcpf(e + 1.f);
    return 0.5f * x * (1.f + th);
}
__device__ __forceinline__ void rl_glds16(const void* gsrc, unsigned lds_dst) { unsigned keep;
    asm volatile("s_mov_b32 %0, m0\n\ts_mov_b32 m0, %2\n\ts_nop 0\n\tglobal_load_lds_dwordx4 %1, off\n\ts_mov_b32 m0, %0" : "=&s"(keep) : "v"(gsrc), "s"(lds_dst) : "memory"); }
template <bool FINAL>
__device__ __forceinline__ void rglru_phase(Frame& F, const bf16* RXY, const bf16* RGW, const float* conv_w, const float* conv_b, const float* rg_ba, const float* rg_bx,
                                            const float* rg_lambda, float* AGG, const float* CARRY, bf16* RR) {
    typedef short bf16x8 __attribute__((ext_vector_type(8)));
    const int tid = F.tid, lane = F.lane, w = F.wave, fr = lane & 15, fq = lane >> 4;
    const int n = F.vcu & 15, cl = 16 * w + fr, cg = n * 128 + cl;
    LAS unsigned char* L = F.lds + RING_OFF;
    LAS float* CW = (LAS float*)(L + RL_CW);
    for (int i = tid; i < 640; i += NWAVES * 64) CW[i] = i < 512 ? conv_w[(i >> 7) * RW + n * 128 + (i & 127)] : conv_b[n * 128 + (i - 512)];
    bf16x8 Bf[4][4]; float bias[4], sp[2];
#pragma unroll
    for (int g = 0; g < 4; ++g) {
#pragma unroll
        for (int ks = 0; ks < 4; ++ks) Bf[g][ks] = *(const bf16x8*)(RGW + ((size_t)(g * 16 + n) * 128 + cl) * 128 + 32 * ks + 8 * fq);
        bias[g] = (g & 1) ? rg_bx[((g >> 1) * 16 + n) * 128 + cl] : rg_ba[((g >> 1) * 16 + n) * 128 + cl]; }
#pragma unroll
    for (int d = 0; d < 2; ++d) sp[d] = log1pf(__expf(-rg_lambda[d * RW + cg]));
    __syncthreads();
    const int t = tid >> 3, c16 = (tid & 7) * 16;
    float k1[2];
#pragma unroll
    for (int d = 0; d < 2; ++d) k1[d] = -8.f * 1.4426950408889634f * sp[d];
#ifndef RL_PASSES
#define RL_PASSES 1
#endif
    const int cstep = F.G >> 4, cfirst = F.vcu >> 4;
#define RL_DMA(ci_, buf_) do { const int row0_ = (ci_) * 64, s0_ = seq_start(row0_), s1_ = seq_end(row0_); \
        _Pragma("unroll") for (int k_ = 0; k_ < (FINAL ? 5 : 3); ++k_) { int q_ = w + NWAVES * k_; q_ = q_ < (FINAL ? 33 : 17) ? q_ : (FINAL ? 32 : 16);     \
            const int lr_ = 4 * (q_ < 17 ? q_ : q_ - 17) + (lane >> 4); int gr_ = q_ < 17 ? row0_ - 2 + lr_ : row0_ + lr_; gr_ = gr_ < s0_ ? s0_ : (gr_ >= s1_ ? s1_ - 1 : gr_); \
            const bf16* gp_ = RXY + (size_t)gr_ * 4096 + (q_ < 17 ? 0 : 2048) + n * 128 + (lane & 15) * 8; \
            rl_glds16(gp_, (unsigned)__builtin_amdgcn_readfirstlane((int)(lds0 + RL_RAW + (buf_) * RL_RAWB + q_ * 1024))); } } while (0)
    const unsigned lds0 = (unsigned)(uintptr_t)L;
    {
#define RL_WRAP(x) ((x) >= NCHUNK ? (x) - NCHUNK : (x))
    float cnx[2] = {0.f, 0.f};
    if (cfirst < NCHUNK) { RL_DMA(cfirst, 0); if (FINAL) { cnx[0] = CARRY[(size_t)(cfirst * 2 + 0) * RW + cg]; cnx[1] = CARRY[(size_t)(cfirst * 2 + 1) * RW + cg]; } }
    int buf = 0;
    for (int cl_ = cfirst; cl_ < NCHUNK * RL_PASSES; cl_ += cstep, buf ^= 1) { const int ci = RL_WRAP(cl_);
        const int row0 = ci * 64, s0 = seq_start(row0), s1 = seq_end(row0);
        LAS unsigned char* RAW = L + RL_RAW + buf * RL_RAWB; LAS unsigned char* YR = RAW + 68 * 256;
        asm volatile("s_waitcnt vmcnt(0) lgkmcnt(0)" ::: "memory"); __builtin_amdgcn_s_barrier(); asm volatile("" ::: "memory");
        const float cin2[2] = {cnx[0], cnx[1]};
        if (cl_ + cstep < NCHUNK * RL_PASSES) { const int cn = RL_WRAP(cl_ + cstep); RL_DMA(cn, buf ^ 1);
            if (FINAL) { cnx[0] = CARRY[(size_t)(cn * 2 + 0) * RW + cg]; cnx[1] = CARRY[(size_t)(cn * 2 + 1) * RW + cg]; } }
        { float xa[16];
#pragma unroll
          for (int k = 0; k < 16; ++k) xa[k] = CW[512 + c16 + k];
#pragma unroll
          for (int j = 0; j < 4; ++j) { const int rr = row0 + t + j - 2; const float msk = (rr >= s0 && rr < s1) ? 1.f : 0.f;
              const LAS v4u* rp = (const LAS v4u*)(RAW + (t + j) * 256 + c16 * 2); const v4u q0 = rp[0], q1 = rp[1];
              const unsigned ww[8] = {q0.x, q0.y, q0.z, q0.w, q1.x, q1.y, q1.z, q1.w};
#pragma unroll
              for (int k = 0; k < 8; ++k) { xa[2 * k] += CW[j * 128 + c16 + 2 * k] * (msk * pg8::bf_lo(ww[k])); xa[2 * k + 1] += CW[j * 128 + c16 + 2 * k + 1] * (msk * pg8::bf_hi(ww[k])); } }
          LAS f32x4* xf = (LAS f32x4*)(L + RL_XF + t * 528 + c16 * 4);
#pragma unroll
          for (int k = 0; k < 4; ++k) xf[k] = (f32x4){xa[4 * k], xa[4 * k + 1], xa[4 * k + 2], xa[4 * k + 3]};
          LAS v4u* xb = (LAS v4u*)(L + RL_XB + t * 272 + c16 * 2);
          xb[0] = (v4u){pk2(xa[0], xa[1]), pk2(xa[2], xa[3]), pk2(xa[4], xa[5]), pk2(xa[6], xa[7])};
          xb[1] = (v4u){pk2(xa[8], xa[9]), pk2(xa[10], xa[11]), pk2(xa[12], xa[13]), pk2(xa[14], xa[15])}; }
        asm volatile("s_waitcnt lgkmcnt(0)" ::: "memory"); __builtin_amdgcn_s_barrier(); asm volatile("" ::: "memory");
        float hsum[4][4];
#pragma unroll
        for (int d = 0; d < 2; ++d) {
            float a[4][4], u[4][4];
#pragma unroll
            for (int mt = 0; mt < 4; ++mt) {
                f32x4 ca = (f32x4){bias[2 * d], bias[2 * d], bias[2 * d], bias[2 * d]}, cx = (f32x4){bias[2 * d + 1], bias[2 * d + 1], bias[2 * d + 1], bias[2 * d + 1]};
#pragma unroll
                for (int ks = 0; ks < 4; ++ks) { const bf16x8 af = *(const LAS bf16x8*)(L + RL_XB + (16 * mt + fr) * 272 + (32 * ks + 8 * fq) * 2);
                    ca = __builtin_amdgcn_mfma_f32_16x16x32_bf16(af, Bf[2 * d][ks], ca, 0, 0, 0); cx = __builtin_amdgcn_mfma_f32_16x16x32_bf16(af, Bf[2 * d + 1][ks], cx, 0, 0, 0); }
#pragma unroll
                for (int i = 0; i < 4; ++i) { const float ra = pg8::sigm(ca[i]), ia = pg8::sigm(cx[i]);
                    const float xv = *(const LAS float*)(L + RL_XF + (16 * mt + 4 * fq + i) * 528 + cl * 4);
                    const float av = __builtin_amdgcn_exp2f(k1[d] * ra);
                    a[mt][i] = av; u[mt][i] = __builtin_amdgcn_sqrtf(fmaxf(fmaf(-av, av, 1.f), 0.f)) * (ia * xv); } }
            float h[4][4], Atot, Hfin;
            const float cin = cin2[d];
            if (d == 0) rl_scan<false>(a, u, cin, h, Atot, Hfin, lane); else rl_scan<true>(a, u, cin, h, Atot, Hfin, lane);
            if (FINAL) {
#pragma unroll
                for (int mt = 0; mt < 4; ++mt)
#pragma unroll
                    for (int i = 0; i < 4; ++i) hsum[mt][i] = d == 0 ? h[mt][i] : hsum[mt][i] + h[mt][i]; }
            else if (fq == 0) { float2 ah; ah.x = Atot; ah.y = Hfin; *(float2*)(AGG + ((size_t)(ci * 2 + d) * RW + cg) * 2) = ah; }
        }
        if (FINAL) {
#pragma unroll
            for (int mt = 0; mt < 4; ++mt)
#pragma unroll
                for (int i = 0; i < 4; ++i) { LAS unsigned short* yp = (LAS unsigned short*)(YR + (16 * mt + 4 * fq + i) * 256 + cl * 2);
                    const float y = __uint_as_float((unsigned)(*yp) << 16); *yp = (unsigned short)f2bf(hsum[mt][i] * gelu_tanh(y)); }
            asm volatile("s_waitcnt lgkmcnt(0)" ::: "memory"); __builtin_amdgcn_s_barrier(); asm volatile("" ::: "memory");
            { const LAS v4u* yb = (const LAS v4u*)(YR + t * 256 + c16 * 2); const v4u o0 = yb[0], o1 = yb[1]; *(v4u*)((unsigned char*)RR + pg8::blk_off(row0 + t, n * 128 + c16, RW / 64)) = o0; *(v4u*)((unsigned char*)RR + pg8::blk_off(row0 + t, n * 128 + c16 + 8, RW / 64)) = o1; }
        }
    }
    asm volatile("s_waitcnt vmcnt(0) lgkmcnt(0)" ::: "memory"); __builtin_amdgcn_s_barrier(); asm volatile("" ::: "memory"); }
#undef RL_DMA
#undef RL_WRAP
}
__device__ __forceinline__ void carry_phase(Frame& F, const float* AGG, float* CARRY) {
    const int gt = F.vcu * (NWAVES * 64) + F.tid;
    if (gt >= 3 * 2 * RW) return;
    const int s = gt / (2 * RW), d = (gt / RW) & 1, c = gt % RW;
    const int c0 = s == 0 ? 0 : (s == 1 ? 64 : 128), c1 = s == 0 ? 64 : (s == 1 ? 128 : NCHUNK);
    float carry = 0.f;
    for (int b = 0; b < c1 - c0; b += 32) {
        float2 ah[32];
#pragma unroll
        for (int k = 0; k < 32; ++k) { const int ch = d == 0 ? c0 + b + k : c1 - 1 - b - k; ah[k] = *(const float2*)(AGG + ((size_t)(ch * 2 + d) * RW + c) * 2); }
#pragma unroll
        for (int k = 0; k < 32; ++k) { const int ch = d == 0 ? c0 + b + k : c1 - 1 - b - k; CARRY[(size_t)(ch * 2 + d) * RW + c] = carry; carry = ah[k].x * carry + ah[k].y; }
    }
}

#ifndef ATT_FORCE_SLOW
#define ATT_FORCE_SLOW 0
#endif
#ifndef GEMM_SP2
#define GEMM_SP2 true
#endif
#ifndef ALL_WGM
#define ALL_WGM 4
#endif
#ifndef GEMM_REV
#define GEMM_REV 0xB
#endif
#ifndef FFO_CSPLIT
#define FFO_CSPLIT 1
#endif
#ifndef FFO_WGM
#define FFO_WGM 4
#endif
#ifndef TAIL_FILL
#define TAIL_FILL 0
#endif
#ifndef SKEW_TICKS
#define SKEW_TICKS 0
#endif
#define PHASE_SKEW() do { if (SKEW_TICKS) { const unsigned long long t0_ = __builtin_amdgcn_s_memrealtime(); const unsigned long long d_ = (unsigned long long)((F.vcu * 8 / F.G) & 7) * SKEW_TICKS; \
        while (__builtin_amdgcn_s_memrealtime() - t0_ < d_) __builtin_amdgcn_s_sleep(16); } } while (0)
#define RESID_WMODE (RESID_PERM ? 2 : 1)
#ifndef RESID_ALIGN
#define RESID_ALIGN true
#endif
struct Args { const float* in[26]; float* out; unsigned char* ws; int ph_lo, ph_hi, li, pad; };
__device__ __forceinline__ double rope_rev(int j) {
    return j == 0 ? 0.15915494309189535 : j == 1 ? 0.03086376340470123 : j == 2 ? 0.005985185712713705 : j == 3 ? 0.001160663641240061 :
           j == 4 ? 0.00022507907903927653 : j == 5 ? 4.364795279280289e-05 : j == 6 ? 8.464330808241401e-06 : 1.6414262627950345e-06;
}
#define TRANSPOSE_STREAM(DESC, NIT) do { int it_ = gw; if (it_ < (NIT)) { float va_[32], vb_[32]; TItem da_ = DESC(it_), db_; titem_load(da_, va_); \
        for (;;) { int nx_ = it_ + NGW; bool hn_ = nx_ < (NIT); db_ = DESC(hn_ ? nx_ : it_); titem_load(db_, vb_); titem_finish(da_, va_, scr, F.lane); if (!hn_) break; it_ = nx_; \
                   nx_ = it_ + NGW; hn_ = nx_ < (NIT); da_ = DESC(hn_ ? nx_ : it_); titem_load(da_, va_); titem_finish(db_, vb_, scr, F.lane); if (!hn_) break; it_ = nx_; } } } while (0)
__global__ void __launch_bounds__(NWAVES * 64, 2) mk_fwd(Args args) {
    extern __shared__ __attribute__((aligned(16))) unsigned char lds[];
    Frame F;
    F.lds = (LAS unsigned char*)lds;
    F.MISC = (volatile LAS unsigned*)(F.lds + MISC_OFF);
    F.tid = threadIdx.x; F.lane = F.tid & 63; F.wave = __builtin_amdgcn_readfirstlane(F.tid >> 6);
    F.G = gridDim.x; { const int bx = blockIdx.x; F.vcu = (F.G % 8 == 0) ? (bx % 8) * (F.G / 8) + bx / 8 : bx; }
    unsigned char* ws = args.ws;
    gu32* ctl = (gu32*)(ws + WS_CTL);
    const float* x_prompt = args.in[0]; const float* x_sample = args.in[1];
    const float* ffn1_norm = args.in[2]; const float* ffn1_w_in = args.in[3]; const float* ffn1_w_out = args.in[4];
    const float* mix_norm = args.in[5]; const float* w_in = args.in[6];
    const float* lq1 = args.in[7]; const float* lk1 = args.in[8]; const float* lq2 = args.in[9]; const float* lk2 = args.in[10];
    const float* subln_gain = args.in[11]; const float* conv_w = args.in[12]; const float* conv_b = args.in[13];
    const float* rg_wa = args.in[14]; const float* rg_ba = args.in[15]; const float* rg_wx = args.in[16]; const float* rg_bx = args.in[17]; const float* rg_lambda = args.in[18];
    const float* w_attn = args.in[19]; const float* w_rnn = args.in[20]; const float* w_out = args.in[21];
    const float* ffn2_norm = args.in[22]; const float* ffn2_w_in = args.in[23]; const float* ffn2_w_out = args.in[24]; const float* final_norm = args.in[25];
    float* out = args.out;
    float* ROPE = (float*)(ws + WS_ROPE); bf16* RGW = (bf16*)(ws + WS_RGW); float* AGG = (float*)(ws + WS_AGG); float* CARRY = (float*)(ws + WS_CARRY);
    bf16* WFI = (bf16*)(ws + WS_WFI); bf16* WFO = (bf16*)(ws + WS_WFO); bf16* WIN = (bf16*)(ws + WS_WIN); bf16* WA = (bf16*)(ws + WS_WA); bf16* WR = (bf16*)(ws + WS_WR); bf16* WO = (bf16*)(ws + WS_WO);
    bf16* H = (bf16*)(ws + WS_H); bf16* OB = H; bf16* RR = (bf16*)(ws + WS_RR);
    bf16* XR = (bf16*)(ws + WS_XR); float* SSQ = (float*)(ws + WS_SSQ); float* RSTD = (float*)(ws + WS_RSTD); bf16* MID = (bf16*)(ws + WS_BIG); bf16* QKV = (bf16*)(ws + WS_QKV); bf16* RXY = (bf16*)(ws + WS_RXY); bf16* GT = (bf16*)(ws + WS_G); bf16* MG = QKV;

    for (int u = F.tid; u < (LDS_BYTES - LDSCTL_OFF) / 4; u += NWAVES * 64) ((LAS unsigned*)(F.lds + LDSCTL_OFF))[u] = 0u;
    __syncthreads();
    XcdBarrier bar; bar.bar = (unsigned*)(ctl + CW_BAR) + args.li * XCD_BAR_WORDS; bar.x = 0; bar.st = nullptr;
    if (!MK_PER_PHASE) bar = xcd_barrier_post((unsigned*)(ctl + CW_BAR) + args.li * XCD_BAR_WORDS, F.MISC + 8);
#define GRID_BAR() do { xcd_barrier(bar); } while (0)
    const int lo = args.ph_lo, hi = args.ph_hi;
#ifndef PH_MASK
#define PH_MASK 0x7fff
#endif
#define IN(k) (((PH_MASK >> (k)) & 1) && lo <= (k) && (k) < hi)
#define BOTH(k) (IN(k) && IN((k) + 1))
#ifndef PH_REP
#define PH_REP 0
#endif
#define REPS(k) ((((PH_REP) >> (k)) & 1) + 1)
    const int gw = F.vcu * NWAVES + F.wave, NGW = F.G * NWAVES;
    LAS float* scr = (LAS float*)(F.lds + RING_OFF + F.wave * 16384);

#ifndef PROBE_ALL2_LO
#define PROBE_ALL2_LO 0
#define PROBE_ALL2_HI (NPHASE - 1)
#endif
#ifndef PROBE_ALL2
#define PROBE_ALL2 0
#endif
    if (IN(0))
_Pragma("unroll")
    for (int rep = 0; rep < REPS(0); ++rep) {
        constexpr int I_FI = (DM / 64) * (2 * DFF / 32), I_FO = (DFF / 64) * (DM / 32), I_IN = (DM / 64) * (NIN / 32), I_A = (AW / 64) * (DM / 32), I_O = (DM / 64) * (DM / 32), I_RG = 512;
        constexpr int NITEMS = I_FI + I_IN + I_O + I_RG + (TAIL_FILL ? 0 : I_FO + 2 * I_A);
        auto desc0 = [&](int it) -> TItem {
            int r = it;
            if (r < I_FI) return titem_matrix(ffn1_w_in, DM, 2 * DFF, WFI, DM / 64, 2, 1, r, F.lane); r -= I_FI;
            if (r < I_IN) return titem_matrix(w_in, DM, NIN, WIN, DM / 64, 2, 0, r, F.lane, mix_norm); r -= I_IN;
            if (r < I_O) return titem_matrix(w_out, DM, DM, WO, DM / 64, RESID_WMODE, 0, r, F.lane); r -= I_O;
            if (!TAIL_FILL) {
            if (r < I_FO) return titem_matrix(ffn1_w_out, DFF, DM, WFO, DFF / 64, RESID_WMODE, 0, r, F.lane); r -= I_FO;
            if (r < I_A) return titem_matrix(w_attn, AW, DM, WA, AW / 64, 2, 0, r, F.lane); r -= I_A;
            if (r < I_A) return titem_matrix(w_rnn, RW, DM, WR, RW / 64, 2, 0, r, F.lane); r -= I_A; }
            const int blk = r >> 3, sub = r & 7, gate = blk >> 5, b = blk & 31, dir = b >> 4, n = b & 15;
            return titem_matrix((gate ? rg_wx : rg_wa) + (size_t)b * 16384, 128, 128, RGW + (size_t)((dir * 2 + gate) * 16 + n) * 16384, 128, 0, 0, sub, F.lane);
        };
        TRANSPOSE_STREAM(desc0, NITEMS);
        for (int idx = gw * 64 + F.lane; idx < 16384 * 8; idx += NGW * 64) { const int pos = idx >> 3, j = idx & 7;
            double rev = (double)pos * rope_rev(j); rev -= __builtin_floor(rev); const float rf = (float)rev;
            float2 cs; cs.x = __builtin_amdgcn_cosf(rf); cs.y = __builtin_amdgcn_sinf(rf); *(float2*)(ROPE + 2 * (size_t)idx) = cs; }
        rms_phase(F, x_prompt, x_sample, ffn1_norm, H);
        if (BOTH(0) || rep + 1 < REPS(0)) GRID_BAR();
    }
    if (IN(1))
_Pragma("unroll")
    for (int rep = 0; rep < REPS(1); ++rep) {
        pg8::Gemm g{H, WFI, TT, 2 * DFF, DM, LDH, LDH}; pg8::StaticOrder S; S.init(TT, 2 * DFF, F.G, (int)blockIdx.x, ALL_WGM); S.rev = (GEMM_REV >> 5) & 1;
        pg8::EpiSwiGLU E{MID, DFF / 64, nullptr};
        pg8::gemm_phase<pg8::EpiSwiGLU, pg8::StaticOrder, true, GEMM_SP2>(F.lds + RING_OFF, g, S, E);
        if (TAIL_FILL && rep == 0) {
            constexpr int I_FO = (DFF / 64) * (DM / 32), I_A = (AW / 64) * (DM / 32);
            const int tail = ((TT / 256) * (2 * DFF / 256)) % F.G, nidle = tail ? F.G - tail : F.G, iw = tail ? (int)blockIdx.x - tail : (int)blockIdx.x;
            if (iw >= 0) { const int gw = iw * NWAVES + F.wave, NGW = nidle * NWAVES;
                auto desc1 = [&](int it) -> TItem { int r = it;
                    if (r < I_FO) return titem_matrix(ffn1_w_out, DFF, DM, WFO, DFF / 64, RESID_WMODE, 0, r, F.lane); r -= I_FO;
                    if (r < I_A) return titem_matrix(w_attn, AW, DM, WA, AW / 64, 2, 0, r, F.lane); r -= I_A;
                    return titem_matrix(w_rnn, RW, DM, WR, RW / 64, 2, 0, r, F.lane); };
                TRANSPOSE_STREAM(desc1, I_FO + 2 * I_A); } }
        if (BOTH(1) || rep + 1 < REPS(1)) GRID_BAR();
    }
#ifdef PROBE_P2B
    if (IN(2)) {
        pg8::Gemm g{MID, WFO, TT, DM, DFF, LDMID, LDMID}; pg8::StaticOrder S; S.init(TT, DM, F.G, (int)blockIdx.x, FFO_WGM); S.csplit = FFO_CSPLIT; S.rev = (GEMM_REV >> 0) & 1;
        pg8::EpiPlainBf16 E{H, 0.5f};
        pg8::gemm_phase<pg8::EpiPlainBf16, pg8::StaticOrder, true, GEMM_SP2>(F.lds + RING_OFF, g, S, E);
        GRID_BAR();
    }
#endif
    if (IN(2))
_Pragma("unroll")
    for (int rep = 0; rep < REPS(2); ++rep) {
        pg8::Gemm g{MID, WFO, TT, DM, DFF, LDMID, LDMID}; pg8::StaticOrder S; S.init(TT, DM, F.G, (int)blockIdx.x, FFO_WGM); S.csplit = FFO_CSPLIT; S.rev = (GEMM_REV >> 0) & 1;
        pg8::EpiResidT<false, true> E{x_prompt, x_sample, 8192, XR, DM, 0.5f, SSQ};
        PHASE_SKEW();
        pg8::gemm_phase<pg8::EpiResidT<false, true>, pg8::StaticOrder, RESID_ALIGN, GEMM_SP2>(F.lds + RING_OFF, g, S, E);
        if (BOTH(2) || rep + 1 < REPS(2)) GRID_BAR();
    }
    if (IN(3))
_Pragma("unroll")
    for (int rep = 0; rep < REPS(3); ++rep) {
        rstd_phase(F, SSQ, RSTD);
        constexpr int I_FI = (DM / 64) * (2 * DFF / 32), I_FO = (DFF / 64) * (DM / 32);
        auto desc3 = [&](int it) -> TItem { return it < I_FI ? titem_matrix(ffn2_w_in, DM, 2 * DFF, WFI, DM / 64, 2, 1, it, F.lane, ffn2_norm) : titem_matrix(ffn2_w_out, DFF, DM, WFO, DFF / 64, RESID_WMODE, 0, it - I_FI, F.lane); };
        TRANSPOSE_STREAM(desc3, I_FI + (TAIL_FILL ? 0 : I_FO));
        if (BOTH(3) || rep + 1 < REPS(3)) GRID_BAR();
    }
    if (IN(4))
_Pragma("unroll")
    for (int rep = 0; rep < REPS(4); ++rep) {
        pg8::Gemm g{XR, WIN, TT, NIN, DM, LDH, LDH}; pg8::StaticOrder S; S.init(TT, NIN, F.G, (int)blockIdx.x, ALL_WGM); S.rev = (GEMM_REV >> 4) & 1;
        pg8::EpiProj E{QKV, RXY, GT, ROPE, RSTD};
        pg8::gemm_phase<pg8::EpiProj, pg8::StaticOrder, true, GEMM_SP2>(F.lds + RING_OFF, g, S, E);
        if (BOTH(4) || rep + 1 < REPS(4)) GRID_BAR();
    }
    if (IN(5))
_Pragma("unroll")
    for (int rep = 0; rep < REPS(5); ++rep) {
        rglru_phase<false>(F, RXY, RGW, conv_w, conv_b, rg_ba, rg_bx, rg_lambda, AGG, CARRY, RR);
        if (BOTH(5) || rep + 1 < REPS(5)) GRID_BAR();
    }
    if (IN(6))
_Pragma("unroll")
    for (int rep = 0; rep < REPS(6); ++rep) {
        carry_phase(F, AGG, CARRY);
        const float lam = __expf(wave_sum(lq1[F.lane] * lk1[F.lane])) - __expf(wave_sum(lq2[F.lane] * lk2[F.lane])) + 0.2f;
        const int lane = F.lane, r32 = lane & 31, hi = lane >> 5, wid = F.wave;
        char* alds = (char*)lds + RING_OFF;
        const __amdgpu_buffer_rsrc_t qkv_rs = __builtin_amdgcn_make_buffer_rsrc((void*)QKV, 0, (int)((size_t)TT * 6144 * 2), 0x00020000);
        float* li_l = (float*)(alds + att::LDS_WS) + wid * 64;
#ifndef ATT_PASSES
#define ATT_PASSES 1
#endif
        for (int L_ = F.vcu; L_ < 1536 * ATT_PASSES; L_ += F.G) { const int L = L_ >= 1536 ? L_ - 1536 : L_;
            int h, qb, row0, seqlen;
            if (L < 1024) { const int i = L >> 8, xcd = (L & 255) >> 5, loc = L & 31; h = 2 * xcd + (i >> 1); qb = 32 * (i & 1) + loc; row0 = 8192; seqlen = 16384; }
            else { const int Lp = L - 1024, j = Lp >> 8, xcd = (Lp & 255) >> 5, loc = Lp & 31, pair = 4 * xcd + 2 * j + (loc >> 4); qb = loc & 15; h = pair & 15; row0 = (pair >> 4) * 4096; seqlen = 4096; }
            for (int m = 0; m < 2; ++m) {
                const unsigned qo = (unsigned)(((row0 + qb * 256) * 2048 + h * 128 + m * 64) * 2);
                const char* kbase = (const char*)QKV + pg8::QKV_KOFF + (size_t)((((row0 >> 6) * 16 + h) * 2 + m)) * 8192;
                const char* vbase = (const char*)QKV + pg8::QKV_VOFF + (size_t)((row0 >> 6) * 16 + h) * 16384;
                att::f32x16 o[4]; float l;
                att::attn_map_body<true>(qkv_rs, qo, kbase, vbase, seqlen, alds, o, l);
                {
                    LAS unsigned* ovf = (LAS unsigned*)(F.lds + RING_OFF + att::LDS_BYTES);
                    const bool bad = ATT_FORCE_SLOW || !(l < 1e30f);
                    const bool anyb = __any(bad);
                    if (lane == 0) ovf[wid] = anyb ? 1u : 0u;
                    asm volatile("s_waitcnt lgkmcnt(0)" ::: "memory"); __syncthreads();
                    unsigned any8 = 0;
#pragma unroll
                    for (int w8 = 0; w8 < 8; ++w8) any8 |= ovf[w8];
                    __syncthreads();
                    if (any8) att::attn_map_body<false>(qkv_rs, qo, kbase, vbase, seqlen, alds, o, l);
                }
                if (hi == 0) li_l[r32] = l;
                asm volatile("s_waitcnt lgkmcnt(0)" ::: "memory");
                float rli[16];
#pragma unroll
                for (int r = 0; r < 16; ++r) rli[r] = __builtin_amdgcn_rcpf(li_l[att::crow(r, hi)]);
                float* const swb = (float*)(ws + WS_ASCR) + (size_t)blockIdx.x * (256 * 128);
                unsigned swo = (unsigned)(((wid * 32 + 4 * hi) * 128 + r32) * 4); asm volatile("" : "+v"(swo));
#define SWL(idx) (*(float*)((unsigned char*)swb + swo + (idx) * 4))
                if (m == 0) {
#pragma unroll
                    for (int r = 0; r < 16; ++r)
#pragma unroll
                        for (int d0 = 0; d0 < 4; ++d0) SWL(((r & 3) + 8 * (r >> 2)) * 128 + d0 * 32) = o[d0][r] * rli[r];
                    asm volatile("s_waitcnt vmcnt(0)" ::: "memory");
                } else {
                    const int orow0 = row0 + qb * 256 + wid * 32;
                    unsigned char* const obb = (unsigned char*)OB + pg8::blk_off(orow0, h * 128, AW / 64);
                    unsigned ob0 = (unsigned)(hi * 256 + r32 * 2); asm volatile("" : "+v"(ob0));
                    unsigned ob1 = (unsigned)(hi * 256 + ((r32 * 2) ^ 32)); asm volatile("" : "+v"(ob1));
                    float gain[4];
#pragma unroll
                    for (int d0 = 0; d0 < 4; ++d0) gain[d0] = subln_gain[d0 * 32 + r32] * 0.8f;
#pragma unroll
                    for (int r = 0; r < 16; ++r) { const int rb = (r & 3) + 8 * (r >> 2); float ss = 0.f; float v[4];
#pragma unroll
                        for (int d0 = 0; d0 < 4; ++d0) { v[d0] = SWL(rb * 128 + d0 * 32) - lam * (o[d0][r] * rli[r]); ss += v[d0] * v[d0]; }
                        ss += __shfl_xor(ss, 1); ss += __shfl_xor(ss, 2); ss += __shfl_xor(ss, 4); ss += __shfl_xor(ss, 8); ss += __shfl_xor(ss, 16);
                        const float rs = 1.f / sqrtf(ss * (1.f / 128.f) + EPS);
#pragma unroll
                        for (int d0 = 0; d0 < 4; ++d0) { const int coff = (d0 >> 1) * 32768 + ((rb >> 4) * 2 + (d0 & 1)) * 1024 + (rb & 15) * 64;
                            *(bf16*)(obb + (((rb & 8) ? ob1 : ob0) + (unsigned)coff)) = (bf16)f2bf(v[d0] * rs * gain[d0]); } }
                }
#undef SWL
                __syncthreads();
            }
        }
        if (BOTH(6) || rep + 1 < REPS(6)) GRID_BAR();
    }
    if (IN(7))
_Pragma("unroll")
    for (int rep = 0; rep < REPS(7); ++rep) {
        rglru_phase<true>(F, RXY, RGW, conv_w, conv_b, rg_ba, rg_bx, rg_lambda, AGG, CARRY, RR);
        if (BOTH(7) || rep + 1 < REPS(7)) GRID_BAR();
    }
#ifndef PROBE_P89
#define PROBE_P89 0
#endif
_Pragma("unroll")
    for (int rep2 = 0; rep2 < (PROBE_P89 ? 2 : 1); ++rep2) {
    if (IN(8)) {
        pg8::Gemm g{OB, WA, TT, DM, AW, LDO, LDO}; pg8::PairOrder S; S.S.init(TT, DM, F.G, (int)blockIdx.x, ALL_WGM);
        pg8::EpiGatePair E{MG, GT, DM / 64};
        pg8::gemm_phase<pg8::EpiGatePair, pg8::PairOrder, true, GEMM_SP2>(F.lds + RING_OFF, g, S, E);
        if (BOTH(8)) GRID_BAR();
    }
    }
#ifndef PROBE_P10
#define PROBE_P10 0
#endif
    if (IN(10))
_Pragma("unroll")
    for (int rep = 0; rep < (PROBE_P10 ? 3 : 1); ++rep) {
        pg8::Gemm g{MG, WO, TT, DM, DM, LDH, LDH}; pg8::StaticOrder S; S.init(TT, DM, F.G, (int)blockIdx.x, ALL_WGM); S.rev = (GEMM_REV >> 1) & 1;
        pg8::EpiResidT<true, true> E{XR, nullptr, TT, XR, DM, rep == 1 ? -1.0f : 1.0f, SSQ};
        PHASE_SKEW();
        pg8::gemm_phase<pg8::EpiResidT<true, true>, pg8::StaticOrder, RESID_ALIGN, GEMM_SP2>(F.lds + RING_OFF, g, S, E);
        if (BOTH(10) || rep + 1 < (PROBE_P10 ? 3 : 1)) GRID_BAR();
    }
    if (IN(11))
_Pragma("unroll")
    for (int rep = 0; rep < REPS(11); ++rep) {
        rstd_phase(F, SSQ, RSTD);
        if (BOTH(11) || rep + 1 < REPS(11)) GRID_BAR();
    }
    if (IN(12))
_Pragma("unroll")
    for (int rep = 0; rep < REPS(12); ++rep) {
        pg8::Gemm g{XR, WFI, TT, 2 * DFF, DM, LDH, LDH}; pg8::StaticOrder S; S.init(TT, 2 * DFF, F.G, (int)blockIdx.x, ALL_WGM); S.rev = (GEMM_REV >> 2) & 1;
        pg8::EpiSwiGLU E{MID, DFF / 64, RSTD};
        pg8::gemm_phase<pg8::EpiSwiGLU, pg8::StaticOrder, true, GEMM_SP2>(F.lds + RING_OFF, g, S, E);
        if (TAIL_FILL && rep == 0) {
            constexpr int I_FO = (DFF / 64) * (DM / 32);
            const int tail = ((TT / 256) * (2 * DFF / 256)) % F.G, nidle = tail ? F.G - tail : F.G, iw = tail ? (int)blockIdx.x - tail : (int)blockIdx.x;
            if (iw >= 0) { const int gw = iw * NWAVES + F.wave, NGW = nidle * NWAVES;
                auto desc12 = [&](int it) -> TItem { return titem_matrix(ffn2_w_out, DFF, DM, WFO, DFF / 64, RESID_WMODE, 0, it, F.lane); };
                TRANSPOSE_STREAM(desc12, I_FO); } }
        if (BOTH(12) || rep + 1 < REPS(12)) GRID_BAR();
    }
#ifndef PROBE_P13
#define PROBE_P13 0
#endif
    if (IN(13))
_Pragma("unroll")
    for (int rep = 0; rep < (PROBE_P13 ? 3 : 1); ++rep) {
        pg8::Gemm g{MID, WFO, TT, DM, DFF, LDMID, LDMID}; pg8::StaticOrder S; S.init(TT, DM, F.G, (int)blockIdx.x, FFO_WGM); S.csplit = FFO_CSPLIT; S.rev = (GEMM_REV >> 3) & 1;
        pg8::EpiResidT<true, true> E{XR, nullptr, TT, XR, DM, rep == 1 ? -0.5f : 0.5f, nullptr};
        PHASE_SKEW();
        pg8::gemm_phase<pg8::EpiResidT<true, true>, pg8::StaticOrder, RESID_ALIGN, GEMM_SP2>(F.lds + RING_OFF, g, S, E);
        if (BOTH(13) || rep + 1 < (PROBE_P13 ? 3 : 1)) GRID_BAR();
    }
    if (IN(14)) {
#ifdef PROBE_BARS
        for (int b_ = 0; b_ < PROBE_BARS; ++b_) GRID_BAR();
#endif
        for (int it = gw; it < TT; it += NGW) { const int m = recent_first_row(it); rms_row_bf16_to_f32(XR, m, final_norm, out + (size_t)m * DM, F.lane); }
    }
#undef IN
#undef BOTH
#undef GRID_BAR
}

extern "C" void kernel_launch(void* const* d_in, const int* in_sizes, int n_in, void* d_out, int out_size, void* d_ws, size_t ws_size, hipStream_t stream) {
    static int grid = 0;
    if (grid == 0) {
        if (n_in != 26 || in_sizes[0] != 8192 * DM || in_sizes[1] != 16384 * DM || out_size != TT * DM || ws_size < WS_END) {
            fprintf(stderr, "kernel_launch: shape mismatch (n_in %d, out %d, ws %zu, need %zu); nothing launched\n", n_in, out_size, ws_size, (size_t)WS_END); grid = -1; return; }
        int dev = 0, cus = 0;
        if (hipGetDevice(&dev) != hipSuccess || hipDeviceGetAttribute(&cus, hipDeviceAttributeMultiprocessorCount, dev) != hipSuccess) { grid = -1; return; }
        if (hipFuncSetAttribute((const void*)mk_fwd, hipFuncAttributeMaxDynamicSharedMemorySize, LDS_BYTES) != hipSuccess) { fprintf(stderr, "kernel_launch: hipFuncSetAttribute failed\n"); grid = -1; return; }
        (void)hipGetLastError();
        grid = cus > 256 ? 256 : cus - (cus % 16);
        if (grid < 16) { grid = -1; return; }
    }
    if (grid < 0) return;
    if (hipMemsetAsync((char*)d_ws + WS_CTL, 0, CTL_ZERO_BYTES, stream) != hipSuccess) return;
    Args a{};
    for (int i = 0; i < 26; ++i) a.in[i] = (const float*)d_in[i];
    a.out = (float*)d_out; a.ws = (unsigned char*)d_ws;
#if MK_PER_PHASE
    for (int k = 0; k < NPHASE; ++k) { a.ph_lo = k; a.ph_hi = k + 1; hipLaunchKernelGGL(mk_fwd, dim3(grid), dim3(NWAVES * 64), LDS_BYTES, stream, a); }
#else
#if PROBE_ALL2
    a.ph_lo = PROBE_ALL2_LO; a.ph_hi = PROBE_ALL2_HI; a.li = 1;
    hipLaunchKernelGGL(mk_fwd, dim3(grid), dim3(NWAVES * 64), LDS_BYTES, stream, a);
#endif
    a.ph_lo = 0; a.ph_hi = NPHASE; a.li = 0;
    hipLaunchKernelGGL(mk_fwd, dim3(grid), dim3(NWAVES * 64), LDS_BYTES, stream, a);
#endif
    const hipError_t le = hipPeekAtLastError();
    if (le != hipSuccess) fprintf(stderr, "kernel_launch: launch failed: %s\n", hipGetErrorName(le));
}
```

```cpp
#include <hip/hip_runtime.h>
#include <hip/hip_bf16.h>
#include <cstdio>
#include <cstdint>
#include <cmath>
namespace pg8 {
#define PG8_LAS __attribute__((address_space(3)))
typedef unsigned short bf16_t;
typedef short bf16x8 __attribute__((ext_vector_type(8)));
typedef float f32x4 __attribute__((ext_vector_type(4)));
typedef unsigned u32x4 __attribute__((ext_vector_type(4)));
constexpr int BM = 256, BK = 64, HALF = 128, HTB = HALF * BK * 2  , STAGE_BYTES = 8 * HTB, NXCD = 8, WGM = 8;

__host__ __device__ __forceinline__ int lds_byte(int r, int c) { const int st = (r >> 4) * 2 + (c >> 5), rr = r & 15, cc = c & 31, ob = rr * 64 + cc * 2; return st * 1024 + (ob ^ (((ob >> 9) & 1) << 5)); }
__host__ __device__ __forceinline__ void stage_rc(int b, int& R, int& C) { const int st = b / 1024, sb = b % 1024, swz = sb ^ (((sb >> 9) & 1) << 5); R = (st >> 1) * 16 + swz / 64; C = (st & 1) * 32 + (swz % 64) / 2; }
__host__ __device__ __forceinline__ int perm32(int rho) { const int n = rho >> 4, i = rho & 15; return 8 * (i >> 2) + 4 * n + (i & 3); }
__host__ __device__ __forceinline__ int inv_perm32(int w) { return 16 * ((w >> 2) & 1) + 4 * (w >> 3) + (w & 3); }
__host__ __device__ __forceinline__ size_t blk_off(int row, int col, int KT) { return ((size_t)((row >> 8) * KT + (col >> 6)) * 2 + ((row >> 7) & 1)) * 16384 + (size_t)lds_byte(row & 127, col & 63); }
__host__ __device__ __forceinline__ size_t blk_off_b(int w, int col, int KT, bool perm) { const int w128 = w & 127, R = perm ? (w128 & ~31) + inv_perm32(w128 & 31) : w128;
    return ((size_t)((w >> 8) * KT + (col >> 6)) * 2 + ((w >> 7) & 1)) * 16384 + (size_t)lds_byte(R, col & 63); }

struct Unit { int pm, pn; };
struct Gemm { const bf16_t* A; const bf16_t* Bt; int M, N, K, lda, ldb; };

#ifndef SERPENTINE
#define SERPENTINE 1
#endif
struct StaticOrder {
    int rev = 0;
    int csplit = 0;
    int nM, nN, nwg, G, c, wgm, serp = SERPENTINE;
    __host__ __device__ void init(int M, int N, int G_, int c_, int wgm_ = WGM) { nM = M / BM; nN = N / BM; nwg = nM * nN; G = G_; c = c_; wgm = wgm_; }
    __host__ __device__ bool next(int i, Unit& u) const {
        const long L = (long)i * G + c; if (L >= nwg) return false;
        if (csplit && nwg % NXCD == 0 && nM % 16 == 0 && nN % 2 == 0) { const int xcd = (int)(L % NXCD), off = (int)(L / NXCD), cpg = nN / 2, rnd = off / (4 * cpg), in = off % (4 * cpg);
            u.pm = (xcd >> 1) * (nM / 4) + rnd * 4 + (in & 3); u.pn = (xcd & 1) * cpg + (in >> 2); if (rev) u.pm = nM - 1 - u.pm; return true; }
        int wgid = (int)L; { const int q = nwg / NXCD, r = nwg % NXCD, xcd = wgid % NXCD, off = wgid / NXCD; wgid = (xcd < r ? xcd * (q + 1) : r * (q + 1) + (xcd - r) * q) + off; }
        const int nig = wgm * nN, gid = wgid / nig, fm = gid * wgm, gsz = (nM - fm) < wgm ? (nM - fm) : wgm;
        u.pm = fm + ((wgid % nig) % gsz); u.pn = (wgid % nig) / gsz;
        if (serp && (nwg / NXCD) % nig == 0 && nwg % NXCD == 0 && (((wgid % (nwg / NXCD)) / nig) & 1)) u.pn = nN - 1 - u.pn;
        if (rev) u.pm = nM - 1 - u.pm;
        return true;
    }
    __device__ __forceinline__ void a_ready(const Unit&) const {}
    __device__ __forceinline__ void done(const Unit&) const {}
};

__device__ __forceinline__ unsigned cvt_pk_bf16(float lo, float hi) { unsigned r; asm volatile("v_cvt_pk_bf16_f32 %0, %1, %2" : "=v"(r) : "v"(lo), "v"(hi)); return r; }
typedef float f32x2 __attribute__((ext_vector_type(2)));
__device__ __forceinline__ float sigm(float x) { return __builtin_amdgcn_rcpf(1.f + __builtin_amdgcn_exp2f(-1.4426950408889634f * x)); }
__device__ __forceinline__ float bf_lo(unsigned w) { return __uint_as_float(w << 16); }
__device__ __forceinline__ float bf_hi(unsigned w) { return __uint_as_float(w & 0xffff0000u); }
#ifndef OUT_NT
#define OUT_NT 0
#endif
struct EpiSwiGLU {
    static constexpr bool PERM = true, AFTER_DRAIN = false;
    bf16_t* O; int KT; const float* rstd;
    __device__ __forceinline__ void operator()(const f32x4 (&acc)[2][2][4][2], const Unit& u, int wr, int wc, int fr, int fq) const {
        const int row0 = u.pm * BM + wr * 64 + fr, col0 = u.pn * HALF + wc * 32 + 8 * fq;
#pragma unroll
        for (int ai = 0; ai < 2; ++ai)
#pragma unroll
            for (int m = 0; m < 4; ++m) {
                bf16_t* rowp = (bf16_t*)((unsigned char*)O + blk_off(row0 + ai * HALF + m * 16, col0, KT));
                float r[8]; const float rs = rstd ? rstd[row0 + ai * HALF + m * 16] : 1.f;
#pragma unroll
                for (int n = 0; n < 2; ++n)
#pragma unroll
                    for (int j = 0; j < 4; ++j) { const float g = acc[ai][0][m][n][j] * rs, up = acc[ai][1][m][n][j] * rs; r[4 * n + j] = g * sigm(g) * up; }
                u32x4 w; w.x = cvt_pk_bf16(r[0], r[1]); w.y = cvt_pk_bf16(r[2], r[3]); w.z = cvt_pk_bf16(r[4], r[5]); w.w = cvt_pk_bf16(r[6], r[7]);
                if (OUT_NT) __builtin_nontemporal_store(w, (u32x4*)rowp); else *(u32x4*)rowp = w;
            }
    }
};
template <bool RB16, bool OB16> struct EpiResidT {
#ifndef RESID_PERM
#define RESID_PERM 1
#endif
    static constexpr bool PERM = RESID_PERM != 0, AFTER_DRAIN = false;
    const void* res0; const void* res1; int split_row; void* out; int ldc; float alpha; float* ssq;
    __device__ __forceinline__ void operator()(const f32x4 (&acc)[2][2][4][2], const Unit& u, int wr, int wc, int fr, int fq) const {
        typedef unsigned u32x2v __attribute__((ext_vector_type(2)));
        const int rowt = u.pm * BM;
        const float* rbf = RB16 ? nullptr : (rowt < split_row ? (const float*)res0 + (size_t)rowt * ldc : (const float*)res1 + (size_t)(rowt - split_row) * ldc);
        float* obf = OB16 ? nullptr : (float*)out + (size_t)rowt * ldc;
#if RESID_PERM
        const int col0 = u.pn * BM + wc * 32 + 8 * fq;
#pragma unroll
        for (int ai = 0; ai < 2; ++ai) {
            f32x4 rv[4][2][2]; u32x4 rw[4][2];
#pragma unroll
            for (int m = 0; m < 4; ++m) { const int rl = ai * HALF + wr * 64 + m * 16 + fr; const size_t off = (size_t)rl * ldc + col0;
#pragma unroll
                for (int bj = 0; bj < 2; ++bj) {
                    if (RB16) rw[m][bj] = *(const u32x4*)((const unsigned char*)res0 + blk_off(rowt + rl, col0 + bj * HALF, 64));
                    else { rv[m][bj][0] = *(const f32x4*)(rbf + off + bj * HALF); rv[m][bj][1] = *(const f32x4*)(rbf + off + bj * HALF + 4); } } }
#pragma unroll
            for (int m = 0; m < 4; ++m) { const int rl = ai * HALF + wr * 64 + m * 16 + fr; const size_t off = (size_t)rl * ldc + col0; float sq = 0.f;
#pragma unroll
                for (int bj = 0; bj < 2; ++bj) {
                    if (RB16) { const u32x4 w = rw[m][bj]; rv[m][bj][0] = (f32x4){bf_lo(w.x), bf_hi(w.x), bf_lo(w.y), bf_hi(w.y)}; rv[m][bj][1] = (f32x4){bf_lo(w.z), bf_hi(w.z), bf_lo(w.w), bf_hi(w.w)}; }
                    const f32x4 v0 = rv[m][bj][0] + acc[ai][bj][m][0] * alpha, v1 = rv[m][bj][1] + acc[ai][bj][m][1] * alpha;
                    sq += ((v0[0] * v0[0] + v0[1] * v0[1]) + (v0[2] * v0[2] + v0[3] * v0[3])) + ((v1[0] * v1[0] + v1[1] * v1[1]) + (v1[2] * v1[2] + v1[3] * v1[3]));
                    if (OB16) { u32x4 w; w.x = cvt_pk_bf16(v0[0], v0[1]); w.y = cvt_pk_bf16(v0[2], v0[3]); w.z = cvt_pk_bf16(v1[0], v1[1]); w.w = cvt_pk_bf16(v1[2], v1[3]);
                        *(u32x4*)((unsigned char*)out + blk_off(rowt + rl, col0 + bj * HALF, 64)) = w; }
                    else { *(f32x4*)(obf + off + bj * HALF) = v0; *(f32x4*)(obf + off + bj * HALF + 4) = v1; } }
                if (ssq) { sq += __shfl_xor(sq, 16); sq += __shfl_xor(sq, 32); if (fq == 0) ssq[(size_t)(rowt + rl) * 64 + u.pn * 4 + wc] = sq; } }
            asm volatile("" ::: "memory"); }
#else
        const int col0 = u.pn * BM + wc * 32 + 4 * fq;
#pragma unroll
        for (int ai = 0; ai < 2; ++ai) {
            f32x4 rv[4][2][2];
#pragma unroll
            for (int m = 0; m < 4; ++m) { const int rl = ai * HALF + wr * 64 + m * 16 + fr; const size_t off = (size_t)rl * ldc + col0;
#pragma unroll
                for (int bj = 0; bj < 2; ++bj)
#pragma unroll
                    for (int n = 0; n < 2; ++n) {
                        if (RB16) { const u32x2v w = *(const u32x2v*)((const unsigned char*)res0 + blk_off(rowt + rl, col0 + bj * HALF + n * 16, 64)); rv[m][bj][n] = (f32x4){bf_lo(w.x), bf_hi(w.x), bf_lo(w.y), bf_hi(w.y)}; }
                        else rv[m][bj][n] = *(const f32x4*)(rbf + off + bj * HALF + n * 16); } }
#pragma unroll
            for (int m = 0; m < 4; ++m) { const int rl = ai * HALF + wr * 64 + m * 16 + fr; const size_t off = (size_t)rl * ldc + col0; float sq = 0.f;
#pragma unroll
                for (int bj = 0; bj < 2; ++bj)
#pragma unroll
                    for (int n = 0; n < 2; ++n) { const f32x4 val = rv[m][bj][n] + acc[ai][bj][m][n] * alpha;
                        sq += (val[0] * val[0] + val[1] * val[1]) + (val[2] * val[2] + val[3] * val[3]);
                        if (OB16) { u32x2v w; w.x = cvt_pk_bf16(val[0], val[1]); w.y = cvt_pk_bf16(val[2], val[3]); *(u32x2v*)((unsigned char*)out + blk_off(rowt + rl, col0 + bj * HALF + n * 16, 64)) = w; }
                        else *(f32x4*)(obf + off + bj * HALF + n * 16) = val; }
                if (ssq) { sq += __shfl_xor(sq, 16); sq += __shfl_xor(sq, 32); if (fq == 0) ssq[(size_t)(rowt + rl) * 64 + u.pn * 4 + wc] = sq; } }
            asm volatile("" ::: "memory"); }
#endif
    }
};
constexpr size_t QKV_KOFF = (size_t)24576 * 2048 * 2, QKV_VOFF = 2 * QKV_KOFF;
__host__ __device__ __forceinline__ int kimg(int r64, int d) { return r64 * 128 + ((d * 2) ^ (((r64 >> 1) & 7) << 4)); }
__host__ __device__ __forceinline__ int vimg(int k, int c) { const int kk = k;     return ((kk >> 3) * 4 + (c >> 5)) * 512 + ((kk & 7) * 32 + (c & 31)) * 2; }
struct EpiPlainBf16 {
    static constexpr bool PERM = false, AFTER_DRAIN = false;
    bf16_t* O; float alpha;
    __device__ __forceinline__ void operator()(const f32x4 (&acc)[2][2][4][2], const Unit& u, int wr, int wc, int fr, int fq) const {
        const int col0 = u.pn * BM + wc * 32 + 4 * fq;
#pragma unroll
        for (int ai = 0; ai < 2; ++ai)
#pragma unroll
            for (int m = 0; m < 4; ++m) { const size_t off = (size_t)(u.pm * BM + ai * HALF + wr * 64 + m * 16 + fr) * 4096 + col0;
#pragma unroll
                for (int bj = 0; bj < 2; ++bj)
#pragma unroll
                    for (int n = 0; n < 2; ++n) { const f32x4 v = acc[ai][bj][m][n] * alpha; unsigned long long w = (unsigned long long)cvt_pk_bf16(v[0], v[1]) | ((unsigned long long)cvt_pk_bf16(v[2], v[3]) << 32);
                        *(unsigned long long*)(O + off + bj * HALF + n * 16) = w; } }
    }
};
struct EpiProj {
    static constexpr bool PERM = true, AFTER_DRAIN = false;
    bf16_t* QKV; bf16_t* RXY; bf16_t* G; const float* rope; const float* rstd;
    __device__ __forceinline__ void operator()(const f32x4 (&acc)[2][2][4][2], const Unit& u, int wr, int wc, int fr, int fq) const {
        const int colt = u.pn * BM, rowt = u.pm * BM;
        bf16_t* base; int ldc, cb;
        if (colt < 6144) { base = QKV; ldc = 6144; cb = colt; } else if (colt < 10240) { base = RXY; ldc = 4096; cb = colt - 6144; } else { base = G; ldc = 8192; cb = colt - 10240; }
        const bool rot = (colt < 4096) && ((wc & 1) == 0);
        const int pos0 = rowt - (rowt < 4096 ? 0 : (rowt < 8192 ? 4096 : 8192));
        const int col0 = cb + wc * 32 + 8 * fq;
        const float sgn = fq == 0 ? -1.f : 1.f;
        const float qs = colt < 2048 ? 0.125f * 1.4426950408889634f : 1.f;
#pragma unroll
        for (int ai = 0; ai < 2; ++ai)
#pragma unroll
            for (int m = 0; m < 4; ++m) {
                const int rl = ai * HALF + wr * 64 + m * 16 + fr;
                const int row = rowt + rl; const float rs = rstd[row];
                f32x4 cs[4];
                if (rot && fq < 2) { const f32x4* tp = (const f32x4*)(rope + (size_t)(pos0 + rl) * 16);
#pragma unroll
                    for (int q = 0; q < 4; ++q) cs[q] = tp[q]; }
#pragma unroll
                for (int bj = 0; bj < 2; ++bj) {
                    f32x4 v0 = acc[ai][bj][m][0] * (qs * rs), v1 = acc[ai][bj][m][1] * (qs * rs);
                    if (rot) {
                        f32x4 p0, p1;
#pragma unroll
                        for (int j = 0; j < 4; ++j) { p0[j] = __shfl_xor(v0[j], 16); p1[j] = __shfl_xor(v1[j], 16); }
                        if (fq < 2) {
                            v0[0] = v0[0] * cs[0][0] + sgn * p0[0] * cs[0][1]; v0[1] = v0[1] * cs[0][2] + sgn * p0[1] * cs[0][3];
                            v0[2] = v0[2] * cs[1][0] + sgn * p0[2] * cs[1][1]; v0[3] = v0[3] * cs[1][2] + sgn * p0[3] * cs[1][3];
                            v1[0] = v1[0] * cs[2][0] + sgn * p1[0] * cs[2][1]; v1[1] = v1[1] * cs[2][2] + sgn * p1[1] * cs[2][3];
                            v1[2] = v1[2] * cs[3][0] + sgn * p1[2] * cs[3][1]; v1[3] = v1[3] * cs[3][2] + sgn * p1[3] * cs[3][3];
                        }
                    }
                    u32x4 w; w.x = cvt_pk_bf16(v0[0], v0[1]); w.y = cvt_pk_bf16(v0[2], v0[3]); w.z = cvt_pk_bf16(v1[0], v1[1]); w.w = cvt_pk_bf16(v1[2], v1[3]);
                    const int col = col0 + bj * HALF;
                    unsigned char* dp;
                    if (colt >= 6144) dp = (unsigned char*)(base + (size_t)row * ldc + col);
                    else if (colt < 2048) dp = (unsigned char*)(QKV + (size_t)row * 2048 + col);
                    else if (colt < 4096) { const int c2 = col - 2048; dp = (unsigned char*)QKV + QKV_KOFF + (size_t)((((row >> 6) * 16 + (c2 >> 7)) * 2 + ((c2 >> 6) & 1))) * 8192 + kimg(row & 63, c2 & 63); }
                    else { const int c2 = col - 4096; dp = (unsigned char*)QKV + QKV_VOFF + (size_t)((row >> 6) * 16 + (c2 >> 7)) * 16384 + vimg(row & 63, c2 & 127); }
                    if (OUT_NT) __builtin_nontemporal_store(w, (u32x4*)dp); else *(u32x4*)dp = w;
                }
            }
    }
};
template <bool ADD> struct EpiGate {
    static constexpr bool PERM = true, AFTER_DRAIN = false;
    bf16_t* O; const bf16_t* Gt; int goff; int KT;
    __device__ __forceinline__ void operator()(const f32x4 (&acc)[2][2][4][2], const Unit& u, int wr, int wc, int fr, int fq) const {
        const int row0 = u.pm * BM + wr * 64 + fr, col0 = u.pn * BM + wc * 32 + 8 * fq;
#pragma unroll
        for (int ai = 0; ai < 2; ++ai)
#pragma unroll
            for (int m = 0; m < 4; ++m) { const size_t row = (size_t)(row0 + ai * HALF + m * 16);
                u32x4 gv[2], ov[2];
#pragma unroll
                for (int bj = 0; bj < 2; ++bj) { gv[bj] = *(const u32x4*)(Gt + row * 8192 + goff + col0 + bj * HALF); if (ADD) ov[bj] = *(const u32x4*)((const unsigned char*)O + blk_off((int)row, col0 + bj * HALF, KT)); }
#pragma unroll
                for (int bj = 0; bj < 2; ++bj) { const f32x4 a0 = acc[ai][bj][m][0], a1 = acc[ai][bj][m][1]; float r[8];
                    r[0] = sigm(bf_lo(gv[bj].x)) * a0[0]; r[1] = sigm(bf_hi(gv[bj].x)) * a0[1]; r[2] = sigm(bf_lo(gv[bj].y)) * a0[2]; r[3] = sigm(bf_hi(gv[bj].y)) * a0[3];
                    r[4] = sigm(bf_lo(gv[bj].z)) * a1[0]; r[5] = sigm(bf_hi(gv[bj].z)) * a1[1]; r[6] = sigm(bf_lo(gv[bj].w)) * a1[2]; r[7] = sigm(bf_hi(gv[bj].w)) * a1[3];
                    if (ADD) { r[0] += bf_lo(ov[bj].x); r[1] += bf_hi(ov[bj].x); r[2] += bf_lo(ov[bj].y); r[3] += bf_hi(ov[bj].y); r[4] += bf_lo(ov[bj].z); r[5] += bf_hi(ov[bj].z); r[6] += bf_lo(ov[bj].w); r[7] += bf_hi(ov[bj].w); }
                    u32x4 w; w.x = cvt_pk_bf16(r[0], r[1]); w.y = cvt_pk_bf16(r[2], r[3]); w.z = cvt_pk_bf16(r[4], r[5]); w.w = cvt_pk_bf16(r[6], r[7]);
                    *(u32x4*)((unsigned char*)O + blk_off((int)row, col0 + bj * HALF, KT)) = w; }
            }
    }
};

struct EpiGatePair {
    static constexpr bool PERM = true, AFTER_DRAIN = false;
    bf16_t* O; const bf16_t* Gt; int KT;
    __device__ __forceinline__ void operator()(const f32x4 (&acc)[2][2][4][2], const Unit& u, int wr, int wc, int fr, int fq) const {
        if (u.pm < 96) { EpiGate<false> e{O, Gt, 0, KT}; e(acc, u, wr, wc, fr, fq); }
        else { Unit v; v.pm = u.pm - 96; v.pn = u.pn - 16; EpiGate<true> e{O, Gt, 4096, KT}; e(acc, v, wr, wc, fr, fq); }
    }
};
struct PairOrder {
    StaticOrder S;
    __device__ __forceinline__ bool next(int i, Unit& u) const { if (!S.next(i >> 1, u)) return false; if (i & 1) { u.pm += 96; u.pn += 16; } return true; }
    __device__ __forceinline__ void a_ready(const Unit&) const {}
    __device__ __forceinline__ void done(const Unit&) const {}
};

template <class Epi, class Sched, bool ALIGN_EPI = false, bool SP2 = false>
__device__ __forceinline__ void gemm_phase(PG8_LAS unsigned char* lds, const Gemm g, const Sched& S, const Epi& E) {
    const int tid = threadIdx.x, wid = __builtin_amdgcn_readfirstlane(tid >> 6), lane = tid & 63, wr = wid >> 2, wc = wid & 3, fr = lane & 15, fq = lane >> 4;
    const int K = g.K, nt = K / BK;
    unsigned voffA[2], voffB[2];
#pragma unroll
    for (int i = 0; i < 2; ++i) { voffA[i] = (unsigned)(tid * 16 + i * 8192); voffB[i] = voffA[i]; }
    const size_t kstep = 32768;
    const size_t hstepA = 16384, hstepB = 16384;
    const size_t tstepA = (size_t)nt * 32768, tstepB = tstepA;
    const unsigned ldsw = (unsigned)wid * 1024u;
    const int aoff = lds_byte(wr * 64 + fr, fq * 8), boff = lds_byte(wc * 32 + fr, fq * 8);
#define PG8_SA(b, h) (((b) * 2 + (h)) * HTB)
#define PG8_SB(b, h) ((4 + (b) * 2 + (h)) * HTB)
#define PG8_STAGE(bufoff, gbase, voff) do { _Pragma("unroll") for (int _i = 0; _i < 2; ++_i) \
        __builtin_amdgcn_global_load_lds((const unsigned*)((const char*)(gbase) + (voff)[_i]), (PG8_LAS unsigned*)(lds + (bufoff) + ldsw + _i * 8192), 16, 0, 0); } while (0)
#ifndef GEMM_B_AUX
#define GEMM_B_AUX 0
#endif
#define PG8_STAGEB(bufoff, gbase, voff) do { _Pragma("unroll") for (int _i = 0; _i < 2; ++_i) \
        __builtin_amdgcn_global_load_lds((const unsigned*)((const char*)(gbase) + (voff)[_i]), (PG8_LAS unsigned*)(lds + (bufoff) + ldsw + _i * 8192), 16, 0, GEMM_B_AUX); } while (0)
#define PG8_LDA(dst, b, h) do { _Pragma("unroll") for (int m = 0; m < 4; ++m) _Pragma("unroll") for (int k = 0; k < 2; ++k) dst[m][k] = *(const PG8_LAS bf16x8*)(lds + PG8_SA(b, h) + aoff + m * 2048 + k * 1024); } while (0)
#define PG8_LDB(dst, b, h) do { _Pragma("unroll") for (int n = 0; n < 2; ++n) _Pragma("unroll") for (int k = 0; k < 2; ++k) dst[n][k] = *(const PG8_LAS bf16x8*)(lds + PG8_SB(b, h) + boff + n * 2048 + k * 1024); } while (0)
#ifndef MMA_ORDER
#define MMA_ORDER 3
#endif
#define PG8_MFMA1(ai, bj, At, Bt, m, n, k) acc[ai][bj][m][n] = __builtin_amdgcn_mfma_f32_16x16x32_bf16(Bt[n][k], At[m][k], acc[ai][bj][m][n], 0, 0, 0)
#define PG8_MMA(ai, bj, At, Bt) do { __builtin_amdgcn_s_setprio(1); \
        if (MMA_ORDER == 1) { _Pragma("unroll") for (int n = 0; n < 2; ++n) _Pragma("unroll") for (int k = 0; k < 2; ++k) _Pragma("unroll") for (int m = 0; m < 4; ++m) PG8_MFMA1(ai, bj, At, Bt, m, n, k); } \
        else if (MMA_ORDER == 2) { _Pragma("unroll") for (int m = 0; m < 4; ++m) _Pragma("unroll") for (int k = 0; k < 2; ++k) _Pragma("unroll") for (int n = 0; n < 2; ++n) PG8_MFMA1(ai, bj, At, Bt, m, n, k); } \
        else if (MMA_ORDER == 3) { _Pragma("unroll") for (int k = 0; k < 2; ++k) _Pragma("unroll") for (int m = 0; m < 4; ++m) _Pragma("unroll") for (int nn = 0; nn < 2; ++nn) { const int n = (m & 1) ? 1 - nn : nn; PG8_MFMA1(ai, bj, At, Bt, m, n, k); } }     \
        else { _Pragma("unroll") for (int m = 0; m < 4; ++m) _Pragma("unroll") for (int n = 0; n < 2; ++n) _Pragma("unroll") for (int k = 0; k < 2; ++k) PG8_MFMA1(ai, bj, At, Bt, m, n, k); } \
        __builtin_amdgcn_s_setprio(0); } while (0)
#define PG8_WAIT_V(n) asm volatile("s_waitcnt vmcnt(" #n ")" ::: "memory")
#define PG8_WAIT_L(n) asm volatile("s_waitcnt lgkmcnt(" #n ")" ::: "memory")
#define PG8_BAR __builtin_amdgcn_s_barrier()
#define PG8_SCHED __builtin_amdgcn_sched_barrier(0)
    Unit cur, nxt; int ui = 0;
    if (!S.next(0, cur)) return;
    f32x4 acc[2][2][4][2];
#pragma unroll
    for (int a = 0; a < 2; ++a)
#pragma unroll
        for (int b = 0; b < 2; ++b)
#pragma unroll
            for (int m = 0; m < 4; ++m)
#pragma unroll
                for (int n = 0; n < 2; ++n) acc[a][b][m][n] = (f32x4){0.f, 0.f, 0.f, 0.f};
    bf16x8 At[4][2], B0[2][2], B1[2][2];
    const char* cA = (const char*)g.A + (size_t)cur.pm * tstepA; const char* cB = (const char*)g.Bt + (size_t)cur.pn * tstepB;
    S.a_ready(cur);
    if constexpr (SP2) {
        PG8_STAGEB(PG8_SB(0, 0), cB, voffB); PG8_STAGEB(PG8_SB(0, 1), cB + hstepB, voffB); PG8_STAGE(PG8_SA(0, 0), cA, voffA); PG8_STAGE(PG8_SA(0, 1), cA + hstepA, voffA);
        if (wr == 1) PG8_BAR;
        PG8_WAIT_V(2); PG8_BAR;
        PG8_STAGEB(PG8_SB(1, 0), cB + kstep, voffB); PG8_STAGE(PG8_SA(1, 0), cA + kstep, voffA); PG8_STAGEB(PG8_SB(1, 1), cB + hstepB + kstep, voffB);
        PG8_WAIT_V(6); PG8_BAR;
    } else {
        PG8_STAGEB(PG8_SB(0, 0), cB, voffB); PG8_STAGE(PG8_SA(0, 0), cA, voffA); PG8_STAGEB(PG8_SB(0, 1), cB + hstepB, voffB); PG8_STAGE(PG8_SA(0, 1), cA + hstepA, voffA);
        if (wr == 1) PG8_BAR;
        PG8_WAIT_V(4); PG8_BAR;
        PG8_STAGEB(PG8_SB(1, 0), cB + kstep, voffB); PG8_STAGE(PG8_SA(1, 0), cA + kstep, voffA); PG8_STAGEB(PG8_SB(1, 1), cB + hstepB + kstep, voffB);
        PG8_WAIT_V(6); PG8_BAR;
    }
    for (;;) {
        const bool has_next = S.next(ui + 1, nxt);
        const char* nA = has_next ? (const char*)g.A + (size_t)nxt.pm * tstepA : cA; const char* nB = has_next ? (const char*)g.Bt + (size_t)nxt.pn * tstepB : cB;
        for (int t = 0; t < nt; t += 2) {
            const bool last = (t == nt - 2);
            const char* a1 = cA + (size_t)(t + 1) * kstep;
            const char* a2 = last ? nA : cA + (size_t)(t + 2) * kstep; const char* b2 = last ? nB : cB + (size_t)(t + 2) * kstep;
            const char* a3 = a2 + kstep; const char* b3 = b2 + kstep;
            if (last && has_next) S.a_ready(nxt);
            if constexpr (SP2) {
            PG8_LDB(B0, 0, 0); PG8_LDB(B1, 0, 1); PG8_SCHED; PG8_LDA(At, 0, 0); PG8_STAGE(PG8_SA(1, 1), a1 + hstepA, voffA);
            PG8_WAIT_V(8); PG8_WAIT_L(0); PG8_BAR; PG8_MMA(0, 0, At, B0); PG8_MMA(0, 1, At, B1); PG8_BAR; PG8_SCHED;
            PG8_LDA(At, 0, 1); PG8_STAGEB(PG8_SB(0, 0), b2, voffB); PG8_STAGEB(PG8_SB(0, 1), b2 + hstepB, voffB); PG8_STAGE(PG8_SA(0, 0), a2, voffA);
            PG8_WAIT_V(8); PG8_WAIT_L(0); PG8_BAR; PG8_MMA(1, 0, At, B0); PG8_MMA(1, 1, At, B1); PG8_BAR; PG8_SCHED;
            PG8_LDB(B0, 1, 0); PG8_LDB(B1, 1, 1); PG8_SCHED; PG8_LDA(At, 1, 0); PG8_STAGE(PG8_SA(0, 1), a2 + hstepA, voffA);
            PG8_WAIT_V(8); PG8_WAIT_L(0); PG8_BAR; PG8_MMA(0, 0, At, B0); PG8_MMA(0, 1, At, B1); PG8_BAR; PG8_SCHED;
            PG8_LDA(At, 1, 1); PG8_STAGEB(PG8_SB(1, 0), b3, voffB); PG8_STAGEB(PG8_SB(1, 1), b3 + hstepB, voffB); PG8_STAGE(PG8_SA(1, 0), a3, voffA);
            PG8_WAIT_V(8); PG8_WAIT_L(0); PG8_BAR; PG8_MMA(1, 0, At, B0); PG8_MMA(1, 1, At, B1); PG8_BAR; PG8_SCHED;
            } else {
            PG8_LDB(B0, 0, 0); PG8_SCHED; PG8_LDA(At, 0, 0); PG8_STAGE(PG8_SA(1, 1), a1 + hstepA, voffA);
            PG8_WAIT_L(8); PG8_BAR; PG8_WAIT_L(0); PG8_MMA(0, 0, At, B0); PG8_BAR; PG8_SCHED;
            PG8_LDB(B1, 0, 1); PG8_STAGEB(PG8_SB(0, 0), b2, voffB);
            PG8_BAR; PG8_WAIT_L(0); PG8_MMA(0, 1, At, B1); PG8_BAR;
            PG8_LDA(At, 0, 1); PG8_STAGE(PG8_SA(0, 0), a2, voffA);
            PG8_BAR; PG8_WAIT_L(0); PG8_MMA(1, 0, At, B0); PG8_BAR; PG8_SCHED;
            PG8_STAGEB(PG8_SB(0, 1), b2 + hstepB, voffB);
            PG8_WAIT_V(6); PG8_BAR; PG8_MMA(1, 1, At, B1); PG8_BAR;
            PG8_LDB(B0, 1, 0); PG8_SCHED; PG8_LDA(At, 1, 0); PG8_STAGE(PG8_SA(0, 1), a2 + hstepA, voffA);
            PG8_WAIT_L(8); PG8_BAR; PG8_WAIT_L(0); PG8_MMA(0, 0, At, B0); PG8_BAR; PG8_SCHED;
            PG8_LDB(B1, 1, 1); PG8_STAGEB(PG8_SB(1, 0), b3, voffB);
            PG8_BAR; PG8_WAIT_L(0); PG8_MMA(0, 1, At, B1); PG8_BAR;
            PG8_LDA(At, 1, 1); PG8_STAGE(PG8_SA(1, 0), a3, voffA);
            PG8_BAR; PG8_WAIT_L(0); PG8_MMA(1, 0, At, B0); PG8_BAR; PG8_SCHED;
            PG8_STAGEB(PG8_SB(1, 1), b3 + hstepB, voffB);
            PG8_WAIT_V(6); PG8_BAR; PG8_MMA(1, 1, At, B1); PG8_BAR;
            }
        }
        if constexpr (ALIGN_EPI) { if (wr == 0) PG8_BAR; }
        if constexpr (!Epi::AFTER_DRAIN) { E(acc, cur, wr, wc, fr, fq); S.done(cur); }
        if (!has_next) break;
#pragma unroll
        for (int a = 0; a < 2; ++a)
#pragma unroll
            for (int b = 0; b < 2; ++b)
#pragma unroll
                for (int m = 0; m < 4; ++m)
#pragma unroll
                    for (int n = 0; n < 2; ++n) acc[a][b][m][n] = (f32x4){0.f, 0.f, 0.f, 0.f};
        cur = nxt; cA = nA; cB = nB; ++ui;
        if constexpr (ALIGN_EPI) { if (wr == 1) PG8_BAR; }
    }
    PG8_WAIT_V(0);
    if constexpr (!ALIGN_EPI) { if (wr == 0) PG8_BAR; }
    PG8_BAR;
    if constexpr (Epi::AFTER_DRAIN) { E.fused(acc, cur, wr, wc, fr, fq, lds, wid, lane); S.done(cur); }
#undef PG8_SA
#undef PG8_SB
#undef PG8_STAGE
#undef PG8_STAGEB
#undef PG8_LDA
#undef PG8_LDB
#undef PG8_MMA
#undef PG8_MFMA1
#undef PG8_WAIT_V
#undef PG8_WAIT_L
#undef PG8_BAR
#undef PG8_SCHED
}
}
#ifndef ATT_SETPRIO
#define ATT_SETPRIO 0
#endif
namespace att {
typedef unsigned short bf16;
using bf16x8 = __attribute__((ext_vector_type(8))) short;
using s16x4  = __attribute__((ext_vector_type(4))) short;
using f32x16 = __attribute__((ext_vector_type(16))) float;
using u32x4  = __attribute__((ext_vector_type(4))) unsigned;
constexpr int NW = 8, QBLK = 32, KVBLK = 64, LDQ = 6144;
constexpr float SCALE = 0.125f;
constexpr float THR = 8.f;
constexpr int SHM_V = KVBLK * 128 * 2, SHM_K = KVBLK * 64 * 2;
constexpr int LDS_K = 0, LDS_V = 3 * SHM_K, LDS_WS = 3 * SHM_K + 4 * SHM_V, LDS_BYTES = LDS_WS + NW * 64 * 4;
#define KSWZ64(row, colB) ((row) * 128 + ((colB) ^ ((((row) >> 1) & 7) << 4)))
#define SBAR() __builtin_amdgcn_sched_barrier(0)
__device__ __forceinline__ int crow(int r, int hi) { return (r & 3) + 8 * (r >> 2) + 4 * hi; }
__device__ __forceinline__ unsigned cvtpk(float lo, float hi) { unsigned r; asm volatile("v_cvt_pk_bf16_f32 %0, %1, %2" : "=v"(r) : "v"(lo), "v"(hi)); return r; }

template <bool FIRST>
__device__ __forceinline__ void partialSM(f32x16& p0, f32x16& p1, float& mhat, f32x16& negm, float& alpha) {
  constexpr float THRL = THR * 1.4426950408889634f;
  float pmax = p0[0];
#pragma unroll
  for (int r = 1; r < 16; ++r) pmax = fmaxf(pmax, p0[r]);
#pragma unroll
  for (int r = 0; r < 16; ++r) pmax = fmaxf(pmax, p1[r]);
  { auto rr = __builtin_amdgcn_permlane32_swap(__float_as_uint(pmax), __float_as_uint(pmax), false, false);
    pmax = fmaxf(__uint_as_float(rr[0]), __uint_as_float(rr[1])); }
  if (!FIRST && __builtin_expect(__all(pmax <= THRL), 1)) { alpha = 1.f; }
  else { const float dl = FIRST ? pmax : fmaxf(pmax, 0.f); mhat += dl; alpha = FIRST ? 1.f : __builtin_amdgcn_exp2f(-dl);
#pragma unroll
    for (int r = 0; r < 16; ++r) { p0[r] -= dl; p1[r] -= dl; }
#pragma unroll
    for (int r = 0; r < 16; ++r) negm[r] = -mhat; }
#pragma unroll
  for (int r = 0; r < 16; ++r) p0[r] = __builtin_amdgcn_exp2f(p0[r]);
}
__device__ __forceinline__ void finishSM(f32x16& p0, f32x16& p1, float alpha, float& l_reg, bf16x8& pa0, bf16x8& pa1, bf16x8& pa2, bf16x8& pa3) {
#pragma unroll
  for (int r = 0; r < 16; ++r) p1[r] = __builtin_amdgcn_exp2f(p1[r]);
  float ps = 0;
#pragma unroll
  for (int r = 0; r < 16; ++r) ps += p0[r];
#pragma unroll
  for (int r = 0; r < 16; ++r) ps += p1[r];
  { auto rr = __builtin_amdgcn_permlane32_swap(__float_as_uint(ps), __float_as_uint(ps), false, false);
    ps = __uint_as_float(rr[0]) + __uint_as_float(rr[1]); }
  l_reg = l_reg * alpha + ps;
#define PK8(P, BASE, OUT) do { u32x4 w = {cvtpk(P[BASE + 0], P[BASE + 1]), cvtpk(P[BASE + 2], P[BASE + 3]), cvtpk(P[BASE + 4], P[BASE + 5]), cvtpk(P[BASE + 6], P[BASE + 7])}; \
    OUT = *reinterpret_cast<bf16x8*>(&w); } while (0)
  PK8(p0, 0, pa0); PK8(p0, 8, pa1); PK8(p1, 0, pa2); PK8(p1, 8, pa3);
#undef PK8
}
__device__ __forceinline__ void qkt(f32x16& p0, f32x16& p1, const char* Ks, const bf16x8* qr, const f32x16& negm, int r32, int hi) {
#pragma unroll
  for (int d0 = 0; d0 < 4; ++d0) { const int cb = (d0 * 16 + hi * 8) * 2;
    bf16x8 b0 = *reinterpret_cast<const bf16x8*>(Ks + KSWZ64(r32, cb));
    bf16x8 b1 = *reinterpret_cast<const bf16x8*>(Ks + KSWZ64(32 + r32, cb));
    if (d0 == 0) { p0 = __builtin_amdgcn_mfma_f32_32x32x16_bf16(b0, qr[0], negm, 0, 0, 0); p1 = __builtin_amdgcn_mfma_f32_32x32x16_bf16(b1, qr[0], negm, 0, 0, 0); }
    else { p0 = __builtin_amdgcn_mfma_f32_32x32x16_bf16(b0, qr[d0], p0, 0, 0, 0); p1 = __builtin_amdgcn_mfma_f32_32x32x16_bf16(b1, qr[d0], p1, 0, 0, 0); } }
}
__device__ __forceinline__ int v_st(int k, int c) { const int kk = (k & ~0xC) | ((k & 4) << 1) | ((k & 8) >> 1); return ((kk >> 3) * 4 + (c >> 5)) * 512 + ((kk & 7) * 32 + (c & 31)) * 2; }
__device__ __forceinline__ int v_rd_base(int lane) { return ((lane & 3) << 3) | (((lane >> 2) & 3) << 6) | (((lane >> 4) & 1) << 5) | (((lane >> 5) & 1) << 8); }
constexpr int v_rd_off(int d0, int ks, int half) { return d0 * 512 + ks * 4096 + half * 2048; }
template <int OFF> __device__ __forceinline__ s16x4 tr_read(int vb) {
  s16x4 r; asm volatile("ds_read_b64_tr_b16 %0, %1 offset:%2" : "=&v"(r) : "v"(vb), "i"(OFF) : "memory"); return r;
}
template <int D0> __device__ __forceinline__ void pv_one(f32x16& od, int vb, bf16x8 pa0, bf16x8 pa1, bf16x8 pa2, bf16x8 pa3) {
  const s16x4 l0 = tr_read<v_rd_off(D0, 0, 0)>(vb), h0 = tr_read<v_rd_off(D0, 0, 1)>(vb), l1 = tr_read<v_rd_off(D0, 1, 0)>(vb), h1 = tr_read<v_rd_off(D0, 1, 1)>(vb);
  const s16x4 l2 = tr_read<v_rd_off(D0, 2, 0)>(vb), h2 = tr_read<v_rd_off(D0, 2, 1)>(vb), l3 = tr_read<v_rd_off(D0, 3, 0)>(vb), h3 = tr_read<v_rd_off(D0, 3, 1)>(vb);
  asm volatile("s_waitcnt lgkmcnt(0)" ::: "memory"); SBAR();
#define PK(L, H) (bf16x8){L[0], L[1], L[2], L[3], H[0], H[1], H[2], H[3]}
#if ATT_SETPRIO
  __builtin_amdgcn_s_setprio(1);
#endif
  od = __builtin_amdgcn_mfma_f32_32x32x16_bf16(pa0, PK(l0, h0), od, 0, 0, 0);
  od = __builtin_amdgcn_mfma_f32_32x32x16_bf16(pa1, PK(l1, h1), od, 0, 0, 0);
  od = __builtin_amdgcn_mfma_f32_32x32x16_bf16(pa2, PK(l2, h2), od, 0, 0, 0);
  od = __builtin_amdgcn_mfma_f32_32x32x16_bf16(pa3, PK(l3, h3), od, 0, 0, 0);
#if ATT_SETPRIO
  __builtin_amdgcn_s_setprio(0);
#endif
#undef PK
}
__device__ __forceinline__ void pv_d0(f32x16* o, int vb, bf16x8 pa0, bf16x8 pa1, bf16x8 pa2, bf16x8 pa3) {
  pv_one<0>(o[0], vb, pa0, pa1, pa2, pa3); pv_one<1>(o[1], vb, pa0, pa1, pa2, pa3); pv_one<2>(o[2], vb, pa0, pa1, pa2, pa3); pv_one<3>(o[3], vb, pa0, pa1, pa2, pa3);
}

__device__ __forceinline__ bf16x8 bload(__amdgpu_buffer_rsrc_t rs, unsigned voff, unsigned soff) { return __builtin_bit_cast(bf16x8, __builtin_amdgcn_raw_buffer_load_b128(rs, voff, soff, 0)); }
__device__ __forceinline__ void glds16s(const char* sbase, unsigned voff, unsigned lds_dst) { unsigned keep;
  asm volatile("s_mov_b32 %0, m0\n\ts_mov_b32 m0, %3\n\ts_nop 0\n\tglobal_load_lds_dwordx4 %1, %2\n\ts_mov_b32 m0, %0" : "=&s"(keep) : "v"(voff), "s"(sbase), "s"(lds_dst) : "memory"); }
#define WAIT_BAR(N) asm volatile("s_waitcnt vmcnt(" #N ") lgkmcnt(0)\n\ts_barrier" ::: "memory")
template <bool FAST>
__device__ __forceinline__ void attn_map_body(__amdgpu_buffer_rsrc_t rs, unsigned qo, const char* kbase, const char* vbase, int seq, char* lds, f32x16 (&o)[4], float& l_out) {
  const int tid = threadIdx.x, wid = __builtin_amdgcn_readfirstlane(tid >> 6), lane = tid & 63, r32 = lane & 31, hi = lane >> 5;
  char* V_lds = lds + LDS_V; char* K_lds = lds + LDS_K;
  float* ws = (float*)(lds + LDS_WS) + wid * 64; float* al_l = ws + 32;
  float mhat = 0.f, l_reg = 0; bf16x8 qr[4]; f32x16 negm = f32x16{};
#pragma unroll
  for (int d = 0; d < 4; ++d) o[d] = f32x16{};
  const unsigned qvo = (unsigned)(((wid * QBLK + r32) * 2048 + hi * 8) * 2);
#pragma unroll
  for (int d0 = 0; d0 < 4; ++d0) qr[d0] = bload(rs, qvo + d0 * 32, qo);
  const unsigned lds0 = (unsigned)(uintptr_t)lds;
  const unsigned kvo = (unsigned)(wid * 1024 + lane * 16);
  unsigned vvo[2];
#pragma unroll
  for (int i = 0; i < 2; ++i) vvo[i] = (unsigned)((wid + 8 * i) * 1024 + lane * 16);
  const unsigned kdst = lds0 + LDS_K + wid * 1024, vdst = lds0 + LDS_V + wid * 1024;
#define DMA_K(t, slot) glds16s(kbase + (size_t)(t) * 262144, kvo, (unsigned)__builtin_amdgcn_readfirstlane((int)(kdst + (slot) * SHM_K)))
#define DMA_V(t, slot) do { const char* vb_ = vbase + (size_t)(t) * 262144; const unsigned vd_ = (unsigned)__builtin_amdgcn_readfirstlane((int)(vdst + (slot) * SHM_V)); \
    glds16s(vb_, vvo[0], vd_); glds16s(vb_, vvo[1], vd_ + 8192); } while (0)
  const int vb0 = (int)(uintptr_t)V_lds + v_rd_base(lane);
#define RESC(a) do { if (__any((a) < 1.f)) { if (hi == 0) al_l[r32] = (a); asm volatile("s_waitcnt lgkmcnt(0)" ::: "memory"); \
    _Pragma("unroll") for (int d = 0; d < 4; ++d) _Pragma("unroll") for (int r = 0; r < 16; ++r) o[d][r] *= al_l[crow(r, hi)]; } } while (0)
  f32x16 pA0, pA1, pB0, pB1; float alA, alB; bf16x8 pa0, pa1, pa2, pa3; const int NT = seq / KVBLK;
  int k3 = 0;
#define K3NEXT() do { k3 = (k3 == 2) ? 0 : k3 + 1; } while (0)
#define SM_STEP(PX0, PX1, alX) do { if (FAST) { alX = 1.f; _Pragma("unroll") for (int r_ = 0; r_ < 16; ++r_) PX0[r_] = __builtin_amdgcn_exp2f(PX0[r_]); } \
    else { partialSM<false>(PX0, PX1, mhat, negm, alX); RESC(alX); } } while (0)
#define A_PART(PX0, PX1, PY0, PY1, alY, j, GK, GV, FIN) do { \
    if (GK) DMA_K((j) + 2, (k3 == 0 ? 2 : k3 - 1)); if (GV) DMA_V((j) + 1, ((j) + 1) & 3); \
    SBAR(); qkt(PX0, PX1, K_lds + k3 * SHM_K, qr, negm, r32, hi); \
    if (FIN) finishSM(PY0, PY1, alY, l_reg, pa0, pa1, pa2, pa3); SBAR(); } while (0)
#ifndef ATT_EXP_IN_PV
#define ATT_EXP_IN_PV 1
#endif
#define B_PART(PX0, PX1, alX, j) do { \
    if (FAST && ATT_EXP_IN_PV) { const int vb_ = vb0 + (((j) + 3) & 3) * SHM_V; alX = 1.f; \
        pv_one<0>(o[0], vb_, pa0, pa1, pa2, pa3); _Pragma("unroll") for (int r_ = 0; r_ < 4; ++r_) PX0[r_] = __builtin_amdgcn_exp2f(PX0[r_]); \
        pv_one<1>(o[1], vb_, pa0, pa1, pa2, pa3); _Pragma("unroll") for (int r_ = 4; r_ < 8; ++r_) PX0[r_] = __builtin_amdgcn_exp2f(PX0[r_]); \
        pv_one<2>(o[2], vb_, pa0, pa1, pa2, pa3); _Pragma("unroll") for (int r_ = 8; r_ < 12; ++r_) PX0[r_] = __builtin_amdgcn_exp2f(PX0[r_]); \
        pv_one<3>(o[3], vb_, pa0, pa1, pa2, pa3); _Pragma("unroll") for (int r_ = 12; r_ < 16; ++r_) PX0[r_] = __builtin_amdgcn_exp2f(PX0[r_]); } \
    else { pv_d0(o, vb0 + (((j) + 3) & 3) * SHM_V, pa0, pa1, pa2, pa3); SM_STEP(PX0, PX1, alX); } } while (0)
#ifndef ATT_LATE_SPLIT
#define ATT_LATE_SPLIT 0
#endif
#define B1_PART(j) do { const int vb_ = vb0 + (((j) + 3) & 3) * SHM_V; if (ATT_LATE_SPLIT) { pv_one<0>(o[0], vb_, pa0, pa1, pa2, pa3); pv_one<1>(o[1], vb_, pa0, pa1, pa2, pa3); } } while (0)
#define B2_PART(PX0, PX1, alX, j) do { const int vb_ = vb0 + (((j) + 3) & 3) * SHM_V; \
    if (ATT_LATE_SPLIT) { pv_one<2>(o[2], vb_, pa0, pa1, pa2, pa3); pv_one<3>(o[3], vb_, pa0, pa1, pa2, pa3); } else pv_d0(o, vb_, pa0, pa1, pa2, pa3); \
    SM_STEP(PX0, PX1, alX); } while (0)
  DMA_K(0, 0); DMA_V(0, 0); DMA_K(1, 1);
  WAIT_BAR(0);
  int j = 1;
  if (wid < 4) {
    A_PART(pA0, pA1, pB0, pB1, alB, 0, true, true, false); partialSM<true>(pA0, pA1, mhat, negm, alA); WAIT_BAR(3); K3NEXT();
    for (; j + 3 < NT; j += 2) {
      A_PART(pB0, pB1, pA0, pA1, alA, j, true, true, true); B_PART(pB0, pB1, alB, j); WAIT_BAR(3); K3NEXT();
      A_PART(pA0, pA1, pB0, pB1, alB, j + 1, true, true, true); B_PART(pA0, pA1, alA, j + 1); WAIT_BAR(3); K3NEXT();
    }
    A_PART(pB0, pB1, pA0, pA1, alA, j, true, true, true); B_PART(pB0, pB1, alB, j); WAIT_BAR(3); K3NEXT();
    A_PART(pA0, pA1, pB0, pB1, alB, j + 1, false, true, true); B_PART(pA0, pA1, alA, j + 1); WAIT_BAR(2); K3NEXT();
    A_PART(pB0, pB1, pA0, pA1, alA, j + 2, false, false, true); B_PART(pB0, pB1, alB, j + 2); WAIT_BAR(0); K3NEXT();
  } else {
    A_PART(pA0, pA1, pB0, pB1, alB, 0, true, true, false); WAIT_BAR(3); K3NEXT();
    partialSM<true>(pA0, pA1, mhat, negm, alA);
    for (; j + 3 < NT; j += 2) {
      A_PART(pB0, pB1, pA0, pA1, alA, j, true, true, true); B1_PART(j); WAIT_BAR(3); K3NEXT(); B2_PART(pB0, pB1, alB, j);
      A_PART(pA0, pA1, pB0, pB1, alB, j + 1, true, true, true); B1_PART(j + 1); WAIT_BAR(3); K3NEXT(); B2_PART(pA0, pA1, alA, j + 1);
    }
    A_PART(pB0, pB1, pA0, pA1, alA, j, true, true, true); B1_PART(j); WAIT_BAR(3); K3NEXT(); B2_PART(pB0, pB1, alB, j);
    A_PART(pA0, pA1, pB0, pB1, alB, j + 1, false, true, true); B1_PART(j + 1); WAIT_BAR(2); K3NEXT(); B2_PART(pA0, pA1, alA, j + 1);
    A_PART(pB0, pB1, pA0, pA1, alA, j + 2, false, false, true); B1_PART(j + 2); WAIT_BAR(0); K3NEXT(); B2_PART(pB0, pB1, alB, j + 2);
  }
  finishSM(pB0, pB1, alB, l_reg, pa0, pa1, pa2, pa3); SBAR();
  pv_d0(o, vb0 + ((NT - 1) & 3) * SHM_V, pa0, pa1, pa2, pa3);
  WAIT_BAR(0);
  l_out = l_reg;
#undef A_PART
#undef SM_STEP
#undef B_PART
#undef B1_PART
#undef B2_PART
#undef K3NEXT
#undef DMA_K
#undef DMA_V
#undef RESC
}
#undef WAIT_BAR
#undef SBAR
}

#define GAS __attribute__((address_space(1)))
#define LAS __attribute__((address_space(3)))
typedef unsigned short bf16;
typedef unsigned v4u __attribute__((ext_vector_type(4)));
typedef float f32x4 __attribute__((ext_vector_type(4)));
typedef short bf16x8 __attribute__((ext_vector_type(8)));
typedef GAS unsigned gu32;
typedef GAS unsigned long long gu64;
#define RLX_AGENT __ATOMIC_RELAXED, __HIP_MEMORY_SCOPE_AGENT
#define LDS_WAIT() asm volatile("s_waitcnt lgkmcnt(0)" ::: "memory")
#define VM_WAIT() asm volatile("s_waitcnt vmcnt(0)" ::: "memory")
__device__ __forceinline__ unsigned long long rt() { return __builtin_amdgcn_s_memrealtime(); }
__device__ __forceinline__ unsigned f2bf(float f) { unsigned u = __builtin_bit_cast(unsigned, f); return (u + 0x7fffu + ((u >> 16) & 1u)) >> 16; }
__device__ __forceinline__ unsigned pk2(float lo, float hi) { return f2bf(lo) | (f2bf(hi) << 16); }
#define XB_TMO      128
#define XB_XCNT(j)  (256  + 64 * (j))
#define XB_XSUB(j)  (1280 + 64 * (j))
#define XB_XGEN(j)  (2304 + 64 * (j))
#define XB_TOP      3328
#define XB_TOPGEN   3392
#define XCD_BAR_WORDS 3456
#define XB_SPIN_CAP (1u << 18)

__device__ __forceinline__ unsigned xb_ld(unsigned* p)              { return __hip_atomic_load(p, __ATOMIC_RELAXED, __HIP_MEMORY_SCOPE_AGENT); }
__device__ __forceinline__ unsigned xb_add(unsigned* p, unsigned v) { return __hip_atomic_fetch_add(p, v, __ATOMIC_RELAXED, __HIP_MEMORY_SCOPE_AGENT); }
__device__ __forceinline__ unsigned xb_xcc_id() { return (unsigned)__builtin_amdgcn_s_getreg((3 << 11) | 20) & 0xFu; }
#define XB_SPIN(cond, bar) do { unsigned _sp = 0; while (cond) { __builtin_amdgcn_s_sleep(1); \
    if ((++_sp & 255u) == 0u) { if (xb_ld(&(bar)[XB_TMO])) break; if (_sp > XB_SPIN_CAP) { atomicAdd(&(bar)[XB_TMO], 1u); break; } } } } while (0)

struct XcdBarrier {
    unsigned* bar; unsigned x;
    volatile LAS unsigned* st;
};

__device__ __forceinline__ XcdBarrier xcd_barrier_post(unsigned* bar, volatile LAS unsigned* st) {
    XcdBarrier b; b.bar = bar; b.x = xb_xcc_id(); b.st = st;
    if (threadIdx.x == 0) (void)xb_add(&bar[XB_XCNT(b.x)], 1u);
    return b;
}
__device__ __forceinline__ void xcd_barrier_complete(unsigned* bar, unsigned x, unsigned& nloc, unsigned& nx) {
    const unsigned G = gridDim.x * gridDim.y * gridDim.z;
    unsigned sum, cnt, mine, sp = 0u;
    for (;;) {
        sum = 0u; cnt = 0u; mine = 0u;
#pragma unroll
        for (unsigned j = 0; j < 16; ++j) { const unsigned c = xb_ld(&bar[XB_XCNT(j)]); sum += c; cnt += (c > 0u) ? 1u : 0u; mine = (j == x) ? c : mine; }
        if (sum == G) break;
        __builtin_amdgcn_s_sleep(1);
        if ((++sp & 255u) == 0u) { if (xb_ld(&bar[XB_TMO])) break; if (sp > XB_SPIN_CAP) { atomicAdd(&bar[XB_TMO], 1u); break; } }
    }
    nloc = mine > 0u ? mine : 1u; nx = cnt > 0u ? cnt : 1u;
}

__device__ __forceinline__ void xcd_barrier(const XcdBarrier& b) {
    asm volatile("s_waitcnt vmcnt(0)" ::: "memory");
    __syncthreads();
    if (threadIdx.x == 0) {
        unsigned* bar = b.bar;
        __builtin_amdgcn_s_waitcnt(0);
        unsigned nloc = b.st[0], nx = b.st[1];
        if (nloc == 0u) { xcd_barrier_complete(bar, b.x, nloc, nx); b.st[0] = nloc; b.st[1] = nx; }
        const unsigned old = xb_add(&bar[XB_XSUB(b.x)], 1u);
        const unsigned gen = old / nloc;
        if (old + 1u == (gen + 1u) * nloc) {
            __builtin_amdgcn_fence(__ATOMIC_RELEASE, "agent");
            asm volatile("s_waitcnt vmcnt(0)" ::: "memory");
            const unsigned og = xb_add(&bar[XB_TOP], 1u);
            const unsigned tg = og / nx;
            if (og + 1u == (tg + 1u) * nx) xb_add(&bar[XB_TOPGEN], 1u);
            else XB_SPIN(xb_ld(&bar[XB_TOPGEN]) == tg, bar);
            __builtin_amdgcn_fence(__ATOMIC_ACQUIRE, "agent");
            xb_add(&bar[XB_XGEN(b.x)], 1u);
            asm volatile("s_waitcnt vmcnt(0)" ::: "memory");
        } else {
            XB_SPIN(xb_ld(&bar[XB_XGEN(b.x)]) == gen, bar);
            __builtin_amdgcn_fence(__ATOMIC_ACQUIRE, "agent");
            asm volatile("s_waitcnt vmcnt(0)" ::: "memory");
        }
    }
    __syncthreads();
}
constexpr int NWAVES = 8;
constexpr int TT = 24576, DM = 4096, DFF = 11008, NIN = 18432;
constexpr int NH = 16, AW = 2048, RW = 2048;
constexpr int NCHUNK = TT / 64;
constexpr float EPS = 1e-6f;
constexpr int NPHASE = 15;
#ifndef MK_PER_PHASE
#define MK_PER_PHASE 0
#endif

constexpr size_t MiB = 1u << 20;
constexpr size_t WS_CTL = 0, CTL_ZERO_BYTES = 1 * MiB;
constexpr size_t WS_ROPE = 1 * MiB;
constexpr size_t WS_RGW = 2 * MiB;
constexpr size_t WS_AGG = 4 * MiB;
constexpr size_t WS_CARRY = 16 * MiB;
constexpr size_t WS_ASCR = 22 * MiB;
constexpr int PADE = 128, LDH = DM + PADE, LDMID = DFF + PADE, LDO = AW + PADE;
constexpr size_t WS_WFI = 54 * MiB, WS_WFO = 232 * MiB;
constexpr size_t WS_WIN = 319 * MiB, WS_WA = 468 * MiB, WS_WR = WS_WA + (size_t)DM * AW * 2  , WS_WO = 502 * MiB;
constexpr size_t WS_H = 535 * MiB;
constexpr size_t WS_RR = WS_H + (size_t)TT * AW * 2;
constexpr size_t WS_BIG = 739 * MiB;
constexpr size_t WS_QKV = WS_BIG, WS_RXY = WS_BIG + 288 * MiB, WS_G = WS_BIG + 480 * MiB, WS_XR = WS_BIG + 864 * MiB, WS_END = WS_XR + 192 * MiB;
static_assert(WS_WFI + (size_t)2 * DFF * LDH * 2 <= WS_WFO && WS_WFO + (size_t)DM * LDMID * 2 <= WS_WIN && WS_WIN + (size_t)NIN * LDH * 2 <= WS_WA && WS_WA + (size_t)DM * AW * 2 <= WS_WR &&
              WS_WR + (size_t)DM * RW * 2 <= WS_WO && WS_WO + (size_t)DM * LDH * 2 <= WS_H && WS_H + (size_t)TT * LDH * 2 <= WS_BIG && WS_H + (size_t)TT * AW * 2 <= WS_RR && WS_RR + (size_t)TT * RW * 2 <= WS_BIG, "ws map");
static_assert(WS_QKV + (size_t)TT * 6144 * 2 <= WS_RXY && WS_RXY + (size_t)TT * 4096 * 2 <= WS_G && WS_G + (size_t)TT * 8192 * 2 <= WS_END && WS_BIG + (size_t)TT * LDMID * 2 <= WS_END && (size_t)TT * LDH * 2 <= 288 * MiB, "ws map 2");
constexpr int CW_BAR = 4096;
constexpr size_t WS_SSQ = WS_ASCR;
constexpr size_t WS_RSTD = WS_CTL + 512 * 1024;

constexpr int RING_OFF = 0, RING_BYTES = 131072;
constexpr int LDSCTL_OFF = RING_BYTES, MISC_OFF = LDSCTL_OFF + 320;
constexpr int LDS_BYTES = 147456;

struct Frame {
    LAS unsigned char* lds;
    volatile LAS unsigned* MISC;
    int tid, lane, wave;
    int vcu, G;
};
__device__ __forceinline__ float wave_sum(float v) {
#pragma unroll
    for (int o = 1; o < 64; o <<= 1) v += __shfl_xor(v, o);
    return v;
}
__device__ __forceinline__ int seq_start(int row) { return row < 4096 ? 0 : (row < 8192 ? 4096 : 8192); }
__device__ __forceinline__ int seq_end(int row) { return row < 4096 ? 4096 : (row < 8192 ? 8192 : TT); }

struct TItem { const float* src; bf16* WT; const float* gk; int N, drow0, k0, KT, mode; };
__device__ __forceinline__ void titem_load(const TItem& d, float (&v)[32]) {
#pragma unroll
    for (int i = 0; i < 32; ++i) v[i] = d.src[(size_t)(2 * i) * d.N];
}
__device__ __forceinline__ void titem_finish(const TItem& d, const float (&v)[32], LAS float* scr, int lane) {
#pragma unroll
    for (int i = 0; i < 32; ++i) scr[(2 * i + (lane >> 5)) * 33 + (lane & 31)] = v[i];
    LDS_WAIT(); asm volatile("" ::: "memory");
    const int c = lane & 7;
    f32x4 g0 = (f32x4){1.f, 1.f, 1.f, 1.f}, g1 = g0;
    if (d.gk) { g0 = *(const GAS f32x4*)(d.gk + d.k0 + 8 * c); g1 = *(const GAS f32x4*)(d.gk + d.k0 + 8 * c + 4); }
#pragma unroll
    for (int j = 0; j < 4; ++j) { const int n = (lane >> 3) + 8 * j; const LAS float* s = scr + (8 * c) * 33 + n;
        v4u o; o.x = pk2(s[0 * 33] * g0.x, s[1 * 33] * g0.y); o.y = pk2(s[2 * 33] * g0.z, s[3 * 33] * g0.w); o.z = pk2(s[4 * 33] * g1.x, s[5 * 33] * g1.y); o.w = pk2(s[6 * 33] * g1.z, s[7 * 33] * g1.w);
        GAS v4u* dp = d.mode == 0 ? (GAS v4u*)(d.WT + (size_t)(d.drow0 + n) * d.KT + d.k0 + 8 * c)
                                  : (GAS v4u*)((unsigned char*)d.WT + pg8::blk_off_b(d.drow0 + n, d.k0 + 8 * c, d.KT, d.mode == 2));
        *dp = o; }
    LDS_WAIT(); asm volatile("" ::: "memory");
}
__device__ __forceinline__ int ffn_in_row(int n) { return n < DFF ? (n >> 7) * 256 + (n & 127) : ((n - DFF) >> 7) * 256 + 128 + ((n - DFF) & 127); }
__device__ __forceinline__ TItem titem_matrix(const float* W, int K, int N, bf16* WT, int KT, int mode, int ffn, int item, int lane, const float* gk = nullptr) {
    const int nblk = N / 32, kb = item / nblk, nb = item % nblk, n0 = 32 * nb, k0 = 64 * kb;
    TItem d; d.src = W + (size_t)(k0 + (lane >> 5)) * N + n0 + (lane & 31); d.WT = WT; d.gk = gk; d.N = N; d.drow0 = ffn ? ffn_in_row(n0) : n0; d.k0 = k0; d.KT = KT; d.mode = mode; return d;
}
__device__ __forceinline__ void rms_row_to_bf16(const float* xrow, const float* g, bf16* Hb, int m, int lane) {
    const GAS f32x4* xr = (const GAS f32x4*)xrow + lane; const GAS f32x4* gr = (const GAS f32x4*)g + lane;
    f32x4 v[16]; float s = 0.f;
#pragma unroll
    for (int j = 0; j < 16; ++j) { v[j] = xr[64 * j]; s += (v[j].x * v[j].x + v[j].y * v[j].y) + (v[j].z * v[j].z + v[j].w * v[j].w); }
    const float rstd = 1.f / sqrtf(wave_sum(s) * (1.f / DM) + EPS);
#pragma unroll
    for (int j = 0; j < 16; ++j) { const f32x4 gg = gr[64 * j];
        *(GAS unsigned long long*)((unsigned char*)Hb + pg8::blk_off(m, 4 * lane + 256 * j, DM / 64)) =
            (unsigned long long)pk2(v[j].x * rstd * gg.x, v[j].y * rstd * gg.y) | ((unsigned long long)pk2(v[j].z * rstd * gg.z, v[j].w * rstd * gg.w) << 32); }
}
__device__ __forceinline__ void rms_row_bf16_to_bf16(const bf16* xrow, const float* g, bf16* Hb, int m, int lane) {
    const GAS v4u* xr = (const GAS v4u*)xrow + lane;
    v4u v[8]; float s = 0.f;
#pragma unroll
    for (int j = 0; j < 8; ++j) { v[j] = xr[64 * j]; const unsigned w[4] = {v[j].x, v[j].y, v[j].z, v[j].w};
#pragma unroll
        for (int k = 0; k < 4; ++k) { const float a = pg8::bf_lo(w[k]), b = pg8::bf_hi(w[k]); s += a * a + b * b; } }
    const float rstd = 1.f / sqrtf(wave_sum(s) * (1.f / DM) + EPS);
#pragma unroll
    for (int j = 0; j < 8; ++j) { const int col = 8 * lane + 512 * j; const f32x4 g0 = *(const GAS f32x4*)(g + col), g1 = *(const GAS f32x4*)(g + col + 4);
        v4u o; o.x = pk2(pg8::bf_lo(v[j].x) * rstd * g0.x, pg8::bf_hi(v[j].x) * rstd * g0.y); o.y = pk2(pg8::bf_lo(v[j].y) * rstd * g0.z, pg8::bf_hi(v[j].y) * rstd * g0.w);
        o.z = pk2(pg8::bf_lo(v[j].z) * rstd * g1.x, pg8::bf_hi(v[j].z) * rstd * g1.y); o.w = pk2(pg8::bf_lo(v[j].w) * rstd * g1.z, pg8::bf_hi(v[j].w) * rstd * g1.w);
        *(GAS v4u*)((unsigned char*)Hb + pg8::blk_off(m, col, DM / 64)) = o; }
}
__device__ __forceinline__ void rms_row_f32_inplace(float* xrow, const float* g, int lane) {
    GAS f32x4* xr = (GAS f32x4*)xrow + lane; const GAS f32x4* gr = (const GAS f32x4*)g + lane;
    f32x4 v[16]; float s = 0.f;
#pragma unroll
    for (int j = 0; j < 16; ++j) { v[j] = xr[64 * j]; s += (v[j].x * v[j].x + v[j].y * v[j].y) + (v[j].z * v[j].z + v[j].w * v[j].w); }
    const float rstd = 1.f / sqrtf(wave_sum(s) * (1.f / DM) + EPS);
#pragma unroll
    for (int j = 0; j < 16; ++j) { const f32x4 gg = gr[64 * j]; xr[64 * j] = v[j] * rstd * gg; }
}
__device__ __forceinline__ int recent_first_row(int it) { const int pp = it >> 8, s = pp >> 5, idx = pp & 31; return ((12 * (idx >> 2) + 4 * (2 - s) + (idx & 3)) << 8) + (it & 255); }
__device__ __forceinline__ void rms_row_bf16_to_f32(const bf16* Xb, int m, const float* g, float* orow, int lane) {
    v4u v[8]; float s = 0.f;
#pragma unroll
    for (int j = 0; j < 8; ++j) { v[j] = *(const GAS v4u*)((const unsigned char*)Xb + pg8::blk_off(m, 8 * lane + 512 * j, DM / 64)); const unsigned w[4] = {v[j].x, v[j].y, v[j].z, v[j].w};
#pragma unroll
        for (int k = 0; k < 4; ++k) { const float a = pg8::bf_lo(w[k]), b = pg8::bf_hi(w[k]); s += a * a + b * b; } }
    const float rstd = 1.f / sqrtf(wave_sum(s) * (1.f / DM) + EPS);
#pragma unroll
    for (int j = 0; j < 8; ++j) { const int col = 8 * lane + 512 * j; const f32x4 g0 = *(const GAS f32x4*)(g + col), g1 = *(const GAS f32x4*)(g + col + 4);
        *(GAS f32x4*)(orow + col) = (f32x4){pg8::bf_lo(v[j].x) * rstd * g0.x, pg8::bf_hi(v[j].x) * rstd * g0.y, pg8::bf_lo(v[j].y) * rstd * g0.z, pg8::bf_hi(v[j].y) * rstd * g0.w};
        *(GAS f32x4*)(orow + col + 4) = (f32x4){pg8::bf_lo(v[j].z) * rstd * g1.x, pg8::bf_hi(v[j].z) * rstd * g1.y, pg8::bf_lo(v[j].w) * rstd * g1.z, pg8::bf_hi(v[j].w) * rstd * g1.w}; }
}
__device__ __forceinline__ void rstd_phase(Frame& F, const float* ssq, float* rstd) {
    for (int m = F.vcu * (NWAVES * 64) + F.tid; m < TT; m += F.G * NWAVES * 64) { const GAS f32x4* p = (const GAS f32x4*)(ssq + (size_t)m * 64); float s = 0.f;
#pragma unroll
        for (int j = 0; j < 16; ++j) { const f32x4 v = p[j]; s += (v.x + v.y) + (v.z + v.w); }
        rstd[m] = 1.f / sqrtf(s * (1.f / DM) + EPS); }
}
__device__ __forceinline__ void rms_phase(Frame& F, const float* xa, const float* xb, const float* g, bf16* H) {
    const int gw = F.vcu * NWAVES + F.wave, NGW = F.G * NWAVES;
    for (int it = gw; it < TT; it += NGW) { const int m = recent_first_row(it); const float* xr = m < 8192 ? xa + (size_t)m * DM : xb + (size_t)(m - 8192) * DM; rms_row_to_bf16(xr, g, H, m, F.lane); }
}

constexpr int RL_XB = 0, RL_XF = 17408, RL_CW = 51200, RL_RAW = 53760, RL_RAWB = 33792;
static_assert(RL_RAW + 2 * RL_RAWB <= RING_BYTES, "rglru LDS");
template <bool REV> __device__ __forceinline__ void rl_scan(const float (&a)[4][4], const float (&u)[4][4], float cin, float (&h)[4][4], float& Atot, float& Hfin, int lane) {
    const int fq = lane >> 4, fr = lane & 15;
    const int src1 = (REV ? lane + 16 : lane - 16) & 63, src2 = (REV ? lane + 32 : lane - 32) & 63, srct = REV ? fr : fr + 48;
    const bool v1 = REV ? fq <= 2 : fq >= 1, v2 = REV ? fq <= 1 : fq >= 2;
    float C = cin; Atot = 1.f;
#pragma unroll
    for (int mtt = 0; mtt < 4; ++mtt) { const int mt = REV ? 3 - mtt : mtt;
        float P[4], Hl[4];
        if (!REV) { P[0] = a[mt][0]; Hl[0] = u[mt][0];
#pragma unroll
            for (int i = 1; i < 4; ++i) { P[i] = a[mt][i] * P[i - 1]; Hl[i] = a[mt][i] * Hl[i - 1] + u[mt][i]; } }
        else { P[3] = a[mt][3]; Hl[3] = u[mt][3];
#pragma unroll
            for (int i = 2; i >= 0; --i) { P[i] = a[mt][i] * P[i + 1]; Hl[i] = a[mt][i] * Hl[i + 1] + u[mt][i]; } }
        float As = REV ? P[0] : P[3], Hs = REV ? Hl[0] : Hl[3];
        { const float Ap = __shfl(As, src1), Hp = __shfl(Hs, src1); if (v1) { Hs = As * Hp + Hs; As = As * Ap; } }
        { const float Ap = __shfl(As, src2), Hp = __shfl(Hs, src2); if (v2) { Hs = As * Hp + Hs; As = As * Ap; } }
        float Ae = __shfl(As, src1), He = __shfl(Hs, src1); if (!v1) { Ae = 1.f; He = 0.f; }
        const float At = __shfl(As, srct), Ht = __shfl(Hs, srct);
        const float E = Ae * C + He;
#pragma unroll
        for (int i = 0; i < 4; ++i) h[mt][i] = P[i] * E + Hl[i];
        C = At * C + Ht; Atot *= At; }
    Hfin = C;
}
__device__ __forceinline__ float gelu_tanh(float x) {
    const float z = 0.7978845608028654f * (x + 0.044715f * x * x * x);
    const float e = __builtin_amdgcn_exp2f(2.f * 1.4426950408889634f * z);
    const float th = 1.f - 2.f * __builtin_amdgcn_rcpf(e + 1.f);
    return 0.5f * x * (1.f + th);
}
__device__ __forceinline__ void rl_glds16(const void* gsrc, unsigned lds_dst) { unsigned keep;
    asm volatile("s_mov_b32 %0, m0\n\ts_mov_b32 m0, %2\n\ts_nop 0\n\tglobal_load_lds_dwordx4 %1, off\n\ts_mov_b32 m0, %0" : "=&s"(keep) : "v"(gsrc), "s"(lds_dst) : "memory"); }
template <bool FINAL>
__device__ __forceinline__ void rglru_phase(Frame& F, const bf16* RXY, const bf16* RGW, const float* conv_w, const float* conv_b, const float* rg_ba, const float* rg_bx,
                                            const float* rg_lambda, float* AGG, const float* CARRY, bf16* RR) {
    typedef short bf16x8 __attribute__((ext_vector_type(8)));
    const int tid = F.tid, lane = F.lane, w = F.wave, fr = lane & 15, fq = lane >> 4;
    const int n = F.vcu & 15, cl = 16 * w + fr, cg = n * 128 + cl;
    LAS unsigned char* L = F.lds + RING_OFF;
    LAS float* CW = (LAS float*)(L + RL_CW);
    for (int i = tid; i < 640; i += NWAVES * 64) CW[i] = i < 512 ? conv_w[(i >> 7) * RW + n * 128 + (i & 127)] : conv_b[n * 128 + (i - 512)];
    bf16x8 Bf[4][4]; float bias[4], sp[2];
#pragma unroll
    for (int g = 0; g < 4; ++g) {
#pragma unroll
        for (int ks = 0; ks < 4; ++ks) Bf[g][ks] = *(const bf16x8*)(RGW + ((size_t)(g * 16 + n) * 128 + cl) * 128 + 32 * ks + 8 * fq);
        bias[g] = (g & 1) ? rg_bx[((g >> 1) * 16 + n) * 128 + cl] : rg_ba[((g >> 1) * 16 + n) * 128 + cl]; }
#pragma unroll
    for (int d = 0; d < 2; ++d) sp[d] = log1pf(__expf(-rg_lambda[d * RW + cg]));
    __syncthreads();
    const int t = tid >> 3, c16 = (tid & 7) * 16;
    float k1[2];
#pragma unroll
    for (int d = 0; d < 2; ++d) k1[d] = -8.f * 1.4426950408889634f * sp[d];
#ifndef RL_PASSES
#define RL_PASSES 1
#endif
    const int cstep = F.G >> 4, cfirst = F.vcu >> 4;
#define RL_DMA(ci_, buf_) do { const int row0_ = (ci_) * 64, s0_ = seq_start(row0_), s1_ = seq_end(row0_); \
        _Pragma("unroll") for (int k_ = 0; k_ < (FINAL ? 5 : 3); ++k_) { int q_ = w + NWAVES * k_; q_ = q_ < (FINAL ? 33 : 17) ? q_ : (FINAL ? 32 : 16);     \
            const int lr_ = 4 * (q_ < 17 ? q_ : q_ - 17) + (lane >> 4); int gr_ = q_ < 17 ? row0_ - 2 + lr_ : row0_ + lr_; gr_ = gr_ < s0_ ? s0_ : (gr_ >= s1_ ? s1_ - 1 : gr_); \
            const bf16* gp_ = RXY + (size_t)gr_ * 4096 + (q_ < 17 ? 0 : 2048) + n * 128 + (lane & 15) * 8; \
            rl_glds16(gp_, (unsigned)__builtin_amdgcn_readfirstlane((int)(lds0 + RL_RAW + (buf_) * RL_RAWB + q_ * 1024))); } } while (0)
    const unsigned lds0 = (unsigned)(uintptr_t)L;
    {
#define RL_WRAP(x) ((x) >= NCHUNK ? (x) - NCHUNK : (x))
    float cnx[2] = {0.f, 0.f};
    if (cfirst < NCHUNK) { RL_DMA(cfirst, 0); if (FINAL) { cnx[0] = CARRY[(size_t)(cfirst * 2 + 0) * RW + cg]; cnx[1] = CARRY[(size_t)(cfirst * 2 + 1) * RW + cg]; } }
    int buf = 0;
    for (int cl_ = cfirst; cl_ < NCHUNK * RL_PASSES; cl_ += cstep, buf ^= 1) { const int ci = RL_WRAP(cl_);
        const int row0 = ci * 64, s0 = seq_start(row0), s1 = seq_end(row0);
        LAS unsigned char* RAW = L + RL_RAW + buf * RL_RAWB; LAS unsigned char* YR = RAW + 68 * 256;
        asm volatile("s_waitcnt vmcnt(0) lgkmcnt(0)" ::: "memory"); __builtin_amdgcn_s_barrier(); asm volatile("" ::: "memory");
        const float cin2[2] = {cnx[0], cnx[1]};
        if (cl_ + cstep < NCHUNK * RL_PASSES) { const int cn = RL_WRAP(cl_ + cstep); RL_DMA(cn, buf ^ 1);
            if (FINAL) { cnx[0] = CARRY[(size_t)(cn * 2 + 0) * RW + cg]; cnx[1] = CARRY[(size_t)(cn * 2 + 1) * RW + cg]; } }
        { float xa[16];
#pragma unroll
          for (int k = 0; k < 16; ++k) xa[k] = CW[512 + c16 + k];
#pragma unroll
          for (int j = 0; j < 4; ++j) { const int rr = row0 + t + j - 2; const float msk = (rr >= s0 && rr < s1) ? 1.f : 0.f;
              const LAS v4u* rp = (const LAS v4u*)(RAW + (t + j) * 256 + c16 * 2); const v4u q0 = rp[0], q1 = rp[1];
              const unsigned ww[8] = {q0.x, q0.y, q0.z, q0.w, q1.x, q1.y, q1.z, q1.w};
#pragma unroll
              for (int k = 0; k < 8; ++k) { xa[2 * k] += CW[j * 128 + c16 + 2 * k] * (msk * pg8::bf_lo(ww[k])); xa[2 * k + 1] += CW[j * 128 + c16 + 2 * k + 1] * (msk * pg8::bf_hi(ww[k])); } }
          LAS f32x4* xf = (LAS f32x4*)(L + RL_XF + t * 528 + c16 * 4);
#pragma unroll
          for (int k = 0; k < 4; ++k) xf[k] = (f32x4){xa[4 * k], xa[4 * k + 1], xa[4 * k + 2], xa[4 * k + 3]};
          LAS v4u* xb = (LAS v4u*)(L + RL_XB + t * 272 + c16 * 2);
          xb[0] = (v4u){pk2(xa[0], xa[1]), pk2(xa[2], xa[3]), pk2(xa[4], xa[5]), pk2(xa[6], xa[7])};
          xb[1] = (v4u){pk2(xa[8], xa[9]), pk2(xa[10], xa[11]), pk2(xa[12], xa[13]), pk2(xa[14], xa[15])}; }
        asm volatile("s_waitcnt lgkmcnt(0)" ::: "memory"); __builtin_amdgcn_s_barrier(); asm volatile("" ::: "memory");
        float hsum[4][4];
#pragma unroll
        for (int d = 0; d < 2; ++d) {
            float a[4][4], u[4][4];
#pragma unroll
            for (int mt = 0; mt < 4; ++mt) {
                f32x4 ca = (f32x4){bias[2 * d], bias[2 * d], bias[2 * d], bias[2 * d]}, cx = (f32x4){bias[2 * d + 1], bias[2 * d + 1], bias[2 * d + 1], bias[2 * d + 1]};
#pragma unroll
                for (int ks = 0; ks < 4; ++ks) { const bf16x8 af = *(const LAS bf16x8*)(L + RL_XB + (16 * mt + fr) * 272 + (32 * ks + 8 * fq) * 2);
                    ca = __builtin_amdgcn_mfma_f32_16x16x32_bf16(af, Bf[2 * d][ks], ca, 0, 0, 0); cx = __builtin_amdgcn_mfma_f32_16x16x32_bf16(af, Bf[2 * d + 1][ks], cx, 0, 0, 0); }
#pragma unroll
                for (int i = 0; i < 4; ++i) { const float ra = pg8::sigm(ca[i]), ia = pg8::sigm(cx[i]);
                    const float xv = *(const LAS float*)(L + RL_XF + (16 * mt + 4 * fq + i) * 528 + cl * 4);
                    const float av = __builtin_amdgcn_exp2f(k1[d] * ra);
                    a[mt][i] = av; u[mt][i] = __builtin_amdgcn_sqrtf(fmaxf(fmaf(-av, av, 1.f), 0.f)) * (ia * xv); } }
            float h[4][4], Atot, Hfin;
            const float cin = cin2[d];
            if (d == 0) rl_scan<false>(a, u, cin, h, Atot, Hfin, lane); else rl_scan<true>(a, u, cin, h, Atot, Hfin, lane);
            if (FINAL) {
#pragma unroll
                for (int mt = 0; mt < 4; ++mt)
#pragma unroll
                    for (int i = 0; i < 4; ++i) hsum[mt][i] = d == 0 ? h[mt][i] : hsum[mt][i] + h[mt][i]; }
            else if (fq == 0) { float2 ah; ah.x = Atot; ah.y = Hfin; *(float2*)(AGG + ((size_t)(ci * 2 + d) * RW + cg) * 2) = ah; }
        }
        if (FINAL) {
#pragma unroll
            for (int mt = 0; mt < 4; ++mt)
#pragma unroll
                for (int i = 0; i < 4; ++i) { LAS unsigned short* yp = (LAS unsigned short*)(YR + (16 * mt + 4 * fq + i) * 256 + cl * 2);
                    const float y = __uint_as_float((unsigned)(*yp) << 16); *yp = (unsigned short)f2bf(hsum[mt][i] * gelu_tanh(y)); }
            asm volatile("s_waitcnt lgkmcnt(0)" ::: "memory"); __builtin_amdgcn_s_barrier(); asm volatile("" ::: "memory");
            { const LAS v4u* yb = (const LAS v4u*)(YR + t * 256 + c16 * 2); const v4u o0 = yb[0], o1 = yb[1]; *(v4u*)((unsigned char*)RR + pg8::blk_off(row0 + t, n * 128 + c16, RW / 64)) = o0; *(v4u*)((unsigned char*)RR + pg8::blk_off(row0 + t, n * 128 + c16 + 8, RW / 64)) = o1; }
        }
    }
    asm volatile("s_waitcnt vmcnt(0) lgkmcnt(0)" ::: "memory"); __builtin_amdgcn_s_barrier(); asm volatile("" ::: "memory"); }
#undef RL_DMA
#undef RL_WRAP
}
__device__ __forceinline__ void carry_phase(Frame& F, const float* AGG, float* CARRY) {
    const int gt = F.vcu * (NWAVES * 64) + F.tid;
    if (gt >= 3 * 2 * RW) return;
    const int s = gt / (2 * RW), d = (gt / RW) & 1, c = gt % RW;
    const int c0 = s == 0 ? 0 : (s == 1 ? 64 : 128), c1 = s == 0 ? 64 : (s == 1 ? 128 : NCHUNK);
    float carry = 0.f;
    for (int b = 0; b < c1 - c0; b += 32) {
        float2 ah[32];
#pragma unroll
        for (int k = 0; k < 32; ++k) { const int ch = d == 0 ? c0 + b + k : c1 - 1 - b - k; ah[k] = *(const float2*)(AGG + ((size_t)(ch * 2 + d) * RW + c) * 2); }
#pragma unroll
        for (int k = 0; k < 32; ++k) { const int ch = d == 0 ? c0 + b + k : c1 - 1 - b - k; CARRY[(size_t)(ch * 2 + d) * RW + c] = carry; carry = ah[k].x * carry + ah[k].y; }
    }
}

#ifndef ATT_FORCE_SLOW
#define ATT_FORCE_SLOW 0
#endif
#ifndef GEMM_SP2
#define GEMM_SP2 true
#endif
#ifndef ALL_WGM
#define ALL_WGM 4
#endif
#ifndef GEMM_REV
#define GEMM_REV 0xB
#endif
#ifndef FFO_CSPLIT
#define FFO_CSPLIT 1
#endif
#ifndef FFO_WGM
#define FFO_WGM 4
#endif
#ifndef TAIL_FILL
#define TAIL_FILL 0
#endif
#ifndef SKEW_TICKS
#define SKEW_TICKS 0
#endif
#define PHASE_SKEW() do { if (SKEW_TICKS) { const unsigned long long t0_ = __builtin_amdgcn_s_memrealtime(); const unsigned long long d_ = (unsigned long long)((F.vcu * 8 / F.G) & 7) * SKEW_TICKS; \
        while (__builtin_amdgcn_s_memrealtime() - t0_ < d_) __builtin_amdgcn_s_sleep(16); } } while (0)
#define RESID_WMODE (RESID_PERM ? 2 : 1)
#ifndef RESID_ALIGN
#define RESID_ALIGN true
#endif
struct Args { const float* in[26]; float* out; unsigned char* ws; int ph_lo, ph_hi, li, pad; };
__device__ __forceinline__ double rope_rev(int j) {
    return j == 0 ? 0.15915494309189535 : j == 1 ? 0.03086376340470123 : j == 2 ? 0.005985185712713705 : j == 3 ? 0.001160663641240061 :
           j == 4 ? 0.00022507907903927653 : j == 5 ? 4.364795279280289e-05 : j == 6 ? 8.464330808241401e-06 : 1.6414262627950345e-06;
}
#define TRANSPOSE_STREAM(DESC, NIT) do { int it_ = gw; if (it_ < (NIT)) { float va_[32], vb_[32]; TItem da_ = DESC(it_), db_; titem_load(da_, va_); \
        for (;;) { int nx_ = it_ + NGW; bool hn_ = nx_ < (NIT); db_ = DESC(hn_ ? nx_ : it_); titem_load(db_, vb_); titem_finish(da_, va_, scr, F.lane); if (!hn_) break; it_ = nx_; \
                   nx_ = it_ + NGW; hn_ = nx_ < (NIT); da_ = DESC(hn_ ? nx_ : it_); titem_load(da_, va_); titem_finish(db_, vb_, scr, F.lane); if (!hn_) break; it_ = nx_; } } } while (0)
__global__ void __launch_bounds__(NWAVES * 64, 2) mk_fwd(Args args) {
    extern __shared__ __attribute__((aligned(16))) unsigned char lds[];
    Frame F;
    F.lds = (LAS unsigned char*)lds;
    F.MISC = (volatile LAS unsigned*)(F.lds + MISC_OFF);
    F.tid = threadIdx.x; F.lane = F.tid & 63; F.wave = __builtin_amdgcn_readfirstlane(F.tid >> 6);
    F.G = gridDim.x; { const int bx = blockIdx.x; F.vcu = (F.G % 8 == 0) ? (bx % 8) * (F.G / 8) + bx / 8 : bx; }
    unsigned char* ws = args.ws;
    gu32* ctl = (gu32*)(ws + WS_CTL);
    const float* x_prompt = args.in[0]; const float* x_sample = args.in[1];
    const float* ffn1_norm = args.in[2]; const float* ffn1_w_in = args.in[3]; const float* ffn1_w_out = args.in[4];
    const float* mix_norm = args.in[5]; const float* w_in = args.in[6];
    const float* lq1 = args.in[7]; const float* lk1 = args.in[8]; const float* lq2 = args.in[9]; const float* lk2 = args.in[10];
    const float* subln_gain = args.in[11]; const float* conv_w = args.in[12]; const float* conv_b = args.in[13];
    const float* rg_wa = args.in[14]; const float* rg_ba = args.in[15]; const float* rg_wx = args.in[16]; const float* rg_bx = args.in[17]; const float* rg_lambda = args.in[18];
    const float* w_attn = args.in[19]; const float* w_rnn = args.in[20]; const float* w_out = args.in[21];
    const float* ffn2_norm = args.in[22]; const float* ffn2_w_in = args.in[23]; const float* ffn2_w_out = args.in[24]; const float* final_norm = args.in[25];
    float* out = args.out;
    float* ROPE = (float*)(ws + WS_ROPE); bf16* RGW = (bf16*)(ws + WS_RGW); float* AGG = (float*)(ws + WS_AGG); float* CARRY = (float*)(ws + WS_CARRY);
    bf16* WFI = (bf16*)(ws + WS_WFI); bf16* WFO = (bf16*)(ws + WS_WFO); bf16* WIN = (bf16*)(ws + WS_WIN); bf16* WA = (bf16*)(ws + WS_WA); bf16* WR = (bf16*)(ws + WS_WR); bf16* WO = (bf16*)(ws + WS_WO);
    bf16* H = (bf16*)(ws + WS_H); bf16* OB = H; bf16* RR = (bf16*)(ws + WS_RR);
    bf16* XR = (bf16*)(ws + WS_XR); float* SSQ = (float*)(ws + WS_SSQ); float* RSTD = (float*)(ws + WS_RSTD); bf16* MID = (bf16*)(ws + WS_BIG); bf16* QKV = (bf16*)(ws + WS_QKV); bf16* RXY = (bf16*)(ws + WS_RXY); bf16* GT = (bf16*)(ws + WS_G); bf16* MG = QKV;

    for (int u = F.tid; u < (LDS_BYTES - LDSCTL_OFF) / 4; u += NWAVES * 64) ((LAS unsigned*)(F.lds + LDSCTL_OFF))[u] = 0u;
    __syncthreads();
    XcdBarrier bar; bar.bar = (unsigned*)(ctl + CW_BAR) + args.li * XCD_BAR_WORDS; bar.x = 0; bar.st = nullptr;
    if (!MK_PER_PHASE) bar = xcd_barrier_post((unsigned*)(ctl + CW_BAR) + args.li * XCD_BAR_WORDS, F.MISC + 8);
#define GRID_BAR() do { xcd_barrier(bar); } while (0)
    const int lo = args.ph_lo, hi = args.ph_hi;
#ifndef PH_MASK
#define PH_MASK 0x7fff
#endif
#define IN(k) (((PH_MASK >> (k)) & 1) && lo <= (k) && (k) < hi)
#define BOTH(k) (IN(k) && IN((k) + 1))
#ifndef PH_REP
#define PH_REP 0
#endif
#define REPS(k) ((((PH_REP) >> (k)) & 1) + 1)
    const int gw = F.vcu * NWAVES + F.wave, NGW = F.G * NWAVES;
    LAS float* scr = (LAS float*)(F.lds + RING_OFF + F.wave * 16384);

#ifndef PROBE_ALL2_LO
#define PROBE_ALL2_LO 0
#define PROBE_ALL2_HI (NPHASE - 1)
#endif
#ifndef PROBE_ALL2
#define PROBE_ALL2 0
#endif
    if (IN(0))
_Pragma("unroll")
    for (int rep = 0; rep < REPS(0); ++rep) {
        constexpr int I_FI = (DM / 64) * (2 * DFF / 32), I_FO = (DFF / 64) * (DM / 32), I_IN = (DM / 64) * (NIN / 32), I_A = (AW / 64) * (DM / 32), I_O = (DM / 64) * (DM / 32), I_RG = 512;
        constexpr int NITEMS = I_FI + I_IN + I_O + I_RG + (TAIL_FILL ? 0 : I_FO + 2 * I_A);
        auto desc0 = [&](int it) -> TItem {
            int r = it;
            if (r < I_FI) return titem_matrix(ffn1_w_in, DM, 2 * DFF, WFI, DM / 64, 2, 1, r, F.lane); r -= I_FI;
            if (r < I_IN) return titem_matrix(w_in, DM, NIN, WIN, DM / 64, 2, 0, r, F.lane, mix_norm); r -= I_IN;
            if (r < I_O) return titem_matrix(w_out, DM, DM, WO, DM / 64, RESID_WMODE, 0, r, F.lane); r -= I_O;
            if (!TAIL_FILL) {
            if (r < I_FO) return titem_matrix(ffn1_w_out, DFF, DM, WFO, DFF / 64, RESID_WMODE, 0, r, F.lane); r -= I_FO;
            if (r < I_A) return titem_matrix(w_attn, AW, DM, WA, AW / 64, 2, 0, r, F.lane); r -= I_A;
            if (r < I_A) return titem_matrix(w_rnn, RW, DM, WR, RW / 64, 2, 0, r, F.lane); r -= I_A; }
            const int blk = r >> 3, sub = r & 7, gate = blk >> 5, b = blk & 31, dir = b >> 4, n = b & 15;
            return titem_matrix((gate ? rg_wx : rg_wa) + (size_t)b * 16384, 128, 128, RGW + (size_t)((dir * 2 + gate) * 16 + n) * 16384, 128, 0, 0, sub, F.lane);
        };
        TRANSPOSE_STREAM(desc0, NITEMS);
        for (int idx = gw * 64 + F.lane; idx < 16384 * 8; idx += NGW * 64) { const int pos = idx >> 3, j = idx & 7;
            double rev = (double)pos * rope_rev(j); rev -= __builtin_floor(rev); const float rf = (float)rev;
            float2 cs; cs.x = __builtin_amdgcn_cosf(rf); cs.y = __builtin_amdgcn_sinf(rf); *(float2*)(ROPE + 2 * (size_t)idx) = cs; }
        rms_phase(F, x_prompt, x_sample, ffn1_norm, H);
        if (BOTH(0) || rep + 1 < REPS(0)) GRID_BAR();
    }
    if (IN(1))
_Pragma("unroll")
    for (int rep = 0; rep < REPS(1); ++rep) {
        pg8::Gemm g{H, WFI, TT, 2 * DFF, DM, LDH, LDH}; pg8::StaticOrder S; S.init(TT, 2 * DFF, F.G, (int)blockIdx.x, ALL_WGM); S.rev = (GEMM_REV >> 5) & 1;
        pg8::EpiSwiGLU E{MID, DFF / 64, nullptr};
        pg8::gemm_phase<pg8::EpiSwiGLU, pg8::StaticOrder, true, GEMM_SP2>(F.lds + RING_OFF, g, S, E);
        if (TAIL_FILL && rep == 0) {
            constexpr int I_FO = (DFF / 64) * (DM / 32), I_A = (AW / 64) * (DM / 32);
            const int tail = ((TT / 256) * (2 * DFF / 256)) % F.G, nidle = tail ? F.G - tail : F.G, iw = tail ? (int)blockIdx.x - tail : (int)blockIdx.x;
            if (iw >= 0) { const int gw = iw * NWAVES + F.wave, NGW = nidle * NWAVES;
                auto desc1 = [&](int it) -> TItem { int r = it;
                    if (r < I_FO) return titem_matrix(ffn1_w_out, DFF, DM, WFO, DFF / 64, RESID_WMODE, 0, r, F.lane); r -= I_FO;
                    if (r < I_A) return titem_matrix(w_attn, AW, DM, WA, AW / 64, 2, 0, r, F.lane); r -= I_A;
                    return titem_matrix(w_rnn, RW, DM, WR, RW / 64, 2, 0, r, F.lane); };
                TRANSPOSE_STREAM(desc1, I_FO + 2 * I_A); } }
        if (BOTH(1) || rep + 1 < REPS(1)) GRID_BAR();
    }
#ifdef PROBE_P2B
    if (IN(2)) {
        pg8::Gemm g{MID, WFO, TT, DM, DFF, LDMID, LDMID}; pg8::StaticOrder S; S.init(TT, DM, F.G, (int)blockIdx.x, FFO_WGM); S.csplit = FFO_CSPLIT; S.rev = (GEMM_REV >> 0) & 1;
        pg8::EpiPlainBf16 E{H, 0.5f};
        pg8::gemm_phase<pg8::EpiPlainBf16, pg8::StaticOrder, true, GEMM_SP2>(F.lds + RING_OFF, g, S, E);
        GRID_BAR();
    }
#endif
    if (IN(2))
_Pragma("unroll")
    for (int rep = 0; rep < REPS(2); ++rep) {
        pg8::Gemm g{MID, WFO, TT, DM, DFF, LDMID, LDMID}; pg8::StaticOrder S; S.init(TT, DM, F.G, (int)blockIdx.x, FFO_WGM); S.csplit = FFO_CSPLIT; S.rev = (GEMM_REV >> 0) & 1;
        pg8::EpiResidT<false, true> E{x_prompt, x_sample, 8192, XR, DM, 0.5f, SSQ};
        PHASE_SKEW();
        pg8::gemm_phase<pg8::EpiResidT<false, true>, pg8::StaticOrder, RESID_ALIGN, GEMM_SP2>(F.lds + RING_OFF, g, S, E);
        if (BOTH(2) || rep + 1 < REPS(2)) GRID_BAR();
    }
    if (IN(3))
_Pragma("unroll")
    for (int rep = 0; rep < REPS(3); ++rep) {
        rstd_phase(F, SSQ, RSTD);
        constexpr int I_FI = (DM / 64) * (2 * DFF / 32), I_FO = (DFF / 64) * (DM / 32);
        auto desc3 = [&](int it) -> TItem { return it < I_FI ? titem_matrix(ffn2_w_in, DM, 2 * DFF, WFI, DM / 64, 2, 1, it, F.lane, ffn2_norm) : titem_matrix(ffn2_w_out, DFF, DM, WFO, DFF / 64, RESID_WMODE, 0, it - I_FI, F.lane); };
        TRANSPOSE_STREAM(desc3, I_FI + (TAIL_FILL ? 0 : I_FO));
        if (BOTH(3) || rep + 1 < REPS(3)) GRID_BAR();
    }
    if (IN(4))
_Pragma("unroll")
    for (int rep = 0; rep < REPS(4); ++rep) {
        pg8::Gemm g{XR, WIN, TT, NIN, DM, LDH, LDH}; pg8::StaticOrder S; S.init(TT, NIN, F.G, (int)blockIdx.x, ALL_WGM); S.rev = (GEMM_REV >> 4) & 1;
        pg8::EpiProj E{QKV, RXY, GT, ROPE, RSTD};
        pg8::gemm_phase<pg8::EpiProj, pg8::StaticOrder, true, GEMM_SP2>(F.lds + RING_OFF, g, S, E);
        if (BOTH(4) || rep + 1 < REPS(4)) GRID_BAR();
    }
    if (IN(5))
_Pragma("unroll")
    for (int rep = 0; rep < REPS(5); ++rep) {
        rglru_phase<false>(F, RXY, RGW, conv_w, conv_b, rg_ba, rg_bx, rg_lambda, AGG, CARRY, RR);
        if (BOTH(5) || rep + 1 < REPS(5)) GRID_BAR();
    }
    if (IN(6))
_Pragma("unroll")
    for (int rep = 0; rep < REPS(6); ++rep) {
        carry_phase(F, AGG, CARRY);
        const float lam = __expf(wave_sum(lq1[F.lane] * lk1[F.lane])) - __expf(wave_sum(lq2[F.lane] * lk2[F.lane])) + 0.2f;
        const int lane = F.lane, r32 = lane & 31, hi = lane >> 5, wid = F.wave;
        char* alds = (char*)lds + RING_OFF;
        const __amdgpu_buffer_rsrc_t qkv_rs = __builtin_amdgcn_make_buffer_rsrc((void*)QKV, 0, (int)((size_t)TT * 6144 * 2), 0x00020000);
        float* li_l = (float*)(alds + att::LDS_WS) + wid * 64;
#ifndef ATT_PASSES
#define ATT_PASSES 1
#endif
        for (int L_ = F.vcu; L_ < 1536 * ATT_PASSES; L_ += F.G) { const int L = L_ >= 1536 ? L_ - 1536 : L_;
            int h, qb, row0, seqlen;
            if (L < 1024) { const int i = L >> 8, xcd = (L & 255) >> 5, loc = L & 31; h = 2 * xcd + (i >> 1); qb = 32 * (i & 1) + loc; row0 = 8192; seqlen = 16384; }
            else { const int Lp = L - 1024, j = Lp >> 8, xcd = (Lp & 255) >> 5, loc = Lp & 31, pair = 4 * xcd + 2 * j + (loc >> 4); qb = loc & 15; h = pair & 15; row0 = (pair >> 4) * 4096; seqlen = 4096; }
            for (int m = 0; m < 2; ++m) {
                const unsigned qo = (unsigned)(((row0 + qb * 256) * 2048 + h * 128 + m * 64) * 2);
                const char* kbase = (const char*)QKV + pg8::QKV_KOFF + (size_t)((((row0 >> 6) * 16 + h) * 2 + m)) * 8192;
                const char* vbase = (const char*)QKV + pg8::QKV_VOFF + (size_t)((row0 >> 6) * 16 + h) * 16384;
                att::f32x16 o[4]; float l;
                att::attn_map_body<true>(qkv_rs, qo, kbase, vbase, seqlen, alds, o, l);
                {
                    LAS unsigned* ovf = (LAS unsigned*)(F.lds + RING_OFF + att::LDS_BYTES);
                    const bool bad = ATT_FORCE_SLOW || !(l < 1e30f);
                    const bool anyb = __any(bad);
                    if (lane == 0) ovf[wid] = anyb ? 1u : 0u;
                    asm volatile("s_waitcnt lgkmcnt(0)" ::: "memory"); __syncthreads();
                    unsigned any8 = 0;
#pragma unroll
                    for (int w8 = 0; w8 < 8; ++w8) any8 |= ovf[w8];
                    __syncthreads();
                    if (any8) att::attn_map_body<false>(qkv_rs, qo, kbase, vbase, seqlen, alds, o, l);
                }
                if (hi == 0) li_l[r32] = l;
                asm volatile("s_waitcnt lgkmcnt(0)" ::: "memory");
                float rli[16];
#pragma unroll
                for (int r = 0; r < 16; ++r) rli[r] = __builtin_amdgcn_rcpf(li_l[att::crow(r, hi)]);
                float* const swb = (float*)(ws + WS_ASCR) + (size_t)blockIdx.x * (256 * 128);
                unsigned swo = (unsigned)(((wid * 32 + 4 * hi) * 128 + r32) * 4); asm volatile("" : "+v"(swo));
#define SWL(idx) (*(float*)((unsigned char*)swb + swo + (idx) * 4))
                if (m == 0) {
#pragma unroll
                    for (int r = 0; r < 16; ++r)
#pragma unroll
                        for (int d0 = 0; d0 < 4; ++d0) SWL(((r & 3) + 8 * (r >> 2)) * 128 + d0 * 32) = o[d0][r] * rli[r];
                    asm volatile("s_waitcnt vmcnt(0)" ::: "memory");
                } else {
                    const int orow0 = row0 + qb * 256 + wid * 32;
                    unsigned char* const obb = (unsigned char*)OB + pg8::blk_off(orow0, h * 128, AW / 64);
                    unsigned ob0 = (unsigned)(hi * 256 + r32 * 2); asm volatile("" : "+v"(ob0));
                    unsigned ob1 = (unsigned)(hi * 256 + ((r32 * 2) ^ 32)); asm volatile("" : "+v"(ob1));
                    float gain[4];
#pragma unroll
                    for (int d0 = 0; d0 < 4; ++d0) gain[d0] = subln_gain[d0 * 32 + r32] * 0.8f;
#pragma unroll
                    for (int r = 0; r < 16; ++r) { const int rb = (r & 3) + 8 * (r >> 2); float ss = 0.f; float v[4];
#pragma unroll
                        for (int d0 = 0; d0 < 4; ++d0) { v[d0] = SWL(rb * 128 + d0 * 32) - lam * (o[d0][r] * rli[r]); ss += v[d0] * v[d0]; }
                        ss += __shfl_xor(ss, 1); ss += __shfl_xor(ss, 2); ss += __shfl_xor(ss, 4); ss += __shfl_xor(ss, 8); ss += __shfl_xor(ss, 16);
                        const float rs = 1.f / sqrtf(ss * (1.f / 128.f) + EPS);
#pragma unroll
                        for (int d0 = 0; d0 < 4; ++d0) { const int coff = (d0 >> 1) * 32768 + ((rb >> 4) * 2 + (d0 & 1)) * 1024 + (rb & 15) * 64;
                            *(bf16*)(obb + (((rb & 8) ? ob1 : ob0) + (unsigned)coff)) = (bf16)f2bf(v[d0] * rs * gain[d0]); } }
                }
#undef SWL
                __syncthreads();
            }
        }
        if (BOTH(6) || rep + 1 < REPS(6)) GRID_BAR();
    }
    if (IN(7))
_Pragma("unroll")
    for (int rep = 0; rep < REPS(7); ++rep) {
        rglru_phase<true>(F, RXY, RGW, conv_w, conv_b, rg_ba, rg_bx, rg_lambda, AGG, CARRY, RR);
        if (BOTH(7) || rep + 1 < REPS(7)) GRID_BAR();
    }
#ifndef PROBE_P89
#define PROBE_P89 0
#endif
_Pragma("unroll")
    for (int rep2 = 0; rep2 < (PROBE_P89 ? 2 : 1); ++rep2) {
    if (IN(8)) {
        pg8::Gemm g{OB, WA, TT, DM, AW, LDO, LDO}; pg8::PairOrder S; S.S.init(TT, DM, F.G, (int)blockIdx.x, ALL_WGM);
        pg8::EpiGatePair E{MG, GT, DM / 64};
        pg8::gemm_phase<pg8::EpiGatePair, pg8::PairOrder, true, GEMM_SP2>(F.lds + RING_OFF, g, S, E);
        if (BOTH(8)) GRID_BAR();
    }
    }
#ifndef PROBE_P10
#define PROBE_P10 0
#endif
    if (IN(10))
_Pragma("unroll")
    for (int rep = 0; rep < (PROBE_P10 ? 3 : 1); ++rep) {
        pg8::Gemm g{MG, WO, TT, DM, DM, LDH, LDH}; pg8::StaticOrder S; S.init(TT, DM, F.G, (int)blockIdx.x, ALL_WGM); S.rev = (GEMM_REV >> 1) & 1;
        pg8::EpiResidT<true, true> E{XR, nullptr, TT, XR, DM, rep == 1 ? -1.0f : 1.0f, SSQ};
        PHASE_SKEW();
        pg8::gemm_phase<pg8::EpiResidT<true, true>, pg8::StaticOrder, RESID_ALIGN, GEMM_SP2>(F.lds + RING_OFF, g, S, E);
        if (BOTH(10) || rep + 1 < (PROBE_P10 ? 3 : 1)) GRID_BAR();
    }
    if (IN(11))
_Pragma("unroll")
    for (int rep = 0; rep < REPS(11); ++rep) {
        rstd_phase(F, SSQ, RSTD);
        if (BOTH(11) || rep + 1 < REPS(11)) GRID_BAR();
    }
    if (IN(12))
_Pragma("unroll")
    for (int rep = 0; rep < REPS(12); ++rep) {
        pg8::Gemm g{XR, WFI, TT, 2 * DFF, DM, LDH, LDH}; pg8::StaticOrder S; S.init(TT, 2 * DFF, F.G, (int)blockIdx.x, ALL_WGM); S.rev = (GEMM_REV >> 2) & 1;
        pg8::EpiSwiGLU E{MID, DFF / 64, RSTD};
        pg8::gemm_phase<pg8::EpiSwiGLU, pg8::StaticOrder, true, GEMM_SP2>(F.lds + RING_OFF, g, S, E);
        if (TAIL_FILL && rep == 0) {
            constexpr int I_FO = (DFF / 64) * (DM / 32);
            const int tail = ((TT / 256) * (2 * DFF / 256)) % F.G, nidle = tail ? F.G - tail : F.G, iw = tail ? (int)blockIdx.x - tail : (int)blockIdx.x;
            if (iw >= 0) { const int gw = iw * NWAVES + F.wave, NGW = nidle * NWAVES;
                auto desc12 = [&](int it) -> TItem { return titem_matrix(ffn2_w_out, DFF, DM, WFO, DFF / 64, RESID_WMODE, 0, it, F.lane); };
                TRANSPOSE_STREAM(desc12, I_FO); } }
        if (BOTH(12) || rep + 1 < REPS(12)) GRID_BAR();
    }
#ifndef PROBE_P13
#define PROBE_P13 0
#endif
    if (IN(13))
_Pragma("unroll")
    for (int rep = 0; rep < (PROBE_P13 ? 3 : 1); ++rep) {
        pg8::Gemm g{MID, WFO, TT, DM, DFF, LDMID, LDMID}; pg8::StaticOrder S; S.init(TT, DM, F.G, (int)blockIdx.x, FFO_WGM); S.csplit = FFO_CSPLIT; S.rev = (GEMM_REV >> 3) & 1;
        pg8::EpiResidT<true, true> E{XR, nullptr, TT, XR, DM, rep == 1 ? -0.5f : 0.5f, nullptr};
        PHASE_SKEW();
        pg8::gemm_phase<pg8::EpiResidT<true, true>, pg8::StaticOrder, RESID_ALIGN, GEMM_SP2>(F.lds + RING_OFF, g, S, E);
        if (BOTH(13) || rep + 1 < (PROBE_P13 ? 3 : 1)) GRID_BAR();
    }
    if (IN(14)) {
#ifdef PROBE_BARS
        for (int b_ = 0; b_ < PROBE_BARS; ++b_) GRID_BAR();
#endif
        for (int it = gw; it < TT; it += NGW) { const int m = recent_first_row(it); rms_row_bf16_to_f32(XR, m, final_norm, out + (size_t)m * DM, F.lane); }
    }
#undef IN
#undef BOTH
#undef GRID_BAR
}

extern "C" void kernel_launch(void* const* d_in, const int* in_sizes, int n_in, void* d_out, int out_size, void* d_ws, size_t ws_size, hipStream_t stream) {
    static int grid = 0;
    if (grid == 0) {
        if (n_in != 26 || in_sizes[0] != 8192 * DM || in_sizes[1] != 16384 * DM || out_size != TT * DM || ws_size < WS_END) {
            fprintf(stderr, "kernel_launch: shape mismatch (n_in %d, out %d, ws %zu, need %zu); nothing launched\n", n_in, out_size, ws_size, (size_t)WS_END); grid = -1; return; }
        int dev = 0, cus = 0;
        if (hipGetDevice(&dev) != hipSuccess || hipDeviceGetAttribute(&cus, hipDeviceAttributeMultiprocessorCount, dev) != hipSuccess) { grid = -1; return; }
        if (hipFuncSetAttribute((const void*)mk_fwd, hipFuncAttributeMaxDynamicSharedMemorySize, LDS_BYTES) != hipSuccess) { fprintf(stderr, "kernel_launch: hipFuncSetAttribute failed\n"); grid = -1; return; }
        (void)hipGetLastError();
        grid = cus > 256 ? 256 : cus - (cus % 16);
        if (grid < 16) { grid = -1; return; }
    }
    if (grid < 0) return;
    if (hipMemsetAsync((char*)d_ws + WS_CTL, 0, CTL_ZERO_BYTES, stream) != hipSuccess) return;
    Args a{};
    for (int i = 0; i < 26; ++i) a.in[i] = (const float*)d_in[i];
    a.out = (float*)d_out; a.ws = (unsigned char*)d_ws;
#if MK_PER_PHASE
    for (int k = 0; k < NPHASE; ++k) { a.ph_lo = k; a.ph_hi = k + 1; hipLaunchKernelGGL(mk_fwd, dim3(grid), dim3(NWAVES * 64), LDS_BYTES, stream, a); }
#else
#if PROBE_ALL2
    a.ph_lo = PROBE_ALL2_LO; a.ph_hi = PROBE_ALL2_HI; a.li = 1;
    hipLaunchKernelGGL(mk_fwd, dim3(grid), dim3(NWAVES * 64), LDS_BYTES, stream, a);
#endif
    a.ph_lo = 0; a.ph_hi = NPHASE; a.li = 0;
    hipLaunchKernelGGL(mk_fwd, dim3(grid), dim3(NWAVES * 64), LDS_BYTES, stream, a);
#endif
    const hipError_t le = hipPeekAtLastError();
    if (le != hipSuccess) fprintf(stderr, "kernel_launch: launch failed: %s\n", hipGetErrorName(le));
}
```

```cpp
#include <hip/hip_runtime.h>
#include <hip/hip_bf16.h>
#include <cstdio>
#include <cstdint>
#include <cmath>
namespace pg8 {
#define PG8_LAS __attribute__((address_space(3)))
typedef unsigned short bf16_t;
typedef short bf16x8 __attribute__((ext_vector_type(8)));
typedef float f32x4 __attribute__((ext_vector_type(4)));
typedef unsigned u32x4 __attribute__((ext_vector_type(4)));
constexpr int BM = 256, BK = 64, HALF = 128, HTB = HALF * BK * 2  , STAGE_BYTES = 8 * HTB, NXCD = 8, WGM = 8;

__host__ __device__ __forceinline__ int lds_byte(int r, int c) { const int st = (r >> 4) * 2 + (c >> 5), rr = r & 15, cc = c & 31, ob = rr * 64 + cc * 2; return st * 1024 + (ob ^ (((ob >> 9) & 1) << 5)); }
__host__ __device__ __forceinline__ void stage_rc(int b, int& R, int& C) { const int st = b / 1024, sb = b % 1024, swz = sb ^ (((sb >> 9) & 1) << 5); R = (st >> 1) * 16 + swz / 64; C = (st & 1) * 32 + (swz % 64) / 2; }
__host__ __device__ __forceinline__ int perm32(int rho) { const int n = rho >> 4, i = rho & 15; return 8 * (i >> 2) + 4 * n + (i & 3); }
__host__ __device__ __forceinline__ int inv_perm32(int w) { return 16 * ((w >> 2) & 1) + 4 * (w >> 3) + (w & 3); }
__host__ __device__ __forceinline__ size_t blk_off(int row, int col, int KT) { return ((size_t)((row >> 8) * KT + (col >> 6)) * 2 + ((row >> 7) & 1)) * 16384 + (size_t)lds_byte(row & 127, col & 63); }
__host__ __device__ __forceinline__ size_t blk_off_b(int w, int col, int KT, bool perm) { const int w128 = w & 127, R = perm ? (w128 & ~31) + inv_perm32(w128 & 31) : w128;
    return ((size_t)((w >> 8) * KT + (col >> 6)) * 2 + ((w >> 7) & 1)) * 16384 + (size_t)lds_byte(R, col & 63); }

struct Unit { int pm, pn; };
struct Gemm { const bf16_t* A; const bf16_t* Bt; int M, N, K, lda, ldb; };

#ifndef SERPENTINE
#define SERPENTINE 1
#endif
struct StaticOrder {
    int rev = 0;
    int csplit = 0;
    int nM, nN, nwg, G, c, wgm, serp = SERPENTINE;
    __host__ __device__ void init(int M, int N, int G_, int c_, int wgm_ = WGM) { nM = M / BM; nN = N / BM; nwg = nM * nN; G = G_; c = c_; wgm = wgm_; }
    __host__ __device__ bool next(int i, Unit& u) const {
        const long L = (long)i * G + c; if (L >= nwg) return false;
        if (csplit && nwg % NXCD == 0 && nM % 16 == 0 && nN % 2 == 0) { const int xcd = (int)(L % NXCD), off = (int)(L / NXCD), cpg = nN / 2, rnd = off / (4 * cpg), in = off % (4 * cpg);
            u.pm = (xcd >> 1) * (nM / 4) + rnd * 4 + (in & 3); u.pn = (xcd & 1) * cpg + (in >> 2); if (rev) u.pm = nM - 1 - u.pm; return true; }
        int wgid = (int)L; { const int q = nwg / NXCD, r = nwg % NXCD, xcd = wgid % NXCD, off = wgid / NXCD; wgid = (xcd < r ? xcd * (q + 1) : r * (q + 1) + (xcd - r) * q) + off; }
        const int nig = wgm * nN, gid = wgid / nig, fm = gid * wgm, gsz = (nM - fm) < wgm ? (nM - fm) : wgm;
        u.pm = fm + ((wgid % nig) % gsz); u.pn = (wgid % nig) / gsz;
        if (serp && (nwg / NXCD) % nig == 0 && nwg % NXCD == 0 && (((wgid % (nwg / NXCD)) / nig) & 1)) u.pn = nN - 1 - u.pn;
        if (rev) u.pm = nM - 1 - u.pm;
        return true;
    }
    __device__ __forceinline__ void a_ready(const Unit&) const {}
    __device__ __forceinline__ void done(const Unit&) const {}
};

__device__ __forceinline__ unsigned cvt_pk_bf16(float lo, float hi) { unsigned r; asm volatile("v_cvt_pk_bf16_f32 %0, %1, %2" : "=v"(r) : "v"(lo), "v"(hi)); return r; }
typedef float f32x2 __attribute__((ext_vector_type(2)));
__device__ __forceinline__ float sigm(float x) { return __builtin_amdgcn_rcpf(1.f + __builtin_amdgcn_exp2f(-1.4426950408889634f * x)); }
__device__ __forceinline__ float bf_lo(unsigned w) { return __uint_as_float(w << 16); }
__device__ __forceinline__ float bf_hi(unsigned w) { return __uint_as_float(w & 0xffff0000u); }
#ifndef OUT_NT
#define OUT_NT 0
#endif
struct EpiSwiGLU {
    static constexpr bool PERM = true, AFTER_DRAIN = false;
    bf16_t* O; int KT; const float* rstd;
    __device__ __forceinline__ void operator()(const f32x4 (&acc)[2][2][4][2], const Unit& u, int wr, int wc, int fr, int fq) const {
        const int row0 = u.pm * BM + wr * 64 + fr, col0 = u.pn * HALF + wc * 32 + 8 * fq;
#pragma unroll
        for (int ai = 0; ai < 2; ++ai)
#pragma unroll
            for (int m = 0; m < 4; ++m) {
                bf16_t* rowp = (bf16_t*)((unsigned char*)O + blk_off(row0 + ai * HALF + m * 16, col0, KT));
                float r[8]; const float rs = rstd ? rstd[row0 + ai * HALF + m * 16] : 1.f;
#pragma unroll
                for (int n = 0; n < 2; ++n)
#pragma unroll
                    for (int j = 0; j < 4; ++j) { const float g = acc[ai][0][m][n][j] * rs, up = acc[ai][1][m][n][j] * rs; r[4 * n + j] = g * sigm(g) * up; }
                u32x4 w; w.x = cvt_pk_bf16(r[0], r[1]); w.y = cvt_pk_bf16(r[2], r[3]); w.z = cvt_pk_bf16(r[4], r[5]); w.w = cvt_pk_bf16(r[6], r[7]);
                if (OUT_NT) __builtin_nontemporal_store(w, (u32x4*)rowp); else *(u32x4*)rowp = w;
            }
    }
};
template <bool RB16, bool OB16> struct EpiResidT {
#ifndef RESID_PERM
#define RESID_PERM 1
#endif
    static constexpr bool PERM = RESID_PERM != 0, AFTER_DRAIN = false;
    const void* res0; const void* res1; int split_row; void* out; int ldc; float alpha; float* ssq;
    __device__ __forceinline__ void operator()(const f32x4 (&acc)[2][2][4][2], const Unit& u, int wr, int wc, int fr, int fq) const {
        typedef unsigned u32x2v __attribute__((ext_vector_type(2)));
        const int rowt = u.pm * BM;
        const float* rbf = RB16 ? nullptr : (rowt < split_row ? (const float*)res0 + (size_t)rowt * ldc : (const float*)res1 + (size_t)(rowt - split_row) * ldc);
        float* obf = OB16 ? nullptr : (float*)out + (size_t)rowt * ldc;
#if RESID_PERM
        const int col0 = u.pn * BM + wc * 32 + 8 * fq;
#pragma unroll
        for (int ai = 0; ai < 2; ++ai) {
            f32x4 rv[4][2][2]; u32x4 rw[4][2];
#pragma unroll
            for (int m = 0; m < 4; ++m) { const int rl = ai * HALF + wr * 64 + m * 16 + fr; const size_t off = (size_t)rl * ldc + col0;
#pragma unroll
                for (int bj = 0; bj < 2; ++bj) {
                    if (RB16) rw[m][bj] = *(const u32x4*)((const unsigned char*)res0 + blk_off(rowt + rl, col0 + bj * HALF, 64));
                    else { rv[m][bj][0] = *(const f32x4*)(rbf + off + bj * HALF); rv[m][bj][1] = *(const f32x4*)(rbf + off + bj * HALF + 4); } } }
#pragma unroll
            for (int m = 0; m < 4; ++m) { const int rl = ai * HALF + wr * 64 + m * 16 + fr; const size_t off = (size_t)rl * ldc + col0; float sq = 0.f;
#pragma unroll
                for (int bj = 0; bj < 2; ++bj) {
                    if (RB16) { const u32x4 w = rw[m][bj]; rv[m][bj][0] = (f32x4){bf_lo(w.x), bf_hi(w.x), bf_lo(w.y), bf_hi(w.y)}; rv[m][bj][1] = (f32x4){bf_lo(w.z), bf_hi(w.z), bf_lo(w.w), bf_hi(w.w)}; }
                    const f32x4 v0 = rv[m][bj][0] + acc[ai][bj][m][0] * alpha, v1 = rv[m][bj][1] + acc[ai][bj][m][1] * alpha;
                    sq += ((v0[0] * v0[0] + v0[1] * v0[1]) + (v0[2] * v0[2] + v0[3] * v0[3])) + ((v1[0] * v1[0] + v1[1] * v1[1]) + (v1[2] * v1[2] + v1[3] * v1[3]));
                    if (OB16) { u32x4 w; w.x = cvt_pk_bf16(v0[0], v0[1]); w.y = cvt_pk_bf16(v0[2], v0[3]); w.z = cvt_pk_bf16(v1[0], v1[1]); w.w = cvt_pk_bf16(v1[2], v1[3]);
                        *(u32x4*)((unsigned char*)out + blk_off(rowt + rl, col0 + bj * HALF, 64)) = w; }
                    else { *(f32x4*)(obf + off + bj * HALF) = v0; *(f32x4*)(obf + off + bj * HALF + 4) = v1; } }
                if (ssq) { sq += __shfl_xor(sq, 16); sq += __shfl_xor(sq, 32); if (fq == 0) ssq[(size_t)(rowt + rl) * 64 + u.pn * 4 + wc] = sq; } }
            asm volatile("" ::: "memory"); }
#else
        const int col0 = u.pn * BM + wc * 32 + 4 * fq;
#pragma unroll
        for (int ai = 0; ai < 2; ++ai) {
            f32x4 rv[4][2][2];
#pragma unroll
            for (int m = 0; m < 4; ++m) { const int rl = ai * HALF + wr * 64 + m * 16 + fr; const size_t off = (size_t)rl * ldc + col0;
#pragma unroll
                for (int bj = 0; bj < 2; ++bj)
#pragma unroll
                    for (int n = 0; n < 2; ++n) {
                        if (RB16) { const u32x2v w = *(const u32x2v*)((const unsigned char*)res0 + blk_off(rowt + rl, col0 + bj * HALF + n * 16, 64)); rv[m][bj][n] = (f32x4){bf_lo(w.x), bf_hi(w.x), bf_lo(w.y), bf_hi(w.y)}; }
                        else rv[m][bj][n] = *(const f32x4*)(rbf + off + bj * HALF + n * 16); } }
#pragma unroll
            for (int m = 0; m < 4; ++m) { const int rl = ai * HALF + wr * 64 + m * 16 + fr; const size_t off = (size_t)rl * ldc + col0; float sq = 0.f;
#pragma unroll
                for (int bj = 0; bj < 2; ++bj)
#pragma unroll
                    for (int n = 0; n < 2; ++n) { const f32x4 val = rv[m][bj][n] + acc[ai][bj][m][n] * alpha;
                        sq += (val[0] * val[0] + val[1] * val[1]) + (val[2] * val[2] + val[3] * val[3]);
                        if (OB16) { u32x2v w; w.x = cvt_pk_bf16(val[0], val[1]); w.y = cvt_pk_bf16(val[2], val[3]); *(u32x2v*)((unsigned char*)out + blk_off(rowt + rl, col0 + bj * HALF + n * 16, 64)) = w; }
                        else *(f32x4*)(obf + off + bj * HALF + n * 16) = val; }
                if (ssq) { sq += __shfl_xor(sq, 16); sq += __shfl_xor(sq, 32); if (fq == 0) ssq[(size_t)(rowt + rl) * 64 + u.pn * 4 + wc] = sq; } }
            asm volatile("" ::: "memory"); }
#endif
    }
};
constexpr size_t QKV_KOFF = (size_t)24576 * 2048 * 2, QKV_VOFF = 2 * QKV_KOFF;
__host__ __device__ __forceinline__ int kimg(int r64, int d) { return r64 * 128 + ((d * 2) ^ (((r64 >> 1) & 7) << 4)); }
__host__ __device__ __forceinline__ int vimg(int k, int c) { const int kk = k;     return ((kk >> 3) * 4 + (c >> 5)) * 512 + ((kk & 7) * 32 + (c & 31)) * 2; }
struct EpiPlainBf16 {
    static constexpr bool PERM = false, AFTER_DRAIN = false;
    bf16_t* O; float alpha;
    __device__ __forceinline__ void operator()(const f32x4 (&acc)[2][2][4][2], const Unit& u, int wr, int wc, int fr, int fq) const {
        const int col0 = u.pn * BM + wc * 32 + 4 * fq;
#pragma unroll
        for (int ai = 0; ai < 2; ++ai)
#pragma unroll
            for (int m = 0; m < 4; ++m) { const size_t off = (size_t)(u.pm * BM + ai * HALF + wr * 64 + m * 16 + fr) * 4096 + col0;
#pragma unroll
                for (int bj = 0; bj < 2; ++bj)
#pragma unroll
                    for (int n = 0; n < 2; ++n) { const f32x4 v = acc[ai][bj][m][n] * alpha; unsigned long long w = (unsigned long long)cvt_pk_bf16(v[0], v[1]) | ((unsigned long long)cvt_pk_bf16(v[2], v[3]) << 32);
                        *(unsigned long long*)(O + off + bj * HALF + n * 16) = w; } }
    }
};
struct EpiProj {
    static constexpr bool PERM = true, AFTER_DRAIN = false;
    bf16_t* QKV; bf16_t* RXY; bf16_t* G; const float* rope; const float* rstd;
    __device__ __forceinline__ void operator()(const f32x4 (&acc)[2][2][4][2], const Unit& u, int wr, int wc, int fr, int fq) const {
        const int colt = u.pn * BM, rowt = u.pm * BM;
        bf16_t* base; int ldc, cb;
        if (colt < 6144) { base = QKV; ldc = 6144; cb = colt; } else if (colt < 10240) { base = RXY; ldc = 4096; cb = colt - 6144; } else { base = G; ldc = 8192; cb = colt - 10240; }
        const bool rot = (colt < 4096) && ((wc & 1) == 0);
        const int pos0 = rowt - (rowt < 4096 ? 0 : (rowt < 8192 ? 4096 : 8192));
        const int col0 = cb + wc * 32 + 8 * fq;
        const float sgn = fq == 0 ? -1.f : 1.f;
        const float qs = colt < 2048 ? 0.125f * 1.4426950408889634f : 1.f;
#pragma unroll
        for (int ai = 0; ai < 2; ++ai)
#pragma unroll
            for (int m = 0; m < 4; ++m) {
                const int rl = ai * HALF + wr * 64 + m * 16 + fr;
                const int row = rowt + rl; const float rs = rstd[row];
                f32x4 cs[4];
                if (rot && fq < 2) { const f32x4* tp = (const f32x4*)(rope + (size_t)(pos0 + rl) * 16);
#pragma unroll
                    for (int q = 0; q < 4; ++q) cs[q] = tp[q]; }
#pragma unroll
                for (int bj = 0; bj < 2; ++bj) {
                    f32x4 v0 = acc[ai][bj][m][0] * (qs * rs), v1 = acc[ai][bj][m][1] * (qs * rs);
                    if (rot) {
                        f32x4 p0, p1;
#pragma unroll
                        for (int j = 0; j < 4; ++j) { p0[j] = __shfl_xor(v0[j], 16); p1[j] = __shfl_xor(v1[j], 16); }
                        if (fq < 2) {
                            v0[0] = v0[0] * cs[0][0] + sgn * p0[0] * cs[0][1]; v0[1] = v0[1] * cs[0][2] + sgn * p0[1] * cs[0][3];
                            v0[2] = v0[2] * cs[1][0] + sgn * p0[2] * cs[1][1]; v0[3] = v0[3] * cs[1][2] + sgn * p0[3] * cs[1][3];
                            v1[0] = v1[0] * cs[2][0] + sgn * p1[0] * cs[2][1]; v1[1] = v1[1] * cs[2][2] + sgn * p1[1] * cs[2][3];
                            v1[2] = v1[2] * cs[3][0] + sgn * p1[2] * cs[3][1]; v1[3] = v1[3] * cs[3][2] + sgn * p1[3] * cs[3][3];
                        }
                    }
                    u32x4 w; w.x = cvt_pk_bf16(v0[0], v0[1]); w.y = cvt_pk_bf16(v0[2], v0[3]); w.z = cvt_pk_bf16(v1[0], v1[1]); w.w = cvt_pk_bf16(v1[2], v1[3]);
                    const int col = col0 + bj * HALF;
                    unsigned char* dp;
                    if (colt >= 6144) dp = (unsigned char*)(base + (size_t)row * ldc + col);
                    else if (colt < 2048) dp = (unsigned char*)(QKV + (size_t)row * 2048 + col);
                    else if (colt < 4096) { const int c2 = col - 2048; dp = (unsigned char*)QKV + QKV_KOFF + (size_t)((((row >> 6) * 16 + (c2 >> 7)) * 2 + ((c2 >> 6) & 1))) * 8192 + kimg(row & 63, c2 & 63); }
                    else { const int c2 = col - 4096; dp = (unsigned char*)QKV + QKV_VOFF + (size_t)((row >> 6) * 16 + (c2 >> 7)) * 16384 + vimg(row & 63, c2 & 127); }
                    if (OUT_NT) __builtin_nontemporal_store(w, (u32x4*)dp); else *(u32x4*)dp = w;
                }
            }
    }
};
template <bool ADD> struct EpiGate {
    static constexpr bool PERM = true, AFTER_DRAIN = false;
    bf16_t* O; const bf16_t* Gt; int goff; int KT;
    __device__ __forceinline__ void operator()(const f32x4 (&acc)[2][2][4][2], const Unit& u, int wr, int wc, int fr, int fq) const {
        const int row0 = u.pm * BM + wr * 64 + fr, col0 = u.pn * BM + wc * 32 + 8 * fq;
#pragma unroll
        for (int ai = 0; ai < 2; ++ai)
#pragma unroll
            for (int m = 0; m < 4; ++m) { const size_t row = (size_t)(row0 + ai * HALF + m * 16);
                u32x4 gv[2], ov[2];
#pragma unroll
                for (int bj = 0; bj < 2; ++bj) { gv[bj] = *(const u32x4*)(Gt + row * 8192 + goff + col0 + bj * HALF); if (ADD) ov[bj] = *(const u32x4*)((const unsigned char*)O + blk_off((int)row, col0 + bj * HALF, KT)); }
#pragma unroll
                for (int bj = 0; bj < 2; ++bj) { const f32x4 a0 = acc[ai][bj][m][0], a1 = acc[ai][bj][m][1]; float r[8];
                    r[0] = sigm(bf_lo(gv[bj].x)) * a0[0]; r[1] = sigm(bf_hi(gv[bj].x)) * a0[1]; r[2] = sigm(bf_lo(gv[bj].y)) * a0[2]; r[3] = sigm(bf_hi(gv[bj].y)) * a0[3];
                    r[4] = sigm(bf_lo(gv[bj].z)) * a1[0]; r[5] = sigm(bf_hi(gv[bj].z)) * a1[1]; r[6] = sigm(bf_lo(gv[bj].w)) * a1[2]; r[7] = sigm(bf_hi(gv[bj].w)) * a1[3];
                    if (ADD) { r[0] += bf_lo(ov[bj].x); r[1] += bf_hi(ov[bj].x); r[2] += bf_lo(ov[bj].y); r[3] += bf_hi(ov[bj].y); r[4] += bf_lo(ov[bj].z); r[5] += bf_hi(ov[bj].z); r[6] += bf_lo(ov[bj].w); r[7] += bf_hi(ov[bj].w); }
                    u32x4 w; w.x = cvt_pk_bf16(r[0], r[1]); w.y = cvt_pk_bf16(r[2], r[3]); w.z = cvt_pk_bf16(r[4], r[5]); w.w = cvt_pk_bf16(r[6], r[7]);
                    *(u32x4*)((unsigned char*)O + blk_off((int)row, col0 + bj * HALF, KT)) = w; }
            }
    }
};

struct EpiGatePair {
    static constexpr bool PERM = true, AFTER_DRAIN = false;
    bf16_t* O; const bf16_t* Gt; int KT;
    __device__ __forceinline__ void operator()(const f32x4 (&acc)[2][2][4][2], const Unit& u, int wr, int wc, int fr, int fq) const {
        if (u.pm < 96) { EpiGate<false> e{O, Gt, 0, KT}; e(acc, u, wr, wc, fr, fq); }
        else { Unit v; v.pm = u.pm - 96; v.pn = u.pn - 16; EpiGate<true> e{O, Gt, 4096, KT}; e(acc, v, wr, wc, fr, fq); }
    }
};
struct PairOrder {
    StaticOrder S;
    __device__ __forceinline__ bool next(int i, Unit& u) const { if (!S.next(i >> 1, u)) return false; if (i & 1) { u.pm += 96; u.pn += 16; } return true; }
    __device__ __forceinline__ void a_ready(const Unit&) const {}
    __device__ __forceinline__ void done(const Unit&) const {}
};

template <class Epi, class Sched, bool ALIGN_EPI = false, bool SP2 = false>
__device__ __forceinline__ void gemm_phase(PG8_LAS unsigned char* lds, const Gemm g, const Sched& S, const Epi& E) {
    const int tid = threadIdx.x, wid = __builtin_amdgcn_readfirstlane(tid >> 6), lane = tid & 63, wr = wid >> 2, wc = wid & 3, fr = lane & 15, fq = lane >> 4;
    const int K = g.K, nt = K / BK;
    unsigned voffA[2], voffB[2];
#pragma unroll
    for (int i = 0; i < 2; ++i) { voffA[i] = (unsigned)(tid * 16 + i * 8192); voffB[i] = voffA[i]; }
    const size_t kstep = 32768;
    const size_t hstepA = 16384, hstepB = 16384;
    const size_t tstepA = (size_t)nt * 32768, tstepB = tstepA;
    const unsigned ldsw = (unsigned)wid * 1024u;
    const int aoff = lds_byte(wr * 64 + fr, fq * 8), boff = lds_byte(wc * 32 + fr, fq * 8);
#define PG8_SA(b, h) (((b) * 2 + (h)) * HTB)
#define PG8_SB(b, h) ((4 + (b) * 2 + (h)) * HTB)
#define PG8_STAGE(bufoff, gbase, voff) do { _Pragma("unroll") for (int _i = 0; _i < 2; ++_i) \
        __builtin_amdgcn_global_load_lds((const unsigned*)((const char*)(gbase) + (voff)[_i]), (PG8_LAS unsigned*)(lds + (bufoff) + ldsw + _i * 8192), 16, 0, 0); } while (0)
#ifndef GEMM_B_AUX
#define GEMM_B_AUX 0
#endif
#define PG8_STAGEB(bufoff, gbase, voff) do { _Pragma("unroll") for (int _i = 0; _i < 2; ++_i) \
        __builtin_amdgcn_global_load_lds((const unsigned*)((const char*)(gbase) + (voff)[_i]), (PG8_LAS unsigned*)(lds + (bufoff) + ldsw + _i * 8192), 16, 0, GEMM_B_AUX); } while (0)
#define PG8_LDA(dst, b, h) do { _Pragma("unroll") for (int m = 0; m < 4; ++m) _Pragma("unroll") for (int k = 0; k < 2; ++k) dst[m][k] = *(const PG8_LAS bf16x8*)(lds + PG8_SA(b, h) + aoff + m * 2048 + k * 1024); } while (0)
#define PG8_LDB(dst, b, h) do { _Pragma("unroll") for (int n = 0; n < 2; ++n) _Pragma("unroll") for (int k = 0; k < 2; ++k) dst[n][k] = *(const PG8_LAS bf16x8*)(lds + PG8_SB(b, h) + boff + n * 2048 + k * 1024); } while (0)
#ifndef MMA_ORDER
#define MMA_ORDER 3
#endif
#define PG8_MFMA1(ai, bj, At, Bt, m, n, k) acc[ai][bj][m][n] = __builtin_amdgcn_mfma_f32_16x16x32_bf16(Bt[n][k], At[m][k], acc[ai][bj][m][n], 0, 0, 0)
#define PG8_MMA(ai, bj, At, Bt) do { __builtin_amdgcn_s_setprio(1); \
        if (MMA_ORDER == 1) { _Pragma("unroll") for (int n = 0; n < 2; ++n) _Pragma("unroll") for (int k = 0; k < 2; ++k) _Pragma("unroll") for (int m = 0; m < 4; ++m) PG8_MFMA1(ai, bj, At, Bt, m, n, k); } \
        else if (MMA_ORDER == 2) { _Pragma("unroll") for (int m = 0; m < 4; ++m) _Pragma("unroll") for (int k = 0; k < 2; ++k) _Pragma("unroll") for (int n = 0; n < 2; ++n) PG8_MFMA1(ai, bj, At, Bt, m, n, k); } \
        else if (MMA_ORDER == 3) { _Pragma("unroll") for (int k = 0; k < 2; ++k) _Pragma("unroll") for (int m = 0; m < 4; ++m) _Pragma("unroll") for (int nn = 0; nn < 2; ++nn) { const int n = (m & 1) ? 1 - nn : nn; PG8_MFMA1(ai, bj, At, Bt, m, n, k); } }     \
        else { _Pragma("unroll") for (int m = 0; m < 4; ++m) _Pragma("unroll") for (int n = 0; n < 2; ++n) _Pragma("unroll") for (int k = 0; k < 2; ++k) PG8_MFMA1(ai, bj, At, Bt, m, n, k); } \
        __builtin_amdgcn_s_setprio(0); } while (0)
#ifndef EARLY_BAR
#define EARLY_BAR 2
#endif
#define PG8_MMA_E(ai, bj, At, Bt) do { __builtin_amdgcn_s_setprio(1); \
        _Pragma("unroll") for (int k = 0; k < 2; ++k) _Pragma("unroll") for (int m = 0; m < 4; ++m) _Pragma("unroll") for (int nn = 0; nn < 2; ++nn) { const int n = (m & 1) ? 1 - nn : nn; \
            if ((k * 4 + m) * 2 + nn == 16 - EARLY_BAR) { __builtin_amdgcn_sched_barrier(0); __builtin_amdgcn_s_setprio(2); __builtin_amdgcn_s_barrier(); __builtin_amdgcn_sched_barrier(0); } \
            PG8_MFMA1(ai, bj, At, Bt, m, n, k); } \
        __builtin_amdgcn_s_setprio(0); } while (0)
#define PG8_WAIT_V(n) asm volatile("s_waitcnt vmcnt(" #n ")" ::: "memory")
#define PG8_WAIT_L(n) asm volatile("s_waitcnt lgkmcnt(" #n ")" ::: "memory")
#define PG8_BAR __builtin_amdgcn_s_barrier()
#define PG8_SCHED __builtin_amdgcn_sched_barrier(0)
    Unit cur, nxt; int ui = 0;
    if (!S.next(0, cur)) return;
    f32x4 acc[2][2][4][2];
#pragma unroll
    for (int a = 0; a < 2; ++a)
#pragma unroll
        for (int b = 0; b < 2; ++b)
#pragma unroll
            for (int m = 0; m < 4; ++m)
#pragma unroll
                for (int n = 0; n < 2; ++n) acc[a][b][m][n] = (f32x4){0.f, 0.f, 0.f, 0.f};
    bf16x8 At[4][2], B0[2][2], B1[2][2];
    const char* cA = (const char*)g.A + (size_t)cur.pm * tstepA; const char* cB = (const char*)g.Bt + (size_t)cur.pn * tstepB;
    S.a_ready(cur);
    if constexpr (SP2) {
        PG8_STAGEB(PG8_SB(0, 0), cB, voffB); PG8_STAGEB(PG8_SB(0, 1), cB + hstepB, voffB); PG8_STAGE(PG8_SA(0, 0), cA, voffA); PG8_STAGE(PG8_SA(0, 1), cA + hstepA, voffA);
        if (wr == 1) PG8_BAR;
        PG8_WAIT_V(2); PG8_BAR;
        PG8_STAGEB(PG8_SB(1, 0), cB + kstep, voffB); PG8_STAGE(PG8_SA(1, 0), cA + kstep, voffA); PG8_STAGEB(PG8_SB(1, 1), cB + hstepB + kstep, voffB);
        PG8_WAIT_V(6); PG8_BAR;
    } else {
        PG8_STAGEB(PG8_SB(0, 0), cB, voffB); PG8_STAGE(PG8_SA(0, 0), cA, voffA); PG8_STAGEB(PG8_SB(0, 1), cB + hstepB, voffB); PG8_STAGE(PG8_SA(0, 1), cA + hstepA, voffA);
        if (wr == 1) PG8_BAR;
        PG8_WAIT_V(4); PG8_BAR;
        PG8_STAGEB(PG8_SB(1, 0), cB + kstep, voffB); PG8_STAGE(PG8_SA(1, 0), cA + kstep, voffA); PG8_STAGEB(PG8_SB(1, 1), cB + hstepB + kstep, voffB);
        PG8_WAIT_V(6); PG8_BAR;
    }
    for (;;) {
        const bool has_next = S.next(ui + 1, nxt);
        const char* nA = has_next ? (const char*)g.A + (size_t)nxt.pm * tstepA : cA; const char* nB = has_next ? (const char*)g.Bt + (size_t)nxt.pn * tstepB : cB;
        for (int t = 0; t < nt; t += 2) {
            const bool last = (t == nt - 2);
            const char* a1 = cA + (size_t)(t + 1) * kstep;
            const char* a2 = last ? nA : cA + (size_t)(t + 2) * kstep; const char* b2 = last ? nB : cB + (size_t)(t + 2) * kstep;
            const char* a3 = a2 + kstep; const char* b3 = b2 + kstep;
            if (last && has_next) S.a_ready(nxt);
            if constexpr (SP2) {
            PG8_LDB(B0, 0, 0); PG8_LDB(B1, 0, 1); PG8_SCHED; PG8_LDA(At, 0, 0); PG8_STAGE(PG8_SA(1, 1), a1 + hstepA, voffA);
            PG8_WAIT_V(8); PG8_WAIT_L(0); PG8_BAR; PG8_MMA(0, 0, At, B0); if (EARLY_BAR) { PG8_MMA_E(0, 1, At, B1); } else { PG8_MMA(0, 1, At, B1); PG8_BAR; } PG8_SCHED;
            PG8_LDA(At, 0, 1); PG8_STAGEB(PG8_SB(0, 0), b2, voffB); PG8_STAGEB(PG8_SB(0, 1), b2 + hstepB, voffB); PG8_STAGE(PG8_SA(0, 0), a2, voffA);
            PG8_WAIT_V(8); PG8_WAIT_L(0); PG8_BAR; PG8_MMA(1, 0, At, B0); if (EARLY_BAR) { PG8_MMA_E(1, 1, At, B1); } else { PG8_MMA(1, 1, At, B1); PG8_BAR; } PG8_SCHED;
            PG8_LDB(B0, 1, 0); PG8_LDB(B1, 1, 1); PG8_SCHED; PG8_LDA(At, 1, 0); PG8_STAGE(PG8_SA(0, 1), a2 + hstepA, voffA);
            PG8_WAIT_V(8); PG8_WAIT_L(0); PG8_BAR; PG8_MMA(0, 0, At, B0); if (EARLY_BAR) { PG8_MMA_E(0, 1, At, B1); } else { PG8_MMA(0, 1, At, B1); PG8_BAR; } PG8_SCHED;
            PG8_LDA(At, 1, 1); PG8_STAGEB(PG8_SB(1, 0), b3, voffB); PG8_STAGEB(PG8_SB(1, 1), b3 + hstepB, voffB); PG8_STAGE(PG8_SA(1, 0), a3, voffA);
            PG8_WAIT_V(8); PG8_WAIT_L(0); PG8_BAR; PG8_MMA(1, 0, At, B0); if (EARLY_BAR) { PG8_MMA_E(1, 1, At, B1); } else { PG8_MMA(1, 1, At, B1); PG8_BAR; } PG8_SCHED;
            } else {
            PG8_LDB(B0, 0, 0); PG8_SCHED; PG8_LDA(At, 0, 0); PG8_STAGE(PG8_SA(1, 1), a1 + hstepA, voffA);
            PG8_WAIT_L(8); PG8_BAR; PG8_WAIT_L(0); PG8_MMA(0, 0, At, B0); PG8_BAR; PG8_SCHED;
            PG8_LDB(B1, 0, 1); PG8_STAGEB(PG8_SB(0, 0), b2, voffB);
            PG8_BAR; PG8_WAIT_L(0); PG8_MMA(0, 1, At, B1); PG8_BAR;
            PG8_LDA(At, 0, 1); PG8_STAGE(PG8_SA(0, 0), a2, voffA);
            PG8_BAR; PG8_WAIT_L(0); PG8_MMA(1, 0, At, B0); PG8_BAR; PG8_SCHED;
            PG8_STAGEB(PG8_SB(0, 1), b2 + hstepB, voffB);
            PG8_WAIT_V(6); PG8_BAR; PG8_MMA(1, 1, At, B1); PG8_BAR;
            PG8_LDB(B0, 1, 0); PG8_SCHED; PG8_LDA(At, 1, 0); PG8_STAGE(PG8_SA(0, 1), a2 + hstepA, voffA);
            PG8_WAIT_L(8); PG8_BAR; PG8_WAIT_L(0); PG8_MMA(0, 0, At, B0); PG8_BAR; PG8_SCHED;
            PG8_LDB(B1, 1, 1); PG8_STAGEB(PG8_SB(1, 0), b3, voffB);
            PG8_BAR; PG8_WAIT_L(0); PG8_MMA(0, 1, At, B1); PG8_BAR;
            PG8_LDA(At, 1, 1); PG8_STAGE(PG8_SA(1, 0), a3, voffA);
            PG8_BAR; PG8_WAIT_L(0); PG8_MMA(1, 0, At, B0); PG8_BAR; PG8_SCHED;
            PG8_STAGEB(PG8_SB(1, 1), b3 + hstepB, voffB);
            PG8_WAIT_V(6); PG8_BAR; PG8_MMA(1, 1, At, B1); PG8_BAR;
            }
        }
        if constexpr (ALIGN_EPI) { if (wr == 0) PG8_BAR; }
        if constexpr (!Epi::AFTER_DRAIN) { E(acc, cur, wr, wc, fr, fq); S.done(cur); }
        if (!has_next) break;
#pragma unroll
        for (int a = 0; a < 2; ++a)
#pragma unroll
            for (int b = 0; b < 2; ++b)
#pragma unroll
                for (int m = 0; m < 4; ++m)
#pragma unroll
                    for (int n = 0; n < 2; ++n) acc[a][b][m][n] = (f32x4){0.f, 0.f, 0.f, 0.f};
        cur = nxt; cA = nA; cB = nB; ++ui;
        if constexpr (ALIGN_EPI) { if (wr == 1) PG8_BAR; }
    }
    PG8_WAIT_V(0);
    if constexpr (!ALIGN_EPI) { if (wr == 0) PG8_BAR; }
    PG8_BAR;
    if constexpr (Epi::AFTER_DRAIN) { E.fused(acc, cur, wr, wc, fr, fq, lds, wid, lane); S.done(cur); }
#undef PG8_SA
#undef PG8_SB
#undef PG8_STAGE
#undef PG8_STAGEB
#undef PG8_LDA
#undef PG8_LDB
#undef PG8_MMA
#undef PG8_MMA_E
#undef PG8_MFMA1
#undef PG8_WAIT_V
#undef PG8_WAIT_L
#undef PG8_BAR
#undef PG8_SCHED
}
}
#ifndef ATT_SETPRIO
#define ATT_SETPRIO 0
#endif
namespace att {
typedef unsigned short bf16;
using bf16x8 = __attribute__((ext_vector_type(8))) short;
using s16x4  = __attribute__((ext_vector_type(4))) short;
using f32x16 = __attribute__((ext_vector_type(16))) float;
using u32x4  = __attribute__((ext_vector_type(4))) unsigned;
constexpr int NW = 8, QBLK = 32, KVBLK = 64, LDQ = 6144;
constexpr float SCALE = 0.125f;
constexpr float THR = 8.f;
constexpr int SHM_V = KVBLK * 128 * 2, SHM_K = KVBLK * 64 * 2;
constexpr int LDS_K = 0, LDS_V = 3 * SHM_K, LDS_WS = 3 * SHM_K + 4 * SHM_V, LDS_BYTES = LDS_WS + NW * 64 * 4;
#define KSWZ64(row, colB) ((row) * 128 + ((colB) ^ ((((row) >> 1) & 7) << 4)))
#define SBAR() __builtin_amdgcn_sched_barrier(0)
__device__ __forceinline__ int crow(int r, int hi) { return (r & 3) + 8 * (r >> 2) + 4 * hi; }
__device__ __forceinline__ unsigned cvtpk(float lo, float hi) { unsigned r; asm volatile("v_cvt_pk_bf16_f32 %0, %1, %2" : "=v"(r) : "v"(lo), "v"(hi)); return r; }

template <bool FIRST>
__device__ __forceinline__ void partialSM(f32x16& p0, f32x16& p1, float& mhat, f32x16& negm, float& alpha) {
  constexpr float THRL = THR * 1.4426950408889634f;
  float pmax = p0[0];
#pragma unroll
  for (int r = 1; r < 16; ++r) pmax = fmaxf(pmax, p0[r]);
#pragma unroll
  for (int r = 0; r < 16; ++r) pmax = fmaxf(pmax, p1[r]);
  { auto rr = __builtin_amdgcn_permlane32_swap(__float_as_uint(pmax), __float_as_uint(pmax), false, false);
    pmax = fmaxf(__uint_as_float(rr[0]), __uint_as_float(rr[1])); }
  if (!FIRST && __builtin_expect(__all(pmax <= THRL), 1)) { alpha = 1.f; }
  else { const float dl = FIRST ? pmax : fmaxf(pmax, 0.f); mhat += dl; alpha = FIRST ? 1.f : __builtin_amdgcn_exp2f(-dl);
#pragma unroll
    for (int r = 0; r < 16; ++r) { p0[r] -= dl; p1[r] -= dl; }
#pragma unroll
    for (int r = 0; r < 16; ++r) negm[r] = -mhat; }
#pragma unroll
  for (int r = 0; r < 16; ++r) p0[r] = __builtin_amdgcn_exp2f(p0[r]);
}
__device__ __forceinline__ void finishSM(f32x16& p0, f32x16& p1, float alpha, float& l_reg, bf16x8& pa0, bf16x8& pa1, bf16x8& pa2, bf16x8& pa3) {
#pragma unroll
  for (int r = 0; r < 16; ++r) p1[r] = __builtin_amdgcn_exp2f(p1[r]);
  float ps = 0;
#pragma unroll
  for (int r = 0; r < 16; ++r) ps += p0[r];
#pragma unroll
  for (int r = 0; r < 16; ++r) ps += p1[r];
  { auto rr = __builtin_amdgcn_permlane32_swap(__float_as_uint(ps), __float_as_uint(ps), false, false);
    ps = __uint_as_float(rr[0]) + __uint_as_float(rr[1]); }
  l_reg = l_reg * alpha + ps;
#define PK8(P, BASE, OUT) do { u32x4 w = {cvtpk(P[BASE + 0], P[BASE + 1]), cvtpk(P[BASE + 2], P[BASE + 3]), cvtpk(P[BASE + 4], P[BASE + 5]), cvtpk(P[BASE + 6], P[BASE + 7])}; \
    OUT = *reinterpret_cast<bf16x8*>(&w); } while (0)
  PK8(p0, 0, pa0); PK8(p0, 8, pa1); PK8(p1, 0, pa2); PK8(p1, 8, pa3);
#undef PK8
}
__device__ __forceinline__ void qkt(f32x16& p0, f32x16& p1, const char* Ks, const bf16x8* qr, const f32x16& negm, int r32, int hi) {
#pragma unroll
  for (int d0 = 0; d0 < 4; ++d0) { const int cb = (d0 * 16 + hi * 8) * 2;
    bf16x8 b0 = *reinterpret_cast<const bf16x8*>(Ks + KSWZ64(r32, cb));
    bf16x8 b1 = *reinterpret_cast<const bf16x8*>(Ks + KSWZ64(32 + r32, cb));
    if (d0 == 0) { p0 = __builtin_amdgcn_mfma_f32_32x32x16_bf16(b0, qr[0], negm, 0, 0, 0); p1 = __builtin_amdgcn_mfma_f32_32x32x16_bf16(b1, qr[0], negm, 0, 0, 0); }
    else { p0 = __builtin_amdgcn_mfma_f32_32x32x16_bf16(b0, qr[d0], p0, 0, 0, 0); p1 = __builtin_amdgcn_mfma_f32_32x32x16_bf16(b1, qr[d0], p1, 0, 0, 0); } }
}
__device__ __forceinline__ int v_st(int k, int c) { const int kk = (k & ~0xC) | ((k & 4) << 1) | ((k & 8) >> 1); return ((kk >> 3) * 4 + (c >> 5)) * 512 + ((kk & 7) * 32 + (c & 31)) * 2; }
__device__ __forceinline__ int v_rd_base(int lane) { return ((lane & 3) << 3) | (((lane >> 2) & 3) << 6) | (((lane >> 4) & 1) << 5) | (((lane >> 5) & 1) << 8); }
constexpr int v_rd_off(int d0, int ks, int half) { return d0 * 512 + ks * 4096 + half * 2048; }
template <int OFF> __device__ __forceinline__ s16x4 tr_read(int vb) {
  s16x4 r; asm volatile("ds_read_b64_tr_b16 %0, %1 offset:%2" : "=&v"(r) : "v"(vb), "i"(OFF) : "memory"); return r;
}
template <int D0> __device__ __forceinline__ void pv_one(f32x16& od, int vb, bf16x8 pa0, bf16x8 pa1, bf16x8 pa2, bf16x8 pa3) {
  const s16x4 l0 = tr_read<v_rd_off(D0, 0, 0)>(vb), h0 = tr_read<v_rd_off(D0, 0, 1)>(vb), l1 = tr_read<v_rd_off(D0, 1, 0)>(vb), h1 = tr_read<v_rd_off(D0, 1, 1)>(vb);
  const s16x4 l2 = tr_read<v_rd_off(D0, 2, 0)>(vb), h2 = tr_read<v_rd_off(D0, 2, 1)>(vb), l3 = tr_read<v_rd_off(D0, 3, 0)>(vb), h3 = tr_read<v_rd_off(D0, 3, 1)>(vb);
  asm volatile("s_waitcnt lgkmcnt(0)" ::: "memory"); SBAR();
#define PK(L, H) (bf16x8){L[0], L[1], L[2], L[3], H[0], H[1], H[2], H[3]}
#if ATT_SETPRIO
  __builtin_amdgcn_s_setprio(1);
#endif
  od = __builtin_amdgcn_mfma_f32_32x32x16_bf16(pa0, PK(l0, h0), od, 0, 0, 0);
  od = __builtin_amdgcn_mfma_f32_32x32x16_bf16(pa1, PK(l1, h1), od, 0, 0, 0);
  od = __builtin_amdgcn_mfma_f32_32x32x16_bf16(pa2, PK(l2, h2), od, 0, 0, 0);
  od = __builtin_amdgcn_mfma_f32_32x32x16_bf16(pa3, PK(l3, h3), od, 0, 0, 0);
#if ATT_SETPRIO
  __builtin_amdgcn_s_setprio(0);
#endif
#undef PK
}
__device__ __forceinline__ void pv_d0(f32x16* o, int vb, bf16x8 pa0, bf16x8 pa1, bf16x8 pa2, bf16x8 pa3) {
  pv_one<0>(o[0], vb, pa0, pa1, pa2, pa3); pv_one<1>(o[1], vb, pa0, pa1, pa2, pa3); pv_one<2>(o[2], vb, pa0, pa1, pa2, pa3); pv_one<3>(o[3], vb, pa0, pa1, pa2, pa3);
}

__device__ __forceinline__ bf16x8 bload(__amdgpu_buffer_rsrc_t rs, unsigned voff, unsigned soff) { return __builtin_bit_cast(bf16x8, __builtin_amdgcn_raw_buffer_load_b128(rs, voff, soff, 0)); }
__device__ __forceinline__ void glds16s(const char* sbase, unsigned voff, unsigned lds_dst) { unsigned keep;
  asm volatile("s_mov_b32 %0, m0\n\ts_mov_b32 m0, %3\n\ts_nop 0\n\tglobal_load_lds_dwordx4 %1, %2\n\ts_mov_b32 m0, %0" : "=&s"(keep) : "v"(voff), "s"(sbase), "s"(lds_dst) : "memory"); }
#define WAIT_BAR(N) asm volatile("s_waitcnt vmcnt(" #N ") lgkmcnt(0)\n\ts_barrier" ::: "memory")
template <bool FAST>
__device__ __forceinline__ void attn_map_body(__amdgpu_buffer_rsrc_t rs, unsigned qo, const char* kbase, const char* vbase, int seq, char* lds, f32x16 (&o)[4], float& l_out) {
  const int tid = threadIdx.x, wid = __builtin_amdgcn_readfirstlane(tid >> 6), lane = tid & 63, r32 = lane & 31, hi = lane >> 5;
  char* V_lds = lds + LDS_V; char* K_lds = lds + LDS_K;
  float* ws = (float*)(lds + LDS_WS) + wid * 64; float* al_l = ws + 32;
  float mhat = 0.f, l_reg = 0; bf16x8 qr[4]; f32x16 negm = f32x16{};
#pragma unroll
  for (int d = 0; d < 4; ++d) o[d] = f32x16{};
  const unsigned qvo = (unsigned)(((wid * QBLK + r32) * 2048 + hi * 8) * 2);
#pragma unroll
  for (int d0 = 0; d0 < 4; ++d0) qr[d0] = bload(rs, qvo + d0 * 32, qo);
  const unsigned lds0 = (unsigned)(uintptr_t)lds;
  const unsigned kvo = (unsigned)(wid * 1024 + lane * 16);
  unsigned vvo[2];
#pragma unroll
  for (int i = 0; i < 2; ++i) vvo[i] = (unsigned)((wid + 8 * i) * 1024 + lane * 16);
  const unsigned kdst = lds0 + LDS_K + wid * 1024, vdst = lds0 + LDS_V + wid * 1024;
#define DMA_K(t, slot) glds16s(kbase + (size_t)(t) * 262144, kvo, (unsigned)__builtin_amdgcn_readfirstlane((int)(kdst + (slot) * SHM_K)))
#define DMA_V(t, slot) do { const char* vb_ = vbase + (size_t)(t) * 262144; const unsigned vd_ = (unsigned)__builtin_amdgcn_readfirstlane((int)(vdst + (slot) * SHM_V)); \
    glds16s(vb_, vvo[0], vd_); glds16s(vb_, vvo[1], vd_ + 8192); } while (0)
  const int vb0 = (int)(uintptr_t)V_lds + v_rd_base(lane);
#define RESC(a) do { if (__any((a) < 1.f)) { if (hi == 0) al_l[r32] = (a); asm volatile("s_waitcnt lgkmcnt(0)" ::: "memory"); \
    _Pragma("unroll") for (int d = 0; d < 4; ++d) _Pragma("unroll") for (int r = 0; r < 16; ++r) o[d][r] *= al_l[crow(r, hi)]; } } while (0)
  f32x16 pA0, pA1, pB0, pB1; float alA, alB; bf16x8 pa0, pa1, pa2, pa3; const int NT = seq / KVBLK;
  int k3 = 0;
#define K3NEXT() do { k3 = (k3 == 2) ? 0 : k3 + 1; } while (0)
#define SM_STEP(PX0, PX1, alX) do { if (FAST) { alX = 1.f; _Pragma("unroll") for (int r_ = 0; r_ < 16; ++r_) PX0[r_] = __builtin_amdgcn_exp2f(PX0[r_]); } \
    else { partialSM<false>(PX0, PX1, mhat, negm, alX); RESC(alX); } } while (0)
#define A_PART(PX0, PX1, PY0, PY1, alY, j, GK, GV, FIN) do { \
    if (GK) DMA_K((j) + 2, (k3 == 0 ? 2 : k3 - 1)); if (GV) DMA_V((j) + 1, ((j) + 1) & 3); \
    SBAR(); qkt(PX0, PX1, K_lds + k3 * SHM_K, qr, negm, r32, hi); \
    if (FIN) finishSM(PY0, PY1, alY, l_reg, pa0, pa1, pa2, pa3); SBAR(); } while (0)
#ifndef ATT_EXP_IN_PV
#define ATT_EXP_IN_PV 1
#endif
#define B_PART(PX0, PX1, alX, j) do { \
    if (FAST && ATT_EXP_IN_PV) { const int vb_ = vb0 + (((j) + 3) & 3) * SHM_V; alX = 1.f; \
        pv_one<0>(o[0], vb_, pa0, pa1, pa2, pa3); _Pragma("unroll") for (int r_ = 0; r_ < 4; ++r_) PX0[r_] = __builtin_amdgcn_exp2f(PX0[r_]); \
        pv_one<1>(o[1], vb_, pa0, pa1, pa2, pa3); _Pragma("unroll") for (int r_ = 4; r_ < 8; ++r_) PX0[r_] = __builtin_amdgcn_exp2f(PX0[r_]); \
        pv_one<2>(o[2], vb_, pa0, pa1, pa2, pa3); _Pragma("unroll") for (int r_ = 8; r_ < 12; ++r_) PX0[r_] = __builtin_amdgcn_exp2f(PX0[r_]); \
        pv_one<3>(o[3], vb_, pa0, pa1, pa2, pa3); _Pragma("unroll") for (int r_ = 12; r_ < 16; ++r_) PX0[r_] = __builtin_amdgcn_exp2f(PX0[r_]); } \
    else { pv_d0(o, vb0 + (((j) + 3) & 3) * SHM_V, pa0, pa1, pa2, pa3); SM_STEP(PX0, PX1, alX); } } while (0)
#ifndef ATT_LATE_SPLIT
#define ATT_LATE_SPLIT 0
#endif
#define B1_PART(j) do { const int vb_ = vb0 + (((j) + 3) & 3) * SHM_V; if (ATT_LATE_SPLIT) { pv_one<0>(o[0], vb_, pa0, pa1, pa2, pa3); pv_one<1>(o[1], vb_, pa0, pa1, pa2, pa3); } } while (0)
#define B2_PART(PX0, PX1, alX, j) do { const int vb_ = vb0 + (((j) + 3) & 3) * SHM_V; \
    if (ATT_LATE_SPLIT) { pv_one<2>(o[2], vb_, pa0, pa1, pa2, pa3); pv_one<3>(o[3], vb_, pa0, pa1, pa2, pa3); } else pv_d0(o, vb_, pa0, pa1, pa2, pa3); \
    SM_STEP(PX0, PX1, alX); } while (0)
  DMA_K(0, 0); DMA_V(0, 0); DMA_K(1, 1);
  WAIT_BAR(0);
  int j = 1;
  if (wid < 4) {
    A_PART(pA0, pA1, pB0, pB1, alB, 0, true, true, false); partialSM<true>(pA0, pA1, mhat, negm, alA); WAIT_BAR(3); K3NEXT();
    for (; j + 3 < NT; j += 2) {
      A_PART(pB0, pB1, pA0, pA1, alA, j, true, true, true); B_PART(pB0, pB1, alB, j); WAIT_BAR(3); K3NEXT();
      A_PART(pA0, pA1, pB0, pB1, alB, j + 1, true, true, true); B_PART(pA0, pA1, alA, j + 1); WAIT_BAR(3); K3NEXT();
    }
    A_PART(pB0, pB1, pA0, pA1, alA, j, true, true, true); B_PART(pB0, pB1, alB, j); WAIT_BAR(3); K3NEXT();
    A_PART(pA0, pA1, pB0, pB1, alB, j + 1, false, true, true); B_PART(pA0, pA1, alA, j + 1); WAIT_BAR(2); K3NEXT();
    A_PART(pB0, pB1, pA0, pA1, alA, j + 2, false, false, true); B_PART(pB0, pB1, alB, j + 2); WAIT_BAR(0); K3NEXT();
  } else {
    A_PART(pA0, pA1, pB0, pB1, alB, 0, true, true, false); WAIT_BAR(3); K3NEXT();
    partialSM<true>(pA0, pA1, mhat, negm, alA);
    for (; j + 3 < NT; j += 2) {
      A_PART(pB0, pB1, pA0, pA1, alA, j, true, true, true); B1_PART(j); WAIT_BAR(3); K3NEXT(); B2_PART(pB0, pB1, alB, j);
      A_PART(pA0, pA1, pB0, pB1, alB, j + 1, true, true, true); B1_PART(j + 1); WAIT_BAR(3); K3NEXT(); B2_PART(pA0, pA1, alA, j + 1);
    }
    A_PART(pB0, pB1, pA0, pA1, alA, j, true, true, true); B1_PART(j); WAIT_BAR(3); K3NEXT(); B2_PART(pB0, pB1, alB, j);
    A_PART(pA0, pA1, pB0, pB1, alB, j + 1, false, true, true); B1_PART(j + 1); WAIT_BAR(2); K3NEXT(); B2_PART(pA0, pA1, alA, j + 1);
    A_PART(pB0, pB1, pA0, pA1, alA, j + 2, false, false, true); B1_PART(j + 2); WAIT_BAR(0); K3NEXT(); B2_PART(pB0, pB1, alB, j + 2);
  }
  finishSM(pB0, pB1, alB, l_reg, pa0, pa1, pa2, pa3); SBAR();
  pv_d0(o, vb0 + ((NT - 1) & 3) * SHM_V, pa0, pa1, pa2, pa3);
  WAIT_BAR(0);
  l_out = l_reg;
#undef A_PART
#undef SM_STEP
#undef B_PART
#undef B1_PART
#undef B2_PART
#undef K3NEXT
#undef DMA_K
#undef DMA_V
#undef RESC
}
#undef WAIT_BAR
#undef SBAR
}

#define GAS __attribute__((address_space(1)))
#define LAS __attribute__((address_space(3)))
typedef unsigned short bf16;
typedef unsigned v4u __attribute__((ext_vector_type(4)));
typedef float f32x4 __attribute__((ext_vector_type(4)));
typedef short bf16x8 __attribute__((ext_vector_type(8)));
typedef GAS unsigned gu32;
typedef GAS unsigned long long gu64;
#define RLX_AGENT __ATOMIC_RELAXED, __HIP_MEMORY_SCOPE_AGENT
#define LDS_WAIT() asm volatile("s_waitcnt lgkmcnt(0)" ::: "memory")
#define VM_WAIT() asm volatile("s_waitcnt vmcnt(0)" ::: "memory")
__device__ __forceinline__ unsigned long long rt() { return __builtin_amdgcn_s_memrealtime(); }
__device__ __forceinline__ unsigned f2bf(float f) { unsigned u = __builtin_bit_cast(unsigned, f); return (u + 0x7fffu + ((u >> 16) & 1u)) >> 16; }
__device__ __forceinline__ unsigned pk2(float lo, float hi) { return f2bf(lo) | (f2bf(hi) << 16); }
#define XB_TMO      128
#define XB_XCNT(j)  (256  + 64 * (j))
#define XB_XSUB(j)  (1280 + 64 * (j))
#define XB_XGEN(j)  (2304 + 64 * (j))
#define XB_TOP      3328
#define XB_TOPGEN   3392
#define XCD_BAR_WORDS 3456
#define XB_SPIN_CAP (1u << 18)

__device__ __forceinline__ unsigned xb_ld(unsigned* p)              { return __hip_atomic_load(p, __ATOMIC_RELAXED, __HIP_MEMORY_SCOPE_AGENT); }
__device__ __forceinline__ unsigned xb_add(unsigned* p, unsigned v) { return __hip_atomic_fetch_add(p, v, __ATOMIC_RELAXED, __HIP_MEMORY_SCOPE_AGENT); }
__device__ __forceinline__ unsigned xb_xcc_id() { return (unsigned)__builtin_amdgcn_s_getreg((3 << 11) | 20) & 0xFu; }
#define XB_SPIN(cond, bar) do { unsigned _sp = 0; while (cond) { __builtin_amdgcn_s_sleep(1); \
    if ((++_sp & 255u) == 0u) { if (xb_ld(&(bar)[XB_TMO])) break; if (_sp > XB_SPIN_CAP) { atomicAdd(&(bar)[XB_TMO], 1u); break; } } } } while (0)

struct XcdBarrier {
    unsigned* bar; unsigned x;
    volatile LAS unsigned* st;
};

__device__ __forceinline__ XcdBarrier xcd_barrier_post(unsigned* bar, volatile LAS unsigned* st) {
    XcdBarrier b; b.bar = bar; b.x = xb_xcc_id(); b.st = st;
    if (threadIdx.x == 0) (void)xb_add(&bar[XB_XCNT(b.x)], 1u);
    return b;
}
__device__ __forceinline__ void xcd_barrier_complete(unsigned* bar, unsigned x, unsigned& nloc, unsigned& nx) {
    const unsigned G = gridDim.x * gridDim.y * gridDim.z;
    unsigned sum, cnt, mine, sp = 0u;
    for (;;) {
        sum = 0u; cnt = 0u; mine = 0u;
#pragma unroll
        for (unsigned j = 0; j < 16; ++j) { const unsigned c = xb_ld(&bar[XB_XCNT(j)]); sum += c; cnt += (c > 0u) ? 1u : 0u; mine = (j == x) ? c : mine; }
        if (sum == G) break;
        __builtin_amdgcn_s_sleep(1);
        if ((++sp & 255u) == 0u) { if (xb_ld(&bar[XB_TMO])) break; if (sp > XB_SPIN_CAP) { atomicAdd(&bar[XB_TMO], 1u); break; } }
    }
    nloc = mine > 0u ? mine : 1u; nx = cnt > 0u ? cnt : 1u;
}

__device__ __forceinline__ void xcd_barrier(const XcdBarrier& b) {
    asm volatile("s_waitcnt vmcnt(0)" ::: "memory");
    __syncthreads();
    if (threadIdx.x == 0) {
        unsigned* bar = b.bar;
        __builtin_amdgcn_s_waitcnt(0);
        unsigned nloc = b.st[0], nx = b.st[1];
        if (nloc == 0u) { xcd_barrier_complete(bar, b.x, nloc, nx); b.st[0] = nloc; b.st[1] = nx; }
        const unsigned old = xb_add(&bar[XB_XSUB(b.x)], 1u);
        const unsigned gen = old / nloc;
        if (old + 1u == (gen + 1u) * nloc) {
            __builtin_amdgcn_fence(__ATOMIC_RELEASE, "agent");
            asm volatile("s_waitcnt vmcnt(0)" ::: "memory");
            const unsigned og = xb_add(&bar[XB_TOP], 1u);
            const unsigned tg = og / nx;
            if (og + 1u == (tg + 1u) * nx) xb_add(&bar[XB_TOPGEN], 1u);
            else XB_SPIN(xb_ld(&bar[XB_TOPGEN]) == tg, bar);
            __builtin_amdgcn_fence(__ATOMIC_ACQUIRE, "agent");
            xb_add(&bar[XB_XGEN(b.x)], 1u);
            asm volatile("s_waitcnt vmcnt(0)" ::: "memory");
        } else {
            XB_SPIN(xb_ld(&bar[XB_XGEN(b.x)]) == gen, bar);
            __builtin_amdgcn_fence(__ATOMIC_ACQUIRE, "agent");
            asm volatile("s_waitcnt vmcnt(0)" ::: "memory");
        }
    }
    __syncthreads();
}
constexpr int NWAVES = 8;
constexpr int TT = 24576, DM = 4096, DFF = 11008, NIN = 18432;
constexpr int NH = 16, AW = 2048, RW = 2048;
constexpr int NCHUNK = TT / 64;
constexpr float EPS = 1e-6f;
constexpr int NPHASE = 15;
#ifndef MK_PER_PHASE
#define MK_PER_PHASE 0
#endif

constexpr size_t MiB = 1u << 20;
constexpr size_t WS_CTL = 0, CTL_ZERO_BYTES = 1 * MiB;
constexpr size_t WS_ROPE = 1 * MiB;
constexpr size_t WS_RGW = 2 * MiB;
constexpr size_t WS_AGG = 4 * MiB;
constexpr size_t WS_CARRY = 16 * MiB;
constexpr size_t WS_ASCR = 22 * MiB;
constexpr int PADE = 128, LDH = DM + PADE, LDMID = DFF + PADE, LDO = AW + PADE;
constexpr size_t WS_WFI = 54 * MiB, WS_WFO = 232 * MiB;
constexpr size_t WS_WIN = 319 * MiB, WS_WA = 468 * MiB, WS_WR = WS_WA + (size_t)DM * AW * 2  , WS_WO = 502 * MiB;
constexpr size_t WS_H = 535 * MiB;
constexpr size_t WS_RR = WS_H + (size_t)TT * AW * 2;
constexpr size_t WS_BIG = 739 * MiB;
constexpr size_t WS_QKV = WS_BIG, WS_RXY = WS_BIG + 288 * MiB, WS_G = WS_BIG + 480 * MiB, WS_XR = WS_BIG + 864 * MiB, WS_END = WS_XR + 192 * MiB;
static_assert(WS_WFI + (size_t)2 * DFF * LDH * 2 <= WS_WFO && WS_WFO + (size_t)DM * LDMID * 2 <= WS_WIN && WS_WIN + (size_t)NIN * LDH * 2 <= WS_WA && WS_WA + (size_t)DM * AW * 2 <= WS_WR &&
              WS_WR + (size_t)DM * RW * 2 <= WS_WO && WS_WO + (size_t)DM * LDH * 2 <= WS_H && WS_H + (size_t)TT * LDH * 2 <= WS_BIG && WS_H + (size_t)TT * AW * 2 <= WS_RR && WS_RR + (size_t)TT * RW * 2 <= WS_BIG, "ws map");
static_assert(WS_QKV + (size_t)TT * 6144 * 2 <= WS_RXY && WS_RXY + (size_t)TT * 4096 * 2 <= WS_G && WS_G + (size_t)TT * 8192 * 2 <= WS_END && WS_BIG + (size_t)TT * LDMID * 2 <= WS_END && (size_t)TT * LDH * 2 <= 288 * MiB, "ws map 2");
constexpr int CW_BAR = 4096;
constexpr size_t WS_SSQ = WS_ASCR;
constexpr size_t WS_RSTD = WS_CTL + 512 * 1024;

constexpr int RING_OFF = 0, RING_BYTES = 131072;
constexpr int LDSCTL_OFF = RING_BYTES, MISC_OFF = LDSCTL_OFF + 320;
constexpr int LDS_BYTES = 147456;

struct Frame {
    LAS unsigned char* lds;
    volatile LAS unsigned* MISC;
    int tid, lane, wave;
    int vcu, G;
};
__device__ __forceinline__ float wave_sum(float v) {
#pragma unroll
    for (int o = 1; o < 64; o <<= 1) v += __shfl_xor(v, o);
    return v;
}
__device__ __forceinline__ int seq_start(int row) { return row < 4096 ? 0 : (row < 8192 ? 4096 : 8192); }
__device__ __forceinline__ int seq_end(int row) { return row < 4096 ? 4096 : (row < 8192 ? 8192 : TT); }

struct TItem { const float* src; bf16* WT; const float* gk; int N, drow0, k0, KT, mode; };
__device__ __forceinline__ void titem_load(const TItem& d, float (&v)[32]) {
#pragma unroll
    for (int i = 0; i < 32; ++i) v[i] = d.src[(size_t)(2 * i) * d.N];
}
__device__ __forceinline__ void titem_finish(const TItem& d, const float (&v)[32], LAS float* scr, int lane) {
#pragma unroll
    for (int i = 0; i < 32; ++i) scr[(2 * i + (lane >> 5)) * 33 + (lane & 31)] = v[i];
    LDS_WAIT(); asm volatile("" ::: "memory");
    const int c = lane & 7;
    f32x4 g0 = (f32x4){1.f, 1.f, 1.f, 1.f}, g1 = g0;
    if (d.gk) { g0 = *(const GAS f32x4*)(d.gk + d.k0 + 8 * c); g1 = *(const GAS f32x4*)(d.gk + d.k0 + 8 * c + 4); }
#pragma unroll
    for (int j = 0; j < 4; ++j) { const int n = (lane >> 3) + 8 * j; const LAS float* s = scr + (8 * c) * 33 + n;
        v4u o; o.x = pk2(s[0 * 33] * g0.x, s[1 * 33] * g0.y); o.y = pk2(s[2 * 33] * g0.z, s[3 * 33] * g0.w); o.z = pk2(s[4 * 33] * g1.x, s[5 * 33] * g1.y); o.w = pk2(s[6 * 33] * g1.z, s[7 * 33] * g1.w);
        GAS v4u* dp = d.mode == 0 ? (GAS v4u*)(d.WT + (size_t)(d.drow0 + n) * d.KT + d.k0 + 8 * c)
                                  : (GAS v4u*)((unsigned char*)d.WT + pg8::blk_off_b(d.drow0 + n, d.k0 + 8 * c, d.KT, d.mode == 2));
        *dp = o; }
    LDS_WAIT(); asm volatile("" ::: "memory");
}
__device__ __forceinline__ int ffn_in_row(int n) { return n < DFF ? (n >> 7) * 256 + (n & 127) : ((n - DFF) >> 7) * 256 + 128 + ((n - DFF) & 127); }
__device__ __forceinline__ TItem titem_matrix(const float* W, int K, int N, bf16* WT, int KT, int mode, int ffn, int item, int lane, const float* gk = nullptr) {
    const int nblk = N / 32, kb = item / nblk, nb = item % nblk, n0 = 32 * nb, k0 = 64 * kb;
    TItem d; d.src = W + (size_t)(k0 + (lane >> 5)) * N + n0 + (lane & 31); d.WT = WT; d.gk = gk; d.N = N; d.drow0 = ffn ? ffn_in_row(n0) : n0; d.k0 = k0; d.KT = KT; d.mode = mode; return d;
}
__device__ __forceinline__ void rms_row_to_bf16(const float* xrow, const float* g, bf16* Hb, int m, int lane) {
    const GAS f32x4* xr = (const GAS f32x4*)xrow + lane; const GAS f32x4* gr = (const GAS f32x4*)g + lane;
    f32x4 v[16]; float s = 0.f;
#pragma unroll
    for (int j = 0; j < 16; ++j) { v[j] = xr[64 * j]; s += (v[j].x * v[j].x + v[j].y * v[j].y) + (v[j].z * v[j].z + v[j].w * v[j].w); }
    const float rstd = 1.f / sqrtf(wave_sum(s) * (1.f / DM) + EPS);
#pragma unroll
    for (int j = 0; j < 16; ++j) { const f32x4 gg = gr[64 * j];
        *(GAS unsigned long long*)((unsigned char*)Hb + pg8::blk_off(m, 4 * lane + 256 * j, DM / 64)) =
            (unsigned long long)pk2(v[j].x * rstd * gg.x, v[j].y * rstd * gg.y) | ((unsigned long long)pk2(v[j].z * rstd * gg.z, v[j].w * rstd * gg.w) << 32); }
}
__device__ __forceinline__ void rms_row_bf16_to_bf16(const bf16* xrow, const float* g, bf16* Hb, int m, int lane) {
    const GAS v4u* xr = (const GAS v4u*)xrow + lane;
    v4u v[8]; float s = 0.f;
#pragma unroll
    for (int j = 0; j < 8; ++j) { v[j] = xr[64 * j]; const unsigned w[4] = {v[j].x, v[j].y, v[j].z, v[j].w};
#pragma unroll
        for (int k = 0; k < 4; ++k) { const float a = pg8::bf_lo(w[k]), b = pg8::bf_hi(w[k]); s += a * a + b * b; } }
    const float rstd = 1.f / sqrtf(wave_sum(s) * (1.f / DM) + EPS);
#pragma unroll
    for (int j = 0; j < 8; ++j) { const int col = 8 * lane + 512 * j; const f32x4 g0 = *(const GAS f32x4*)(g + col), g1 = *(const GAS f32x4*)(g + col + 4);
        v4u o; o.x = pk2(pg8::bf_lo(v[j].x) * rstd * g0.x, pg8::bf_hi(v[j].x) * rstd * g0.y); o.y = pk2(pg8::bf_lo(v[j].y) * rstd * g0.z, pg8::bf_hi(v[j].y) * rstd * g0.w);
        o.z = pk2(pg8::bf_lo(v[j].z) * rstd * g1.x, pg8::bf_hi(v[j].z) * rstd * g1.y); o.w = pk2(pg8::bf_lo(v[j].w) * rstd * g1.z, pg8::bf_hi(v[j].w) * rstd * g1.w);
        *(GAS v4u*)((unsigned char*)Hb + pg8::blk_off(m, col, DM / 64)) = o; }
}
__device__ __forceinline__ void rms_row_f32_inplace(float* xrow, const float* g, int lane) {
    GAS f32x4* xr = (GAS f32x4*)xrow + lane; const GAS f32x4* gr = (const GAS f32x4*)g + lane;
    f32x4 v[16]; float s = 0.f;
#pragma unroll
    for (int j = 0; j < 16; ++j) { v[j] = xr[64 * j]; s += (v[j].x * v[j].x + v[j].y * v[j].y) + (v[j].z * v[j].z + v[j].w * v[j].w); }
    const float rstd = 1.f / sqrtf(wave_sum(s) * (1.f / DM) + EPS);
#pragma unroll
    for (int j = 0; j < 16; ++j) { const f32x4 gg = gr[64 * j]; xr[64 * j] = v[j] * rstd * gg; }
}
__device__ __forceinline__ int recent_first_row(int it) { const int pp = it >> 8, s = pp >> 5, idx = pp & 31; return ((12 * (idx >> 2) + 4 * (2 - s) + (idx & 3)) << 8) + (it & 255); }
__device__ __forceinline__ void rms_row_bf16_to_f32(const bf16* Xb, int m, const float* g, float* orow, int lane) {
    v4u v[8]; float s = 0.f;
#pragma unroll
    for (int j = 0; j < 8; ++j) { v[j] = *(const GAS v4u*)((const unsigned char*)Xb + pg8::blk_off(m, 8 * lane + 512 * j, DM / 64)); const unsigned w[4] = {v[j].x, v[j].y, v[j].z, v[j].w};
#pragma unroll
        for (int k = 0; k < 4; ++k) { const float a = pg8::bf_lo(w[k]), b = pg8::bf_hi(w[k]); s += a * a + b * b; } }
    const float rstd = 1.f / sqrtf(wave_sum(s) * (1.f / DM) + EPS);
#pragma unroll
    for (int j = 0; j < 8; ++j) { const int col = 8 * lane + 512 * j; const f32x4 g0 = *(const GAS f32x4*)(g + col), g1 = *(const GAS f32x4*)(g + col + 4);
        *(GAS f32x4*)(orow + col) = (f32x4){pg8::bf_lo(v[j].x) * rstd * g0.x, pg8::bf_hi(v[j].x) * rstd * g0.y, pg8::bf_lo(v[j].y) * rstd * g0.z, pg8::bf_hi(v[j].y) * rstd * g0.w};
        *(GAS f32x4*)(orow + col + 4) = (f32x4){pg8::bf_lo(v[j].z) * rstd * g1.x, pg8::bf_hi(v[j].z) * rstd * g1.y, pg8::bf_lo(v[j].w) * rstd * g1.z, pg8::bf_hi(v[j].w) * rstd * g1.w}; }
}
__device__ __forceinline__ void rstd_phase(Frame& F, const float* ssq, float* rstd) {
    for (int m = F.vcu * (NWAVES * 64) + F.tid; m < TT; m += F.G * NWAVES * 64) { const GAS f32x4* p = (const GAS f32x4*)(ssq + (size_t)m * 64); float s = 0.f;
#pragma unroll
        for (int j = 0; j < 16; ++j) { const f32x4 v = p[j]; s += (v.x + v.y) + (v.z + v.w); }
        rstd[m] = 1.f / sqrtf(s * (1.f / DM) + EPS); }
}
__device__ __forceinline__ void rms_phase(Frame& F, const float* xa, const float* xb, const float* g, bf16* H) {
    const int gw = F.vcu * NWAVES + F.wave, NGW = F.G * NWAVES;
    for (int it = gw; it < TT; it += NGW) { const int m = recent_first_row(it); const float* xr = m < 8192 ? xa + (size_t)m * DM : xb + (size_t)(m - 8192) * DM; rms_row_to_bf16(xr, g, H, m, F.lane); }
}

constexpr int RL_XB = 0, RL_XF = 17408, RL_CW = 51200, RL_RAW = 53760, RL_RAWB = 33792;
static_assert(RL_RAW + 2 * RL_RAWB <= RING_BYTES, "rglru LDS");
template <bool REV> __device__ __forceinline__ void rl_scan(const float (&a)[4][4], const float (&u)[4][4], float cin, float (&h)[4][4], float& Atot, float& Hfin, int lane) {
    const int fq = lane >> 4, fr = lane & 15;
    const int src1 = (REV ? lane + 16 : lane - 16) & 63, src2 = (REV ? lane + 32 : lane - 32) & 63, srct = REV ? fr : fr + 48;
    const bool v1 = REV ? fq <= 2 : fq >= 1, v2 = REV ? fq <= 1 : fq >= 2;
    float C = cin; Atot = 1.f;
#pragma unroll
    for (int mtt = 0; mtt < 4; ++mtt) { const int mt = REV ? 3 - mtt : mtt;
        float P[4], Hl[4];
        if (!REV) { P[0] = a[mt][0]; Hl[0] = u[mt][0];
#pragma unroll
            for (int i = 1; i < 4; ++i) { P[i] = a[mt][i] * P[i - 1]; Hl[i] = a[mt][i] * Hl[i - 1] + u[mt][i]; } }
        else { P[3] = a[mt][3]; Hl[3] = u[mt][3];
#pragma unroll
            for (int i = 2; i >= 0; --i) { P[i] = a[mt][i] * P[i + 1]; Hl[i] = a[mt][i] * Hl[i + 1] + u[mt][i]; } }
        float As = REV ? P[0] : P[3], Hs = REV ? Hl[0] : Hl[3];
        { const float Ap = __shfl(As, src1), Hp = __shfl(Hs, src1); if (v1) { Hs = As * Hp + Hs; As = As * Ap; } }
        { const float Ap = __shfl(As, src2), Hp = __shfl(Hs, src2); if (v2) { Hs = As * Hp + Hs; As = As * Ap; } }
        float Ae = __shfl(As, src1), He = __shfl(Hs, src1); if (!v1) { Ae = 1.f; He = 0.f; }
        const float At = __shfl(As, srct), Ht = __shfl(Hs, srct);
        const float E = Ae * C + He;
#pragma unroll
        for (int i = 0; i < 4; ++i) h[mt][i] = P[i] * E + Hl[i];
        C = At * C + Ht; Atot *= At; }
    Hfin = C;
}
__device__ __forceinline__ float gelu_tanh(float x) {
    const float z = 0.7978845608028654f * (x + 0.044715f * x * x * x);
    const float e = __builtin_amdgcn_exp2f(2.f * 1.4426950408889634f * z);
    const float th = 1.f - 2.f * __builtin_amdgcn_rcpf(e + 1.f);
    return 0.5f * x * (1.f + th);
}
__device__ __forceinline__ void rl_glds16(const void* gsrc, unsigned lds_dst) { unsigned keep;
    asm volatile("s_mov_b32 %0, m0\n\ts_mov_b32 m0, %2\n\ts_nop 0\n\tglobal_load_lds_dwordx4 %1, off\n\ts_mov_b32 m0, %0" : "=&s"(keep) : "v"(gsrc), "s"(lds_dst) : "memory"); }
template <bool FINAL>
__device__ __forceinline__ void rglru_phase(Frame& F, const bf16* RXY, const bf16* RGW, const float* conv_w, const float* conv_b, const float* rg_ba, const float* rg_bx,
                                            const float* rg_lambda, float* AGG, const float* CARRY, bf16* RR) {
    typedef short bf16x8 __attribute__((ext_vector_type(8)));
    const int tid = F.tid, lane = F.lane, w = F.wave, fr = lane & 15, fq = lane >> 4;
    const int n = F.vcu & 15, cl = 16 * w + fr, cg = n * 128 + cl;
    LAS unsigned char* L = F.lds + RING_OFF;
    LAS float* CW = (LAS float*)(L + RL_CW);
    for (int i = tid; i < 640; i += NWAVES * 64) CW[i] = i < 512 ? conv_w[(i >> 7) * RW + n * 128 + (i & 127)] : conv_b[n * 128 + (i - 512)];
    bf16x8 Bf[4][4]; float bias[4], sp[2];
#pragma unroll
    for (int g = 0; g < 4; ++g) {
#pragma unroll
        for (int ks = 0; ks < 4; ++ks) Bf[g][ks] = *(const bf16x8*)(RGW + ((size_t)(g * 16 + n) * 128 + cl) * 128 + 32 * ks + 8 * fq);
        bias[g] = (g & 1) ? rg_bx[((g >> 1) * 16 + n) * 128 + cl] : rg_ba[((g >> 1) * 16 + n) * 128 + cl]; }
#pragma unroll
    for (int d = 0; d < 2; ++d) sp[d] = log1pf(__expf(-rg_lambda[d * RW + cg]));
    __syncthreads();
    const int t = tid >> 3, c16 = (tid & 7) * 16;
    float k1[2];
#pragma unroll
    for (int d = 0; d < 2; ++d) k1[d] = -8.f * 1.4426950408889634f * sp[d];
#ifndef RL_PASSES
#define RL_PASSES 1
#endif
    const int cstep = F.G >> 4, cfirst = F.vcu >> 4;
#define RL_DMA(ci_, buf_) do { const int row0_ = (ci_) * 64, s0_ = seq_start(row0_), s1_ = seq_end(row0_); \
        _Pragma("unroll") for (int k_ = 0; k_ < (FINAL ? 5 : 3); ++k_) { int q_ = w + NWAVES * k_; q_ = q_ < (FINAL ? 33 : 17) ? q_ : (FINAL ? 32 : 16);     \
            const int lr_ = 4 * (q_ < 17 ? q_ : q_ - 17) + (lane >> 4); int gr_ = q_ < 17 ? row0_ - 2 + lr_ : row0_ + lr_; gr_ = gr_ < s0_ ? s0_ : (gr_ >= s1_ ? s1_ - 1 : gr_); \
            const bf16* gp_ = RXY + (size_t)gr_ * 4096 + (q_ < 17 ? 0 : 2048) + n * 128 + (lane & 15) * 8; \
            rl_glds16(gp_, (unsigned)__builtin_amdgcn_readfirstlane((int)(lds0 + RL_RAW + (buf_) * RL_RAWB + q_ * 1024))); } } while (0)
    const unsigned lds0 = (unsigned)(uintptr_t)L;
    {
#define RL_WRAP(x) ((x) >= NCHUNK ? (x) - NCHUNK : (x))
    float cnx[2] = {0.f, 0.f};
    if (cfirst < NCHUNK) { RL_DMA(cfirst, 0); if (FINAL) { cnx[0] = CARRY[(size_t)(cfirst * 2 + 0) * RW + cg]; cnx[1] = CARRY[(size_t)(cfirst * 2 + 1) * RW + cg]; } }
    int buf = 0;
    for (int cl_ = cfirst; cl_ < NCHUNK * RL_PASSES; cl_ += cstep, buf ^= 1) { const int ci = RL_WRAP(cl_);
        const int row0 = ci * 64, s0 = seq_start(row0), s1 = seq_end(row0);
        LAS unsigned char* RAW = L + RL_RAW + buf * RL_RAWB; LAS unsigned char* YR = RAW + 68 * 256;
        asm volatile("s_waitcnt vmcnt(0) lgkmcnt(0)" ::: "memory"); __builtin_amdgcn_s_barrier(); asm volatile("" ::: "memory");
        const float cin2[2] = {cnx[0], cnx[1]};
        if (cl_ + cstep < NCHUNK * RL_PASSES) { const int cn = RL_WRAP(cl_ + cstep); RL_DMA(cn, buf ^ 1);
            if (FINAL) { cnx[0] = CARRY[(size_t)(cn * 2 + 0) * RW + cg]; cnx[1] = CARRY[(size_t)(cn * 2 + 1) * RW + cg]; } }
        { float xa[16];
#pragma unroll
          for (int k = 0; k < 16; ++k) xa[k] = CW[512 + c16 + k];
#pragma unroll
          for (int j = 0; j < 4; ++j) { const int rr = row0 + t + j - 2; const float msk = (rr >= s0 && rr < s1) ? 1.f : 0.f;
              const LAS v4u* rp = (const LAS v4u*)(RAW + (t + j) * 256 + c16 * 2); const v4u q0 = rp[0], q1 = rp[1];
              const unsigned ww[8] = {q0.x, q0.y, q0.z, q0.w, q1.x, q1.y, q1.z, q1.w};
#pragma unroll
              for (int k = 0; k < 8; ++k) { xa[2 * k] += CW[j * 128 + c16 + 2 * k] * (msk * pg8::bf_lo(ww[k])); xa[2 * k + 1] += CW[j * 128 + c16 + 2 * k + 1] * (msk * pg8::bf_hi(ww[k])); } }
          LAS f32x4* xf = (LAS f32x4*)(L + RL_XF + t * 528 + c16 * 4);
#pragma unroll
          for (int k = 0; k < 4; ++k) xf[k] = (f32x4){xa[4 * k], xa[4 * k + 1], xa[4 * k + 2], xa[4 * k + 3]};
          LAS v4u* xb = (LAS v4u*)(L + RL_XB + t * 272 + c16 * 2);
          xb[0] = (v4u){pk2(xa[0], xa[1]), pk2(xa[2], xa[3]), pk2(xa[4], xa[5]), pk2(xa[6], xa[7])};
          xb[1] = (v4u){pk2(xa[8], xa[9]), pk2(xa[10], xa[11]), pk2(xa[12], xa[13]), pk2(xa[14], xa[15])}; }
        asm volatile("s_waitcnt lgkmcnt(0)" ::: "memory"); __builtin_amdgcn_s_barrier(); asm volatile("" ::: "memory");
        float hsum[4][4];
#pragma unroll
        for (int d = 0; d < 2; ++d) {
            float a[4][4], u[4][4];
#pragma unroll
            for (int mt = 0; mt < 4; ++mt) {
                f32x4 ca = (f32x4){bias[2 * d], bias[2 * d], bias[2 * d], bias[2 * d]}, cx = (f32x4){bias[2 * d + 1], bias[2 * d + 1], bias[2 * d + 1], bias[2 * d + 1]};
#pragma unroll
                for (int ks = 0; ks < 4; ++ks) { const bf16x8 af = *(const LAS bf16x8*)(L + RL_XB + (16 * mt + fr) * 272 + (32 * ks + 8 * fq) * 2);
                    ca = __builtin_amdgcn_mfma_f32_16x16x32_bf16(af, Bf[2 * d][ks], ca, 0, 0, 0); cx = __builtin_amdgcn_mfma_f32_16x16x32_bf16(af, Bf[2 * d + 1][ks], cx, 0, 0, 0); }
#pragma unroll
                for (int i = 0; i < 4; ++i) { const float ra = pg8::sigm(ca[i]), ia = pg8::sigm(cx[i]);
                    const float xv = *(const LAS float*)(L + RL_XF + (16 * mt + 4 * fq + i) * 528 + cl * 4);
                    const float av = __builtin_amdgcn_exp2f(k1[d] * ra);
                    a[mt][i] = av; u[mt][i] = __builtin_amdgcn_sqrtf(fmaxf(fmaf(-av, av, 1.f), 0.f)) * (ia * xv); } }
            float h[4][4], Atot, Hfin;
            const float cin = cin2[d];
            if (d == 0) rl_scan<false>(a, u, cin, h, Atot, Hfin, lane); else rl_scan<true>(a, u, cin, h, Atot, Hfin, lane);
            if (FINAL) {
#pragma unroll
                for (int mt = 0; mt < 4; ++mt)
#pragma unroll
                    for (int i = 0; i < 4; ++i) hsum[mt][i] = d == 0 ? h[mt][i] : hsum[mt][i] + h[mt][i]; }
            else if (fq == 0) { float2 ah; ah.x = Atot; ah.y = Hfin; *(float2*)(AGG + ((size_t)(ci * 2 + d) * RW + cg) * 2) = ah; }
        }
        if (FINAL) {
#pragma unroll
            for (int mt = 0; mt < 4; ++mt)
#pragma unroll
                for (int i = 0; i < 4; ++i) { LAS unsigned short* yp = (LAS unsigned short*)(YR + (16 * mt + 4 * fq + i) * 256 + cl * 2);
                    const float y = __uint_as_float((unsigned)(*yp) << 16); *yp = (unsigned short)f2bf(hsum[mt][i] * gelu_tanh(y)); }
            asm volatile("s_waitcnt lgkmcnt(0)" ::: "memory"); __builtin_amdgcn_s_barrier(); asm volatile("" ::: "memory");
            { const LAS v4u* yb = (const LAS v4u*)(YR + t * 256 + c16 * 2); const v4u o0 = yb[0], o1 = yb[1]; *(v4u*)((unsigned char*)RR + pg8::blk_off(row0 + t, n * 128 + c16, RW / 64)) = o0; *(v4u*)((unsigned char*)RR + pg8::blk_off(row0 + t, n * 128 + c16 + 8, RW / 64)) = o1; }
        }
    }
    asm volatile("s_waitcnt vmcnt(0) lgkmcnt(0)" ::: "memory"); __builtin_amdgcn_s_barrier(); asm volatile("" ::: "memory"); }
#undef RL_DMA
#undef RL_WRAP
}
__device__ __forceinline__ void carry_phase(Frame& F, const float* AGG, float* CARRY) {
    const int gt = F.vcu * (NWAVES * 64) + F.tid;
    if (gt >= 3 * 2 * RW) return;
    const int s = gt / (2 * RW), d = (gt / RW) & 1, c = gt % RW;
    const int c0 = s == 0 ? 0 : (s == 1 ? 64 : 128), c1 = s == 0 ? 64 : (s == 1 ? 128 : NCHUNK);
    float carry = 0.f;
    for (int b = 0; b < c1 - c0; b += 32) {
        float2 ah[32];
#pragma unroll
        for (int k = 0; k < 32; ++k) { const int ch = d == 0 ? c0 + b + k : c1 - 1 - b - k; ah[k] = *(const float2*)(AGG + ((size_t)(ch * 2 + d) * RW + c) * 2); }
#pragma unroll
        for (int k = 0; k < 32; ++k) { const int ch = d == 0 ? c0 + b + k : c1 - 1 - b - k; CARRY[(size_t)(ch * 2 + d) * RW + c] = carry; carry = ah[k].x * carry + ah[k].y; }
    }
}

#ifndef ATT_FORCE_SLOW
#define ATT_FORCE_SLOW 0
#endif
#ifndef GEMM_SP2
#define GEMM_SP2 true
#endif
#ifndef ALL_WGM
#define ALL_WGM 4
#endif
#ifndef GEMM_REV
#define GEMM_REV 0xB
#endif
#ifndef FFO_CSPLIT
#define FFO_CSPLIT 1
#endif
#ifndef FFO_WGM
#define FFO_WGM 4
#endif
#ifndef TAIL_FILL
#define TAIL_FILL 0
#endif
#ifndef SKEW_TICKS
#define SKEW_TICKS 0
#endif
#define PHASE_SKEW() do { if (SKEW_TICKS) { const unsigned long long t0_ = __builtin_amdgcn_s_memrealtime(); const unsigned long long d_ = (unsigned long long)((F.vcu * 8 / F.G) & 7) * SKEW_TICKS; \
        while (__builtin_amdgcn_s_memrealtime() - t0_ < d_) __builtin_amdgcn_s_sleep(16); } } while (0)
#define RESID_WMODE (RESID_PERM ? 2 : 1)
#ifndef RESID_ALIGN
#define RESID_ALIGN true
#endif
struct Args { const float* in[26]; float* out; unsigned char* ws; int ph_lo, ph_hi, li, pad; };
__device__ __forceinline__ double rope_rev(int j) {
    return j == 0 ? 0.15915494309189535 : j == 1 ? 0.03086376340470123 : j == 2 ? 0.005985185712713705 : j == 3 ? 0.001160663641240061 :
           j == 4 ? 0.00022507907903927653 : j == 5 ? 4.364795279280289e-05 : j == 6 ? 8.464330808241401e-06 : 1.6414262627950345e-06;
}
#define TRANSPOSE_STREAM(DESC, NIT) do { int it_ = gw; if (it_ < (NIT)) { float va_[32], vb_[32]; TItem da_ = DESC(it_), db_; titem_load(da_, va_); \
        for (;;) { int nx_ = it_ + NGW; bool hn_ = nx_ < (NIT); db_ = DESC(hn_ ? nx_ : it_); titem_load(db_, vb_); titem_finish(da_, va_, scr, F.lane); if (!hn_) break; it_ = nx_; \
                   nx_ = it_ + NGW; hn_ = nx_ < (NIT); da_ = DESC(hn_ ? nx_ : it_); titem_load(da_, va_); titem_finish(db_, vb_, scr, F.lane); if (!hn_) break; it_ = nx_; } } } while (0)
__global__ void __launch_bounds__(NWAVES * 64, 2) mk_fwd(Args args) {
    extern __shared__ __attribute__((aligned(16))) unsigned char lds[];
    Frame F;
    F.lds = (LAS unsigned char*)lds;
    F.MISC = (volatile LAS unsigned*)(F.lds + MISC_OFF);
    F.tid = threadIdx.x; F.lane = F.tid & 63; F.wave = __builtin_amdgcn_readfirstlane(F.tid >> 6);
    F.G = gridDim.x; { const int bx = blockIdx.x; F.vcu = (F.G % 8 == 0) ? (bx % 8) * (F.G / 8) + bx / 8 : bx; }
    unsigned char* ws = args.ws;
    gu32* ctl = (gu32*)(ws + WS_CTL);
    const float* x_prompt = args.in[0]; const float* x_sample = args.in[1];
    const float* ffn1_norm = args.in[2]; const float* ffn1_w_in = args.in[3]; const float* ffn1_w_out = args.in[4];
    const float* mix_norm = args.in[5]; const float* w_in = args.in[6];
    const float* lq1 = args.in[7]; const float* lk1 = args.in[8]; const float* lq2 = args.in[9]; const float* lk2 = args.in[10];
    const float* subln_gain = args.in[11]; const float* conv_w = args.in[12]; const float* conv_b = args.in[13];
    const float* rg_wa = args.in[14]; const float* rg_ba = args.in[15]; const float* rg_wx = args.in[16]; const float* rg_bx = args.in[17]; const float* rg_lambda = args.in[18];
    const float* w_attn = args.in[19]; const float* w_rnn = args.in[20]; const float* w_out = args.in[21];
    const float* ffn2_norm = args.in[22]; const float* ffn2_w_in = args.in[23]; const float* ffn2_w_out = args.in[24]; const float* final_norm = args.in[25];
    float* out = args.out;
    float* ROPE = (float*)(ws + WS_ROPE); bf16* RGW = (bf16*)(ws + WS_RGW); float* AGG = (float*)(ws + WS_AGG); float* CARRY = (float*)(ws + WS_CARRY);
    bf16* WFI = (bf16*)(ws + WS_WFI); bf16* WFO = (bf16*)(ws + WS_WFO); bf16* WIN = (bf16*)(ws + WS_WIN); bf16* WA = (bf16*)(ws + WS_WA); bf16* WR = (bf16*)(ws + WS_WR); bf16* WO = (bf16*)(ws + WS_WO);
    bf16* H = (bf16*)(ws + WS_H); bf16* OB = H; bf16* RR = (bf16*)(ws + WS_RR);
    bf16* XR = (bf16*)(ws + WS_XR); float* SSQ = (float*)(ws + WS_SSQ); float* RSTD = (float*)(ws + WS_RSTD); bf16* MID = (bf16*)(ws + WS_BIG); bf16* QKV = (bf16*)(ws + WS_QKV); bf16* RXY = (bf16*)(ws + WS_RXY); bf16* GT = (bf16*)(ws + WS_G); bf16* MG = QKV;

    for (int u = F.tid; u < (LDS_BYTES - LDSCTL_OFF) / 4; u += NWAVES * 64) ((LAS unsigned*)(F.lds + LDSCTL_OFF))[u] = 0u;
    __syncthreads();
    XcdBarrier bar; bar.bar = (unsigned*)(ctl + CW_BAR) + args.li * XCD_BAR_WORDS; bar.x = 0; bar.st = nullptr;
    if (!MK_PER_PHASE) bar = xcd_barrier_post((unsigned*)(ctl + CW_BAR) + args.li * XCD_BAR_WORDS, F.MISC + 8);
#define GRID_BAR() do { xcd_barrier(bar); } while (0)
    const int lo = args.ph_lo, hi = args.ph_hi;
#ifndef PH_MASK
#define PH_MASK 0x7fff
#endif
#define IN(k) (((PH_MASK >> (k)) & 1) && lo <= (k) && (k) < hi)
#define BOTH(k) (IN(k) && IN((k) + 1))
#ifndef PH_REP
#define PH_REP 0
#endif
#define REPS(k) ((((PH_REP) >> (k)) & 1) + 1)
    const int gw = F.vcu * NWAVES + F.wave, NGW = F.G * NWAVES;
    LAS float* scr = (LAS float*)(F.lds + RING_OFF + F.wave * 16384);

#ifndef PROBE_ALL2_LO
#define PROBE_ALL2_LO 0
#define PROBE_ALL2_HI (NPHASE - 1)
#endif
#ifndef PROBE_ALL2
#define PROBE_ALL2 0
#endif
    if (IN(0))
_Pragma("unroll")
    for (int rep = 0; rep < REPS(0); ++rep) {
        constexpr int I_FI = (DM / 64) * (2 * DFF / 32), I_FO = (DFF / 64) * (DM / 32), I_IN = (DM / 64) * (NIN / 32), I_A = (AW / 64) * (DM / 32), I_O = (DM / 64) * (DM / 32), I_RG = 512;
        constexpr int NITEMS = I_FI + I_IN + I_O + I_RG + (TAIL_FILL ? 0 : I_FO + 2 * I_A);
        auto desc0 = [&](int it) -> TItem {
            int r = it;
            if (r < I_FI) return titem_matrix(ffn1_w_in, DM, 2 * DFF, WFI, DM / 64, 2, 1, r, F.lane); r -= I_FI;
            if (r < I_IN) return titem_matrix(w_in, DM, NIN, WIN, DM / 64, 2, 0, r, F.lane, mix_norm); r -= I_IN;
            if (r < I_O) return titem_matrix(w_out, DM, DM, WO, DM / 64, RESID_WMODE, 0, r, F.lane); r -= I_O;
            if (!TAIL_FILL) {
            if (r < I_FO) return titem_matrix(ffn1_w_out, DFF, DM, WFO, DFF / 64, RESID_WMODE, 0, r, F.lane); r -= I_FO;
            if (r < I_A) return titem_matrix(w_attn, AW, DM, WA, AW / 64, 2, 0, r, F.lane); r -= I_A;
            if (r < I_A) return titem_matrix(w_rnn, RW, DM, WR, RW / 64, 2, 0, r, F.lane); r -= I_A; }
            const int blk = r >> 3, sub = r & 7, gate = blk >> 5, b = blk & 31, dir = b >> 4, n = b & 15;
            return titem_matrix((gate ? rg_wx : rg_wa) + (size_t)b * 16384, 128, 128, RGW + (size_t)((dir * 2 + gate) * 16 + n) * 16384, 128, 0, 0, sub, F.lane);
        };
        TRANSPOSE_STREAM(desc0, NITEMS);
        for (int idx = gw * 64 + F.lane; idx < 16384 * 8; idx += NGW * 64) { const int pos = idx >> 3, j = idx & 7;
            double rev = (double)pos * rope_rev(j); rev -= __builtin_floor(rev); const float rf = (float)rev;
            float2 cs; cs.x = __builtin_amdgcn_cosf(rf); cs.y = __builtin_amdgcn_sinf(rf); *(float2*)(ROPE + 2 * (size_t)idx) = cs; }
        rms_phase(F, x_prompt, x_sample, ffn1_norm, H);
        if (BOTH(0) || rep + 1 < REPS(0)) GRID_BAR();
    }
    if (IN(1))
_Pragma("unroll")
    for (int rep = 0; rep < REPS(1); ++rep) {
        pg8::Gemm g{H, WFI, TT, 2 * DFF, DM, LDH, LDH}; pg8::StaticOrder S; S.init(TT, 2 * DFF, F.G, (int)blockIdx.x, ALL_WGM); S.rev = (GEMM_REV >> 5) & 1;
        pg8::EpiSwiGLU E{MID, DFF / 64, nullptr};
        pg8::gemm_phase<pg8::EpiSwiGLU, pg8::StaticOrder, true, GEMM_SP2>(F.lds + RING_OFF, g, S, E);
        if (TAIL_FILL && rep == 0) {
            constexpr int I_FO = (DFF / 64) * (DM / 32), I_A = (AW / 64) * (DM / 32);
            const int tail = ((TT / 256) * (2 * DFF / 256)) % F.G, nidle = tail ? F.G - tail : F.G, iw = tail ? (int)blockIdx.x - tail : (int)blockIdx.x;
            if (iw >= 0) { const int gw = iw * NWAVES + F.wave, NGW = nidle * NWAVES;
                auto desc1 = [&](int it) -> TItem { int r = it;
                    if (r < I_FO) return titem_matrix(ffn1_w_out, DFF, DM, WFO, DFF / 64, RESID_WMODE, 0, r, F.lane); r -= I_FO;
                    if (r < I_A) return titem_matrix(w_attn, AW, DM, WA, AW / 64, 2, 0, r, F.lane); r -= I_A;
                    return titem_matrix(w_rnn, RW, DM, WR, RW / 64, 2, 0, r, F.lane); };
                TRANSPOSE_STREAM(desc1, I_FO + 2 * I_A); } }
        if (BOTH(1) || rep + 1 < REPS(1)) GRID_BAR();
    }
#ifdef PROBE_P2B
    if (IN(2)) {
        pg8::Gemm g{MID, WFO, TT, DM, DFF, LDMID, LDMID}; pg8::StaticOrder S; S.init(TT, DM, F.G, (int)blockIdx.x, FFO_WGM); S.csplit = FFO_CSPLIT; S.rev = (GEMM_REV >> 0) & 1;
        pg8::EpiPlainBf16 E{H, 0.5f};
        pg8::gemm_phase<pg8::EpiPlainBf16, pg8::StaticOrder, true, GEMM_SP2>(F.lds + RING_OFF, g, S, E);
        GRID_BAR();
    }
#endif
    if (IN(2))
_Pragma("unroll")
    for (int rep = 0; rep < REPS(2); ++rep) {
        pg8::Gemm g{MID, WFO, TT, DM, DFF, LDMID, LDMID}; pg8::StaticOrder S; S.init(TT, DM, F.G, (int)blockIdx.x, FFO_WGM); S.csplit = FFO_CSPLIT; S.rev = (GEMM_REV >> 0) & 1;
        pg8::EpiResidT<false, true> E{x_prompt, x_sample, 8192, XR, DM, 0.5f, SSQ};
        PHASE_SKEW();
        pg8::gemm_phase<pg8::EpiResidT<false, true>, pg8::StaticOrder, RESID_ALIGN, GEMM_SP2>(F.lds + RING_OFF, g, S, E);
        if (BOTH(2) || rep + 1 < REPS(2)) GRID_BAR();
    }
    if (IN(3))
_Pragma("unroll")
    for (int rep = 0; rep < REPS(3); ++rep) {
        rstd_phase(F, SSQ, RSTD);
        constexpr int I_FI = (DM / 64) * (2 * DFF / 32), I_FO = (DFF / 64) * (DM / 32);
        auto desc3 = [&](int it) -> TItem { return it < I_FI ? titem_matrix(ffn2_w_in, DM, 2 * DFF, WFI, DM / 64, 2, 1, it, F.lane, ffn2_norm) : titem_matrix(ffn2_w_out, DFF, DM, WFO, DFF / 64, RESID_WMODE, 0, it - I_FI, F.lane); };
        TRANSPOSE_STREAM(desc3, I_FI + (TAIL_FILL ? 0 : I_FO));
        if (BOTH(3) || rep + 1 < REPS(3)) GRID_BAR();
    }
    if (IN(4))
_Pragma("unroll")
    for (int rep = 0; rep < REPS(4); ++rep) {
        pg8::Gemm g{XR, WIN, TT, NIN, DM, LDH, LDH}; pg8::StaticOrder S; S.init(TT, NIN, F.G, (int)blockIdx.x, ALL_WGM); S.rev = (GEMM_REV >> 4) & 1;
        pg8::EpiProj E{QKV, RXY, GT, ROPE, RSTD};
        pg8::gemm_phase<pg8::EpiProj, pg8::StaticOrder, true, GEMM_SP2>(F.lds + RING_OFF, g, S, E);
        if (BOTH(4) || rep + 1 < REPS(4)) GRID_BAR();
    }
    if (IN(5))
_Pragma("unroll")
    for (int rep = 0; rep < REPS(5); ++rep) {
        rglru_phase<false>(F, RXY, RGW, conv_w, conv_b, rg_ba, rg_bx, rg_lambda, AGG, CARRY, RR);
        if (BOTH(5) || rep + 1 < REPS(5)) GRID_BAR();
    }
    if (IN(6))
_Pragma("unroll")
    for (int rep = 0; rep < REPS(6); ++rep) {
        carry_phase(F, AGG, CARRY);
        const float lam = __expf(wave_sum(lq1[F.lane] * lk1[F.lane])) - __expf(wave_sum(lq2[F.lane] * lk2[F.lane])) + 0.2f;
        const int lane = F.lane, r32 = lane & 31, hi = lane >> 5, wid = F.wave;
        char* alds = (char*)lds + RING_OFF;
        const __amdgpu_buffer_rsrc_t qkv_rs = __builtin_amdgcn_make_buffer_rsrc((void*)QKV, 0, (int)((size_t)TT * 6144 * 2), 0x00020000);
        float* li_l = (float*)(alds + att::LDS_WS) + wid * 64;
#ifndef ATT_PASSES
#define ATT_PASSES 1
#endif
        for (int L_ = F.vcu; L_ < 1536 * ATT_PASSES; L_ += F.G) { const int L = L_ >= 1536 ? L_ - 1536 : L_;
            int h, qb, row0, seqlen;
            if (L < 1024) { const int i = L >> 8, xcd = (L & 255) >> 5, loc = L & 31; h = 2 * xcd + (i >> 1); qb = 32 * (i & 1) + loc; row0 = 8192; seqlen = 16384; }
            else { const int Lp = L - 1024, j = Lp >> 8, xcd = (Lp & 255) >> 5, loc = Lp & 31, pair = 4 * xcd + 2 * j + (loc >> 4); qb = loc & 15; h = pair & 15; row0 = (pair >> 4) * 4096; seqlen = 4096; }
            for (int m = 0; m < 2; ++m) {
                const unsigned qo = (unsigned)(((row0 + qb * 256) * 2048 + h * 128 + m * 64) * 2);
                const char* kbase = (const char*)QKV + pg8::QKV_KOFF + (size_t)((((row0 >> 6) * 16 + h) * 2 + m)) * 8192;
                const char* vbase = (const char*)QKV + pg8::QKV_VOFF + (size_t)((row0 >> 6) * 16 + h) * 16384;
                att::f32x16 o[4]; float l;
                att::attn_map_body<true>(qkv_rs, qo, kbase, vbase, seqlen, alds, o, l);
                {
                    LAS unsigned* ovf = (LAS unsigned*)(F.lds + RING_OFF + att::LDS_BYTES);
                    const bool bad = ATT_FORCE_SLOW || !(l < 1e30f);
                    const bool anyb = __any(bad);
                    if (lane == 0) ovf[wid] = anyb ? 1u : 0u;
                    asm volatile("s_waitcnt lgkmcnt(0)" ::: "memory"); __syncthreads();
                    unsigned any8 = 0;
#pragma unroll
                    for (int w8 = 0; w8 < 8; ++w8) any8 |= ovf[w8];
                    __syncthreads();
                    if (any8) att::attn_map_body<false>(qkv_rs, qo, kbase, vbase, seqlen, alds, o, l);
                }
                if (hi == 0) li_l[r32] = l;
                asm volatile("s_waitcnt lgkmcnt(0)" ::: "memory");
                float rli[16];
#pragma unroll
                for (int r = 0; r < 16; ++r) rli[r] = __builtin_amdgcn_rcpf(li_l[att::crow(r, hi)]);
                float* const swb = (float*)(ws + WS_ASCR) + (size_t)blockIdx.x * (256 * 128);
                unsigned swo = (unsigned)(((wid * 32 + 4 * hi) * 128 + r32) * 4); asm volatile("" : "+v"(swo));
#define SWL(idx) (*(float*)((unsigned char*)swb + swo + (idx) * 4))
                if (m == 0) {
#pragma unroll
                    for (int r = 0; r < 16; ++r)
#pragma unroll
                        for (int d0 = 0; d0 < 4; ++d0) SWL(((r & 3) + 8 * (r >> 2)) * 128 + d0 * 32) = o[d0][r] * rli[r];
                    asm volatile("s_waitcnt vmcnt(0)" ::: "memory");
                } else {
                    const int orow0 = row0 + qb * 256 + wid * 32;
                    unsigned char* const obb = (unsigned char*)OB + pg8::blk_off(orow0, h * 128, AW / 64);
                    unsigned ob0 = (unsigned)(hi * 256 + r32 * 2); asm volatile("" : "+v"(ob0));
                    unsigned ob1 = (unsigned)(hi * 256 + ((r32 * 2) ^ 32)); asm volatile("" : "+v"(ob1));
                    float gain[4];
#pragma unroll
                    for (int d0 = 0; d0 < 4; ++d0) gain[d0] = subln_gain[d0 * 32 + r32] * 0.8f;
#pragma unroll
                    for (int r = 0; r < 16; ++r) { const int rb = (r & 3) + 8 * (r >> 2); float ss = 0.f; float v[4];
#pragma unroll
                        for (int d0 = 0; d0 < 4; ++d0) { v[d0] = SWL(rb * 128 + d0 * 32) - lam * (o[d0][r] * rli[r]); ss += v[d0] * v[d0]; }
                        ss += __shfl_xor(ss, 1); ss += __shfl_xor(ss, 2); ss += __shfl_xor(ss, 4); ss += __shfl_xor(ss, 8); ss += __shfl_xor(ss, 16);
                        const float rs = 1.f / sqrtf(ss * (1.f / 128.f) + EPS);
#pragma unroll
                        for (int d0 = 0; d0 < 4; ++d0) { const int coff = (d0 >> 1) * 32768 + ((rb >> 4) * 2 + (d0 & 1)) * 1024 + (rb & 15) * 64;
                            *(bf16*)(obb + (((rb & 8) ? ob1 : ob0) + (unsigned)coff)) = (bf16)f2bf(v[d0] * rs * gain[d0]); } }
                }
#undef SWL
                __syncthreads();
            }
        }
        if (BOTH(6) || rep + 1 < REPS(6)) GRID_BAR();
    }
    if (IN(7))
_Pragma("unroll")
    for (int rep = 0; rep < REPS(7); ++rep) {
        rglru_phase<true>(F, RXY, RGW, conv_w, conv_b, rg_ba, rg_bx, rg_lambda, AGG, CARRY, RR);
        if (BOTH(7) || rep + 1 < REPS(7)) GRID_BAR();
    }
#ifndef PROBE_P89
#define PROBE_P89 0
#endif
_Pragma("unroll")
    for (int rep2 = 0; rep2 < (PROBE_P89 ? 2 : 1); ++rep2) {
    if (IN(8)) {
        pg8::Gemm g{OB, WA, TT, DM, AW, LDO, LDO}; pg8::PairOrder S; S.S.init(TT, DM, F.G, (int)blockIdx.x, ALL_WGM);
        pg8::EpiGatePair E{MG, GT, DM / 64};
        pg8::gemm_phase<pg8::EpiGatePair, pg8::PairOrder, true, GEMM_SP2>(F.lds + RING_OFF, g, S, E);
        if (BOTH(8)) GRID_BAR();
    }
    }
#ifndef PROBE_P10
#define PROBE_P10 0
#endif
    if (IN(10))
_Pragma("unroll")
    for (int rep = 0; rep < (PROBE_P10 ? 3 : 1); ++rep) {
        pg8::Gemm g{MG, WO, TT, DM, DM, LDH, LDH}; pg8::StaticOrder S; S.init(TT, DM, F.G, (int)blockIdx.x, ALL_WGM); S.rev = (GEMM_REV >> 1) & 1;
        pg8::EpiResidT<true, true> E{XR, nullptr, TT, XR, DM, rep == 1 ? -1.0f : 1.0f, SSQ};
        PHASE_SKEW();
        pg8::gemm_phase<pg8::EpiResidT<true, true>, pg8::StaticOrder, RESID_ALIGN, GEMM_SP2>(F.lds + RING_OFF, g, S, E);
        if (BOTH(10) || rep + 1 < (PROBE_P10 ? 3 : 1)) GRID_BAR();
    }
    if (IN(11))
_Pragma("unroll")
    for (int rep = 0; rep < REPS(11); ++rep) {
        rstd_phase(F, SSQ, RSTD);
        if (BOTH(11) || rep + 1 < REPS(11)) GRID_BAR();
    }
    if (IN(12))
_Pragma("unroll")
    for (int rep = 0; rep < REPS(12); ++rep) {
        pg8::Gemm g{XR, WFI, TT, 2 * DFF, DM, LDH, LDH}; pg8::StaticOrder S; S.init(TT, 2 * DFF, F.G, (int)blockIdx.x, ALL_WGM); S.rev = (GEMM_REV >> 2) & 1;
        pg8::EpiSwiGLU E{MID, DFF / 64, RSTD};
        pg8::gemm_phase<pg8::EpiSwiGLU, pg8::StaticOrder, true, GEMM_SP2>(F.lds + RING_OFF, g, S, E);
        if (TAIL_FILL && rep == 0) {
            constexpr int I_FO = (DFF / 64) * (DM / 32);
            const int tail = ((TT / 256) * (2 * DFF / 256)) % F.G, nidle = tail ? F.G - tail : F.G, iw = tail ? (int)blockIdx.x - tail : (int)blockIdx.x;
            if (iw >= 0) { const int gw = iw * NWAVES + F.wave, NGW = nidle * NWAVES;
                auto desc12 = [&](int it) -> TItem { return titem_matrix(ffn2_w_out, DFF, DM, WFO, DFF / 64, RESID_WMODE, 0, it, F.lane); };
                TRANSPOSE_STREAM(desc12, I_FO); } }
        if (BOTH(12) || rep + 1 < REPS(12)) GRID_BAR();
    }
#ifndef PROBE_P13
#define PROBE_P13 0
#endif
    if (IN(13))
_Pragma("unroll")
    for (int rep = 0; rep < (PROBE_P13 ? 3 : 1); ++rep) {
        pg8::Gemm g{MID, WFO, TT, DM, DFF, LDMID, LDMID}; pg8::StaticOrder S; S.init(TT, DM, F.G, (int)blockIdx.x, FFO_WGM); S.csplit = FFO_CSPLIT; S.rev = (GEMM_REV >> 3) & 1;
        pg8::EpiResidT<true, true> E{XR, nullptr, TT, XR, DM, rep == 1 ? -0.5f : 0.5f, nullptr};
        PHASE_SKEW();
        pg8::gemm_phase<pg8::EpiResidT<true, true>, pg8::StaticOrder, RESID_ALIGN, GEMM_SP2>(F.lds + RING_OFF, g, S, E);
        if (BOTH(13) || rep + 1 < (PROBE_P13 ? 3 : 1)) GRID_BAR();
    }
    if (IN(14)) {
#ifdef PROBE_BARS
        for (int b_ = 0; b_ < PROBE_BARS; ++b_) GRID_BAR();
#endif
        for (int it = gw; it < TT; it += NGW) { const int m = recent_first_row(it); rms_row_bf16_to_f32(XR, m, final_norm, out + (size_t)m * DM, F.lane); }
    }
#undef IN
#undef BOTH
#undef GRID_BAR
}

extern "C" void kernel_launch(void* const* d_in, const int* in_sizes, int n_in, void* d_out, int out_size, void* d_ws, size_t ws_size, hipStream_t stream) {
    static int grid = 0;
    if (grid == 0) {
        if (n_in != 26 || in_sizes[0] != 8192 * DM || in_sizes[1] != 16384 * DM || out_size != TT * DM || ws_size < WS_END) {
            fprintf(stderr, "kernel_launch: shape mismatch (n_in %d, out %d, ws %zu, need %zu); nothing launched\n", n_in, out_size, ws_size, (size_t)WS_END); grid = -1; return; }
        int dev = 0, cus = 0;
        if (hipGetDevice(&dev) != hipSuccess || hipDeviceGetAttribute(&cus, hipDeviceAttributeMultiprocessorCount, dev) != hipSuccess) { grid = -1; return; }
        if (hipFuncSetAttribute((const void*)mk_fwd, hipFuncAttributeMaxDynamicSharedMemorySize, LDS_BYTES) != hipSuccess) { fprintf(stderr, "kernel_launch: hipFuncSetAttribute failed\n"); grid = -1; return; }
        (void)hipGetLastError();
        grid = cus > 256 ? 256 : cus - (cus % 16);
        if (grid < 16) { grid = -1; return; }
    }
    if (grid < 0) return;
    if (hipMemsetAsync((char*)d_ws + WS_CTL, 0, CTL_ZERO_BYTES, stream) != hipSuccess) return;
    Args a{};
    for (int i = 0; i < 26; ++i) a.in[i] = (const float*)d_in[i];
    a.out = (float*)d_out; a.ws = (unsigned char*)d_ws;
#if MK_PER_PHASE
    for (int k = 0; k < NPHASE; ++k) { a.ph_lo = k; a.ph_hi = k + 1; hipLaunchKernelGGL(mk_fwd, dim3(grid), dim3(NWAVES * 64), LDS_BYTES, stream, a); }
#else
#if PROBE_ALL2
    a.ph_lo = PROBE_ALL2_LO; a.ph_hi = PROBE_ALL2_HI; a.li = 1;
    hipLaunchKernelGGL(mk_fwd, dim3(grid), dim3(NWAVES * 64), LDS_BYTES, stream, a);
#endif
    a.ph_lo = 0; a.ph_hi = NPHASE; a.li = 0;
    hipLaunchKernelGGL(mk_fwd, dim3(grid), dim3(NWAVES * 64), LDS_BYTES, stream, a);
#endif
    const hipError_t le = hipPeekAtLastError();
    if (le != hipSuccess) fprintf(stderr, "kernel_launch: launch failed: %s\n", hipGetErrorName(le));
}
```

```cpp
#include <hip/hip_runtime.h>
#include <hip/hip_bf16.h>
#include <cstdio>
#include <cstdint>
#include <cmath>
#define EARLY_BAR 4
namespace pg8 {
#define PG8_LAS __attribute__((address_space(3)))
typedef unsigned short bf16_t;
typedef short bf16x8 __attribute__((ext_vector_type(8)));
typedef float f32x4 __attribute__((ext_vector_type(4)));
typedef unsigned u32x4 __attribute__((ext_vector_type(4)));
constexpr int BM = 256, BK = 64, HALF = 128, HTB = HALF * BK * 2  , STAGE_BYTES = 8 * HTB, NXCD = 8, WGM = 8;

__host__ __device__ __forceinline__ int lds_byte(int r, int c) { const int st = (r >> 4) * 2 + (c >> 5), rr = r & 15, cc = c & 31, ob = rr * 64 + cc * 2; return st * 1024 + (ob ^ (((ob >> 9) & 1) << 5)); }
__host__ __device__ __forceinline__ void stage_rc(int b, int& R, int& C) { const int st = b / 1024, sb = b % 1024, swz = sb ^ (((sb >> 9) & 1) << 5); R = (st >> 1) * 16 + swz / 64; C = (st & 1) * 32 + (swz % 64) / 2; }
__host__ __device__ __forceinline__ int perm32(int rho) { const int n = rho >> 4, i = rho & 15; return 8 * (i >> 2) + 4 * n + (i & 3); }
__host__ __device__ __forceinline__ int inv_perm32(int w) { return 16 * ((w >> 2) & 1) + 4 * (w >> 3) + (w & 3); }
__host__ __device__ __forceinline__ size_t blk_off(int row, int col, int KT) { return ((size_t)((row >> 8) * KT + (col >> 6)) * 2 + ((row >> 7) & 1)) * 16384 + (size_t)lds_byte(row & 127, col & 63); }
__host__ __device__ __forceinline__ size_t blk_off_b(int w, int col, int KT, bool perm) { const int w128 = w & 127, R = perm ? (w128 & ~31) + inv_perm32(w128 & 31) : w128;
    return ((size_t)((w >> 8) * KT + (col >> 6)) * 2 + ((w >> 7) & 1)) * 16384 + (size_t)lds_byte(R, col & 63); }

struct Unit { int pm, pn; };
struct Gemm { const bf16_t* A; const bf16_t* Bt; int M, N, K, lda, ldb; };

#ifndef SERPENTINE
#define SERPENTINE 1
#endif
struct StaticOrder {
    int rev = 0;
    int csplit = 0;
    int nM, nN, nwg, G, c, wgm, serp = SERPENTINE;
    __host__ __device__ void init(int M, int N, int G_, int c_, int wgm_ = WGM) { nM = M / BM; nN = N / BM; nwg = nM * nN; G = G_; c = c_; wgm = wgm_; }
    __host__ __device__ bool next(int i, Unit& u) const {
        const long L = (long)i * G + c; if (L >= nwg) return false;
        if (csplit && nwg % NXCD == 0 && nM % 16 == 0 && nN % 2 == 0) { const int xcd = (int)(L % NXCD), off = (int)(L / NXCD), cpg = nN / 2, rnd = off / (4 * cpg), in = off % (4 * cpg);
            u.pm = (xcd >> 1) * (nM / 4) + rnd * 4 + (in & 3); u.pn = (xcd & 1) * cpg + (in >> 2); if (rev) u.pm = nM - 1 - u.pm; return true; }
        int wgid = (int)L; { const int q = nwg / NXCD, r = nwg % NXCD, xcd = wgid % NXCD, off = wgid / NXCD; wgid = (xcd < r ? xcd * (q + 1) : r * (q + 1) + (xcd - r) * q) + off; }
        const int nig = wgm * nN, gid = wgid / nig, fm = gid * wgm, gsz = (nM - fm) < wgm ? (nM - fm) : wgm;
        u.pm = fm + ((wgid % nig) % gsz); u.pn = (wgid % nig) / gsz;
        if (serp && (nwg / NXCD) % nig == 0 && nwg % NXCD == 0 && (((wgid % (nwg / NXCD)) / nig) & 1)) u.pn = nN - 1 - u.pn;
        if (rev) u.pm = nM - 1 - u.pm;
        return true;
    }
    __device__ __forceinline__ void a_ready(const Unit&) const {}
    __device__ __forceinline__ void done(const Unit&) const {}
};

__device__ __forceinline__ unsigned cvt_pk_bf16(float lo, float hi) { unsigned r; asm volatile("v_cvt_pk_bf16_f32 %0, %1, %2" : "=v"(r) : "v"(lo), "v"(hi)); return r; }
typedef float f32x2 __attribute__((ext_vector_type(2)));
__device__ __forceinline__ float sigm(float x) { return __builtin_amdgcn_rcpf(1.f + __builtin_amdgcn_exp2f(-1.4426950408889634f * x)); }
__device__ __forceinline__ float bf_lo(unsigned w) { return __uint_as_float(w << 16); }
__device__ __forceinline__ float bf_hi(unsigned w) { return __uint_as_float(w & 0xffff0000u); }
#ifndef OUT_NT
#define OUT_NT 0
#endif
struct EpiSwiGLU {
    static constexpr bool PERM = true, AFTER_DRAIN = false;
    bf16_t* O; int KT; const float* rstd;
    __device__ __forceinline__ void operator()(const f32x4 (&acc)[2][2][4][2], const Unit& u, int wr, int wc, int fr, int fq) const {
        const int row0 = u.pm * BM + wr * 64 + fr, col0 = u.pn * HALF + wc * 32 + 8 * fq;
#pragma unroll
        for (int ai = 0; ai < 2; ++ai)
#pragma unroll
            for (int m = 0; m < 4; ++m) {
                bf16_t* rowp = (bf16_t*)((unsigned char*)O + blk_off(row0 + ai * HALF + m * 16, col0, KT));
                float r[8]; const float rs = rstd ? rstd[row0 + ai * HALF + m * 16] : 1.f;
#pragma unroll
                for (int n = 0; n < 2; ++n)
#pragma unroll
                    for (int j = 0; j < 4; ++j) { const float g = acc[ai][0][m][n][j] * rs, up = acc[ai][1][m][n][j] * rs; r[4 * n + j] = g * sigm(g) * up; }
                u32x4 w; w.x = cvt_pk_bf16(r[0], r[1]); w.y = cvt_pk_bf16(r[2], r[3]); w.z = cvt_pk_bf16(r[4], r[5]); w.w = cvt_pk_bf16(r[6], r[7]);
                if (OUT_NT) __builtin_nontemporal_store(w, (u32x4*)rowp); else *(u32x4*)rowp = w;
            }
    }
};
template <bool RB16, bool OB16> struct EpiResidT {
#ifndef RESID_PERM
#define RESID_PERM 1
#endif
    static constexpr bool PERM = RESID_PERM != 0, AFTER_DRAIN = false;
    const void* res0; const void* res1; int split_row; void* out; int ldc; float alpha; float* ssq;
    __device__ __forceinline__ void operator()(const f32x4 (&acc)[2][2][4][2], const Unit& u, int wr, int wc, int fr, int fq) const {
        typedef unsigned u32x2v __attribute__((ext_vector_type(2)));
        const int rowt = u.pm * BM;
        const float* rbf = RB16 ? nullptr : (rowt < split_row ? (const float*)res0 + (size_t)rowt * ldc : (const float*)res1 + (size_t)(rowt - split_row) * ldc);
        float* obf = OB16 ? nullptr : (float*)out + (size_t)rowt * ldc;
#if RESID_PERM
        const int col0 = u.pn * BM + wc * 32 + 8 * fq;
#pragma unroll
        for (int ai = 0; ai < 2; ++ai) {
            f32x4 rv[4][2][2]; u32x4 rw[4][2];
#pragma unroll
            for (int m = 0; m < 4; ++m) { const int rl = ai * HALF + wr * 64 + m * 16 + fr; const size_t off = (size_t)rl * ldc + col0;
#pragma unroll
                for (int bj = 0; bj < 2; ++bj) {
                    if (RB16) rw[m][bj] = *(const u32x4*)((const unsigned char*)res0 + blk_off(rowt + rl, col0 + bj * HALF, 64));
                    else { rv[m][bj][0] = *(const f32x4*)(rbf + off + bj * HALF); rv[m][bj][1] = *(const f32x4*)(rbf + off + bj * HALF + 4); } } }
#pragma unroll
            for (int m = 0; m < 4; ++m) { const int rl = ai * HALF + wr * 64 + m * 16 + fr; const size_t off = (size_t)rl * ldc + col0; float sq = 0.f;
#pragma unroll
                for (int bj = 0; bj < 2; ++bj) {
                    if (RB16) { const u32x4 w = rw[m][bj]; rv[m][bj][0] = (f32x4){bf_lo(w.x), bf_hi(w.x), bf_lo(w.y), bf_hi(w.y)}; rv[m][bj][1] = (f32x4){bf_lo(w.z), bf_hi(w.z), bf_lo(w.w), bf_hi(w.w)}; }
                    const f32x4 v0 = rv[m][bj][0] + acc[ai][bj][m][0] * alpha, v1 = rv[m][bj][1] + acc[ai][bj][m][1] * alpha;
                    sq += ((v0[0] * v0[0] + v0[1] * v0[1]) + (v0[2] * v0[2] + v0[3] * v0[3])) + ((v1[0] * v1[0] + v1[1] * v1[1]) + (v1[2] * v1[2] + v1[3] * v1[3]));
                    if (OB16) { u32x4 w; w.x = cvt_pk_bf16(v0[0], v0[1]); w.y = cvt_pk_bf16(v0[2], v0[3]); w.z = cvt_pk_bf16(v1[0], v1[1]); w.w = cvt_pk_bf16(v1[2], v1[3]);
                        *(u32x4*)((unsigned char*)out + blk_off(rowt + rl, col0 + bj * HALF, 64)) = w; }
                    else { *(f32x4*)(obf + off + bj * HALF) = v0; *(f32x4*)(obf + off + bj * HALF + 4) = v1; } }
                if (ssq) { sq += __shfl_xor(sq, 16); sq += __shfl_xor(sq, 32); if (fq == 0) ssq[(size_t)(rowt + rl) * 64 + u.pn * 4 + wc] = sq; } }
            asm volatile("" ::: "memory"); }
#else
        const int col0 = u.pn * BM + wc * 32 + 4 * fq;
#pragma unroll
        for (int ai = 0; ai < 2; ++ai) {
            f32x4 rv[4][2][2];
#pragma unroll
            for (int m = 0; m < 4; ++m) { const int rl = ai * HALF + wr * 64 + m * 16 + fr; const size_t off = (size_t)rl * ldc + col0;
#pragma unroll
                for (int bj = 0; bj < 2; ++bj)
#pragma unroll
                    for (int n = 0; n < 2; ++n) {
                        if (RB16) { const u32x2v w = *(const u32x2v*)((const unsigned char*)res0 + blk_off(rowt + rl, col0 + bj * HALF + n * 16, 64)); rv[m][bj][n] = (f32x4){bf_lo(w.x), bf_hi(w.x), bf_lo(w.y), bf_hi(w.y)}; }
                        else rv[m][bj][n] = *(const f32x4*)(rbf + off + bj * HALF + n * 16); } }
#pragma unroll
            for (int m = 0; m < 4; ++m) { const int rl = ai * HALF + wr * 64 + m * 16 + fr; const size_t off = (size_t)rl * ldc + col0; float sq = 0.f;
#pragma unroll
                for (int bj = 0; bj < 2; ++bj)
#pragma unroll
                    for (int n = 0; n < 2; ++n) { const f32x4 val = rv[m][bj][n] + acc[ai][bj][m][n] * alpha;
                        sq += (val[0] * val[0] + val[1] * val[1]) + (val[2] * val[2] + val[3] * val[3]);
                        if (OB16) { u32x2v w; w.x = cvt_pk_bf16(val[0], val[1]); w.y = cvt_pk_bf16(val[2], val[3]); *(u32x2v*)((unsigned char*)out + blk_off(rowt + rl, col0 + bj * HALF + n * 16, 64)) = w; }
                        else *(f32x4*)(obf + off + bj * HALF + n * 16) = val; }
                if (ssq) { sq += __shfl_xor(sq, 16); sq += __shfl_xor(sq, 32); if (fq == 0) ssq[(size_t)(rowt + rl) * 64 + u.pn * 4 + wc] = sq; } }
            asm volatile("" ::: "memory"); }
#endif
    }
};
constexpr size_t QKV_KOFF = (size_t)24576 * 2048 * 2, QKV_VOFF = 2 * QKV_KOFF;
__host__ __device__ __forceinline__ int kimg(int r64, int d) { return r64 * 128 + ((d * 2) ^ (((r64 >> 1) & 7) << 4)); }
__host__ __device__ __forceinline__ int vimg(int k, int c) { const int kk = k;     return ((kk >> 3) * 4 + (c >> 5)) * 512 + ((kk & 7) * 32 + (c & 31)) * 2; }
struct EpiPlainBf16 {
    static constexpr bool PERM = false, AFTER_DRAIN = false;
    bf16_t* O; float alpha;
    __device__ __forceinline__ void operator()(const f32x4 (&acc)[2][2][4][2], const Unit& u, int wr, int wc, int fr, int fq) const {
        const int col0 = u.pn * BM + wc * 32 + 4 * fq;
#pragma unroll
        for (int ai = 0; ai < 2; ++ai)
#pragma unroll
            for (int m = 0; m < 4; ++m) { const size_t off = (size_t)(u.pm * BM + ai * HALF + wr * 64 + m * 16 + fr) * 4096 + col0;
#pragma unroll
                for (int bj = 0; bj < 2; ++bj)
#pragma unroll
                    for (int n = 0; n < 2; ++n) { const f32x4 v = acc[ai][bj][m][n] * alpha; unsigned long long w = (unsigned long long)cvt_pk_bf16(v[0], v[1]) | ((unsigned long long)cvt_pk_bf16(v[2], v[3]) << 32);
                        *(unsigned long long*)(O + off + bj * HALF + n * 16) = w; } }
    }
};
struct EpiProj {
    static constexpr bool PERM = true, AFTER_DRAIN = false;
    bf16_t* QKV; bf16_t* RXY; bf16_t* G; const float* rope; const float* rstd;
    __device__ __forceinline__ void operator()(const f32x4 (&acc)[2][2][4][2], const Unit& u, int wr, int wc, int fr, int fq) const {
        const int colt = u.pn * BM, rowt = u.pm * BM;
        bf16_t* base; int ldc, cb;
        if (colt < 6144) { base = QKV; ldc = 6144; cb = colt; } else if (colt < 10240) { base = RXY; ldc = 4096; cb = colt - 6144; } else { base = G; ldc = 8192; cb = colt - 10240; }
        const bool rot = (colt < 4096) && ((wc & 1) == 0);
        const int pos0 = rowt - (rowt < 4096 ? 0 : (rowt < 8192 ? 4096 : 8192));
        const int col0 = cb + wc * 32 + 8 * fq;
        const float sgn = fq == 0 ? -1.f : 1.f;
        const float qs = colt < 2048 ? 0.125f * 1.4426950408889634f : 1.f;
#pragma unroll
        for (int ai = 0; ai < 2; ++ai)
#pragma unroll
            for (int m = 0; m < 4; ++m) {
                const int rl = ai * HALF + wr * 64 + m * 16 + fr;
                const int row = rowt + rl; const float rs = rstd[row];
                f32x4 cs[4];
                if (rot && fq < 2) { const f32x4* tp = (const f32x4*)(rope + (size_t)(pos0 + rl) * 16);
#pragma unroll
                    for (int q = 0; q < 4; ++q) cs[q] = tp[q]; }
#pragma unroll
                for (int bj = 0; bj < 2; ++bj) {
                    f32x4 v0 = acc[ai][bj][m][0] * (qs * rs), v1 = acc[ai][bj][m][1] * (qs * rs);
                    if (rot) {
                        f32x4 p0, p1;
#pragma unroll
                        for (int j = 0; j < 4; ++j) { p0[j] = __shfl_xor(v0[j], 16); p1[j] = __shfl_xor(v1[j], 16); }
                        if (fq < 2) {
                            v0[0] = v0[0] * cs[0][0] + sgn * p0[0] * cs[0][1]; v0[1] = v0[1] * cs[0][2] + sgn * p0[1] * cs[0][3];
                            v0[2] = v0[2] * cs[1][0] + sgn * p0[2] * cs[1][1]; v0[3] = v0[3] * cs[1][2] + sgn * p0[3] * cs[1][3];
                            v1[0] = v1[0] * cs[2][0] + sgn * p1[0] * cs[2][1]; v1[1] = v1[1] * cs[2][2] + sgn * p1[1] * cs[2][3];
                            v1[2] = v1[2] * cs[3][0] + sgn * p1[2] * cs[3][1]; v1[3] = v1[3] * cs[3][2] + sgn * p1[3] * cs[3][3];
                        }
                    }
                    u32x4 w; w.x = cvt_pk_bf16(v0[0], v0[1]); w.y = cvt_pk_bf16(v0[2], v0[3]); w.z = cvt_pk_bf16(v1[0], v1[1]); w.w = cvt_pk_bf16(v1[2], v1[3]);
                    const int col = col0 + bj * HALF;
                    unsigned char* dp;
                    if (colt >= 6144) dp = (unsigned char*)(base + (size_t)row * ldc + col);
                    else if (colt < 2048) dp = (unsigned char*)(QKV + (size_t)row * 2048 + col);
                    else if (colt < 4096) { const int c2 = col - 2048; dp = (unsigned char*)QKV + QKV_KOFF + (size_t)((((row >> 6) * 16 + (c2 >> 7)) * 2 + ((c2 >> 6) & 1))) * 8192 + kimg(row & 63, c2 & 63); }
                    else { const int c2 = col - 4096; dp = (unsigned char*)QKV + QKV_VOFF + (size_t)((row >> 6) * 16 + (c2 >> 7)) * 16384 + vimg(row & 63, c2 & 127); }
                    if (OUT_NT) __builtin_nontemporal_store(w, (u32x4*)dp); else *(u32x4*)dp = w;
                }
            }
    }
};
template <bool ADD> struct EpiGate {
    static constexpr bool PERM = true, AFTER_DRAIN = false;
    bf16_t* O; const bf16_t* Gt; int goff; int KT;
    __device__ __forceinline__ void operator()(const f32x4 (&acc)[2][2][4][2], const Unit& u, int wr, int wc, int fr, int fq) const {
        const int row0 = u.pm * BM + wr * 64 + fr, col0 = u.pn * BM + wc * 32 + 8 * fq;
#pragma unroll
        for (int ai = 0; ai < 2; ++ai)
#pragma unroll
            for (int m = 0; m < 4; ++m) { const size_t row = (size_t)(row0 + ai * HALF + m * 16);
                u32x4 gv[2], ov[2];
#pragma unroll
                for (int bj = 0; bj < 2; ++bj) { gv[bj] = *(const u32x4*)(Gt + row * 8192 + goff + col0 + bj * HALF); if (ADD) ov[bj] = *(const u32x4*)((const unsigned char*)O + blk_off((int)row, col0 + bj * HALF, KT)); }
#pragma unroll
                for (int bj = 0; bj < 2; ++bj) { const f32x4 a0 = acc[ai][bj][m][0], a1 = acc[ai][bj][m][1]; float r[8];
                    r[0] = sigm(bf_lo(gv[bj].x)) * a0[0]; r[1] = sigm(bf_hi(gv[bj].x)) * a0[1]; r[2] = sigm(bf_lo(gv[bj].y)) * a0[2]; r[3] = sigm(bf_hi(gv[bj].y)) * a0[3];
                    r[4] = sigm(bf_lo(gv[bj].z)) * a1[0]; r[5] = sigm(bf_hi(gv[bj].z)) * a1[1]; r[6] = sigm(bf_lo(gv[bj].w)) * a1[2]; r[7] = sigm(bf_hi(gv[bj].w)) * a1[3];
                    if (ADD) { r[0] += bf_lo(ov[bj].x); r[1] += bf_hi(ov[bj].x); r[2] += bf_lo(ov[bj].y); r[3] += bf_hi(ov[bj].y); r[4] += bf_lo(ov[bj].z); r[5] += bf_hi(ov[bj].z); r[6] += bf_lo(ov[bj].w); r[7] += bf_hi(ov[bj].w); }
                    u32x4 w; w.x = cvt_pk_bf16(r[0], r[1]); w.y = cvt_pk_bf16(r[2], r[3]); w.z = cvt_pk_bf16(r[4], r[5]); w.w = cvt_pk_bf16(r[6], r[7]);
                    *(u32x4*)((unsigned char*)O + blk_off((int)row, col0 + bj * HALF, KT)) = w; }
            }
    }
};

struct EpiGatePair {
    static constexpr bool PERM = true, AFTER_DRAIN = false;
    bf16_t* O; const bf16_t* Gt; int KT;
    __device__ __forceinline__ void operator()(const f32x4 (&acc)[2][2][4][2], const Unit& u, int wr, int wc, int fr, int fq) const {
        if (u.pm < 96) { EpiGate<false> e{O, Gt, 0, KT}; e(acc, u, wr, wc, fr, fq); }
        else { Unit v; v.pm = u.pm - 96; v.pn = u.pn - 16; EpiGate<true> e{O, Gt, 4096, KT}; e(acc, v, wr, wc, fr, fq); }
    }
};
struct PairOrder {
    StaticOrder S;
    __device__ __forceinline__ bool next(int i, Unit& u) const { if (!S.next(i >> 1, u)) return false; if (i & 1) { u.pm += 96; u.pn += 16; } return true; }
    __device__ __forceinline__ void a_ready(const Unit&) const {}
    __device__ __forceinline__ void done(const Unit&) const {}
};

template <class Epi, class Sched, bool ALIGN_EPI = false, bool SP2 = false>
__device__ __forceinline__ void gemm_phase(PG8_LAS unsigned char* lds, const Gemm g, const Sched& S, const Epi& E) {
    const int tid = threadIdx.x, wid = __builtin_amdgcn_readfirstlane(tid >> 6), lane = tid & 63, wr = wid >> 2, wc = wid & 3, fr = lane & 15, fq = lane >> 4;
    const int K = g.K, nt = K / BK;
    unsigned voffA[2], voffB[2];
#pragma unroll
    for (int i = 0; i < 2; ++i) { voffA[i] = (unsigned)(tid * 16 + i * 8192); voffB[i] = voffA[i]; }
    const size_t kstep = 32768;
    const size_t hstepA = 16384, hstepB = 16384;
    const size_t tstepA = (size_t)nt * 32768, tstepB = tstepA;
    const unsigned ldsw = (unsigned)wid * 1024u;
    const int aoff = lds_byte(wr * 64 + fr, fq * 8), boff = lds_byte(wc * 32 + fr, fq * 8);
#define PG8_SA(b, h) (((b) * 2 + (h)) * HTB)
#define PG8_SB(b, h) ((4 + (b) * 2 + (h)) * HTB)
#define PG8_STAGE(bufoff, gbase, voff) do { _Pragma("unroll") for (int _i = 0; _i < 2; ++_i) \
        __builtin_amdgcn_global_load_lds((const unsigned*)((const char*)(gbase) + (voff)[_i]), (PG8_LAS unsigned*)(lds + (bufoff) + ldsw + _i * 8192), 16, 0, 0); } while (0)
#ifndef GEMM_B_AUX
#define GEMM_B_AUX 0
#endif
#define PG8_STAGEB(bufoff, gbase, voff) do { _Pragma("unroll") for (int _i = 0; _i < 2; ++_i) \
        __builtin_amdgcn_global_load_lds((const unsigned*)((const char*)(gbase) + (voff)[_i]), (PG8_LAS unsigned*)(lds + (bufoff) + ldsw + _i * 8192), 16, 0, GEMM_B_AUX); } while (0)
#define PG8_LDA(dst, b, h) do { _Pragma("unroll") for (int m = 0; m < 4; ++m) _Pragma("unroll") for (int k = 0; k < 2; ++k) dst[m][k] = *(const PG8_LAS bf16x8*)(lds + PG8_SA(b, h) + aoff + m * 2048 + k * 1024); } while (0)
#define PG8_LDB(dst, b, h) do { _Pragma("unroll") for (int n = 0; n < 2; ++n) _Pragma("unroll") for (int k = 0; k < 2; ++k) dst[n][k] = *(const PG8_LAS bf16x8*)(lds + PG8_SB(b, h) + boff + n * 2048 + k * 1024); } while (0)
#ifndef MMA_ORDER
#define MMA_ORDER 3
#endif
#define PG8_MFMA1(ai, bj, At, Bt, m, n, k) acc[ai][bj][m][n] = __builtin_amdgcn_mfma_f32_16x16x32_bf16(Bt[n][k], At[m][k], acc[ai][bj][m][n], 0, 0, 0)
#define PG8_MMA(ai, bj, At, Bt) do { __builtin_amdgcn_s_setprio(1); \
        if (MMA_ORDER == 1) { _Pragma("unroll") for (int n = 0; n < 2; ++n) _Pragma("unroll") for (int k = 0; k < 2; ++k) _Pragma("unroll") for (int m = 0; m < 4; ++m) PG8_MFMA1(ai, bj, At, Bt, m, n, k); } \
        else if (MMA_ORDER == 2) { _Pragma("unroll") for (int m = 0; m < 4; ++m) _Pragma("unroll") for (int k = 0; k < 2; ++k) _Pragma("unroll") for (int n = 0; n < 2; ++n) PG8_MFMA1(ai, bj, At, Bt, m, n, k); } \
        else if (MMA_ORDER == 3) { _Pragma("unroll") for (int k = 0; k < 2; ++k) _Pragma("unroll") for (int m = 0; m < 4; ++m) _Pragma("unroll") for (int nn = 0; nn < 2; ++nn) { const int n = (m & 1) ? 1 - nn : nn; PG8_MFMA1(ai, bj, At, Bt, m, n, k); } }     \
        else { _Pragma("unroll") for (int m = 0; m < 4; ++m) _Pragma("unroll") for (int n = 0; n < 2; ++n) _Pragma("unroll") for (int k = 0; k < 2; ++k) PG8_MFMA1(ai, bj, At, Bt, m, n, k); } \
        __builtin_amdgcn_s_setprio(0); } while (0)
#ifndef EARLY_BAR
#define EARLY_BAR 2
#endif
#define PG8_MMA_E(ai, bj, At, Bt) do { __builtin_amdgcn_s_setprio(1); \
        _Pragma("unroll") for (int k = 0; k < 2; ++k) _Pragma("unroll") for (int m = 0; m < 4; ++m) _Pragma("unroll") for (int nn = 0; nn < 2; ++nn) { const int n = (m & 1) ? 1 - nn : nn; \
            if ((k * 4 + m) * 2 + nn == 16 - EARLY_BAR) { __builtin_amdgcn_sched_barrier(0); __builtin_amdgcn_s_setprio(2); __builtin_amdgcn_s_barrier(); __builtin_amdgcn_sched_barrier(0); } \
            PG8_MFMA1(ai, bj, At, Bt, m, n, k); } \
        __builtin_amdgcn_s_setprio(0); } while (0)
#define PG8_WAIT_V(n) asm volatile("s_waitcnt vmcnt(" #n ")" ::: "memory")
#define PG8_WAIT_L(n) asm volatile("s_waitcnt lgkmcnt(" #n ")" ::: "memory")
#define PG8_BAR __builtin_amdgcn_s_barrier()
#define PG8_SCHED __builtin_amdgcn_sched_barrier(0)
    Unit cur, nxt; int ui = 0;
    if (!S.next(0, cur)) return;
    f32x4 acc[2][2][4][2];
#pragma unroll
    for (int a = 0; a < 2; ++a)
#pragma unroll
        for (int b = 0; b < 2; ++b)
#pragma unroll
            for (int m = 0; m < 4; ++m)
#pragma unroll
                for (int n = 0; n < 2; ++n) acc[a][b][m][n] = (f32x4){0.f, 0.f, 0.f, 0.f};
    bf16x8 At[4][2], B0[2][2], B1[2][2];
    const char* cA = (const char*)g.A + (size_t)cur.pm * tstepA; const char* cB = (const char*)g.Bt + (size_t)cur.pn * tstepB;
    S.a_ready(cur);
    if constexpr (SP2) {
        PG8_STAGEB(PG8_SB(0, 0), cB, voffB); PG8_STAGEB(PG8_SB(0, 1), cB + hstepB, voffB); PG8_STAGE(PG8_SA(0, 0), cA, voffA); PG8_STAGE(PG8_SA(0, 1), cA + hstepA, voffA);
        if (wr == 1) PG8_BAR;
        PG8_WAIT_V(2); PG8_BAR;
        PG8_STAGEB(PG8_SB(1, 0), cB + kstep, voffB); PG8_STAGE(PG8_SA(1, 0), cA + kstep, voffA); PG8_STAGEB(PG8_SB(1, 1), cB + hstepB + kstep, voffB);
        PG8_WAIT_V(6); PG8_BAR;
    } else {
        PG8_STAGEB(PG8_SB(0, 0), cB, voffB); PG8_STAGE(PG8_SA(0, 0), cA, voffA); PG8_STAGEB(PG8_SB(0, 1), cB + hstepB, voffB); PG8_STAGE(PG8_SA(0, 1), cA + hstepA, voffA);
        if (wr == 1) PG8_BAR;
        PG8_WAIT_V(4); PG8_BAR;
        PG8_STAGEB(PG8_SB(1, 0), cB + kstep, voffB); PG8_STAGE(PG8_SA(1, 0), cA + kstep, voffA); PG8_STAGEB(PG8_SB(1, 1), cB + hstepB + kstep, voffB);
        PG8_WAIT_V(6); PG8_BAR;
    }
    for (;;) {
        const bool has_next = S.next(ui + 1, nxt);
        const char* nA = has_next ? (const char*)g.A + (size_t)nxt.pm * tstepA : cA; const char* nB = has_next ? (const char*)g.Bt + (size_t)nxt.pn * tstepB : cB;
        for (int t = 0; t < nt; t += 2) {
            const bool last = (t == nt - 2);
            const char* a1 = cA + (size_t)(t + 1) * kstep;
            const char* a2 = last ? nA : cA + (size_t)(t + 2) * kstep; const char* b2 = last ? nB : cB + (size_t)(t + 2) * kstep;
            const char* a3 = a2 + kstep; const char* b3 = b2 + kstep;
            if (last && has_next) S.a_ready(nxt);
            if constexpr (SP2) {
            PG8_LDB(B0, 0, 0); PG8_LDB(B1, 0, 1); PG8_SCHED; PG8_LDA(At, 0, 0); PG8_STAGE(PG8_SA(1, 1), a1 + hstepA, voffA);
            PG8_WAIT_V(8); PG8_WAIT_L(0); PG8_BAR; PG8_MMA(0, 0, At, B0); if (EARLY_BAR) { PG8_MMA_E(0, 1, At, B1); } else { PG8_MMA(0, 1, At, B1); PG8_BAR; } PG8_SCHED;
            PG8_LDA(At, 0, 1); PG8_STAGEB(PG8_SB(0, 0), b2, voffB); PG8_STAGEB(PG8_SB(0, 1), b2 + hstepB, voffB); PG8_STAGE(PG8_SA(0, 0), a2, voffA);
            PG8_WAIT_V(8); PG8_WAIT_L(0); PG8_BAR; PG8_MMA(1, 0, At, B0); if (EARLY_BAR) { PG8_MMA_E(1, 1, At, B1); } else { PG8_MMA(1, 1, At, B1); PG8_BAR; } PG8_SCHED;
            PG8_LDB(B0, 1, 0); PG8_LDB(B1, 1, 1); PG8_SCHED; PG8_LDA(At, 1, 0); PG8_STAGE(PG8_SA(0, 1), a2 + hstepA, voffA);
            PG8_WAIT_V(8); PG8_WAIT_L(0); PG8_BAR; PG8_MMA(0, 0, At, B0); if (EARLY_BAR) { PG8_MMA_E(0, 1, At, B1); } else { PG8_MMA(0, 1, At, B1); PG8_BAR; } PG8_SCHED;
            PG8_LDA(At, 1, 1); PG8_STAGEB(PG8_SB(1, 0), b3, voffB); PG8_STAGEB(PG8_SB(1, 1), b3 + hstepB, voffB); PG8_STAGE(PG8_SA(1, 0), a3, voffA);
            PG8_WAIT_V(8); PG8_WAIT_L(0); PG8_BAR; PG8_MMA(1, 0, At, B0); if (EARLY_BAR) { PG8_MMA_E(1, 1, At, B1); } else { PG8_MMA(1, 1, At, B1); PG8_BAR; } PG8_SCHED;
            } else {
            PG8_LDB(B0, 0, 0); PG8_SCHED; PG8_LDA(At, 0, 0); PG8_STAGE(PG8_SA(1, 1), a1 + hstepA, voffA);
            PG8_WAIT_L(8); PG8_BAR; PG8_WAIT_L(0); PG8_MMA(0, 0, At, B0); PG8_BAR; PG8_SCHED;
            PG8_LDB(B1, 0, 1); PG8_STAGEB(PG8_SB(0, 0), b2, voffB);
            PG8_BAR; PG8_WAIT_L(0); PG8_MMA(0, 1, At, B1); PG8_BAR;
            PG8_LDA(At, 0, 1); PG8_STAGE(PG8_SA(0, 0), a2, voffA);
            PG8_BAR; PG8_WAIT_L(0); PG8_MMA(1, 0, At, B0); PG8_BAR; PG8_SCHED;
            PG8_STAGEB(PG8_SB(0, 1), b2 + hstepB, voffB);
            PG8_WAIT_V(6); PG8_BAR; PG8_MMA(1, 1, At, B1); PG8_BAR;
            PG8_LDB(B0, 1, 0); PG8_SCHED; PG8_LDA(At, 1, 0); PG8_STAGE(PG8_SA(0, 1), a2 + hstepA, voffA);
            PG8_WAIT_L(8); PG8_BAR; PG8_WAIT_L(0); PG8_MMA(0, 0, At, B0); PG8_BAR; PG8_SCHED;
            PG8_LDB(B1, 1, 1); PG8_STAGEB(PG8_SB(1, 0), b3, voffB);
            PG8_BAR; PG8_WAIT_L(0); PG8_MMA(0, 1, At, B1); PG8_BAR;
            PG8_LDA(At, 1, 1); PG8_STAGE(PG8_SA(1, 0), a3, voffA);
            PG8_BAR; PG8_WAIT_L(0); PG8_MMA(1, 0, At, B0); PG8_BAR; PG8_SCHED;
            PG8_STAGEB(PG8_SB(1, 1), b3 + hstepB, voffB);
            PG8_WAIT_V(6); PG8_BAR; PG8_MMA(1, 1, At, B1); PG8_BAR;
            }
        }
        if constexpr (ALIGN_EPI) { if (wr == 0) PG8_BAR; }
        if constexpr (!Epi::AFTER_DRAIN) { E(acc, cur, wr, wc, fr, fq); S.done(cur); }
        if (!has_next) break;
#pragma unroll
        for (int a = 0; a < 2; ++a)
#pragma unroll
            for (int b = 0; b < 2; ++b)
#pragma unroll
                for (int m = 0; m < 4; ++m)
#pragma unroll
                    for (int n = 0; n < 2; ++n) acc[a][b][m][n] = (f32x4){0.f, 0.f, 0.f, 0.f};
        cur = nxt; cA = nA; cB = nB; ++ui;
        if constexpr (ALIGN_EPI) { if (wr == 1) PG8_BAR; }
    }
    PG8_WAIT_V(0);
    if constexpr (!ALIGN_EPI) { if (wr == 0) PG8_BAR; }
    PG8_BAR;
    if constexpr (Epi::AFTER_DRAIN) { E.fused(acc, cur, wr, wc, fr, fq, lds, wid, lane); S.done(cur); }
#undef PG8_SA
#undef PG8_SB
#undef PG8_STAGE
#undef PG8_STAGEB
#undef PG8_LDA
#undef PG8_LDB
#undef PG8_MMA
#undef PG8_MMA_E
#undef PG8_MFMA1
#undef PG8_WAIT_V
#undef PG8_WAIT_L
#undef PG8_BAR
#undef PG8_SCHED
}
}
#ifndef ATT_SETPRIO
#define ATT_SETPRIO 0
#endif
namespace att {
typedef unsigned short bf16;
using bf16x8 = __attribute__((ext_vector_type(8))) short;
using s16x4  = __attribute__((ext_vector_type(4))) short;
using f32x16 = __attribute__((ext_vector_type(16))) float;
using u32x4  = __attribute__((ext_vector_type(4))) unsigned;
constexpr int NW = 8, QBLK = 32, KVBLK = 64, LDQ = 6144;
constexpr float SCALE = 0.125f;
constexpr float THR = 8.f;
constexpr int SHM_V = KVBLK * 128 * 2, SHM_K = KVBLK * 64 * 2;
constexpr int LDS_K = 0, LDS_V = 3 * SHM_K, LDS_WS = 3 * SHM_K + 4 * SHM_V, LDS_BYTES = LDS_WS + NW * 64 * 4;
#define KSWZ64(row, colB) ((row) * 128 + ((colB) ^ ((((row) >> 1) & 7) << 4)))
#define SBAR() __builtin_amdgcn_sched_barrier(0)
__device__ __forceinline__ int crow(int r, int hi) { return (r & 3) + 8 * (r >> 2) + 4 * hi; }
__device__ __forceinline__ unsigned cvtpk(float lo, float hi) { unsigned r; asm volatile("v_cvt_pk_bf16_f32 %0, %1, %2" : "=v"(r) : "v"(lo), "v"(hi)); return r; }

template <bool FIRST>
__device__ __forceinline__ void partialSM(f32x16& p0, f32x16& p1, float& mhat, f32x16& negm, float& alpha) {
  constexpr float THRL = THR * 1.4426950408889634f;
  float pmax = p0[0];
#pragma unroll
  for (int r = 1; r < 16; ++r) pmax = fmaxf(pmax, p0[r]);
#pragma unroll
  for (int r = 0; r < 16; ++r) pmax = fmaxf(pmax, p1[r]);
  { auto rr = __builtin_amdgcn_permlane32_swap(__float_as_uint(pmax), __float_as_uint(pmax), false, false);
    pmax = fmaxf(__uint_as_float(rr[0]), __uint_as_float(rr[1])); }
  if (!FIRST && __builtin_expect(__all(pmax <= THRL), 1)) { alpha = 1.f; }
  else { const float dl = FIRST ? pmax : fmaxf(pmax, 0.f); mhat += dl; alpha = FIRST ? 1.f : __builtin_amdgcn_exp2f(-dl);
#pragma unroll
    for (int r = 0; r < 16; ++r) { p0[r] -= dl; p1[r] -= dl; }
#pragma unroll
    for (int r = 0; r < 16; ++r) negm[r] = -mhat; }
#pragma unroll
  for (int r = 0; r < 16; ++r) p0[r] = __builtin_amdgcn_exp2f(p0[r]);
}
__device__ __forceinline__ void finishSM(f32x16& p0, f32x16& p1, float alpha, float& l_reg, bf16x8& pa0, bf16x8& pa1, bf16x8& pa2, bf16x8& pa3) {
#pragma unroll
  for (int r = 0; r < 16; ++r) p1[r] = __builtin_amdgcn_exp2f(p1[r]);
  float ps = 0;
#pragma unroll
  for (int r = 0; r < 16; ++r) ps += p0[r];
#pragma unroll
  for (int r = 0; r < 16; ++r) ps += p1[r];
  { auto rr = __builtin_amdgcn_permlane32_swap(__float_as_uint(ps), __float_as_uint(ps), false, false);
    ps = __uint_as_float(rr[0]) + __uint_as_float(rr[1]); }
  l_reg = l_reg * alpha + ps;
#define PK8(P, BASE, OUT) do { u32x4 w = {cvtpk(P[BASE + 0], P[BASE + 1]), cvtpk(P[BASE + 2], P[BASE + 3]), cvtpk(P[BASE + 4], P[BASE + 5]), cvtpk(P[BASE + 6], P[BASE + 7])}; \
    OUT = *reinterpret_cast<bf16x8*>(&w); } while (0)
  PK8(p0, 0, pa0); PK8(p0, 8, pa1); PK8(p1, 0, pa2); PK8(p1, 8, pa3);
#undef PK8
}
__device__ __forceinline__ void qkt(f32x16& p0, f32x16& p1, const char* Ks, const bf16x8* qr, const f32x16& negm, int r32, int hi) {
#pragma unroll
  for (int d0 = 0; d0 < 4; ++d0) { const int cb = (d0 * 16 + hi * 8) * 2;
    bf16x8 b0 = *reinterpret_cast<const bf16x8*>(Ks + KSWZ64(r32, cb));
    bf16x8 b1 = *reinterpret_cast<const bf16x8*>(Ks + KSWZ64(32 + r32, cb));
    if (d0 == 0) { p0 = __builtin_amdgcn_mfma_f32_32x32x16_bf16(b0, qr[0], negm, 0, 0, 0); p1 = __builtin_amdgcn_mfma_f32_32x32x16_bf16(b1, qr[0], negm, 0, 0, 0); }
    else { p0 = __builtin_amdgcn_mfma_f32_32x32x16_bf16(b0, qr[d0], p0, 0, 0, 0); p1 = __builtin_amdgcn_mfma_f32_32x32x16_bf16(b1, qr[d0], p1, 0, 0, 0); } }
}
__device__ __forceinline__ int v_st(int k, int c) { const int kk = (k & ~0xC) | ((k & 4) << 1) | ((k & 8) >> 1); return ((kk >> 3) * 4 + (c >> 5)) * 512 + ((kk & 7) * 32 + (c & 31)) * 2; }
__device__ __forceinline__ int v_rd_base(int lane) { return ((lane & 3) << 3) | (((lane >> 2) & 3) << 6) | (((lane >> 4) & 1) << 5) | (((lane >> 5) & 1) << 8); }
constexpr int v_rd_off(int d0, int ks, int half) { return d0 * 512 + ks * 4096 + half * 2048; }
template <int OFF> __device__ __forceinline__ s16x4 tr_read(int vb) {
  s16x4 r; asm volatile("ds_read_b64_tr_b16 %0, %1 offset:%2" : "=&v"(r) : "v"(vb), "i"(OFF) : "memory"); return r;
}
template <int D0> __device__ __forceinline__ void pv_one(f32x16& od, int vb, bf16x8 pa0, bf16x8 pa1, bf16x8 pa2, bf16x8 pa3) {
  const s16x4 l0 = tr_read<v_rd_off(D0, 0, 0)>(vb), h0 = tr_read<v_rd_off(D0, 0, 1)>(vb), l1 = tr_read<v_rd_off(D0, 1, 0)>(vb), h1 = tr_read<v_rd_off(D0, 1, 1)>(vb);
  const s16x4 l2 = tr_read<v_rd_off(D0, 2, 0)>(vb), h2 = tr_read<v_rd_off(D0, 2, 1)>(vb), l3 = tr_read<v_rd_off(D0, 3, 0)>(vb), h3 = tr_read<v_rd_off(D0, 3, 1)>(vb);
  asm volatile("s_waitcnt lgkmcnt(0)" ::: "memory"); SBAR();
#define PK(L, H) (bf16x8){L[0], L[1], L[2], L[3], H[0], H[1], H[2], H[3]}
#if ATT_SETPRIO
  __builtin_amdgcn_s_setprio(1);
#endif
  od = __builtin_amdgcn_mfma_f32_32x32x16_bf16(pa0, PK(l0, h0), od, 0, 0, 0);
  od = __builtin_amdgcn_mfma_f32_32x32x16_bf16(pa1, PK(l1, h1), od, 0, 0, 0);
  od = __builtin_amdgcn_mfma_f32_32x32x16_bf16(pa2, PK(l2, h2), od, 0, 0, 0);
  od = __builtin_amdgcn_mfma_f32_32x32x16_bf16(pa3, PK(l3, h3), od, 0, 0, 0);
#if ATT_SETPRIO
  __builtin_amdgcn_s_setprio(0);
#endif
#undef PK
}
__device__ __forceinline__ void pv_d0(f32x16* o, int vb, bf16x8 pa0, bf16x8 pa1, bf16x8 pa2, bf16x8 pa3) {
  pv_one<0>(o[0], vb, pa0, pa1, pa2, pa3); pv_one<1>(o[1], vb, pa0, pa1, pa2, pa3); pv_one<2>(o[2], vb, pa0, pa1, pa2, pa3); pv_one<3>(o[3], vb, pa0, pa1, pa2, pa3);
}

__device__ __forceinline__ bf16x8 bload(__amdgpu_buffer_rsrc_t rs, unsigned voff, unsigned soff) { return __builtin_bit_cast(bf16x8, __builtin_amdgcn_raw_buffer_load_b128(rs, voff, soff, 0)); }
__device__ __forceinline__ void glds16s(const char* sbase, unsigned voff, unsigned lds_dst) { unsigned keep;
  asm volatile("s_mov_b32 %0, m0\n\ts_mov_b32 m0, %3\n\ts_nop 0\n\tglobal_load_lds_dwordx4 %1, %2\n\ts_mov_b32 m0, %0" : "=&s"(keep) : "v"(voff), "s"(sbase), "s"(lds_dst) : "memory"); }
#define WAIT_BAR(N) asm volatile("s_waitcnt vmcnt(" #N ") lgkmcnt(0)\n\ts_barrier" ::: "memory")
template <bool FAST>
__device__ __forceinline__ void attn_map_body(__amdgpu_buffer_rsrc_t rs, unsigned qo, const char* kbase, const char* vbase, int seq, char* lds, f32x16 (&o)[4], float& l_out) {
  const int tid = threadIdx.x, wid = __builtin_amdgcn_readfirstlane(tid >> 6), lane = tid & 63, r32 = lane & 31, hi = lane >> 5;
  char* V_lds = lds + LDS_V; char* K_lds = lds + LDS_K;
  float* ws = (float*)(lds + LDS_WS) + wid * 64; float* al_l = ws + 32;
  float mhat = 0.f, l_reg = 0; bf16x8 qr[4]; f32x16 negm = f32x16{};
#pragma unroll
  for (int d = 0; d < 4; ++d) o[d] = f32x16{};
  const unsigned qvo = (unsigned)(((wid * QBLK + r32) * 2048 + hi * 8) * 2);
#pragma unroll
  for (int d0 = 0; d0 < 4; ++d0) qr[d0] = bload(rs, qvo + d0 * 32, qo);
  const unsigned lds0 = (unsigned)(uintptr_t)lds;
  const unsigned kvo = (unsigned)(wid * 1024 + lane * 16);
  unsigned vvo[2];
#pragma unroll
  for (int i = 0; i < 2; ++i) vvo[i] = (unsigned)((wid + 8 * i) * 1024 + lane * 16);
  const unsigned kdst = lds0 + LDS_K + wid * 1024, vdst = lds0 + LDS_V + wid * 1024;
#define DMA_K(t, slot) glds16s(kbase + (size_t)(t) * 262144, kvo, (unsigned)__builtin_amdgcn_readfirstlane((int)(kdst + (slot) * SHM_K)))
#define DMA_V(t, slot) do { const char* vb_ = vbase + (size_t)(t) * 262144; const unsigned vd_ = (unsigned)__builtin_amdgcn_readfirstlane((int)(vdst + (slot) * SHM_V)); \
    glds16s(vb_, vvo[0], vd_); glds16s(vb_, vvo[1], vd_ + 8192); } while (0)
  const int vb0 = (int)(uintptr_t)V_lds + v_rd_base(lane);
#define RESC(a) do { if (__any((a) < 1.f)) { if (hi == 0) al_l[r32] = (a); asm volatile("s_waitcnt lgkmcnt(0)" ::: "memory"); \
    _Pragma("unroll") for (int d = 0; d < 4; ++d) _Pragma("unroll") for (int r = 0; r < 16; ++r) o[d][r] *= al_l[crow(r, hi)]; } } while (0)
  f32x16 pA0, pA1, pB0, pB1; float alA, alB; bf16x8 pa0, pa1, pa2, pa3; const int NT = seq / KVBLK;
  int k3 = 0;
#define K3NEXT() do { k3 = (k3 == 2) ? 0 : k3 + 1; } while (0)
#define SM_STEP(PX0, PX1, alX) do { if (FAST) { alX = 1.f; _Pragma("unroll") for (int r_ = 0; r_ < 16; ++r_) PX0[r_] = __builtin_amdgcn_exp2f(PX0[r_]); } \
    else { partialSM<false>(PX0, PX1, mhat, negm, alX); RESC(alX); } } while (0)
#define A_PART(PX0, PX1, PY0, PY1, alY, j, GK, GV, FIN) do { \
    if (GK) DMA_K((j) + 2, (k3 == 0 ? 2 : k3 - 1)); if (GV) DMA_V((j) + 1, ((j) + 1) & 3); \
    SBAR(); qkt(PX0, PX1, K_lds + k3 * SHM_K, qr, negm, r32, hi); \
    if (FIN) finishSM(PY0, PY1, alY, l_reg, pa0, pa1, pa2, pa3); SBAR(); } while (0)
#ifndef ATT_EXP_IN_PV
#define ATT_EXP_IN_PV 1
#endif
#define B_PART(PX0, PX1, alX, j) do { \
    if (FAST && ATT_EXP_IN_PV) { const int vb_ = vb0 + (((j) + 3) & 3) * SHM_V; alX = 1.f; \
        pv_one<0>(o[0], vb_, pa0, pa1, pa2, pa3); _Pragma("unroll") for (int r_ = 0; r_ < 4; ++r_) PX0[r_] = __builtin_amdgcn_exp2f(PX0[r_]); \
        pv_one<1>(o[1], vb_, pa0, pa1, pa2, pa3); _Pragma("unroll") for (int r_ = 4; r_ < 8; ++r_) PX0[r_] = __builtin_amdgcn_exp2f(PX0[r_]); \
        pv_one<2>(o[2], vb_, pa0, pa1, pa2, pa3); _Pragma("unroll") for (int r_ = 8; r_ < 12; ++r_) PX0[r_] = __builtin_amdgcn_exp2f(PX0[r_]); \
        pv_one<3>(o[3], vb_, pa0, pa1, pa2, pa3); _Pragma("unroll") for (int r_ = 12; r_ < 16; ++r_) PX0[r_] = __builtin_amdgcn_exp2f(PX0[r_]); } \
    else { pv_d0(o, vb0 + (((j) + 3) & 3) * SHM_V, pa0, pa1, pa2, pa3); SM_STEP(PX0, PX1, alX); } } while (0)
#ifndef ATT_LATE_SPLIT
#define ATT_LATE_SPLIT 0
#endif
#define B1_PART(j) do { const int vb_ = vb0 + (((j) + 3) & 3) * SHM_V; if (ATT_LATE_SPLIT) { pv_one<0>(o[0], vb_, pa0, pa1, pa2, pa3); pv_one<1>(o[1], vb_, pa0, pa1, pa2, pa3); } } while (0)
#define B2_PART(PX0, PX1, alX, j) do { const int vb_ = vb0 + (((j) + 3) & 3) * SHM_V; \
    if (ATT_LATE_SPLIT) { pv_one<2>(o[2], vb_, pa0, pa1, pa2, pa3); pv_one<3>(o[3], vb_, pa0, pa1, pa2, pa3); } else pv_d0(o, vb_, pa0, pa1, pa2, pa3); \
    SM_STEP(PX0, PX1, alX); } while (0)
  DMA_K(0, 0); DMA_V(0, 0); DMA_K(1, 1);
  WAIT_BAR(0);
  int j = 1;
  if (wid < 4) {
    A_PART(pA0, pA1, pB0, pB1, alB, 0, true, true, false); partialSM<true>(pA0, pA1, mhat, negm, alA); WAIT_BAR(3); K3NEXT();
    for (; j + 3 < NT; j += 2) {
      A_PART(pB0, pB1, pA0, pA1, alA, j, true, true, true); B_PART(pB0, pB1, alB, j); WAIT_BAR(3); K3NEXT();
      A_PART(pA0, pA1, pB0, pB1, alB, j + 1, true, true, true); B_PART(pA0, pA1, alA, j + 1); WAIT_BAR(3); K3NEXT();
    }
    A_PART(pB0, pB1, pA0, pA1, alA, j, true, true, true); B_PART(pB0, pB1, alB, j); WAIT_BAR(3); K3NEXT();
    A_PART(pA0, pA1, pB0, pB1, alB, j + 1, false, true, true); B_PART(pA0, pA1, alA, j + 1); WAIT_BAR(2); K3NEXT();
    A_PART(pB0, pB1, pA0, pA1, alA, j + 2, false, false, true); B_PART(pB0, pB1, alB, j + 2); WAIT_BAR(0); K3NEXT();
  } else {
    A_PART(pA0, pA1, pB0, pB1, alB, 0, true, true, false); WAIT_BAR(3); K3NEXT();
    partialSM<true>(pA0, pA1, mhat, negm, alA);
    for (; j + 3 < NT; j += 2) {
      A_PART(pB0, pB1, pA0, pA1, alA, j, true, true, true); B1_PART(j); WAIT_BAR(3); K3NEXT(); B2_PART(pB0, pB1, alB, j);
      A_PART(pA0, pA1, pB0, pB1, alB, j + 1, true, true, true); B1_PART(j + 1); WAIT_BAR(3); K3NEXT(); B2_PART(pA0, pA1, alA, j + 1);
    }
    A_PART(pB0, pB1, pA0, pA1, alA, j, true, true, true); B1_PART(j); WAIT_BAR(3); K3NEXT(); B2_PART(pB0, pB1, alB, j);
    A_PART(pA0, pA1, pB0, pB1, alB, j + 1, false, true, true); B1_PART(j + 1); WAIT_BAR(2); K3NEXT(); B2_PART(pA0, pA1, alA, j + 1);
    A_PART(pB0, pB1, pA0, pA1, alA, j + 2, false, false, true); B1_PART(j + 2); WAIT_BAR(0); K3NEXT(); B2_PART(pB0, pB1, alB, j + 2);
  }
  finishSM(pB0, pB1, alB, l_reg, pa0, pa1, pa2, pa3); SBAR();
  pv_d0(o, vb0 + ((NT - 1) & 3) * SHM_V, pa0, pa1, pa2, pa3);
  WAIT_BAR(0);
  l_out = l_reg;
#undef A_PART
#undef SM_STEP
#undef B_PART
#undef B1_PART
#undef B2_PART
#undef K3NEXT
#undef DMA_K
#undef DMA_V
#undef RESC
}
#undef WAIT_BAR
#undef SBAR
}

#define GAS __attribute__((address_space(1)))
#define LAS __attribute__((address_space(3)))
typedef unsigned short bf16;
typedef unsigned v4u __attribute__((ext_vector_type(4)));
typedef float f32x4 __attribute__((ext_vector_type(4)));
typedef short bf16x8 __attribute__((ext_vector_type(8)));
typedef GAS unsigned gu32;
typedef GAS unsigned long long gu64;
#define RLX_AGENT __ATOMIC_RELAXED, __HIP_MEMORY_SCOPE_AGENT
#define LDS_WAIT() asm volatile("s_waitcnt lgkmcnt(0)" ::: "memory")
#define VM_WAIT() asm volatile("s_waitcnt vmcnt(0)" ::: "memory")
__device__ __forceinline__ unsigned long long rt() { return __builtin_amdgcn_s_memrealtime(); }
__device__ __forceinline__ unsigned f2bf(float f) { unsigned u = __builtin_bit_cast(unsigned, f); return (u + 0x7fffu + ((u >> 16) & 1u)) >> 16; }
__device__ __forceinline__ unsigned pk2(float lo, float hi) { return f2bf(lo) | (f2bf(hi) << 16); }
#define XB_TMO      128
#define XB_XCNT(j)  (256  + 64 * (j))
#define XB_XSUB(j)  (1280 + 64 * (j))
#define XB_XGEN(j)  (2304 + 64 * (j))
#define XB_TOP      3328
#define XB_TOPGEN   3392
#define XCD_BAR_WORDS 3456
#define XB_SPIN_CAP (1u << 18)

__device__ __forceinline__ unsigned xb_ld(unsigned* p)              { return __hip_atomic_load(p, __ATOMIC_RELAXED, __HIP_MEMORY_SCOPE_AGENT); }
__device__ __forceinline__ unsigned xb_add(unsigned* p, unsigned v) { return __hip_atomic_fetch_add(p, v, __ATOMIC_RELAXED, __HIP_MEMORY_SCOPE_AGENT); }
__device__ __forceinline__ unsigned xb_xcc_id() { return (unsigned)__builtin_amdgcn_s_getreg((3 << 11) | 20) & 0xFu; }
#define XB_SPIN(cond, bar) do { unsigned _sp = 0; while (cond) { __builtin_amdgcn_s_sleep(1); \
    if ((++_sp & 255u) == 0u) { if (xb_ld(&(bar)[XB_TMO])) break; if (_sp > XB_SPIN_CAP) { atomicAdd(&(bar)[XB_TMO], 1u); break; } } } } while (0)

struct XcdBarrier {
    unsigned* bar; unsigned x;
    volatile LAS unsigned* st;
};

__device__ __forceinline__ XcdBarrier xcd_barrier_post(unsigned* bar, volatile LAS unsigned* st) {
    XcdBarrier b; b.bar = bar; b.x = xb_xcc_id(); b.st = st;
    if (threadIdx.x == 0) (void)xb_add(&bar[XB_XCNT(b.x)], 1u);
    return b;
}
__device__ __forceinline__ void xcd_barrier_complete(unsigned* bar, unsigned x, unsigned& nloc, unsigned& nx) {
    const unsigned G = gridDim.x * gridDim.y * gridDim.z;
    unsigned sum, cnt, mine, sp = 0u;
    for (;;) {
        sum = 0u; cnt = 0u; mine = 0u;
#pragma unroll
        for (unsigned j = 0; j < 16; ++j) { const unsigned c = xb_ld(&bar[XB_XCNT(j)]); sum += c; cnt += (c > 0u) ? 1u : 0u; mine = (j == x) ? c : mine; }
        if (sum == G) break;
        __builtin_amdgcn_s_sleep(1);
        if ((++sp & 255u) == 0u) { if (xb_ld(&bar[XB_TMO])) break; if (sp > XB_SPIN_CAP) { atomicAdd(&bar[XB_TMO], 1u); break; } }
    }
    nloc = mine > 0u ? mine : 1u; nx = cnt > 0u ? cnt : 1u;
}

__device__ __forceinline__ void xcd_barrier(const XcdBarrier& b) {
    asm volatile("s_waitcnt vmcnt(0)" ::: "memory");
    __syncthreads();
    if (threadIdx.x == 0) {
        unsigned* bar = b.bar;
        __builtin_amdgcn_s_waitcnt(0);
        unsigned nloc = b.st[0], nx = b.st[1];
        if (nloc == 0u) { xcd_barrier_complete(bar, b.x, nloc, nx); b.st[0] = nloc; b.st[1] = nx; }
        const unsigned old = xb_add(&bar[XB_XSUB(b.x)], 1u);
        const unsigned gen = old / nloc;
        if (old + 1u == (gen + 1u) * nloc) {
            __builtin_amdgcn_fence(__ATOMIC_RELEASE, "agent");
            asm volatile("s_waitcnt vmcnt(0)" ::: "memory");
            const unsigned og = xb_add(&bar[XB_TOP], 1u);
            const unsigned tg = og / nx;
            if (og + 1u == (tg + 1u) * nx) xb_add(&bar[XB_TOPGEN], 1u);
            else XB_SPIN(xb_ld(&bar[XB_TOPGEN]) == tg, bar);
            __builtin_amdgcn_fence(__ATOMIC_ACQUIRE, "agent");
            xb_add(&bar[XB_XGEN(b.x)], 1u);
            asm volatile("s_waitcnt vmcnt(0)" ::: "memory");
        } else {
            XB_SPIN(xb_ld(&bar[XB_XGEN(b.x)]) == gen, bar);
            __builtin_amdgcn_fence(__ATOMIC_ACQUIRE, "agent");
            asm volatile("s_waitcnt vmcnt(0)" ::: "memory");
        }
    }
    __syncthreads();
}
constexpr int NWAVES = 8;
constexpr int TT = 24576, DM = 4096, DFF = 11008, NIN = 18432;
constexpr int NH = 16, AW = 2048, RW = 2048;
constexpr int NCHUNK = TT / 64;
constexpr float EPS = 1e-6f;
constexpr int NPHASE = 15;
#ifndef MK_PER_PHASE
#define MK_PER_PHASE 0
#endif

constexpr size_t MiB = 1u << 20;
constexpr size_t WS_CTL = 0, CTL_ZERO_BYTES = 1 * MiB;
constexpr size_t WS_ROPE = 1 * MiB;
constexpr size_t WS_RGW = 2 * MiB;
constexpr size_t WS_AGG = 4 * MiB;
constexpr size_t WS_CARRY = 16 * MiB;
constexpr size_t WS_ASCR = 22 * MiB;
constexpr int PADE = 128, LDH = DM + PADE, LDMID = DFF + PADE, LDO = AW + PADE;
constexpr size_t WS_WFI = 54 * MiB, WS_WFO = 232 * MiB;
constexpr size_t WS_WIN = 319 * MiB, WS_WA = 468 * MiB, WS_WR = WS_WA + (size_t)DM * AW * 2  , WS_WO = 502 * MiB;
constexpr size_t WS_H = 535 * MiB;
constexpr size_t WS_RR = WS_H + (size_t)TT * AW * 2;
constexpr size_t WS_BIG = 739 * MiB;
constexpr size_t WS_QKV = WS_BIG, WS_RXY = WS_BIG + 288 * MiB, WS_G = WS_BIG + 480 * MiB, WS_XR = WS_BIG + 864 * MiB, WS_END = WS_XR + 192 * MiB;
static_assert(WS_WFI + (size_t)2 * DFF * LDH * 2 <= WS_WFO && WS_WFO + (size_t)DM * LDMID * 2 <= WS_WIN && WS_WIN + (size_t)NIN * LDH * 2 <= WS_WA && WS_WA + (size_t)DM * AW * 2 <= WS_WR &&
              WS_WR + (size_t)DM * RW * 2 <= WS_WO && WS_WO + (size_t)DM * LDH * 2 <= WS_H && WS_H + (size_t)TT * LDH * 2 <= WS_BIG && WS_H + (size_t)TT * AW * 2 <= WS_RR && WS_RR + (size_t)TT * RW * 2 <= WS_BIG, "ws map");
static_assert(WS_QKV + (size_t)TT * 6144 * 2 <= WS_RXY && WS_RXY + (size_t)TT * 4096 * 2 <= WS_G && WS_G + (size_t)TT * 8192 * 2 <= WS_END && WS_BIG + (size_t)TT * LDMID * 2 <= WS_END && (size_t)TT * LDH * 2 <= 288 * MiB, "ws map 2");
constexpr int CW_BAR = 4096;
constexpr size_t WS_SSQ = WS_ASCR;
constexpr size_t WS_RSTD = WS_CTL + 512 * 1024;

constexpr int RING_OFF = 0, RING_BYTES = 131072;
constexpr int LDSCTL_OFF = RING_BYTES, MISC_OFF = LDSCTL_OFF + 320;
constexpr int LDS_BYTES = 147456;

struct Frame {
    LAS unsigned char* lds;
    volatile LAS unsigned* MISC;
    int tid, lane, wave;
    int vcu, G;
};
__device__ __forceinline__ float wave_sum(float v) {
#pragma unroll
    for (int o = 1; o < 64; o <<= 1) v += __shfl_xor(v, o);
    return v;
}
__device__ __forceinline__ int seq_start(int row) { return row < 4096 ? 0 : (row < 8192 ? 4096 : 8192); }
__device__ __forceinline__ int seq_end(int row) { return row < 4096 ? 4096 : (row < 8192 ? 8192 : TT); }

struct TItem { const float* src; bf16* WT; const float* gk; int N, drow0, k0, KT, mode; };
__device__ __forceinline__ void titem_load(const TItem& d, float (&v)[32]) {
#pragma unroll
    for (int i = 0; i < 32; ++i) v[i] = d.src[(size_t)(2 * i) * d.N];
}
__device__ __forceinline__ void titem_finish(const TItem& d, const float (&v)[32], LAS float* scr, int lane) {
#pragma unroll
    for (int i = 0; i < 32; ++i) scr[(2 * i + (lane >> 5)) * 33 + (lane & 31)] = v[i];
    LDS_WAIT(); asm volatile("" ::: "memory");
    const int c = lane & 7;
    f32x4 g0 = (f32x4){1.f, 1.f, 1.f, 1.f}, g1 = g0;
    if (d.gk) { g0 = *(const GAS f32x4*)(d.gk + d.k0 + 8 * c); g1 = *(const GAS f32x4*)(d.gk + d.k0 + 8 * c + 4); }
#pragma unroll
    for (int j = 0; j < 4; ++j) { const int n = (lane >> 3) + 8 * j; const LAS float* s = scr + (8 * c) * 33 + n;
        v4u o; o.x = pk2(s[0 * 33] * g0.x, s[1 * 33] * g0.y); o.y = pk2(s[2 * 33] * g0.z, s[3 * 33] * g0.w); o.z = pk2(s[4 * 33] * g1.x, s[5 * 33] * g1.y); o.w = pk2(s[6 * 33] * g1.z, s[7 * 33] * g1.w);
        GAS v4u* dp = d.mode == 0 ? (GAS v4u*)(d.WT + (size_t)(d.drow0 + n) * d.KT + d.k0 + 8 * c)
                                  : (GAS v4u*)((unsigned char*)d.WT + pg8::blk_off_b(d.drow0 + n, d.k0 + 8 * c, d.KT, d.mode == 2));
        *dp = o; }
    LDS_WAIT(); asm volatile("" ::: "memory");
}
__device__ __forceinline__ int ffn_in_row(int n) { return n < DFF ? (n >> 7) * 256 + (n & 127) : ((n - DFF) >> 7) * 256 + 128 + ((n - DFF) & 127); }
__device__ __forceinline__ TItem titem_matrix(const float* W, int K, int N, bf16* WT, int KT, int mode, int ffn, int item, int lane, const float* gk = nullptr) {
    const int nblk = N / 32, kb = item / nblk, nb = item % nblk, n0 = 32 * nb, k0 = 64 * kb;
    TItem d; d.src = W + (size_t)(k0 + (lane >> 5)) * N + n0 + (lane & 31); d.WT = WT; d.gk = gk; d.N = N; d.drow0 = ffn ? ffn_in_row(n0) : n0; d.k0 = k0; d.KT = KT; d.mode = mode; return d;
}
__device__ __forceinline__ void rms_row_to_bf16(const float* xrow, const float* g, bf16* Hb, int m, int lane) {
    const GAS f32x4* xr = (const GAS f32x4*)xrow + lane; const GAS f32x4* gr = (const GAS f32x4*)g + lane;
    f32x4 v[16]; float s = 0.f;
#pragma unroll
    for (int j = 0; j < 16; ++j) { v[j] = xr[64 * j]; s += (v[j].x * v[j].x + v[j].y * v[j].y) + (v[j].z * v[j].z + v[j].w * v[j].w); }
    const float rstd = 1.f / sqrtf(wave_sum(s) * (1.f / DM) + EPS);
#pragma unroll
    for (int j = 0; j < 16; ++j) { const f32x4 gg = gr[64 * j];
        *(GAS unsigned long long*)((unsigned char*)Hb + pg8::blk_off(m, 4 * lane + 256 * j, DM / 64)) =
            (unsigned long long)pk2(v[j].x * rstd * gg.x, v[j].y * rstd * gg.y) | ((unsigned long long)pk2(v[j].z * rstd * gg.z, v[j].w * rstd * gg.w) << 32); }
}
__device__ __forceinline__ void rms_row_bf16_to_bf16(const bf16* xrow, const float* g, bf16* Hb, int m, int lane) {
    const GAS v4u* xr = (const GAS v4u*)xrow + lane;
    v4u v[8]; float s = 0.f;
#pragma unroll
    for (int j = 0; j < 8; ++j) { v[j] = xr[64 * j]; const unsigned w[4] = {v[j].x, v[j].y, v[j].z, v[j].w};
#pragma unroll
        for (int k = 0; k < 4; ++k) { const float a = pg8::bf_lo(w[k]), b = pg8::bf_hi(w[k]); s += a * a + b * b; } }
    const float rstd = 1.f / sqrtf(wave_sum(s) * (1.f / DM) + EPS);
#pragma unroll
    for (int j = 0; j < 8; ++j) { const int col = 8 * lane + 512 * j; const f32x4 g0 = *(const GAS f32x4*)(g + col), g1 = *(const GAS f32x4*)(g + col + 4);
        v4u o; o.x = pk2(pg8::bf_lo(v[j].x) * rstd * g0.x, pg8::bf_hi(v[j].x) * rstd * g0.y); o.y = pk2(pg8::bf_lo(v[j].y) * rstd * g0.z, pg8::bf_hi(v[j].y) * rstd * g0.w);
        o.z = pk2(pg8::bf_lo(v[j].z) * rstd * g1.x, pg8::bf_hi(v[j].z) * rstd * g1.y); o.w = pk2(pg8::bf_lo(v[j].w) * rstd * g1.z, pg8::bf_hi(v[j].w) * rstd * g1.w);
        *(GAS v4u*)((unsigned char*)Hb + pg8::blk_off(m, col, DM / 64)) = o; }
}
__device__ __forceinline__ void rms_row_f32_inplace(float* xrow, const float* g, int lane) {
    GAS f32x4* xr = (GAS f32x4*)xrow + lane; const GAS f32x4* gr = (const GAS f32x4*)g + lane;
    f32x4 v[16]; float s = 0.f;
#pragma unroll
    for (int j = 0; j < 16; ++j) { v[j] = xr[64 * j]; s += (v[j].x * v[j].x + v[j].y * v[j].y) + (v[j].z * v[j].z + v[j].w * v[j].w); }
    const float rstd = 1.f / sqrtf(wave_sum(s) * (1.f / DM) + EPS);
#pragma unroll
    for (int j = 0; j < 16; ++j) { const f32x4 gg = gr[64 * j]; xr[64 * j] = v[j] * rstd * gg; }
}
__device__ __forceinline__ int recent_first_row(int it) { const int pp = it >> 8, s = pp >> 5, idx = pp & 31; return ((12 * (idx >> 2) + 4 * (2 - s) + (idx & 3)) << 8) + (it & 255); }
__device__ __forceinline__ void rms_row_bf16_to_f32(const bf16* Xb, int m, const float* g, float* orow, int lane) {
    v4u v[8]; float s = 0.f;
#pragma unroll
    for (int j = 0; j < 8; ++j) { v[j] = *(const GAS v4u*)((const unsigned char*)Xb + pg8::blk_off(m, 8 * lane + 512 * j, DM / 64)); const unsigned w[4] = {v[j].x, v[j].y, v[j].z, v[j].w};
#pragma unroll
        for (int k = 0; k < 4; ++k) { const float a = pg8::bf_lo(w[k]), b = pg8::bf_hi(w[k]); s += a * a + b * b; } }
    const float rstd = 1.f / sqrtf(wave_sum(s) * (1.f / DM) + EPS);
#pragma unroll
    for (int j = 0; j < 8; ++j) { const int col = 8 * lane + 512 * j; const f32x4 g0 = *(const GAS f32x4*)(g + col), g1 = *(const GAS f32x4*)(g + col + 4);
        *(GAS f32x4*)(orow + col) = (f32x4){pg8::bf_lo(v[j].x) * rstd * g0.x, pg8::bf_hi(v[j].x) * rstd * g0.y, pg8::bf_lo(v[j].y) * rstd * g0.z, pg8::bf_hi(v[j].y) * rstd * g0.w};
        *(GAS f32x4*)(orow + col + 4) = (f32x4){pg8::bf_lo(v[j].z) * rstd * g1.x, pg8::bf_hi(v[j].z) * rstd * g1.y, pg8::bf_lo(v[j].w) * rstd * g1.z, pg8::bf_hi(v[j].w) * rstd * g1.w}; }
}
__device__ __forceinline__ void rstd_phase(Frame& F, const float* ssq, float* rstd) {
    for (int m = F.vcu * (NWAVES * 64) + F.tid; m < TT; m += F.G * NWAVES * 64) { const GAS f32x4* p = (const GAS f32x4*)(ssq + (size_t)m * 64); float s = 0.f;
#pragma unroll
        for (int j = 0; j < 16; ++j) { const f32x4 v = p[j]; s += (v.x + v.y) + (v.z + v.w); }
        rstd[m] = 1.f / sqrtf(s * (1.f / DM) + EPS); }
}
__device__ __forceinline__ void rms_phase(Frame& F, const float* xa, const float* xb, const float* g, bf16* H) {
    const int gw = F.vcu * NWAVES + F.wave, NGW = F.G * NWAVES;
    for (int it = gw; it < TT; it += NGW) { const int m = recent_first_row(it); const float* xr = m < 8192 ? xa + (size_t)m * DM : xb + (size_t)(m - 8192) * DM; rms_row_to_bf16(xr, g, H, m, F.lane); }
}

constexpr int RL_XB = 0, RL_XF = 17408, RL_CW = 51200, RL_RAW = 53760, RL_RAWB = 33792;
static_assert(RL_RAW + 2 * RL_RAWB <= RING_BYTES, "rglru LDS");
template <bool REV> __device__ __forceinline__ void rl_scan(const float (&a)[4][4], const float (&u)[4][4], float cin, float (&h)[4][4], float& Atot, float& Hfin, int lane) {
    const int fq = lane >> 4, fr = lane & 15;
    const int src1 = (REV ? lane + 16 : lane - 16) & 63, src2 = (REV ? lane + 32 : lane - 32) & 63, srct = REV ? fr : fr + 48;
    const bool v1 = REV ? fq <= 2 : fq >= 1, v2 = REV ? fq <= 1 : fq >= 2;
    float C = cin; Atot = 1.f;
#pragma unroll
    for (int mtt = 0; mtt < 4; ++mtt) { const int mt = REV ? 3 - mtt : mtt;
        float P[4], Hl[4];
        if (!REV) { P[0] = a[mt][0]; Hl[0] = u[mt][0];
#pragma unroll
            for (int i = 1; i < 4; ++i) { P[i] = a[mt][i] * P[i - 1]; Hl[i] = a[mt][i] * Hl[i - 1] + u[mt][i]; } }
        else { P[3] = a[mt][3]; Hl[3] = u[mt][3];
#pragma unroll
            for (int i = 2; i >= 0; --i) { P[i] = a[mt][i] * P[i + 1]; Hl[i] = a[mt][i] * Hl[i + 1] + u[mt][i]; } }
        float As = REV ? P[0] : P[3], Hs = REV ? Hl[0] : Hl[3];
        { const float Ap = __shfl(As, src1), Hp = __shfl(Hs, src1); if (v1) { Hs = As * Hp + Hs; As = As * Ap; } }
        { const float Ap = __shfl(As, src2), Hp = __shfl(Hs, src2); if (v2) { Hs = As * Hp + Hs; As = As * Ap; } }
        float Ae = __shfl(As, src1), He = __shfl(Hs, src1); if (!v1) { Ae = 1.f; He = 0.f; }
        const float At = __shfl(As, srct), Ht = __shfl(Hs, srct);
        const float E = Ae * C + He;
#pragma unroll
        for (int i = 0; i < 4; ++i) h[mt][i] = P[i] * E + Hl[i];
        C = At * C + Ht; Atot *= At; }
    Hfin = C;
}
__device__ __forceinline__ float gelu_tanh(float x) {
    const float z = 0.7978845608028654f * (x + 0.044715f * x * x * x);
    const float e = __builtin_amdgcn_exp2f(2.f * 1.4426950408889634f * z);
    const float th = 1.f - 2.f * __builtin_amdgcn_rcpf(e + 1.f);
    return 0.5f * x * (1.f + th);
}
__device__ __forceinline__ void rl_glds16(const void* gsrc, unsigned lds_dst) { unsigned keep;
    asm volatile("s_mov_b32 %0, m0\n\ts_mov_b32 m0, %2\n\ts_nop 0\n\tglobal_load_lds_dwordx4 %1, off\n\ts_mov_b32 m0, %0" : "=&s"(keep) : "v"(gsrc), "s"(lds_dst) : "memory"); }
template <bool FINAL>
__device__ __forceinline__ void rglru_phase(Frame& F, const bf16* RXY, const bf16* RGW, const float* conv_w, const float* conv_b, const float* rg_ba, const float* rg_bx,
                                            const float* rg_lambda, float* AGG, const float* CARRY, bf16* RR) {
    typedef short bf16x8 __attribute__((ext_vector_type(8)));
    const int tid = F.tid, lane = F.lane, w = F.wave, fr = lane & 15, fq = lane >> 4;
    const int n = F.vcu & 15, cl = 16 * w + fr, cg = n * 128 + cl;
    LAS unsigned char* L = F.lds + RING_OFF;
    LAS float* CW = (LAS float*)(L + RL_CW);
    for (int i = tid; i < 640; i += NWAVES * 64) CW[i] = i < 512 ? conv_w[(i >> 7) * RW + n * 128 + (i & 127)] : conv_b[n * 128 + (i - 512)];
    bf16x8 Bf[4][4]; float bias[4], sp[2];
#pragma unroll
    for (int g = 0; g < 4; ++g) {
#pragma unroll
        for (int ks = 0; ks < 4; ++ks) Bf[g][ks] = *(const bf16x8*)(RGW + ((size_t)(g * 16 + n) * 128 + cl) * 128 + 32 * ks + 8 * fq);
        bias[g] = (g & 1) ? rg_bx[((g >> 1) * 16 + n) * 128 + cl] : rg_ba[((g >> 1) * 16 + n) * 128 + cl]; }
#pragma unroll
    for (int d = 0; d < 2; ++d) sp[d] = log1pf(__expf(-rg_lambda[d * RW + cg]));
    __syncthreads();
    const int t = tid >> 3, c16 = (tid & 7) * 16;
    float k1[2];
#pragma unroll
    for (int d = 0; d < 2; ++d) k1[d] = -8.f * 1.4426950408889634f * sp[d];
#ifndef RL_PASSES
#define RL_PASSES 1
#endif
    const int cstep = F.G >> 4, cfirst = F.vcu >> 4;
#define RL_DMA(ci_, buf_) do { const int row0_ = (ci_) * 64, s0_ = seq_start(row0_), s1_ = seq_end(row0_); \
        _Pragma("unroll") for (int k_ = 0; k_ < (FINAL ? 5 : 3); ++k_) { int q_ = w + NWAVES * k_; q_ = q_ < (FINAL ? 33 : 17) ? q_ : (FINAL ? 32 : 16);     \
            const int lr_ = 4 * (q_ < 17 ? q_ : q_ - 17) + (lane >> 4); int gr_ = q_ < 17 ? row0_ - 2 + lr_ : row0_ + lr_; gr_ = gr_ < s0_ ? s0_ : (gr_ >= s1_ ? s1_ - 1 : gr_); \
            const bf16* gp_ = RXY + (size_t)gr_ * 4096 + (q_ < 17 ? 0 : 2048) + n * 128 + (lane & 15) * 8; \
            rl_glds16(gp_, (unsigned)__builtin_amdgcn_readfirstlane((int)(lds0 + RL_RAW + (buf_) * RL_RAWB + q_ * 1024))); } } while (0)
    const unsigned lds0 = (unsigned)(uintptr_t)L;
    {
#define RL_WRAP(x) ((x) >= NCHUNK ? (x) - NCHUNK : (x))
    float cnx[2] = {0.f, 0.f};
    if (cfirst < NCHUNK) { RL_DMA(cfirst, 0); if (FINAL) { cnx[0] = CARRY[(size_t)(cfirst * 2 + 0) * RW + cg]; cnx[1] = CARRY[(size_t)(cfirst * 2 + 1) * RW + cg]; } }
    int buf = 0;
    for (int cl_ = cfirst; cl_ < NCHUNK * RL_PASSES; cl_ += cstep, buf ^= 1) { const int ci = RL_WRAP(cl_);
        const int row0 = ci * 64, s0 = seq_start(row0), s1 = seq_end(row0);
        LAS unsigned char* RAW = L + RL_RAW + buf * RL_RAWB; LAS unsigned char* YR = RAW + 68 * 256;
        asm volatile("s_waitcnt vmcnt(0) lgkmcnt(0)" ::: "memory"); __builtin_amdgcn_s_barrier(); asm volatile("" ::: "memory");
        const float cin2[2] = {cnx[0], cnx[1]};
        if (cl_ + cstep < NCHUNK * RL_PASSES) { const int cn = RL_WRAP(cl_ + cstep); RL_DMA(cn, buf ^ 1);
            if (FINAL) { cnx[0] = CARRY[(size_t)(cn * 2 + 0) * RW + cg]; cnx[1] = CARRY[(size_t)(cn * 2 + 1) * RW + cg]; } }
        { float xa[16];
#pragma unroll
          for (int k = 0; k < 16; ++k) xa[k] = CW[512 + c16 + k];
#pragma unroll
          for (int j = 0; j < 4; ++j) { const int rr = row0 + t + j - 2; const float msk = (rr >= s0 && rr < s1) ? 1.f : 0.f;
              const LAS v4u* rp = (const LAS v4u*)(RAW + (t + j) * 256 + c16 * 2); const v4u q0 = rp[0], q1 = rp[1];
              const unsigned ww[8] = {q0.x, q0.y, q0.z, q0.w, q1.x, q1.y, q1.z, q1.w};
#pragma unroll
              for (int k = 0; k < 8; ++k) { xa[2 * k] += CW[j * 128 + c16 + 2 * k] * (msk * pg8::bf_lo(ww[k])); xa[2 * k + 1] += CW[j * 128 + c16 + 2 * k + 1] * (msk * pg8::bf_hi(ww[k])); } }
          LAS f32x4* xf = (LAS f32x4*)(L + RL_XF + t * 528 + c16 * 4);
#pragma unroll
          for (int k = 0; k < 4; ++k) xf[k] = (f32x4){xa[4 * k], xa[4 * k + 1], xa[4 * k + 2], xa[4 * k + 3]};
          LAS v4u* xb = (LAS v4u*)(L + RL_XB + t * 272 + c16 * 2);
          xb[0] = (v4u){pk2(xa[0], xa[1]), pk2(xa[2], xa[3]), pk2(xa[4], xa[5]), pk2(xa[6], xa[7])};
          xb[1] = (v4u){pk2(xa[8], xa[9]), pk2(xa[10], xa[11]), pk2(xa[12], xa[13]), pk2(xa[14], xa[15])}; }
        asm volatile("s_waitcnt lgkmcnt(0)" ::: "memory"); __builtin_amdgcn_s_barrier(); asm volatile("" ::: "memory");
        float hsum[4][4];
#pragma unroll
        for (int d = 0; d < 2; ++d) {
            float a[4][4], u[4][4];
#pragma unroll
            for (int mt = 0; mt < 4; ++mt) {
                f32x4 ca = (f32x4){bias[2 * d], bias[2 * d], bias[2 * d], bias[2 * d]}, cx = (f32x4){bias[2 * d + 1], bias[2 * d + 1], bias[2 * d + 1], bias[2 * d + 1]};
#pragma unroll
                for (int ks = 0; ks < 4; ++ks) { const bf16x8 af = *(const LAS bf16x8*)(L + RL_XB + (16 * mt + fr) * 272 + (32 * ks + 8 * fq) * 2);
                    ca = __builtin_amdgcn_mfma_f32_16x16x32_bf16(af, Bf[2 * d][ks], ca, 0, 0, 0); cx = __builtin_amdgcn_mfma_f32_16x16x32_bf16(af, Bf[2 * d + 1][ks], cx, 0, 0, 0); }
#pragma unroll
                for (int i = 0; i < 4; ++i) { const float ra = pg8::sigm(ca[i]), ia = pg8::sigm(cx[i]);
                    const float xv = *(const LAS float*)(L + RL_XF + (16 * mt + 4 * fq + i) * 528 + cl * 4);
                    const float av = __builtin_amdgcn_exp2f(k1[d] * ra);
                    a[mt][i] = av; u[mt][i] = __builtin_amdgcn_sqrtf(fmaxf(fmaf(-av, av, 1.f), 0.f)) * (ia * xv); } }
            float h[4][4], Atot, Hfin;
            const float cin = cin2[d];
            if (d == 0) rl_scan<false>(a, u, cin, h, Atot, Hfin, lane); else rl_scan<true>(a, u, cin, h, Atot, Hfin, lane);
            if (FINAL) {
#pragma unroll
                for (int mt = 0; mt < 4; ++mt)
#pragma unroll
                    for (int i = 0; i < 4; ++i) hsum[mt][i] = d == 0 ? h[mt][i] : hsum[mt][i] + h[mt][i]; }
            else if (fq == 0) { float2 ah; ah.x = Atot; ah.y = Hfin; *(float2*)(AGG + ((size_t)(ci * 2 + d) * RW + cg) * 2) = ah; }
        }
        if (FINAL) {
#pragma unroll
            for (int mt = 0; mt < 4; ++mt)
#pragma unroll
                for (int i = 0; i < 4; ++i) { LAS unsigned short* yp = (LAS unsigned short*)(YR + (16 * mt + 4 * fq + i) * 256 + cl * 2);
                    const float y = __uint_as_float((unsigned)(*yp) << 16); *yp = (unsigned short)f2bf(hsum[mt][i] * gelu_tanh(y)); }
            asm volatile("s_waitcnt lgkmcnt(0)" ::: "memory"); __builtin_amdgcn_s_barrier(); asm volatile("" ::: "memory");
            { const LAS v4u* yb = (const LAS v4u*)(YR + t * 256 + c16 * 2); const v4u o0 = yb[0], o1 = yb[1]; *(v4u*)((unsigned char*)RR + pg8::blk_off(row0 + t, n * 128 + c16, RW / 64)) = o0; *(v4u*)((unsigned char*)RR + pg8::blk_off(row0 + t, n * 128 + c16 + 8, RW / 64)) = o1; }
        }
    }
    asm volatile("s_waitcnt vmcnt(0) lgkmcnt(0)" ::: "memory"); __builtin_amdgcn_s_barrier(); asm volatile("" ::: "memory"); }
#undef RL_DMA
#undef RL_WRAP
}
__device__ __forceinline__ void carry_phase(Frame& F, const float* AGG, float* CARRY) {
    const int gt = F.vcu * (NWAVES * 64) + F.tid;
    if (gt >= 3 * 2 * RW) return;
    const int s = gt / (2 * RW), d = (gt / RW) & 1, c = gt % RW;
    const int c0 = s == 0 ? 0 : (s == 1 ? 64 : 128), c1 = s == 0 ? 64 : (s == 1 ? 128 : NCHUNK);
    float carry = 0.f;
    for (int b = 0; b < c1 - c0; b += 32) {
        float2 ah[32];
#pragma unroll
        for (int k = 0; k < 32; ++k) { const int ch = d == 0 ? c0 + b + k : c1 - 1 - b - k; ah[k] = *(const float2*)(AGG + ((size_t)(ch * 2 + d) * RW + c) * 2); }
#pragma unroll
        for (int k = 0; k < 32; ++k) { const int ch = d == 0 ? c0 + b + k : c1 - 1 - b - k; CARRY[(size_t)(ch * 2 + d) * RW + c] = carry; carry = ah[k].x * carry + ah[k].y; }
    }
}

#ifndef ATT_FORCE_SLOW
#define ATT_FORCE_SLOW 0
#endif
#ifndef GEMM_SP2
#define GEMM_SP2 true
#endif
#ifndef ALL_WGM
#define ALL_WGM 4
#endif
#ifndef GEMM_REV
#define GEMM_REV 0xB
#endif
#ifndef FFO_CSPLIT
#define FFO_CSPLIT 1
#endif
#ifndef FFO_WGM
#define FFO_WGM 4
#endif
#ifndef TAIL_FILL
#define TAIL_FILL 0
#endif
#ifndef SKEW_TICKS
#define SKEW_TICKS 0
#endif
#define PHASE_SKEW() do { if (SKEW_TICKS) { const unsigned long long t0_ = __builtin_amdgcn_s_memrealtime(); const unsigned long long d_ = (unsigned long long)((F.vcu * 8 / F.G) & 7) * SKEW_TICKS; \
        while (__builtin_amdgcn_s_memrealtime() - t0_ < d_) __builtin_amdgcn_s_sleep(16); } } while (0)
#define RESID_WMODE (RESID_PERM ? 2 : 1)
#ifndef RESID_ALIGN
#define RESID_ALIGN true
#endif
struct Args { const float* in[26]; float* out; unsigned char* ws; int ph_lo, ph_hi, li, pad; };
__device__ __forceinline__ double rope_rev(int j) {
    return j == 0 ? 0.15915494309189535 : j == 1 ? 0.03086376340470123 : j == 2 ? 0.005985185712713705 : j == 3 ? 0.001160663641240061 :
           j == 4 ? 0.00022507907903927653 : j == 5 ? 4.364795279280289e-05 : j == 6 ? 8.464330808241401e-06 : 1.6414262627950345e-06;
}
#define TRANSPOSE_STREAM(DESC, NIT) do { int it_ = gw; if (it_ < (NIT)) { float va_[32], vb_[32]; TItem da_ = DESC(it_), db_; titem_load(da_, va_); \
        for (;;) { int nx_ = it_ + NGW; bool hn_ = nx_ < (NIT); db_ = DESC(hn_ ? nx_ : it_); titem_load(db_, vb_); titem_finish(da_, va_, scr, F.lane); if (!hn_) break; it_ = nx_; \
                   nx_ = it_ + NGW; hn_ = nx_ < (NIT); da_ = DESC(hn_ ? nx_ : it_); titem_load(da_, va_); titem_finish(db_, vb_, scr, F.lane); if (!hn_) break; it_ = nx_; } } } while (0)
__global__ void __launch_bounds__(NWAVES * 64, 2) mk_fwd(Args args) {
    extern __shared__ __attribute__((aligned(16))) unsigned char lds[];
    Frame F;
    F.lds = (LAS unsigned char*)lds;
    F.MISC = (volatile LAS unsigned*)(F.lds + MISC_OFF);
    F.tid = threadIdx.x; F.lane = F.tid & 63; F.wave = __builtin_amdgcn_readfirstlane(F.tid >> 6);
    F.G = gridDim.x; { const int bx = blockIdx.x; F.vcu = (F.G % 8 == 0) ? (bx % 8) * (F.G / 8) + bx / 8 : bx; }
    unsigned char* ws = args.ws;
    gu32* ctl = (gu32*)(ws + WS_CTL);
    const float* x_prompt = args.in[0]; const float* x_sample = args.in[1];
    const float* ffn1_norm = args.in[2]; const float* ffn1_w_in = args.in[3]; const float* ffn1_w_out = args.in[4];
    const float* mix_norm = args.in[5]; const float* w_in = args.in[6];
    const float* lq1 = args.in[7]; const float* lk1 = args.in[8]; const float* lq2 = args.in[9]; const float* lk2 = args.in[10];
    const float* subln_gain = args.in[11]; const float* conv_w = args.in[12]; const float* conv_b = args.in[13];
    const float* rg_wa = args.in[14]; const float* rg_ba = args.in[15]; const float* rg_wx = args.in[16]; const float* rg_bx = args.in[17]; const float* rg_lambda = args.in[18];
    const float* w_attn = args.in[19]; const float* w_rnn = args.in[20]; const float* w_out = args.in[21];
    const float* ffn2_norm = args.in[22]; const float* ffn2_w_in = args.in[23]; const float* ffn2_w_out = args.in[24]; const float* final_norm = args.in[25];
    float* out = args.out;
    float* ROPE = (float*)(ws + WS_ROPE); bf16* RGW = (bf16*)(ws + WS_RGW); float* AGG = (float*)(ws + WS_AGG); float* CARRY = (float*)(ws + WS_CARRY);
    bf16* WFI = (bf16*)(ws + WS_WFI); bf16* WFO = (bf16*)(ws + WS_WFO); bf16* WIN = (bf16*)(ws + WS_WIN); bf16* WA = (bf16*)(ws + WS_WA); bf16* WR = (bf16*)(ws + WS_WR); bf16* WO = (bf16*)(ws + WS_WO);
    bf16* H = (bf16*)(ws + WS_H); bf16* OB = H; bf16* RR = (bf16*)(ws + WS_RR);
    bf16* XR = (bf16*)(ws + WS_XR); float* SSQ = (float*)(ws + WS_SSQ); float* RSTD = (float*)(ws + WS_RSTD); bf16* MID = (bf16*)(ws + WS_BIG); bf16* QKV = (bf16*)(ws + WS_QKV); bf16* RXY = (bf16*)(ws + WS_RXY); bf16* GT = (bf16*)(ws + WS_G); bf16* MG = QKV;

    for (int u = F.tid; u < (LDS_BYTES - LDSCTL_OFF) / 4; u += NWAVES * 64) ((LAS unsigned*)(F.lds + LDSCTL_OFF))[u] = 0u;
    __syncthreads();
    XcdBarrier bar; bar.bar = (unsigned*)(ctl + CW_BAR) + args.li * XCD_BAR_WORDS; bar.x = 0; bar.st = nullptr;
    if (!MK_PER_PHASE) bar = xcd_barrier_post((unsigned*)(ctl + CW_BAR) + args.li * XCD_BAR_WORDS, F.MISC + 8);
#define GRID_BAR() do { xcd_barrier(bar); } while (0)
    const int lo = args.ph_lo, hi = args.ph_hi;
#ifndef PH_MASK
#define PH_MASK 0x7fff
#endif
#define IN(k) (((PH_MASK >> (k)) & 1) && lo <= (k) && (k) < hi)
#define BOTH(k) (IN(k) && IN((k) + 1))
#ifndef PH_REP
#define PH_REP 0
#endif
#define REPS(k) ((((PH_REP) >> (k)) & 1) + 1)
    const int gw = F.vcu * NWAVES + F.wave, NGW = F.G * NWAVES;
    LAS float* scr = (LAS float*)(F.lds + RING_OFF + F.wave * 16384);

#ifndef PROBE_ALL2_LO
#define PROBE_ALL2_LO 0
#define PROBE_ALL2_HI (NPHASE - 1)
#endif
#ifndef PROBE_ALL2
#define PROBE_ALL2 0
#endif
    if (IN(0))
_Pragma("unroll")
    for (int rep = 0; rep < REPS(0); ++rep) {
        constexpr int I_FI = (DM / 64) * (2 * DFF / 32), I_FO = (DFF / 64) * (DM / 32), I_IN = (DM / 64) * (NIN / 32), I_A = (AW / 64) * (DM / 32), I_O = (DM / 64) * (DM / 32), I_RG = 512;
        constexpr int NITEMS = I_FI + I_IN + I_O + I_RG + (TAIL_FILL ? 0 : I_FO + 2 * I_A);
        auto desc0 = [&](int it) -> TItem {
            int r = it;
            if (r < I_FI) return titem_matrix(ffn1_w_in, DM, 2 * DFF, WFI, DM / 64, 2, 1, r, F.lane); r -= I_FI;
            if (r < I_IN) return titem_matrix(w_in, DM, NIN, WIN, DM / 64, 2, 0, r, F.lane, mix_norm); r -= I_IN;
            if (r < I_O) return titem_matrix(w_out, DM, DM, WO, DM / 64, RESID_WMODE, 0, r, F.lane); r -= I_O;
            if (!TAIL_FILL) {
            if (r < I_FO) return titem_matrix(ffn1_w_out, DFF, DM, WFO, DFF / 64, RESID_WMODE, 0, r, F.lane); r -= I_FO;
            if (r < I_A) return titem_matrix(w_attn, AW, DM, WA, AW / 64, 2, 0, r, F.lane); r -= I_A;
            if (r < I_A) return titem_matrix(w_rnn, RW, DM, WR, RW / 64, 2, 0, r, F.lane); r -= I_A; }
            const int blk = r >> 3, sub = r & 7, gate = blk >> 5, b = blk & 31, dir = b >> 4, n = b & 15;
            return titem_matrix((gate ? rg_wx : rg_wa) + (size_t)b * 16384, 128, 128, RGW + (size_t)((dir * 2 + gate) * 16 + n) * 16384, 128, 0, 0, sub, F.lane);
        };
        TRANSPOSE_STREAM(desc0, NITEMS);
        for (int idx = gw * 64 + F.lane; idx < 16384 * 8; idx += NGW * 64) { const int pos = idx >> 3, j = idx & 7;
            double rev = (double)pos * rope_rev(j); rev -= __builtin_floor(rev); const float rf = (float)rev;
            float2 cs; cs.x = __builtin_amdgcn_cosf(rf); cs.y = __builtin_amdgcn_sinf(rf); *(float2*)(ROPE + 2 * (size_t)idx) = cs; }
        rms_phase(F, x_prompt, x_sample, ffn1_norm, H);
        if (BOTH(0) || rep + 1 < REPS(0)) GRID_BAR();
    }
    if (IN(1))
_Pragma("unroll")
    for (int rep = 0; rep < REPS(1); ++rep) {
        pg8::Gemm g{H, WFI, TT, 2 * DFF, DM, LDH, LDH}; pg8::StaticOrder S; S.init(TT, 2 * DFF, F.G, (int)blockIdx.x, ALL_WGM); S.rev = (GEMM_REV >> 5) & 1;
        pg8::EpiSwiGLU E{MID, DFF / 64, nullptr};
        pg8::gemm_phase<pg8::EpiSwiGLU, pg8::StaticOrder, true, GEMM_SP2>(F.lds + RING_OFF, g, S, E);
        if (TAIL_FILL && rep == 0) {
            constexpr int I_FO = (DFF / 64) * (DM / 32), I_A = (AW / 64) * (DM / 32);
            const int tail = ((TT / 256) * (2 * DFF / 256)) % F.G, nidle = tail ? F.G - tail : F.G, iw = tail ? (int)blockIdx.x - tail : (int)blockIdx.x;
            if (iw >= 0) { const int gw = iw * NWAVES + F.wave, NGW = nidle * NWAVES;
                auto desc1 = [&](int it) -> TItem { int r = it;
                    if (r < I_FO) return titem_matrix(ffn1_w_out, DFF, DM, WFO, DFF / 64, RESID_WMODE, 0, r, F.lane); r -= I_FO;
                    if (r < I_A) return titem_matrix(w_attn, AW, DM, WA, AW / 64, 2, 0, r, F.lane); r -= I_A;
                    return titem_matrix(w_rnn, RW, DM, WR, RW / 64, 2, 0, r, F.lane); };
                TRANSPOSE_STREAM(desc1, I_FO + 2 * I_A); } }
        if (BOTH(1) || rep + 1 < REPS(1)) GRID_BAR();
    }
#ifdef PROBE_P2B
    if (IN(2)) {
        pg8::Gemm g{MID, WFO, TT, DM, DFF, LDMID, LDMID}; pg8::StaticOrder S; S.init(TT, DM, F.G, (int)blockIdx.x, FFO_WGM); S.csplit = FFO_CSPLIT; S.rev = (GEMM_REV >> 0) & 1;
        pg8::EpiPlainBf16 E{H, 0.5f};
        pg8::gemm_phase<pg8::EpiPlainBf16, pg8::StaticOrder, true, GEMM_SP2>(F.lds + RING_OFF, g, S, E);
        GRID_BAR();
    }
#endif
    if (IN(2))
_Pragma("unroll")
    for (int rep = 0; rep < REPS(2); ++rep) {
        pg8::Gemm g{MID, WFO, TT, DM, DFF, LDMID, LDMID}; pg8::StaticOrder S; S.init(TT, DM, F.G, (int)blockIdx.x, FFO_WGM); S.csplit = FFO_CSPLIT; S.rev = (GEMM_REV >> 0) & 1;
        pg8::EpiResidT<false, true> E{x_prompt, x_sample, 8192, XR, DM, 0.5f, SSQ};
        PHASE_SKEW();
        pg8::gemm_phase<pg8::EpiResidT<false, true>, pg8::StaticOrder, RESID_ALIGN, GEMM_SP2>(F.lds + RING_OFF, g, S, E);
        if (BOTH(2) || rep + 1 < REPS(2)) GRID_BAR();
    }
    if (IN(3))
_Pragma("unroll")
    for (int rep = 0; rep < REPS(3); ++rep) {
        rstd_phase(F, SSQ, RSTD);
        constexpr int I_FI = (DM / 64) * (2 * DFF / 32), I_FO = (DFF / 64) * (DM / 32);
        auto desc3 = [&](int it) -> TItem { return it < I_FI ? titem_matrix(ffn2_w_in, DM, 2 * DFF, WFI, DM / 64, 2, 1, it, F.lane, ffn2_norm) : titem_matrix(ffn2_w_out, DFF, DM, WFO, DFF / 64, RESID_WMODE, 0, it - I_FI, F.lane); };
        TRANSPOSE_STREAM(desc3, I_FI + (TAIL_FILL ? 0 : I_FO));
        if (BOTH(3) || rep + 1 < REPS(3)) GRID_BAR();
    }
    if (IN(4))
_Pragma("unroll")
    for (int rep = 0; rep < REPS(4); ++rep) {
        pg8::Gemm g{XR, WIN, TT, NIN, DM, LDH, LDH}; pg8::StaticOrder S; S.init(TT, NIN, F.G, (int)blockIdx.x, ALL_WGM); S.rev = (GEMM_REV >> 4) & 1;
        pg8::EpiProj E{QKV, RXY, GT, ROPE, RSTD};
        pg8::gemm_phase<pg8::EpiProj, pg8::StaticOrder, true, GEMM_SP2>(F.lds + RING_OFF, g, S, E);
        if (BOTH(4) || rep + 1 < REPS(4)) GRID_BAR();
    }
    if (IN(5))
_Pragma("unroll")
    for (int rep = 0; rep < REPS(5); ++rep) {
        rglru_phase<false>(F, RXY, RGW, conv_w, conv_b, rg_ba, rg_bx, rg_lambda, AGG, CARRY, RR);
        if (BOTH(5) || rep + 1 < REPS(5)) GRID_BAR();
    }
    if (IN(6))
_Pragma("unroll")
    for (int rep = 0; rep < REPS(6); ++rep) {
        carry_phase(F, AGG, CARRY);
        const float lam = __expf(wave_sum(lq1[F.lane] * lk1[F.lane])) - __expf(wave_sum(lq2[F.lane] * lk2[F.lane])) + 0.2f;
        const int lane = F.lane, r32 = lane & 31, hi = lane >> 5, wid = F.wave;
        char* alds = (char*)lds + RING_OFF;
        const __amdgpu_buffer_rsrc_t qkv_rs = __builtin_amdgcn_make_buffer_rsrc((void*)QKV, 0, (int)((size_t)TT * 6144 * 2), 0x00020000);
        float* li_l = (float*)(alds + att::LDS_WS) + wid * 64;
#ifndef ATT_PASSES
#define ATT_PASSES 1
#endif
        for (int L_ = F.vcu; L_ < 1536 * ATT_PASSES; L_ += F.G) { const int L = L_ >= 1536 ? L_ - 1536 : L_;
            int h, qb, row0, seqlen;
            if (L < 1024) { const int i = L >> 8, xcd = (L & 255) >> 5, loc = L & 31; h = 2 * xcd + (i >> 1); qb = 32 * (i & 1) + loc; row0 = 8192; seqlen = 16384; }
            else { const int Lp = L - 1024, j = Lp >> 8, xcd = (Lp & 255) >> 5, loc = Lp & 31, pair = 4 * xcd + 2 * j + (loc >> 4); qb = loc & 15; h = pair & 15; row0 = (pair >> 4) * 4096; seqlen = 4096; }
            for (int m = 0; m < 2; ++m) {
                const unsigned qo = (unsigned)(((row0 + qb * 256) * 2048 + h * 128 + m * 64) * 2);
                const char* kbase = (const char*)QKV + pg8::QKV_KOFF + (size_t)((((row0 >> 6) * 16 + h) * 2 + m)) * 8192;
                const char* vbase = (const char*)QKV + pg8::QKV_VOFF + (size_t)((row0 >> 6) * 16 + h) * 16384;
                att::f32x16 o[4]; float l;
                att::attn_map_body<true>(qkv_rs, qo, kbase, vbase, seqlen, alds, o, l);
                {
                    LAS unsigned* ovf = (LAS unsigned*)(F.lds + RING_OFF + att::LDS_BYTES);
                    const bool bad = ATT_FORCE_SLOW || !(l < 1e30f);
                    const bool anyb = __any(bad);
                    if (lane == 0) ovf[wid] = anyb ? 1u : 0u;
                    asm volatile("s_waitcnt lgkmcnt(0)" ::: "memory"); __syncthreads();
                    unsigned any8 = 0;
#pragma unroll
                    for (int w8 = 0; w8 < 8; ++w8) any8 |= ovf[w8];
                    __syncthreads();
                    if (any8) att::attn_map_body<false>(qkv_rs, qo, kbase, vbase, seqlen, alds, o, l);
                }
                if (hi == 0) li_l[r32] = l;
                asm volatile("s_waitcnt lgkmcnt(0)" ::: "memory");
                float rli[16];
#pragma unroll
                for (int r = 0; r < 16; ++r) rli[r] = __builtin_amdgcn_rcpf(li_l[att::crow(r, hi)]);
                float* const swb = (float*)(ws + WS_ASCR) + (size_t)blockIdx.x * (256 * 128);
                unsigned swo = (unsigned)(((wid * 32 + 4 * hi) * 128 + r32) * 4); asm volatile("" : "+v"(swo));
#define SWL(idx) (*(float*)((unsigned char*)swb + swo + (idx) * 4))
                if (m == 0) {
#pragma unroll
                    for (int r = 0; r < 16; ++r)
#pragma unroll
                        for (int d0 = 0; d0 < 4; ++d0) SWL(((r & 3) + 8 * (r >> 2)) * 128 + d0 * 32) = o[d0][r] * rli[r];
                    asm volatile("s_waitcnt vmcnt(0)" ::: "memory");
                } else {
                    const int orow0 = row0 + qb * 256 + wid * 32;
                    unsigned char* const obb = (unsigned char*)OB + pg8::blk_off(orow0, h * 128, AW / 64);
                    unsigned ob0 = (unsigned)(hi * 256 + r32 * 2); asm volatile("" : "+v"(ob0));
                    unsigned ob1 = (unsigned)(hi * 256 + ((r32 * 2) ^ 32)); asm volatile("" : "+v"(ob1));
                    float gain[4];
#pragma unroll
                    for (int d0 = 0; d0 < 4; ++d0) gain[d0] = subln_gain[d0 * 32 + r32] * 0.8f;
#pragma unroll
                    for (int r = 0; r < 16; ++r) { const int rb = (r & 3) + 8 * (r >> 2); float ss = 0.f; float v[4];
#pragma unroll
                        for (int d0 = 0; d0 < 4; ++d0) { v[d0] = SWL(rb * 128 + d0 * 32) - lam * (o[d0][r] * rli[r]); ss += v[d0] * v[d0]; }
                        ss += __shfl_xor(ss, 1); ss += __shfl_xor(ss, 2); ss += __shfl_xor(ss, 4); ss += __shfl_xor(ss, 8); ss += __shfl_xor(ss, 16);
                        const float rs = 1.f / sqrtf(ss * (1.f / 128.f) + EPS);
#pragma unroll
                        for (int d0 = 0; d0 < 4; ++d0) { const int coff = (d0 >> 1) * 32768 + ((rb >> 4) * 2 + (d0 & 1)) * 1024 + (rb & 15) * 64;
                            *(bf16*)(obb + (((rb & 8) ? ob1 : ob0) + (unsigned)coff)) = (bf16)f2bf(v[d0] * rs * gain[d0]); } }
                }
#undef SWL
                __syncthreads();
            }
        }
        if (BOTH(6) || rep + 1 < REPS(6)) GRID_BAR();
    }
    if (IN(7))
_Pragma("unroll")
    for (int rep = 0; rep < REPS(7); ++rep) {
        rglru_phase<true>(F, RXY, RGW, conv_w, conv_b, rg_ba, rg_bx, rg_lambda, AGG, CARRY, RR);
        if (BOTH(7) || rep + 1 < REPS(7)) GRID_BAR();
    }
#ifndef PROBE_P89
#define PROBE_P89 0
#endif
_Pragma("unroll")
    for (int rep2 = 0; rep2 < (PROBE_P89 ? 2 : 1); ++rep2) {
    if (IN(8)) {
        pg8::Gemm g{OB, WA, TT, DM, AW, LDO, LDO}; pg8::PairOrder S; S.S.init(TT, DM, F.G, (int)blockIdx.x, ALL_WGM);
        pg8::EpiGatePair E{MG, GT, DM / 64};
        pg8::gemm_phase<pg8::EpiGatePair, pg8::PairOrder, true, GEMM_SP2>(F.lds + RING_OFF, g, S, E);
        if (BOTH(8)) GRID_BAR();
    }
    }
#ifndef PROBE_P10
#define PROBE_P10 0
#endif
    if (IN(10))
_Pragma("unroll")
    for (int rep = 0; rep < (PROBE_P10 ? 3 : 1); ++rep) {
        pg8::Gemm g{MG, WO, TT, DM, DM, LDH, LDH}; pg8::StaticOrder S; S.init(TT, DM, F.G, (int)blockIdx.x, ALL_WGM); S.rev = (GEMM_REV >> 1) & 1;
        pg8::EpiResidT<true, true> E{XR, nullptr, TT, XR, DM, rep == 1 ? -1.0f : 1.0f, SSQ};
        PHASE_SKEW();
        pg8::gemm_phase<pg8::EpiResidT<true, true>, pg8::StaticOrder, RESID_ALIGN, GEMM_SP2>(F.lds + RING_OFF, g, S, E);
        if (BOTH(10) || rep + 1 < (PROBE_P10 ? 3 : 1)) GRID_BAR();
    }
    if (IN(11))
_Pragma("unroll")
    for (int rep = 0; rep < REPS(11); ++rep) {
        rstd_phase(F, SSQ, RSTD);
        if (BOTH(11) || rep + 1 < REPS(11)) GRID_BAR();
    }
    if (IN(12))
_Pragma("unroll")
    for (int rep = 0; rep < REPS(12); ++rep) {
        pg8::Gemm g{XR, WFI, TT, 2 * DFF, DM, LDH, LDH}; pg8::StaticOrder S; S.init(TT, 2 * DFF, F.G, (int)blockIdx.x, ALL_WGM); S.rev = (GEMM_REV >> 2) & 1;
        pg8::EpiSwiGLU E{MID, DFF / 64, RSTD};
        pg8::gemm_phase<pg8::EpiSwiGLU, pg8::StaticOrder, true, GEMM_SP2>(F.lds + RING_OFF, g, S, E);
        if (TAIL_FILL && rep == 0) {
            constexpr int I_FO = (DFF / 64) * (DM / 32);
            const int tail = ((TT / 256) * (2 * DFF / 256)) % F.G, nidle = tail ? F.G - tail : F.G, iw = tail ? (int)blockIdx.x - tail : (int)blockIdx.x;
            if (iw >= 0) { const int gw = iw * NWAVES + F.wave, NGW = nidle * NWAVES;
                auto desc12 = [&](int it) -> TItem { return titem_matrix(ffn2_w_out, DFF, DM, WFO, DFF / 64, RESID_WMODE, 0, it, F.lane); };
                TRANSPOSE_STREAM(desc12, I_FO); } }
        if (BOTH(12) || rep + 1 < REPS(12)) GRID_BAR();
    }
#ifndef PROBE_P13
#define PROBE_P13 0
#endif
    if (IN(13))
_Pragma("unroll")
    for (int rep = 0; rep < (PROBE_P13 ? 3 : 1); ++rep) {
        pg8::Gemm g{MID, WFO, TT, DM, DFF, LDMID, LDMID}; pg8::StaticOrder S; S.init(TT, DM, F.G, (int)blockIdx.x, FFO_WGM); S.csplit = FFO_CSPLIT; S.rev = (GEMM_REV >> 3) & 1;
        pg8::EpiResidT<true, true> E{XR, nullptr, TT, XR, DM, rep == 1 ? -0.5f : 0.5f, nullptr};
        PHASE_SKEW();
        pg8::gemm_phase<pg8::EpiResidT<true, true>, pg8::StaticOrder, RESID_ALIGN, GEMM_SP2>(F.lds + RING_OFF, g, S, E);
        if (BOTH(13) || rep + 1 < (PROBE_P13 ? 3 : 1)) GRID_BAR();
    }
    if (IN(14)) {
#ifdef PROBE_BARS
        for (int b_ = 0; b_ < PROBE_BARS; ++b_) GRID_BAR();
#endif
        for (int it = gw; it < TT; it += NGW) { const int m = recent_first_row(it); rms_row_bf16_to_f32(XR, m, final_norm, out + (size_t)m * DM, F.lane); }
    }
#undef IN
#undef BOTH
#undef GRID_BAR
}

extern "C" void kernel_launch(void* const* d_in, const int* in_sizes, int n_in, void* d_out, int out_size, void* d_ws, size_t ws_size, hipStream_t stream) {
    static int grid = 0;
    if (grid == 0) {
        if (n_in != 26 || in_sizes[0] != 8192 * DM || in_sizes[1] != 16384 * DM || out_size != TT * DM || ws_size < WS_END) {
            fprintf(stderr, "kernel_launch: shape mismatch (n_in %d, out %d, ws %zu, need %zu); nothing launched\n", n_in, out_size, ws_size, (size_t)WS_END); grid = -1; return; }
        int dev = 0, cus = 0;
        if (hipGetDevice(&dev) != hipSuccess || hipDeviceGetAttribute(&cus, hipDeviceAttributeMultiprocessorCount, dev) != hipSuccess) { grid = -1; return; }
        if (hipFuncSetAttribute((const void*)mk_fwd, hipFuncAttributeMaxDynamicSharedMemorySize, LDS_BYTES) != hipSuccess) { fprintf(stderr, "kernel_launch: hipFuncSetAttribute failed\n"); grid = -1; return; }
        (void)hipGetLastError();
        grid = cus > 256 ? 256 : cus - (cus % 16);
        if (grid < 16) { grid = -1; return; }
    }
    if (grid < 0) return;
    if (hipMemsetAsync((char*)d_ws + WS_CTL, 0, CTL_ZERO_BYTES, stream) != hipSuccess) return;
    Args a{};
    for (int i = 0; i < 26; ++i) a.in[i] = (const float*)d_in[i];
    a.out = (float*)d_out; a.ws = (unsigned char*)d_ws;
#if MK_PER_PHASE
    for (int k = 0; k < NPHASE; ++k) { a.ph_lo = k; a.ph_hi = k + 1; hipLaunchKernelGGL(mk_fwd, dim3(grid), dim3(NWAVES * 64), LDS_BYTES, stream, a); }
#else
#if PROBE_ALL2
    a.ph_lo = PROBE_ALL2_LO; a.ph_hi = PROBE_ALL2_HI; a.li = 1;
    hipLaunchKernelGGL(mk_fwd, dim3(grid), dim3(NWAVES * 64), LDS_BYTES, stream, a);
#endif
    a.ph_lo = 0; a.ph_hi = NPHASE; a.li = 0;
    hipLaunchKernelGGL(mk_fwd, dim3(grid), dim3(NWAVES * 64), LDS_BYTES, stream, a);
#endif
    const hipError_t le = hipPeekAtLastError();
    if (le != hipSuccess) fprintf(stderr, "kernel_launch: launch failed: %s\n", hipGetErrorName(le));
}
```

```cpp
#include <hip/hip_runtime.h>
#include <hip/hip_bf16.h>
#include <cstdio>
#include <cstdint>
#include <cmath>
#define EARLY_BAR 4
namespace pg8 {
#define PG8_LAS __attribute__((address_space(3)))
typedef unsigned short bf16_t;
typedef short bf16x8 __attribute__((ext_vector_type(8)));
typedef float f32x4 __attribute__((ext_vector_type(4)));
typedef unsigned u32x4 __attribute__((ext_vector_type(4)));
constexpr int BM = 256, BK = 64, HALF = 128, HTB = HALF * BK * 2  , STAGE_BYTES = 8 * HTB, NXCD = 8, WGM = 8;

__host__ __device__ __forceinline__ int lds_byte(int r, int c) { const int st = (r >> 4) * 2 + (c >> 5), rr = r & 15, cc = c & 31, ob = rr * 64 + cc * 2; return st * 1024 + (ob ^ (((ob >> 9) & 1) << 5)); }
__host__ __device__ __forceinline__ void stage_rc(int b, int& R, int& C) { const int st = b / 1024, sb = b % 1024, swz = sb ^ (((sb >> 9) & 1) << 5); R = (st >> 1) * 16 + swz / 64; C = (st & 1) * 32 + (swz % 64) / 2; }
__host__ __device__ __forceinline__ int perm32(int rho) { const int n = rho >> 4, i = rho & 15; return 8 * (i >> 2) + 4 * n + (i & 3); }
__host__ __device__ __forceinline__ int inv_perm32(int w) { return 16 * ((w >> 2) & 1) + 4 * (w >> 3) + (w & 3); }
__host__ __device__ __forceinline__ size_t blk_off(int row, int col, int KT) { return ((size_t)((row >> 8) * KT + (col >> 6)) * 2 + ((row >> 7) & 1)) * 16384 + (size_t)lds_byte(row & 127, col & 63); }
__host__ __device__ __forceinline__ size_t blk_off_b(int w, int col, int KT, bool perm) { const int w128 = w & 127, R = perm ? (w128 & ~31) + inv_perm32(w128 & 31) : w128;
    return ((size_t)((w >> 8) * KT + (col >> 6)) * 2 + ((w >> 7) & 1)) * 16384 + (size_t)lds_byte(R, col & 63); }

struct Unit { int pm, pn; };
struct Gemm { const bf16_t* A; const bf16_t* Bt; int M, N, K, lda, ldb; };

#ifndef SERPENTINE
#define SERPENTINE 1
#endif
struct StaticOrder {
    int rev = 0;
    int csplit = 0;
    int nM, nN, nwg, G, c, wgm, serp = SERPENTINE;
    __host__ __device__ void init(int M, int N, int G_, int c_, int wgm_ = WGM) { nM = M / BM; nN = N / BM; nwg = nM * nN; G = G_; c = c_; wgm = wgm_; }
    __host__ __device__ bool next(int i, Unit& u) const {
        const long L = (long)i * G + c; if (L >= nwg) return false;
        if (csplit && nwg % NXCD == 0 && nM % 16 == 0 && nN % 2 == 0) { const int xcd = (int)(L % NXCD), off = (int)(L / NXCD), cpg = nN / 2, rnd = off / (4 * cpg), in = off % (4 * cpg);
            u.pm = (xcd >> 1) * (nM / 4) + rnd * 4 + (in & 3); u.pn = (xcd & 1) * cpg + (in >> 2); if (rev) u.pm = nM - 1 - u.pm; return true; }
        int wgid = (int)L; { const int q = nwg / NXCD, r = nwg % NXCD, xcd = wgid % NXCD, off = wgid / NXCD; wgid = (xcd < r ? xcd * (q + 1) : r * (q + 1) + (xcd - r) * q) + off; }
        const int nig = wgm * nN, gid = wgid / nig, fm = gid * wgm, gsz = (nM - fm) < wgm ? (nM - fm) : wgm;
        u.pm = fm + ((wgid % nig) % gsz); u.pn = (wgid % nig) / gsz;
        if (serp && (nwg / NXCD) % nig == 0 && nwg % NXCD == 0 && (((wgid % (nwg / NXCD)) / nig) & 1)) u.pn = nN - 1 - u.pn;
        if (rev) u.pm = nM - 1 - u.pm;
        return true;
    }
    __device__ __forceinline__ void a_ready(const Unit&) const {}
    __device__ __forceinline__ void done(const Unit&) const {}
};

__device__ __forceinline__ unsigned cvt_pk_bf16(float lo, float hi) { unsigned r; asm volatile("v_cvt_pk_bf16_f32 %0, %1, %2" : "=v"(r) : "v"(lo), "v"(hi)); return r; }
typedef float f32x2 __attribute__((ext_vector_type(2)));
__device__ __forceinline__ float sigm(float x) { return __builtin_amdgcn_rcpf(1.f + __builtin_amdgcn_exp2f(-1.4426950408889634f * x)); }
__device__ __forceinline__ float bf_lo(unsigned w) { return __uint_as_float(w << 16); }
__device__ __forceinline__ float bf_hi(unsigned w) { return __uint_as_float(w & 0xffff0000u); }
#ifndef OUT_NT
#define OUT_NT 0
#endif
struct EpiSwiGLU {
    static constexpr bool PERM = true, AFTER_DRAIN = false;
    bf16_t* O; int KT; const float* rstd;
    __device__ __forceinline__ void operator()(const f32x4 (&acc)[2][2][4][2], const Unit& u, int wr, int wc, int fr, int fq) const {
        const int row0 = u.pm * BM + wr * 64 + fr, col0 = u.pn * HALF + wc * 32 + 8 * fq;
        float rs8[2][4];
#pragma unroll
        for (int ai = 0; ai < 2; ++ai)
#pragma unroll
            for (int m = 0; m < 4; ++m) rs8[ai][m] = rstd ? rstd[row0 + ai * HALF + m * 16] : 1.f;
        asm volatile("" ::: "memory");
#pragma unroll
        for (int ai = 0; ai < 2; ++ai)
#pragma unroll
            for (int m = 0; m < 4; ++m) {
                bf16_t* rowp = (bf16_t*)((unsigned char*)O + blk_off(row0 + ai * HALF + m * 16, col0, KT));
                float r[8]; const float rs = rs8[ai][m];
#pragma unroll
                for (int n = 0; n < 2; ++n)
#pragma unroll
                    for (int j = 0; j < 4; ++j) { const float g = acc[ai][0][m][n][j] * rs, up = acc[ai][1][m][n][j] * rs; r[4 * n + j] = g * sigm(g) * up; }
                u32x4 w; w.x = cvt_pk_bf16(r[0], r[1]); w.y = cvt_pk_bf16(r[2], r[3]); w.z = cvt_pk_bf16(r[4], r[5]); w.w = cvt_pk_bf16(r[6], r[7]);
                if (OUT_NT) __builtin_nontemporal_store(w, (u32x4*)rowp); else *(u32x4*)rowp = w;
            }
    }
};
template <bool RB16, bool OB16> struct EpiResidT {
#ifndef RESID_PERM
#define RESID_PERM 1
#endif
    static constexpr bool PERM = RESID_PERM != 0, AFTER_DRAIN = false;
    const void* res0; const void* res1; int split_row; void* out; int ldc; float alpha; float* ssq;
    __device__ __forceinline__ void operator()(const f32x4 (&acc)[2][2][4][2], const Unit& u, int wr, int wc, int fr, int fq) const {
        typedef unsigned u32x2v __attribute__((ext_vector_type(2)));
        const int rowt = u.pm * BM;
        const float* rbf = RB16 ? nullptr : (rowt < split_row ? (const float*)res0 + (size_t)rowt * ldc : (const float*)res1 + (size_t)(rowt - split_row) * ldc);
        float* obf = OB16 ? nullptr : (float*)out + (size_t)rowt * ldc;
#if RESID_PERM
        const int col0 = u.pn * BM + wc * 32 + 8 * fq;
#pragma unroll
        for (int ai = 0; ai < 2; ++ai) {
            f32x4 rv[4][2][2]; u32x4 rw[4][2];
#pragma unroll
            for (int m = 0; m < 4; ++m) { const int rl = ai * HALF + wr * 64 + m * 16 + fr; const size_t off = (size_t)rl * ldc + col0;
#pragma unroll
                for (int bj = 0; bj < 2; ++bj) {
                    if (RB16) rw[m][bj] = *(const u32x4*)((const unsigned char*)res0 + blk_off(rowt + rl, col0 + bj * HALF, 64));
                    else { rv[m][bj][0] = *(const f32x4*)(rbf + off + bj * HALF); rv[m][bj][1] = *(const f32x4*)(rbf + off + bj * HALF + 4); } } }
#pragma unroll
            for (int m = 0; m < 4; ++m) { const int rl = ai * HALF + wr * 64 + m * 16 + fr; const size_t off = (size_t)rl * ldc + col0; float sq = 0.f;
#pragma unroll
                for (int bj = 0; bj < 2; ++bj) {
                    if (RB16) { const u32x4 w = rw[m][bj]; rv[m][bj][0] = (f32x4){bf_lo(w.x), bf_hi(w.x), bf_lo(w.y), bf_hi(w.y)}; rv[m][bj][1] = (f32x4){bf_lo(w.z), bf_hi(w.z), bf_lo(w.w), bf_hi(w.w)}; }
                    const f32x4 v0 = rv[m][bj][0] + acc[ai][bj][m][0] * alpha, v1 = rv[m][bj][1] + acc[ai][bj][m][1] * alpha;
                    sq += ((v0[0] * v0[0] + v0[1] * v0[1]) + (v0[2] * v0[2] + v0[3] * v0[3])) + ((v1[0] * v1[0] + v1[1] * v1[1]) + (v1[2] * v1[2] + v1[3] * v1[3]));
                    if (OB16) { u32x4 w; w.x = cvt_pk_bf16(v0[0], v0[1]); w.y = cvt_pk_bf16(v0[2], v0[3]); w.z = cvt_pk_bf16(v1[0], v1[1]); w.w = cvt_pk_bf16(v1[2], v1[3]);
                        *(u32x4*)((unsigned char*)out + blk_off(rowt + rl, col0 + bj * HALF, 64)) = w; }
                    else { *(f32x4*)(obf + off + bj * HALF) = v0; *(f32x4*)(obf + off + bj * HALF + 4) = v1; } }
                if (ssq) { sq += __shfl_xor(sq, 16); sq += __shfl_xor(sq, 32); if (fq == 0) ssq[(size_t)(rowt + rl) * 64 + u.pn * 4 + wc] = sq; } }
            asm volatile("" ::: "memory"); }
#else
        const int col0 = u.pn * BM + wc * 32 + 4 * fq;
#pragma unroll
        for (int ai = 0; ai < 2; ++ai) {
            f32x4 rv[4][2][2];
#pragma unroll
            for (int m = 0; m < 4; ++m) { const int rl = ai * HALF + wr * 64 + m * 16 + fr; const size_t off = (size_t)rl * ldc + col0;
#pragma unroll
                for (int bj = 0; bj < 2; ++bj)
#pragma unroll
                    for (int n = 0; n < 2; ++n) {
                        if (RB16) { const u32x2v w = *(const u32x2v*)((const unsigned char*)res0 + blk_off(rowt + rl, col0 + bj * HALF + n * 16, 64)); rv[m][bj][n] = (f32x4){bf_lo(w.x), bf_hi(w.x), bf_lo(w.y), bf_hi(w.y)}; }
                        else rv[m][bj][n] = *(const f32x4*)(rbf + off + bj * HALF + n * 16); } }
#pragma unroll
            for (int m = 0; m < 4; ++m) { const int rl = ai * HALF + wr * 64 + m * 16 + fr; const size_t off = (size_t)rl * ldc + col0; float sq = 0.f;
#pragma unroll
                for (int bj = 0; bj < 2; ++bj)
#pragma unroll
                    for (int n = 0; n < 2; ++n) { const f32x4 val = rv[m][bj][n] + acc[ai][bj][m][n] * alpha;
                        sq += (val[0] * val[0] + val[1] * val[1]) + (val[2] * val[2] + val[3] * val[3]);
                        if (OB16) { u32x2v w; w.x = cvt_pk_bf16(val[0], val[1]); w.y = cvt_pk_bf16(val[2], val[3]); *(u32x2v*)((unsigned char*)out + blk_off(rowt + rl, col0 + bj * HALF + n * 16, 64)) = w; }
                        else *(f32x4*)(obf + off + bj * HALF + n * 16) = val; }
                if (ssq) { sq += __shfl_xor(sq, 16); sq += __shfl_xor(sq, 32); if (fq == 0) ssq[(size_t)(rowt + rl) * 64 + u.pn * 4 + wc] = sq; } }
            asm volatile("" ::: "memory"); }
#endif
    }
};
constexpr size_t QKV_KOFF = (size_t)24576 * 2048 * 2, QKV_VOFF = 2 * QKV_KOFF;
__host__ __device__ __forceinline__ int kimg(int r64, int d) { return r64 * 128 + ((d * 2) ^ (((r64 >> 1) & 7) << 4)); }
__host__ __device__ __forceinline__ int vimg(int k, int c) { const int kk = k;     return ((kk >> 3) * 4 + (c >> 5)) * 512 + ((kk & 7) * 32 + (c & 31)) * 2; }
struct EpiPlainBf16 {
    static constexpr bool PERM = false, AFTER_DRAIN = false;
    bf16_t* O; float alpha;
    __device__ __forceinline__ void operator()(const f32x4 (&acc)[2][2][4][2], const Unit& u, int wr, int wc, int fr, int fq) const {
        const int col0 = u.pn * BM + wc * 32 + 4 * fq;
#pragma unroll
        for (int ai = 0; ai < 2; ++ai)
#pragma unroll
            for (int m = 0; m < 4; ++m) { const size_t off = (size_t)(u.pm * BM + ai * HALF + wr * 64 + m * 16 + fr) * 4096 + col0;
#pragma unroll
                for (int bj = 0; bj < 2; ++bj)
#pragma unroll
                    for (int n = 0; n < 2; ++n) { const f32x4 v = acc[ai][bj][m][n] * alpha; unsigned long long w = (unsigned long long)cvt_pk_bf16(v[0], v[1]) | ((unsigned long long)cvt_pk_bf16(v[2], v[3]) << 32);
                        *(unsigned long long*)(O + off + bj * HALF + n * 16) = w; } }
    }
};
struct EpiProj {
    static constexpr bool PERM = true, AFTER_DRAIN = false;
    bf16_t* QKV; bf16_t* RXY; bf16_t* G; const float* rope; const float* rstd;
    __device__ __forceinline__ void operator()(const f32x4 (&acc)[2][2][4][2], const Unit& u, int wr, int wc, int fr, int fq) const {
        const int colt = u.pn * BM, rowt = u.pm * BM;
        bf16_t* base; int ldc, cb;
        if (colt < 6144) { base = QKV; ldc = 6144; cb = colt; } else if (colt < 10240) { base = RXY; ldc = 4096; cb = colt - 6144; } else { base = G; ldc = 8192; cb = colt - 10240; }
        const bool rot = (colt < 4096) && ((wc & 1) == 0);
        const int pos0 = rowt - (rowt < 4096 ? 0 : (rowt < 8192 ? 4096 : 8192));
        const int col0 = cb + wc * 32 + 8 * fq;
        const float sgn = fq == 0 ? -1.f : 1.f;
        const float qs = colt < 2048 ? 0.125f * 1.4426950408889634f : 1.f;
        float rs8[8];
#pragma unroll
        for (int it = 0; it < 8; ++it) rs8[it] = rstd[rowt + (it >> 2) * HALF + wr * 64 + (it & 3) * 16 + fr];
        asm volatile("" ::: "memory");
        if (rot) body<true>(acc, rs8, base, ldc, colt, rowt, pos0, col0, sgn, qs, wr, fr, fq);
        else body<false>(acc, rs8, base, ldc, colt, rowt, pos0, col0, sgn, qs, wr, fr, fq);
    }
    template <bool ROT>
    __device__ __forceinline__ void body(const f32x4 (&acc)[2][2][4][2], const float (&rs8)[8], bf16_t* base, int ldc, int colt, int rowt, int pos0, int col0, float sgn, float qs, int wr, int fr, int fq) const {
        f32x4 cs[2][4];
        if (ROT) { const f32x4* tp = (const f32x4*)(rope + (size_t)(pos0 + wr * 64 + fr) * 16);
#pragma unroll
            for (int q = 0; q < 4; ++q) cs[0][q] = tp[q]; }
#pragma unroll
        for (int it = 0; it < 8; ++it) { const int ai = it >> 2, m = it & 3;
                const int rl = ai * HALF + wr * 64 + m * 16 + fr;
                const int row = rowt + rl; const float rs = rs8[it];
                if (ROT && it + 1 < 8) { const int rn = ((it + 1) >> 2) * HALF + wr * 64 + ((it + 1) & 3) * 16 + fr; const f32x4* tp = (const f32x4*)(rope + (size_t)(pos0 + rn) * 16);
#pragma unroll
                    for (int q = 0; q < 4; ++q) cs[(it + 1) & 1][q] = tp[q];
                    asm volatile("" ::: "memory"); }
#pragma unroll
                for (int bj = 0; bj < 2; ++bj) {
                    f32x4 v0 = acc[ai][bj][m][0] * (qs * rs), v1 = acc[ai][bj][m][1] * (qs * rs);
                    if (ROT) { const f32x4 (&c)[4] = cs[it & 1];
                        f32x4 p0, p1;
#pragma unroll
                        for (int j = 0; j < 4; ++j) { p0[j] = __shfl_xor(v0[j], 16); p1[j] = __shfl_xor(v1[j], 16); }
                        if (fq < 2) {
                            v0[0] = v0[0] * c[0][0] + sgn * p0[0] * c[0][1]; v0[1] = v0[1] * c[0][2] + sgn * p0[1] * c[0][3];
                            v0[2] = v0[2] * c[1][0] + sgn * p0[2] * c[1][1]; v0[3] = v0[3] * c[1][2] + sgn * p0[3] * c[1][3];
                            v1[0] = v1[0] * c[2][0] + sgn * p1[0] * c[2][1]; v1[1] = v1[1] * c[2][2] + sgn * p1[1] * c[2][3];
                            v1[2] = v1[2] * c[3][0] + sgn * p1[2] * c[3][1]; v1[3] = v1[3] * c[3][2] + sgn * p1[3] * c[3][3];
                        }
                    }
                    u32x4 w; w.x = cvt_pk_bf16(v0[0], v0[1]); w.y = cvt_pk_bf16(v0[2], v0[3]); w.z = cvt_pk_bf16(v1[0], v1[1]); w.w = cvt_pk_bf16(v1[2], v1[3]);
                    const int col = col0 + bj * HALF;
                    unsigned char* dp;
                    if (colt >= 6144) dp = (unsigned char*)(base + (size_t)row * ldc + col);
                    else if (colt < 2048) dp = (unsigned char*)(QKV + (size_t)row * 2048 + col);
                    else if (colt < 4096) { const int c2 = col - 2048; dp = (unsigned char*)QKV + QKV_KOFF + (size_t)((((row >> 6) * 16 + (c2 >> 7)) * 2 + ((c2 >> 6) & 1))) * 8192 + kimg(row & 63, c2 & 63); }
                    else { const int c2 = col - 4096; dp = (unsigned char*)QKV + QKV_VOFF + (size_t)((row >> 6) * 16 + (c2 >> 7)) * 16384 + vimg(row & 63, c2 & 127); }
                    if (OUT_NT) __builtin_nontemporal_store(w, (u32x4*)dp); else *(u32x4*)dp = w;
                }
            }
    }
};
template <bool ADD> struct EpiGate {
    static constexpr bool PERM = true, AFTER_DRAIN = false;
    bf16_t* O; const bf16_t* Gt; int goff; int KT;
    __device__ __forceinline__ void operator()(const f32x4 (&acc)[2][2][4][2], const Unit& u, int wr, int wc, int fr, int fq) const {
        const int row0 = u.pm * BM + wr * 64 + fr, col0 = u.pn * BM + wc * 32 + 8 * fq;
#pragma unroll
        for (int ai = 0; ai < 2; ++ai) {
            u32x4 gv[4][2], ov[4][2];
#pragma unroll
            for (int m = 0; m < 4; ++m) { const size_t row = (size_t)(row0 + ai * HALF + m * 16);
#pragma unroll
                for (int bj = 0; bj < 2; ++bj) { gv[m][bj] = *(const u32x4*)(Gt + row * 8192 + goff + col0 + bj * HALF); if (ADD) ov[m][bj] = *(const u32x4*)((const unsigned char*)O + blk_off((int)row, col0 + bj * HALF, KT)); } }
            asm volatile("" ::: "memory");
#pragma unroll
            for (int m = 0; m < 4; ++m) { const size_t row = (size_t)(row0 + ai * HALF + m * 16);
#pragma unroll
                for (int bj = 0; bj < 2; ++bj) { const f32x4 a0 = acc[ai][bj][m][0], a1 = acc[ai][bj][m][1]; float r[8]; const u32x4 g = gv[m][bj];
                    r[0] = sigm(bf_lo(g.x)) * a0[0]; r[1] = sigm(bf_hi(g.x)) * a0[1]; r[2] = sigm(bf_lo(g.y)) * a0[2]; r[3] = sigm(bf_hi(g.y)) * a0[3];
                    r[4] = sigm(bf_lo(g.z)) * a1[0]; r[5] = sigm(bf_hi(g.z)) * a1[1]; r[6] = sigm(bf_lo(g.w)) * a1[2]; r[7] = sigm(bf_hi(g.w)) * a1[3];
                    if (ADD) { const u32x4 o = ov[m][bj]; r[0] += bf_lo(o.x); r[1] += bf_hi(o.x); r[2] += bf_lo(o.y); r[3] += bf_hi(o.y); r[4] += bf_lo(o.z); r[5] += bf_hi(o.z); r[6] += bf_lo(o.w); r[7] += bf_hi(o.w); }
                    u32x4 w; w.x = cvt_pk_bf16(r[0], r[1]); w.y = cvt_pk_bf16(r[2], r[3]); w.z = cvt_pk_bf16(r[4], r[5]); w.w = cvt_pk_bf16(r[6], r[7]);
                    *(u32x4*)((unsigned char*)O + blk_off((int)row, col0 + bj * HALF, KT)) = w; } }
            asm volatile("" ::: "memory"); }
    }
};

struct EpiGatePair {
    static constexpr bool PERM = true, AFTER_DRAIN = false;
    bf16_t* O; const bf16_t* Gt; int KT;
    __device__ __forceinline__ void operator()(const f32x4 (&acc)[2][2][4][2], const Unit& u, int wr, int wc, int fr, int fq) const {
        if (u.pm < 96) { EpiGate<false> e{O, Gt, 0, KT}; e(acc, u, wr, wc, fr, fq); }
        else { Unit v; v.pm = u.pm - 96; v.pn = u.pn - 16; EpiGate<true> e{O, Gt, 4096, KT}; e(acc, v, wr, wc, fr, fq); }
    }
};
struct PairOrder {
    StaticOrder S;
    __device__ __forceinline__ bool next(int i, Unit& u) const { if (!S.next(i >> 1, u)) return false; if (i & 1) { u.pm += 96; u.pn += 16; } return true; }
    __device__ __forceinline__ void a_ready(const Unit&) const {}
    __device__ __forceinline__ void done(const Unit&) const {}
};

template <class Epi, class Sched, bool ALIGN_EPI = false, bool SP2 = false>
__device__ __forceinline__ void gemm_phase(PG8_LAS unsigned char* lds, const Gemm g, const Sched& S, const Epi& E) {
    const int tid = threadIdx.x, wid = __builtin_amdgcn_readfirstlane(tid >> 6), lane = tid & 63, wr = wid >> 2, wc = wid & 3, fr = lane & 15, fq = lane >> 4;
    const int K = g.K, nt = K / BK;
    unsigned voffA[2], voffB[2];
#pragma unroll
    for (int i = 0; i < 2; ++i) { voffA[i] = (unsigned)(tid * 16 + i * 8192); voffB[i] = voffA[i]; }
    const size_t kstep = 32768;
    const size_t hstepA = 16384, hstepB = 16384;
    const size_t tstepA = (size_t)nt * 32768, tstepB = tstepA;
    const unsigned ldsw = (unsigned)wid * 1024u;
    const int aoff = lds_byte(wr * 64 + fr, fq * 8), boff = lds_byte(wc * 32 + fr, fq * 8);
#define PG8_SA(b, h) (((b) * 2 + (h)) * HTB)
#define PG8_SB(b, h) ((4 + (b) * 2 + (h)) * HTB)
#define PG8_STAGE(bufoff, gbase, voff) do { _Pragma("unroll") for (int _i = 0; _i < 2; ++_i) \
        __builtin_amdgcn_global_load_lds((const unsigned*)((const char*)(gbase) + (voff)[_i]), (PG8_LAS unsigned*)(lds + (bufoff) + ldsw + _i * 8192), 16, 0, 0); } while (0)
#ifndef GEMM_B_AUX
#define GEMM_B_AUX 0
#endif
#define PG8_STAGEB(bufoff, gbase, voff) do { _Pragma("unroll") for (int _i = 0; _i < 2; ++_i) \
        __builtin_amdgcn_global_load_lds((const unsigned*)((const char*)(gbase) + (voff)[_i]), (PG8_LAS unsigned*)(lds + (bufoff) + ldsw + _i * 8192), 16, 0, GEMM_B_AUX); } while (0)
#define PG8_LDA(dst, b, h) do { _Pragma("unroll") for (int m = 0; m < 4; ++m) _Pragma("unroll") for (int k = 0; k < 2; ++k) dst[m][k] = *(const PG8_LAS bf16x8*)(lds + PG8_SA(b, h) + aoff + m * 2048 + k * 1024); } while (0)
#define PG8_LDB(dst, b, h) do { _Pragma("unroll") for (int n = 0; n < 2; ++n) _Pragma("unroll") for (int k = 0; k < 2; ++k) dst[n][k] = *(const PG8_LAS bf16x8*)(lds + PG8_SB(b, h) + boff + n * 2048 + k * 1024); } while (0)
#ifndef MMA_ORDER
#define MMA_ORDER 3
#endif
#define PG8_MFMA1(ai, bj, At, Bt, m, n, k) acc[ai][bj][m][n] = __builtin_amdgcn_mfma_f32_16x16x32_bf16(Bt[n][k], At[m][k], acc[ai][bj][m][n], 0, 0, 0)
#define PG8_MMA(ai, bj, At, Bt) do { __builtin_amdgcn_s_setprio(1); \
        if (MMA_ORDER == 1) { _Pragma("unroll") for (int n = 0; n < 2; ++n) _Pragma("unroll") for (int k = 0; k < 2; ++k) _Pragma("unroll") for (int m = 0; m < 4; ++m) PG8_MFMA1(ai, bj, At, Bt, m, n, k); } \
        else if (MMA_ORDER == 2) { _Pragma("unroll") for (int m = 0; m < 4; ++m) _Pragma("unroll") for (int k = 0; k < 2; ++k) _Pragma("unroll") for (int n = 0; n < 2; ++n) PG8_MFMA1(ai, bj, At, Bt, m, n, k); } \
        else if (MMA_ORDER == 3) { _Pragma("unroll") for (int k = 0; k < 2; ++k) _Pragma("unroll") for (int m = 0; m < 4; ++m) _Pragma("unroll") for (int nn = 0; nn < 2; ++nn) { const int n = (m & 1) ? 1 - nn : nn; PG8_MFMA1(ai, bj, At, Bt, m, n, k); } }     \
        else { _Pragma("unroll") for (int m = 0; m < 4; ++m) _Pragma("unroll") for (int n = 0; n < 2; ++n) _Pragma("unroll") for (int k = 0; k < 2; ++k) PG8_MFMA1(ai, bj, At, Bt, m, n, k); } \
        __builtin_amdgcn_s_setprio(0); } while (0)
#ifndef EARLY_BAR
#define EARLY_BAR 2
#endif
#define PG8_MMA_E(ai, bj, At, Bt) do { __builtin_amdgcn_s_setprio(1); \
        _Pragma("unroll") for (int k = 0; k < 2; ++k) _Pragma("unroll") for (int m = 0; m < 4; ++m) _Pragma("unroll") for (int nn = 0; nn < 2; ++nn) { const int n = (m & 1) ? 1 - nn : nn; \
            if ((k * 4 + m) * 2 + nn == 16 - EARLY_BAR) { __builtin_amdgcn_sched_barrier(0); __builtin_amdgcn_s_setprio(2); __builtin_amdgcn_s_barrier(); __builtin_amdgcn_sched_barrier(0); } \
            PG8_MFMA1(ai, bj, At, Bt, m, n, k); } \
        __builtin_amdgcn_s_setprio(0); } while (0)
#define PG8_WAIT_V(n) asm volatile("s_waitcnt vmcnt(" #n ")" ::: "memory")
#define PG8_WAIT_L(n) asm volatile("s_waitcnt lgkmcnt(" #n ")" ::: "memory")
#define PG8_BAR __builtin_amdgcn_s_barrier()
#define PG8_SCHED __builtin_amdgcn_sched_barrier(0)
    Unit cur, nxt; int ui = 0;
    if (!S.next(0, cur)) return;
    f32x4 acc[2][2][4][2];
#pragma unroll
    for (int a = 0; a < 2; ++a)
#pragma unroll
        for (int b = 0; b < 2; ++b)
#pragma unroll
            for (int m = 0; m < 4; ++m)
#pragma unroll
                for (int n = 0; n < 2; ++n) acc[a][b][m][n] = (f32x4){0.f, 0.f, 0.f, 0.f};
    bf16x8 At[4][2], B0[2][2], B1[2][2];
    const char* cA = (const char*)g.A + (size_t)cur.pm * tstepA; const char* cB = (const char*)g.Bt + (size_t)cur.pn * tstepB;
    S.a_ready(cur);
    if constexpr (SP2) {
        PG8_STAGEB(PG8_SB(0, 0), cB, voffB); PG8_STAGEB(PG8_SB(0, 1), cB + hstepB, voffB); PG8_STAGE(PG8_SA(0, 0), cA, voffA); PG8_STAGE(PG8_SA(0, 1), cA + hstepA, voffA);
        if (wr == 1) PG8_BAR;
        PG8_WAIT_V(2); PG8_BAR;
        PG8_STAGEB(PG8_SB(1, 0), cB + kstep, voffB); PG8_STAGE(PG8_SA(1, 0), cA + kstep, voffA); PG8_STAGEB(PG8_SB(1, 1), cB + hstepB + kstep, voffB);
        PG8_WAIT_V(6); PG8_BAR;
    } else {
        PG8_STAGEB(PG8_SB(0, 0), cB, voffB); PG8_STAGE(PG8_SA(0, 0), cA, voffA); PG8_STAGEB(PG8_SB(0, 1), cB + hstepB, voffB); PG8_STAGE(PG8_SA(0, 1), cA + hstepA, voffA);
        if (wr == 1) PG8_BAR;
        PG8_WAIT_V(4); PG8_BAR;
        PG8_STAGEB(PG8_SB(1, 0), cB + kstep, voffB); PG8_STAGE(PG8_SA(1, 0), cA + kstep, voffA); PG8_STAGEB(PG8_SB(1, 1), cB + hstepB + kstep, voffB);
        PG8_WAIT_V(6); PG8_BAR;
    }
    for (;;) {
        const bool has_next = S.next(ui + 1, nxt);
        const char* nA = has_next ? (const char*)g.A + (size_t)nxt.pm * tstepA : cA; const char* nB = has_next ? (const char*)g.Bt + (size_t)nxt.pn * tstepB : cB;
        for (int t = 0; t < nt; t += 2) {
            const bool last = (t == nt - 2);
            const char* a1 = cA + (size_t)(t + 1) * kstep;
            const char* a2 = last ? nA : cA + (size_t)(t + 2) * kstep; const char* b2 = last ? nB : cB + (size_t)(t + 2) * kstep;
            const char* a3 = a2 + kstep; const char* b3 = b2 + kstep;
            if (last && has_next) S.a_ready(nxt);
            if constexpr (SP2) {
            PG8_LDB(B0, 0, 0); PG8_LDB(B1, 0, 1); PG8_SCHED; PG8_LDA(At, 0, 0); PG8_STAGE(PG8_SA(1, 1), a1 + hstepA, voffA);
            PG8_WAIT_V(8); PG8_WAIT_L(0); PG8_BAR; PG8_MMA(0, 0, At, B0); if (EARLY_BAR) { PG8_MMA_E(0, 1, At, B1); } else { PG8_MMA(0, 1, At, B1); PG8_BAR; } PG8_SCHED;
            PG8_LDA(At, 0, 1); PG8_STAGEB(PG8_SB(0, 0), b2, voffB); PG8_STAGEB(PG8_SB(0, 1), b2 + hstepB, voffB); PG8_STAGE(PG8_SA(0, 0), a2, voffA);
            PG8_WAIT_V(8); PG8_WAIT_L(0); PG8_BAR; PG8_MMA(1, 0, At, B0); if (EARLY_BAR) { PG8_MMA_E(1, 1, At, B1); } else { PG8_MMA(1, 1, At, B1); PG8_BAR; } PG8_SCHED;
            PG8_LDB(B0, 1, 0); PG8_LDB(B1, 1, 1); PG8_SCHED; PG8_LDA(At, 1, 0); PG8_STAGE(PG8_SA(0, 1), a2 + hstepA, voffA);
            PG8_WAIT_V(8); PG8_WAIT_L(0); PG8_BAR; PG8_MMA(0, 0, At, B0); if (EARLY_BAR) { PG8_MMA_E(0, 1, At, B1); } else { PG8_MMA(0, 1, At, B1); PG8_BAR; } PG8_SCHED;
            PG8_LDA(At, 1, 1); PG8_STAGEB(PG8_SB(1, 0), b3, voffB); PG8_STAGEB(PG8_SB(1, 1), b3 + hstepB, voffB); PG8_STAGE(PG8_SA(1, 0), a3, voffA);
            PG8_WAIT_V(8); PG8_WAIT_L(0); PG8_BAR; PG8_MMA(1, 0, At, B0); if (EARLY_BAR) { PG8_MMA_E(1, 1, At, B1); } else { PG8_MMA(1, 1, At, B1); PG8_BAR; } PG8_SCHED;
            } else {
            PG8_LDB(B0, 0, 0); PG8_SCHED; PG8_LDA(At, 0, 0); PG8_STAGE(PG8_SA(1, 1), a1 + hstepA, voffA);
            PG8_WAIT_L(8); PG8_BAR; PG8_WAIT_L(0); PG8_MMA(0, 0, At, B0); PG8_BAR; PG8_SCHED;
            PG8_LDB(B1, 0, 1); PG8_STAGEB(PG8_SB(0, 0), b2, voffB);
            PG8_BAR; PG8_WAIT_L(0); PG8_MMA(0, 1, At, B1); PG8_BAR;
            PG8_LDA(At, 0, 1); PG8_STAGE(PG8_SA(0, 0), a2, voffA);
            PG8_BAR; PG8_WAIT_L(0); PG8_MMA(1, 0, At, B0); PG8_BAR; PG8_SCHED;
            PG8_STAGEB(PG8_SB(0, 1), b2 + hstepB, voffB);
            PG8_WAIT_V(6); PG8_BAR; PG8_MMA(1, 1, At, B1); PG8_BAR;
            PG8_LDB(B0, 1, 0); PG8_SCHED; PG8_LDA(At, 1, 0); PG8_STAGE(PG8_SA(0, 1), a2 + hstepA, voffA);
            PG8_WAIT_L(8); PG8_BAR; PG8_WAIT_L(0); PG8_MMA(0, 0, At, B0); PG8_BAR; PG8_SCHED;
            PG8_LDB(B1, 1, 1); PG8_STAGEB(PG8_SB(1, 0), b3, voffB);
            PG8_BAR; PG8_WAIT_L(0); PG8_MMA(0, 1, At, B1); PG8_BAR;
            PG8_LDA(At, 1, 1); PG8_STAGE(PG8_SA(1, 0), a3, voffA);
            PG8_BAR; PG8_WAIT_L(0); PG8_MMA(1, 0, At, B0); PG8_BAR; PG8_SCHED;
            PG8_STAGEB(PG8_SB(1, 1), b3 + hstepB, voffB);
            PG8_WAIT_V(6); PG8_BAR; PG8_MMA(1, 1, At, B1); PG8_BAR;
            }
        }
        if constexpr (ALIGN_EPI) { if (wr == 0) PG8_BAR; }
        if constexpr (!Epi::AFTER_DRAIN) { E(acc, cur, wr, wc, fr, fq); S.done(cur); }
        if (!has_next) break;
#pragma unroll
        for (int a = 0; a < 2; ++a)
#pragma unroll
            for (int b = 0; b < 2; ++b)
#pragma unroll
                for (int m = 0; m < 4; ++m)
#pragma unroll
                    for (int n = 0; n < 2; ++n) acc[a][b][m][n] = (f32x4){0.f, 0.f, 0.f, 0.f};
        cur = nxt; cA = nA; cB = nB; ++ui;
        if constexpr (ALIGN_EPI) { if (wr == 1) PG8_BAR; }
    }
    PG8_WAIT_V(0);
    if constexpr (!ALIGN_EPI) { if (wr == 0) PG8_BAR; }
    PG8_BAR;
    if constexpr (Epi::AFTER_DRAIN) { E.fused(acc, cur, wr, wc, fr, fq, lds, wid, lane); S.done(cur); }
#undef PG8_SA
#undef PG8_SB
#undef PG8_STAGE
#undef PG8_STAGEB
#undef PG8_LDA
#undef PG8_LDB
#undef PG8_MMA
#undef PG8_MMA_E
#undef PG8_MFMA1
#undef PG8_WAIT_V
#undef PG8_WAIT_L
#undef PG8_BAR
#undef PG8_SCHED
}
}
#ifndef ATT_SETPRIO
#define ATT_SETPRIO 0
#endif
namespace att {
typedef unsigned short bf16;
using bf16x8 = __attribute__((ext_vector_type(8))) short;
using s16x4  = __attribute__((ext_vector_type(4))) short;
using f32x16 = __attribute__((ext_vector_type(16))) float;
using u32x4  = __attribute__((ext_vector_type(4))) unsigned;
constexpr int NW = 8, QBLK = 32, KVBLK = 64, LDQ = 6144;
constexpr float SCALE = 0.125f;
constexpr float THR = 8.f;
constexpr int SHM_V = KVBLK * 128 * 2, SHM_K = KVBLK * 64 * 2;
constexpr int LDS_K = 0, LDS_V = 3 * SHM_K, LDS_WS = 3 * SHM_K + 4 * SHM_V, LDS_BYTES = LDS_WS + NW * 64 * 4;
#define KSWZ64(row, colB) ((row) * 128 + ((colB) ^ ((((row) >> 1) & 7) << 4)))
#define SBAR() __builtin_amdgcn_sched_barrier(0)
__device__ __forceinline__ int crow(int r, int hi) { return (r & 3) + 8 * (r >> 2) + 4 * hi; }
__device__ __forceinline__ unsigned cvtpk(float lo, float hi) { unsigned r; asm volatile("v_cvt_pk_bf16_f32 %0, %1, %2" : "=v"(r) : "v"(lo), "v"(hi)); return r; }

template <bool FIRST>
__device__ __forceinline__ void partialSM(f32x16& p0, f32x16& p1, float& mhat, f32x16& negm, float& alpha) {
  constexpr float THRL = THR * 1.4426950408889634f;
  float pmax = p0[0];
#pragma unroll
  for (int r = 1; r < 16; ++r) pmax = fmaxf(pmax, p0[r]);
#pragma unroll
  for (int r = 0; r < 16; ++r) pmax = fmaxf(pmax, p1[r]);
  { auto rr = __builtin_amdgcn_permlane32_swap(__float_as_uint(pmax), __float_as_uint(pmax), false, false);
    pmax = fmaxf(__uint_as_float(rr[0]), __uint_as_float(rr[1])); }
  if (!FIRST && __builtin_expect(__all(pmax <= THRL), 1)) { alpha = 1.f; }
  else { const float dl = FIRST ? pmax : fmaxf(pmax, 0.f); mhat += dl; alpha = FIRST ? 1.f : __builtin_amdgcn_exp2f(-dl);
#pragma unroll
    for (int r = 0; r < 16; ++r) { p0[r] -= dl; p1[r] -= dl; }
#pragma unroll
    for (int r = 0; r < 16; ++r) negm[r] = -mhat; }
#pragma unroll
  for (int r = 0; r < 16; ++r) p0[r] = __builtin_amdgcn_exp2f(p0[r]);
}
__device__ __forceinline__ void finishSM(f32x16& p0, f32x16& p1, float alpha, float& l_reg, bf16x8& pa0, bf16x8& pa1, bf16x8& pa2, bf16x8& pa3) {
#pragma unroll
  for (int r = 0; r < 16; ++r) p1[r] = __builtin_amdgcn_exp2f(p1[r]);
  float ps = 0;
#pragma unroll
  for (int r = 0; r < 16; ++r) ps += p0[r];
#pragma unroll
  for (int r = 0; r < 16; ++r) ps += p1[r];
  { auto rr = __builtin_amdgcn_permlane32_swap(__float_as_uint(ps), __float_as_uint(ps), false, false);
    ps = __uint_as_float(rr[0]) + __uint_as_float(rr[1]); }
  l_reg = l_reg * alpha + ps;
#define PK8(P, BASE, OUT) do { u32x4 w = {cvtpk(P[BASE + 0], P[BASE + 1]), cvtpk(P[BASE + 2], P[BASE + 3]), cvtpk(P[BASE + 4], P[BASE + 5]), cvtpk(P[BASE + 6], P[BASE + 7])}; \
    OUT = *reinterpret_cast<bf16x8*>(&w); } while (0)
  PK8(p0, 0, pa0); PK8(p0, 8, pa1); PK8(p1, 0, pa2); PK8(p1, 8, pa3);
#undef PK8
}
__device__ __forceinline__ void qkt(f32x16& p0, f32x16& p1, const char* Ks, const bf16x8* qr, const f32x16& negm, int r32, int hi) {
#pragma unroll
  for (int d0 = 0; d0 < 4; ++d0) { const int cb = (d0 * 16 + hi * 8) * 2;
    bf16x8 b0 = *reinterpret_cast<const bf16x8*>(Ks + KSWZ64(r32, cb));
    bf16x8 b1 = *reinterpret_cast<const bf16x8*>(Ks + KSWZ64(32 + r32, cb));
    if (d0 == 0) { p0 = __builtin_amdgcn_mfma_f32_32x32x16_bf16(b0, qr[0], negm, 0, 0, 0); p1 = __builtin_amdgcn_mfma_f32_32x32x16_bf16(b1, qr[0], negm, 0, 0, 0); }
    else { p0 = __builtin_amdgcn_mfma_f32_32x32x16_bf16(b0, qr[d0], p0, 0, 0, 0); p1 = __builtin_amdgcn_mfma_f32_32x32x16_bf16(b1, qr[d0], p1, 0, 0, 0); } }
}
__device__ __forceinline__ int v_st(int k, int c) { const int kk = (k & ~0xC) | ((k & 4) << 1) | ((k & 8) >> 1); return ((kk >> 3) * 4 + (c >> 5)) * 512 + ((kk & 7) * 32 + (c & 31)) * 2; }
__device__ __forceinline__ int v_rd_base(int lane) { return ((lane & 3) << 3) | (((lane >> 2) & 3) << 6) | (((lane >> 4) & 1) << 5) | (((lane >> 5) & 1) << 8); }
constexpr int v_rd_off(int d0, int ks, int half) { return d0 * 512 + ks * 4096 + half * 2048; }
template <int OFF> __device__ __forceinline__ s16x4 tr_read(int vb) {
  s16x4 r; asm volatile("ds_read_b64_tr_b16 %0, %1 offset:%2" : "=&v"(r) : "v"(vb), "i"(OFF) : "memory"); return r;
}
template <int D0> __device__ __forceinline__ void pv_one(f32x16& od, int vb, bf16x8 pa0, bf16x8 pa1, bf16x8 pa2, bf16x8 pa3) {
  const s16x4 l0 = tr_read<v_rd_off(D0, 0, 0)>(vb), h0 = tr_read<v_rd_off(D0, 0, 1)>(vb), l1 = tr_read<v_rd_off(D0, 1, 0)>(vb), h1 = tr_read<v_rd_off(D0, 1, 1)>(vb);
  const s16x4 l2 = tr_read<v_rd_off(D0, 2, 0)>(vb), h2 = tr_read<v_rd_off(D0, 2, 1)>(vb), l3 = tr_read<v_rd_off(D0, 3, 0)>(vb), h3 = tr_read<v_rd_off(D0, 3, 1)>(vb);
  asm volatile("s_waitcnt lgkmcnt(0)" ::: "memory"); SBAR();
#define PK(L, H) (bf16x8){L[0], L[1], L[2], L[3], H[0], H[1], H[2], H[3]}
#if ATT_SETPRIO
  __builtin_amdgcn_s_setprio(1);
#endif
  od = __builtin_amdgcn_mfma_f32_32x32x16_bf16(pa0, PK(l0, h0), od, 0, 0, 0);
  od = __builtin_amdgcn_mfma_f32_32x32x16_bf16(pa1, PK(l1, h1), od, 0, 0, 0);
  od = __builtin_amdgcn_mfma_f32_32x32x16_bf16(pa2, PK(l2, h2), od, 0, 0, 0);
  od = __builtin_amdgcn_mfma_f32_32x32x16_bf16(pa3, PK(l3, h3), od, 0, 0, 0);
#if ATT_SETPRIO
  __builtin_amdgcn_s_setprio(0);
#endif
#undef PK
}
__device__ __forceinline__ void pv_d0(f32x16* o, int vb, bf16x8 pa0, bf16x8 pa1, bf16x8 pa2, bf16x8 pa3) {
  pv_one<0>(o[0], vb, pa0, pa1, pa2, pa3); pv_one<1>(o[1], vb, pa0, pa1, pa2, pa3); pv_one<2>(o[2], vb, pa0, pa1, pa2, pa3); pv_one<3>(o[3], vb, pa0, pa1, pa2, pa3);
}

__device__ __forceinline__ bf16x8 bload(__amdgpu_buffer_rsrc_t rs, unsigned voff, unsigned soff) { return __builtin_bit_cast(bf16x8, __builtin_amdgcn_raw_buffer_load_b128(rs, voff, soff, 0)); }
__device__ __forceinline__ void glds16s(const char* sbase, unsigned voff, unsigned lds_dst) { unsigned keep;
  asm volatile("s_mov_b32 %0, m0\n\ts_mov_b32 m0, %3\n\ts_nop 0\n\tglobal_load_lds_dwordx4 %1, %2\n\ts_mov_b32 m0, %0" : "=&s"(keep) : "v"(voff), "s"(sbase), "s"(lds_dst) : "memory"); }
#define WAIT_BAR(N) asm volatile("s_waitcnt vmcnt(" #N ") lgkmcnt(0)\n\ts_barrier" ::: "memory")
template <bool FAST>
__device__ __forceinline__ void attn_map_body(__amdgpu_buffer_rsrc_t rs, unsigned qo, const char* kbase, const char* vbase, int seq, char* lds, f32x16 (&o)[4], float& l_out) {
  const int tid = threadIdx.x, wid = __builtin_amdgcn_readfirstlane(tid >> 6), lane = tid & 63, r32 = lane & 31, hi = lane >> 5;
  char* V_lds = lds + LDS_V; char* K_lds = lds + LDS_K;
  float* ws = (float*)(lds + LDS_WS) + wid * 64; float* al_l = ws + 32;
  float mhat = 0.f, l_reg = 0; bf16x8 qr[4]; f32x16 negm = f32x16{};
#pragma unroll
  for (int d = 0; d < 4; ++d) o[d] = f32x16{};
  const unsigned qvo = (unsigned)(((wid * QBLK + r32) * 2048 + hi * 8) * 2);
#pragma unroll
  for (int d0 = 0; d0 < 4; ++d0) qr[d0] = bload(rs, qvo + d0 * 32, qo);
  const unsigned lds0 = (unsigned)(uintptr_t)lds;
  const unsigned kvo = (unsigned)(wid * 1024 + lane * 16);
  unsigned vvo[2];
#pragma unroll
  for (int i = 0; i < 2; ++i) vvo[i] = (unsigned)((wid + 8 * i) * 1024 + lane * 16);
  const unsigned kdst = lds0 + LDS_K + wid * 1024, vdst = lds0 + LDS_V + wid * 1024;
#define DMA_K(t, slot) glds16s(kbase + (size_t)(t) * 262144, kvo, (unsigned)__builtin_amdgcn_readfirstlane((int)(kdst + (slot) * SHM_K)))
#define DMA_V(t, slot) do { const char* vb_ = vbase + (size_t)(t) * 262144; const unsigned vd_ = (unsigned)__builtin_amdgcn_readfirstlane((int)(vdst + (slot) * SHM_V)); \
    glds16s(vb_, vvo[0], vd_); glds16s(vb_, vvo[1], vd_ + 8192); } while (0)
  const int vb0 = (int)(uintptr_t)V_lds + v_rd_base(lane);
#define RESC(a) do { if (__any((a) < 1.f)) { if (hi == 0) al_l[r32] = (a); asm volatile("s_waitcnt lgkmcnt(0)" ::: "memory"); \
    _Pragma("unroll") for (int d = 0; d < 4; ++d) _Pragma("unroll") for (int r = 0; r < 16; ++r) o[d][r] *= al_l[crow(r, hi)]; } } while (0)
  f32x16 pA0, pA1, pB0, pB1; float alA, alB; bf16x8 pa0, pa1, pa2, pa3; const int NT = seq / KVBLK;
  int k3 = 0;
#define K3NEXT() do { k3 = (k3 == 2) ? 0 : k3 + 1; } while (0)
#define SM_STEP(PX0, PX1, alX) do { if (FAST) { alX = 1.f; _Pragma("unroll") for (int r_ = 0; r_ < 16; ++r_) PX0[r_] = __builtin_amdgcn_exp2f(PX0[r_]); } \
    else { partialSM<false>(PX0, PX1, mhat, negm, alX); RESC(alX); } } while (0)
#define A_PART(PX0, PX1, PY0, PY1, alY, j, GK, GV, FIN) do { \
    if (GK) DMA_K((j) + 2, (k3 == 0 ? 2 : k3 - 1)); if (GV) DMA_V((j) + 1, ((j) + 1) & 3); \
    SBAR(); qkt(PX0, PX1, K_lds + k3 * SHM_K, qr, negm, r32, hi); \
    if (FIN) finishSM(PY0, PY1, alY, l_reg, pa0, pa1, pa2, pa3); SBAR(); } while (0)
#ifndef ATT_EXP_IN_PV
#define ATT_EXP_IN_PV 1
#endif
#define B_PART(PX0, PX1, alX, j) do { \
    if (FAST && ATT_EXP_IN_PV) { const int vb_ = vb0 + (((j) + 3) & 3) * SHM_V; alX = 1.f; \
        pv_one<0>(o[0], vb_, pa0, pa1, pa2, pa3); _Pragma("unroll") for (int r_ = 0; r_ < 4; ++r_) PX0[r_] = __builtin_amdgcn_exp2f(PX0[r_]); \
        pv_one<1>(o[1], vb_, pa0, pa1, pa2, pa3); _Pragma("unroll") for (int r_ = 4; r_ < 8; ++r_) PX0[r_] = __builtin_amdgcn_exp2f(PX0[r_]); \
        pv_one<2>(o[2], vb_, pa0, pa1, pa2, pa3); _Pragma("unroll") for (int r_ = 8; r_ < 12; ++r_) PX0[r_] = __builtin_amdgcn_exp2f(PX0[r_]); \
        pv_one<3>(o[3], vb_, pa0, pa1, pa2, pa3); _Pragma("unroll") for (int r_ = 12; r_ < 16; ++r_) PX0[r_] = __builtin_amdgcn_exp2f(PX0[r_]); } \
    else { pv_d0(o, vb0 + (((j) + 3) & 3) * SHM_V, pa0, pa1, pa2, pa3); SM_STEP(PX0, PX1, alX); } } while (0)
#ifndef ATT_LATE_SPLIT
#define ATT_LATE_SPLIT 0
#endif
#define B1_PART(j) do { const int vb_ = vb0 + (((j) + 3) & 3) * SHM_V; if (ATT_LATE_SPLIT) { pv_one<0>(o[0], vb_, pa0, pa1, pa2, pa3); pv_one<1>(o[1], vb_, pa0, pa1, pa2, pa3); } } while (0)
#define B2_PART(PX0, PX1, alX, j) do { const int vb_ = vb0 + (((j) + 3) & 3) * SHM_V; \
    if (ATT_LATE_SPLIT) { pv_one<2>(o[2], vb_, pa0, pa1, pa2, pa3); pv_one<3>(o[3], vb_, pa0, pa1, pa2, pa3); } else pv_d0(o, vb_, pa0, pa1, pa2, pa3); \
    SM_STEP(PX0, PX1, alX); } while (0)
  DMA_K(0, 0); DMA_V(0, 0); DMA_K(1, 1);
  WAIT_BAR(0);
  int j = 1;
  if (wid < 4) {
    A_PART(pA0, pA1, pB0, pB1, alB, 0, true, true, false); partialSM<true>(pA0, pA1, mhat, negm, alA); WAIT_BAR(3); K3NEXT();
    for (; j + 3 < NT; j += 2) {
      A_PART(pB0, pB1, pA0, pA1, alA, j, true, true, true); B_PART(pB0, pB1, alB, j); WAIT_BAR(3); K3NEXT();
      A_PART(pA0, pA1, pB0, pB1, alB, j + 1, true, true, true); B_PART(pA0, pA1, alA, j + 1); WAIT_BAR(3); K3NEXT();
    }
    A_PART(pB0, pB1, pA0, pA1, alA, j, true, true, true); B_PART(pB0, pB1, alB, j); WAIT_BAR(3); K3NEXT();
    A_PART(pA0, pA1, pB0, pB1, alB, j + 1, false, true, true); B_PART(pA0, pA1, alA, j + 1); WAIT_BAR(2); K3NEXT();
    A_PART(pB0, pB1, pA0, pA1, alA, j + 2, false, false, true); B_PART(pB0, pB1, alB, j + 2); WAIT_BAR(0); K3NEXT();
  } else {
    A_PART(pA0, pA1, pB0, pB1, alB, 0, true, true, false); WAIT_BAR(3); K3NEXT();
    partialSM<true>(pA0, pA1, mhat, negm, alA);
    for (; j + 3 < NT; j += 2) {
      A_PART(pB0, pB1, pA0, pA1, alA, j, true, true, true); B1_PART(j); WAIT_BAR(3); K3NEXT(); B2_PART(pB0, pB1, alB, j);
      A_PART(pA0, pA1, pB0, pB1, alB, j + 1, true, true, true); B1_PART(j + 1); WAIT_BAR(3); K3NEXT(); B2_PART(pA0, pA1, alA, j + 1);
    }
    A_PART(pB0, pB1, pA0, pA1, alA, j, true, true, true); B1_PART(j); WAIT_BAR(3); K3NEXT(); B2_PART(pB0, pB1, alB, j);
    A_PART(pA0, pA1, pB0, pB1, alB, j + 1, false, true, true); B1_PART(j + 1); WAIT_BAR(2); K3NEXT(); B2_PART(pA0, pA1, alA, j + 1);
    A_PART(pB0, pB1, pA0, pA1, alA, j + 2, false, false, true); B1_PART(j + 2); WAIT_BAR(0); K3NEXT(); B2_PART(pB0, pB1, alB, j + 2);
  }
  finishSM(pB0, pB1, alB, l_reg, pa0, pa1, pa2, pa3); SBAR();
  pv_d0(o, vb0 + ((NT - 1) & 3) * SHM_V, pa0, pa1, pa2, pa3);
  WAIT_BAR(0);
  l_out = l_reg;
#undef A_PART
#undef SM_STEP
#undef B_PART
#undef B1_PART
#undef B2_PART
#undef K3NEXT
#undef DMA_K
#undef DMA_V
#undef RESC
}
#undef WAIT_BAR
#undef SBAR
}

#define GAS __attribute__((address_space(1)))
#define LAS __attribute__((address_space(3)))
typedef unsigned short bf16;
typedef unsigned v4u __attribute__((ext_vector_type(4)));
typedef float f32x4 __attribute__((ext_vector_type(4)));
typedef short bf16x8 __attribute__((ext_vector_type(8)));
typedef GAS unsigned gu32;
typedef GAS unsigned long long gu64;
#define RLX_AGENT __ATOMIC_RELAXED, __HIP_MEMORY_SCOPE_AGENT
#define LDS_WAIT() asm volatile("s_waitcnt lgkmcnt(0)" ::: "memory")
#define VM_WAIT() asm volatile("s_waitcnt vmcnt(0)" ::: "memory")
__device__ __forceinline__ unsigned long long rt() { return __builtin_amdgcn_s_memrealtime(); }
__device__ __forceinline__ unsigned f2bf(float f) { unsigned u = __builtin_bit_cast(unsigned, f); return (u + 0x7fffu + ((u >> 16) & 1u)) >> 16; }
__device__ __forceinline__ unsigned pk2(float lo, float hi) { return f2bf(lo) | (f2bf(hi) << 16); }
#define XB_TMO      128
#define XB_XCNT(j)  (256  + 64 * (j))
#define XB_XSUB(j)  (1280 + 64 * (j))
#define XB_XGEN(j)  (2304 + 64 * (j))
#define XB_TOP      3328
#define XB_TOPGEN   3392
#define XCD_BAR_WORDS 3456
#define XB_SPIN_CAP (1u << 18)

__device__ __forceinline__ unsigned xb_ld(unsigned* p)              { return __hip_atomic_load(p, __ATOMIC_RELAXED, __HIP_MEMORY_SCOPE_AGENT); }
__device__ __forceinline__ unsigned xb_add(unsigned* p, unsigned v) { return __hip_atomic_fetch_add(p, v, __ATOMIC_RELAXED, __HIP_MEMORY_SCOPE_AGENT); }
__device__ __forceinline__ unsigned xb_xcc_id() { return (unsigned)__builtin_amdgcn_s_getreg((3 << 11) | 20) & 0xFu; }
#define XB_SPIN(cond, bar) do { unsigned _sp = 0; while (cond) { __builtin_amdgcn_s_sleep(1); \
    if ((++_sp & 255u) == 0u) { if (xb_ld(&(bar)[XB_TMO])) break; if (_sp > XB_SPIN_CAP) { atomicAdd(&(bar)[XB_TMO], 1u); break; } } } } while (0)

struct XcdBarrier {
    unsigned* bar; unsigned x;
    volatile LAS unsigned* st;
};

__device__ __forceinline__ XcdBarrier xcd_barrier_post(unsigned* bar, volatile LAS unsigned* st) {
    XcdBarrier b; b.bar = bar; b.x = xb_xcc_id(); b.st = st;
    if (threadIdx.x == 0) (void)xb_add(&bar[XB_XCNT(b.x)], 1u);
    return b;
}
__device__ __forceinline__ void xcd_barrier_complete(unsigned* bar, unsigned x, unsigned& nloc, unsigned& nx) {
    const unsigned G = gridDim.x * gridDim.y * gridDim.z;
    unsigned sum, cnt, mine, sp = 0u;
    for (;;) {
        sum = 0u; cnt = 0u; mine = 0u;
#pragma unroll
        for (unsigned j = 0; j < 16; ++j) { const unsigned c = xb_ld(&bar[XB_XCNT(j)]); sum += c; cnt += (c > 0u) ? 1u : 0u; mine = (j == x) ? c : mine; }
        if (sum == G) break;
        __builtin_amdgcn_s_sleep(1);
        if ((++sp & 255u) == 0u) { if (xb_ld(&bar[XB_TMO])) break; if (sp > XB_SPIN_CAP) { atomicAdd(&bar[XB_TMO], 1u); break; } }
    }
    nloc = mine > 0u ? mine : 1u; nx = cnt > 0u ? cnt : 1u;
}

__device__ __forceinline__ void xcd_barrier(const XcdBarrier& b) {
    asm volatile("s_waitcnt vmcnt(0)" ::: "memory");
    __syncthreads();
    if (threadIdx.x == 0) {
        unsigned* bar = b.bar;
        __builtin_amdgcn_s_waitcnt(0);
        unsigned nloc = b.st[0], nx = b.st[1];
        if (nloc == 0u) { xcd_barrier_complete(bar, b.x, nloc, nx); b.st[0] = nloc; b.st[1] = nx; }
        const unsigned old = xb_add(&bar[XB_XSUB(b.x)], 1u);
        const unsigned gen = old / nloc;
        if (old + 1u == (gen + 1u) * nloc) {
            __builtin_amdgcn_fence(__ATOMIC_RELEASE, "agent");
            asm volatile("s_waitcnt vmcnt(0)" ::: "memory");
            const unsigned og = xb_add(&bar[XB_TOP], 1u);
            const unsigned tg = og / nx;
            if (og + 1u == (tg + 1u) * nx) xb_add(&bar[XB_TOPGEN], 1u);
            else XB_SPIN(xb_ld(&bar[XB_TOPGEN]) == tg, bar);
            __builtin_amdgcn_fence(__ATOMIC_ACQUIRE, "agent");
            xb_add(&bar[XB_XGEN(b.x)], 1u);
            asm volatile("s_waitcnt vmcnt(0)" ::: "memory");
        } else {
            XB_SPIN(xb_ld(&bar[XB_XGEN(b.x)]) == gen, bar);
            __builtin_amdgcn_fence(__ATOMIC_ACQUIRE, "agent");
            asm volatile("s_waitcnt vmcnt(0)" ::: "memory");
        }
    }
    __syncthreads();
}
constexpr int NWAVES = 8;
constexpr int TT = 24576, DM = 4096, DFF = 11008, NIN = 18432;
constexpr int NH = 16, AW = 2048, RW = 2048;
constexpr int NCHUNK = TT / 64;
constexpr float EPS = 1e-6f;
constexpr int NPHASE = 15;
#ifndef MK_PER_PHASE
#define MK_PER_PHASE 0
#endif

constexpr size_t MiB = 1u << 20;
constexpr size_t WS_CTL = 0, CTL_ZERO_BYTES = 1 * MiB;
constexpr size_t WS_ROPE = 1 * MiB;
constexpr size_t WS_RGW = 2 * MiB;
constexpr size_t WS_AGG = 4 * MiB;
constexpr size_t WS_CARRY = 16 * MiB;
constexpr size_t WS_ASCR = 22 * MiB;
constexpr int PADE = 128, LDH = DM + PADE, LDMID = DFF + PADE, LDO = AW + PADE;
constexpr size_t WS_WFI = 54 * MiB, WS_WFO = 232 * MiB;
constexpr size_t WS_WIN = 319 * MiB, WS_WA = 468 * MiB, WS_WR = WS_WA + (size_t)DM * AW * 2  , WS_WO = 502 * MiB;
constexpr size_t WS_H = 535 * MiB;
constexpr size_t WS_RR = WS_H + (size_t)TT * AW * 2;
constexpr size_t WS_BIG = 739 * MiB;
constexpr size_t WS_QKV = WS_BIG, WS_RXY = WS_BIG + 288 * MiB, WS_G = WS_BIG + 480 * MiB, WS_XR = WS_BIG + 864 * MiB, WS_END = WS_XR + 192 * MiB;
static_assert(WS_WFI + (size_t)2 * DFF * LDH * 2 <= WS_WFO && WS_WFO + (size_t)DM * LDMID * 2 <= WS_WIN && WS_WIN + (size_t)NIN * LDH * 2 <= WS_WA && WS_WA + (size_t)DM * AW * 2 <= WS_WR &&
              WS_WR + (size_t)DM * RW * 2 <= WS_WO && WS_WO + (size_t)DM * LDH * 2 <= WS_H && WS_H + (size_t)TT * LDH * 2 <= WS_BIG && WS_H + (size_t)TT * AW * 2 <= WS_RR && WS_RR + (size_t)TT * RW * 2 <= WS_BIG, "ws map");
static_assert(WS_QKV + (size_t)TT * 6144 * 2 <= WS_RXY && WS_RXY + (size_t)TT * 4096 * 2 <= WS_G && WS_G + (size_t)TT * 8192 * 2 <= WS_END && WS_BIG + (size_t)TT * LDMID * 2 <= WS_END && (size_t)TT * LDH * 2 <= 288 * MiB, "ws map 2");
constexpr int CW_BAR = 4096;
constexpr size_t WS_SSQ = WS_ASCR;
constexpr size_t WS_RSTD = WS_CTL + 512 * 1024;

constexpr int RING_OFF = 0, RING_BYTES = 131072;
constexpr int LDSCTL_OFF = RING_BYTES, MISC_OFF = LDSCTL_OFF + 320;
constexpr int LDS_BYTES = 147456;

struct Frame {
    LAS unsigned char* lds;
    volatile LAS unsigned* MISC;
    int tid, lane, wave;
    int vcu, G;
};
__device__ __forceinline__ float wave_sum(float v) {
#pragma unroll
    for (int o = 1; o < 64; o <<= 1) v += __shfl_xor(v, o);
    return v;
}
__device__ __forceinline__ int seq_start(int row) { return row < 4096 ? 0 : (row < 8192 ? 4096 : 8192); }
__device__ __forceinline__ int seq_end(int row) { return row < 4096 ? 4096 : (row < 8192 ? 8192 : TT); }

struct TItem { const float* src; bf16* WT; const float* gk; int N, drow0, k0, KT, mode; };
__device__ __forceinline__ void titem_load(const TItem& d, float (&v)[32]) {
#pragma unroll
    for (int i = 0; i < 32; ++i) v[i] = d.src[(size_t)(2 * i) * d.N];
}
__device__ __forceinline__ void titem_finish(const TItem& d, const float (&v)[32], LAS float* scr, int lane) {
#pragma unroll
    for (int i = 0; i < 32; ++i) scr[(2 * i + (lane >> 5)) * 33 + (lane & 31)] = v[i];
    LDS_WAIT(); asm volatile("" ::: "memory");
    const int c = lane & 7;
    f32x4 g0 = (f32x4){1.f, 1.f, 1.f, 1.f}, g1 = g0;
    if (d.gk) { g0 = *(const GAS f32x4*)(d.gk + d.k0 + 8 * c); g1 = *(const GAS f32x4*)(d.gk + d.k0 + 8 * c + 4); }
#pragma unroll
    for (int j = 0; j < 4; ++j) { const int n = (lane >> 3) + 8 * j; const LAS float* s = scr + (8 * c) * 33 + n;
        v4u o; o.x = pk2(s[0 * 33] * g0.x, s[1 * 33] * g0.y); o.y = pk2(s[2 * 33] * g0.z, s[3 * 33] * g0.w); o.z = pk2(s[4 * 33] * g1.x, s[5 * 33] * g1.y); o.w = pk2(s[6 * 33] * g1.z, s[7 * 33] * g1.w);
        GAS v4u* dp = d.mode == 0 ? (GAS v4u*)(d.WT + (size_t)(d.drow0 + n) * d.KT + d.k0 + 8 * c)
                                  : (GAS v4u*)((unsigned char*)d.WT + pg8::blk_off_b(d.drow0 + n, d.k0 + 8 * c, d.KT, d.mode == 2));
        *dp = o; }
    LDS_WAIT(); asm volatile("" ::: "memory");
}
__device__ __forceinline__ int ffn_in_row(int n) { return n < DFF ? (n >> 7) * 256 + (n & 127) : ((n - DFF) >> 7) * 256 + 128 + ((n - DFF) & 127); }
__device__ __forceinline__ TItem titem_matrix(const float* W, int K, int N, bf16* WT, int KT, int mode, int ffn, int item, int lane, const float* gk = nullptr) {
    const int nblk = N / 32, kb = item / nblk, nb = item % nblk, n0 = 32 * nb, k0 = 64 * kb;
    TItem d; d.src = W + (size_t)(k0 + (lane >> 5)) * N + n0 + (lane & 31); d.WT = WT; d.gk = gk; d.N = N; d.drow0 = ffn ? ffn_in_row(n0) : n0; d.k0 = k0; d.KT = KT; d.mode = mode; return d;
}
__device__ __forceinline__ void rms_row_to_bf16(const float* xrow, const float* g, bf16* Hb, int m, int lane) {
    const GAS f32x4* xr = (const GAS f32x4*)xrow + lane; const GAS f32x4* gr = (const GAS f32x4*)g + lane;
    f32x4 v[16]; float s = 0.f;
#pragma unroll
    for (int j = 0; j < 16; ++j) { v[j] = xr[64 * j]; s += (v[j].x * v[j].x + v[j].y * v[j].y) + (v[j].z * v[j].z + v[j].w * v[j].w); }
    const float rstd = 1.f / sqrtf(wave_sum(s) * (1.f / DM) + EPS);
#pragma unroll
    for (int j = 0; j < 16; ++j) { const f32x4 gg = gr[64 * j];
        *(GAS unsigned long long*)((unsigned char*)Hb + pg8::blk_off(m, 4 * lane + 256 * j, DM / 64)) =
            (unsigned long long)pk2(v[j].x * rstd * gg.x, v[j].y * rstd * gg.y) | ((unsigned long long)pk2(v[j].z * rstd * gg.z, v[j].w * rstd * gg.w) << 32); }
}
__device__ __forceinline__ void rms_row_bf16_to_bf16(const bf16* xrow, const float* g, bf16* Hb, int m, int lane) {
    const GAS v4u* xr = (const GAS v4u*)xrow + lane;
    v4u v[8]; float s = 0.f;
#pragma unroll
    for (int j = 0; j < 8; ++j) { v[j] = xr[64 * j]; const unsigned w[4] = {v[j].x, v[j].y, v[j].z, v[j].w};
#pragma unroll
        for (int k = 0; k < 4; ++k) { const float a = pg8::bf_lo(w[k]), b = pg8::bf_hi(w[k]); s += a * a + b * b; } }
    const float rstd = 1.f / sqrtf(wave_sum(s) * (1.f / DM) + EPS);
#pragma unroll
    for (int j = 0; j < 8; ++j) { const int col = 8 * lane + 512 * j; const f32x4 g0 = *(const GAS f32x4*)(g + col), g1 = *(const GAS f32x4*)(g + col + 4);
        v4u o; o.x = pk2(pg8::bf_lo(v[j].x) * rstd * g0.x, pg8::bf_hi(v[j].x) * rstd * g0.y); o.y = pk2(pg8::bf_lo(v[j].y) * rstd * g0.z, pg8::bf_hi(v[j].y) * rstd * g0.w);
        o.z = pk2(pg8::bf_lo(v[j].z) * rstd * g1.x, pg8::bf_hi(v[j].z) * rstd * g1.y); o.w = pk2(pg8::bf_lo(v[j].w) * rstd * g1.z, pg8::bf_hi(v[j].w) * rstd * g1.w);
        *(GAS v4u*)((unsigned char*)Hb + pg8::blk_off(m, col, DM / 64)) = o; }
}
__device__ __forceinline__ void rms_row_f32_inplace(float* xrow, const float* g, int lane) {
    GAS f32x4* xr = (GAS f32x4*)xrow + lane; const GAS f32x4* gr = (const GAS f32x4*)g + lane;
    f32x4 v[16]; float s = 0.f;
#pragma unroll
    for (int j = 0; j < 16; ++j) { v[j] = xr[64 * j]; s += (v[j].x * v[j].x + v[j].y * v[j].y) + (v[j].z * v[j].z + v[j].w * v[j].w); }
    const float rstd = 1.f / sqrtf(wave_sum(s) * (1.f / DM) + EPS);
#pragma unroll
    for (int j = 0; j < 16; ++j) { const f32x4 gg = gr[64 * j]; xr[64 * j] = v[j] * rstd * gg; }
}
__device__ __forceinline__ int recent_first_row(int it) { const int pp = it >> 8, s = pp >> 5, idx = pp & 31; return ((12 * (idx >> 2) + 4 * (2 - s) + (idx & 3)) << 8) + (it & 255); }
__device__ __forceinline__ void rms_row_bf16_to_f32(const bf16* Xb, int m, const float* g, float* orow, int lane) {
    v4u v[8]; float s = 0.f;
#pragma unroll
    for (int j = 0; j < 8; ++j) { v[j] = *(const GAS v4u*)((const unsigned char*)Xb + pg8::blk_off(m, 8 * lane + 512 * j, DM / 64)); const unsigned w[4] = {v[j].x, v[j].y, v[j].z, v[j].w};
#pragma unroll
        for (int k = 0; k < 4; ++k) { const float a = pg8::bf_lo(w[k]), b = pg8::bf_hi(w[k]); s += a * a + b * b; } }
    const float rstd = 1.f / sqrtf(wave_sum(s) * (1.f / DM) + EPS);
#pragma unroll
    for (int j = 0; j < 8; ++j) { const int col = 8 * lane + 512 * j; const f32x4 g0 = *(const GAS f32x4*)(g + col), g1 = *(const GAS f32x4*)(g + col + 4);
        *(GAS f32x4*)(orow + col) = (f32x4){pg8::bf_lo(v[j].x) * rstd * g0.x, pg8::bf_hi(v[j].x) * rstd * g0.y, pg8::bf_lo(v[j].y) * rstd * g0.z, pg8::bf_hi(v[j].y) * rstd * g0.w};
        *(GAS f32x4*)(orow + col + 4) = (f32x4){pg8::bf_lo(v[j].z) * rstd * g1.x, pg8::bf_hi(v[j].z) * rstd * g1.y, pg8::bf_lo(v[j].w) * rstd * g1.z, pg8::bf_hi(v[j].w) * rstd * g1.w}; }
}
__device__ __forceinline__ void rstd_phase(Frame& F, const float* ssq, float* rstd) {
    for (int m = F.vcu * (NWAVES * 64) + F.tid; m < TT; m += F.G * NWAVES * 64) { const GAS f32x4* p = (const GAS f32x4*)(ssq + (size_t)m * 64); float s = 0.f;
#pragma unroll
        for (int j = 0; j < 16; ++j) { const f32x4 v = p[j]; s += (v.x + v.y) + (v.z + v.w); }
        rstd[m] = 1.f / sqrtf(s * (1.f / DM) + EPS); }
}
__device__ __forceinline__ void rms_phase(Frame& F, const float* xa, const float* xb, const float* g, bf16* H) {
    const int gw = F.vcu * NWAVES + F.wave, NGW = F.G * NWAVES;
    for (int it = gw; it < TT; it += NGW) { const int m = recent_first_row(it); const float* xr = m < 8192 ? xa + (size_t)m * DM : xb + (size_t)(m - 8192) * DM; rms_row_to_bf16(xr, g, H, m, F.lane); }
}

constexpr int RL_XB = 0, RL_XF = 17408, RL_CW = 51200, RL_RAW = 53760, RL_RAWB = 33792;
static_assert(RL_RAW + 2 * RL_RAWB <= RING_BYTES, "rglru LDS");
template <bool REV> __device__ __forceinline__ void rl_scan(const float (&a)[4][4], const float (&u)[4][4], float cin, float (&h)[4][4], float& Atot, float& Hfin, int lane) {
    const int fq = lane >> 4, fr = lane & 15;
    const int src1 = (REV ? lane + 16 : lane - 16) & 63, src2 = (REV ? lane + 32 : lane - 32) & 63, srct = REV ? fr : fr + 48;
    const bool v1 = REV ? fq <= 2 : fq >= 1, v2 = REV ? fq <= 1 : fq >= 2;
    float C = cin; Atot = 1.f;
#pragma unroll
    for (int mtt = 0; mtt < 4; ++mtt) { const int mt = REV ? 3 - mtt : mtt;
        float P[4], Hl[4];
        if (!REV) { P[0] = a[mt][0]; Hl[0] = u[mt][0];
#pragma unroll
            for (int i = 1; i < 4; ++i) { P[i] = a[mt][i] * P[i - 1]; Hl[i] = a[mt][i] * Hl[i - 1] + u[mt][i]; } }
        else { P[3] = a[mt][3]; Hl[3] = u[mt][3];
#pragma unroll
            for (int i = 2; i >= 0; --i) { P[i] = a[mt][i] * P[i + 1]; Hl[i] = a[mt][i] * Hl[i + 1] + u[mt][i]; } }
        float As = REV ? P[0] : P[3], Hs = REV ? Hl[0] : Hl[3];
        { const float Ap = __shfl(As, src1), Hp = __shfl(Hs, src1); if (v1) { Hs = As * Hp + Hs; As = As * Ap; } }
        { const float Ap = __shfl(As, src2), Hp = __shfl(Hs, src2); if (v2) { Hs = As * Hp + Hs; As = As * Ap; } }
        float Ae = __shfl(As, src1), He = __shfl(Hs, src1); if (!v1) { Ae = 1.f; He = 0.f; }
        const float At = __shfl(As, srct), Ht = __shfl(Hs, srct);
        const float E = Ae * C + He;
#pragma unroll
        for (int i = 0; i < 4; ++i) h[mt][i] = P[i] * E + Hl[i];
        C = At * C + Ht; Atot *= At; }
    Hfin = C;
}
__device__ __forceinline__ float gelu_tanh(float x) {
    const float z = 0.7978845608028654f * (x + 0.044715f * x * x * x);
    const float e = __builtin_amdgcn_exp2f(2.f * 1.4426950408889634f * z);
    const float th = 1.f - 2.f * __builtin_amdgcn_rcpf(e + 1.f);
    return 0.5f * x * (1.f + th);
}
__device__ __forceinline__ void rl_glds16(const void* gsrc, unsigned lds_dst) { unsigned keep;
    asm volatile("s_mov_b32 %0, m0\n\ts_mov_b32 m0, %2\n\ts_nop 0\n\tglobal_load_lds_dwordx4 %1, off\n\ts_mov_b32 m0, %0" : "=&s"(keep) : "v"(gsrc), "s"(lds_dst) : "memory"); }
template <bool FINAL>
__device__ __forceinline__ void rglru_phase(Frame& F, const bf16* RXY, const bf16* RGW, const float* conv_w, const float* conv_b, const float* rg_ba, const float* rg_bx,
                                            const float* rg_lambda, float* AGG, const float* CARRY, bf16* RR) {
    typedef short bf16x8 __attribute__((ext_vector_type(8)));
    const int tid = F.tid, lane = F.lane, w = F.wave, fr = lane & 15, fq = lane >> 4;
    const int n = F.vcu & 15, cl = 16 * w + fr, cg = n * 128 + cl;
    LAS unsigned char* L = F.lds + RING_OFF;
    LAS float* CW = (LAS float*)(L + RL_CW);
    for (int i = tid; i < 640; i += NWAVES * 64) CW[i] = i < 512 ? conv_w[(i >> 7) * RW + n * 128 + (i & 127)] : conv_b[n * 128 + (i - 512)];
    bf16x8 Bf[4][4]; float bias[4], sp[2];
#pragma unroll
    for (int g = 0; g < 4; ++g) {
#pragma unroll
        for (int ks = 0; ks < 4; ++ks) Bf[g][ks] = *(const bf16x8*)(RGW + ((size_t)(g * 16 + n) * 128 + cl) * 128 + 32 * ks + 8 * fq);
        bias[g] = (g & 1) ? rg_bx[((g >> 1) * 16 + n) * 128 + cl] : rg_ba[((g >> 1) * 16 + n) * 128 + cl]; }
#pragma unroll
    for (int d = 0; d < 2; ++d) sp[d] = log1pf(__expf(-rg_lambda[d * RW + cg]));
    __syncthreads();
    const int t = tid >> 3, c16 = (tid & 7) * 16;
    float k1[2];
#pragma unroll
    for (int d = 0; d < 2; ++d) k1[d] = -8.f * 1.4426950408889634f * sp[d];
#ifndef RL_PASSES
#define RL_PASSES 1
#endif
    const int cstep = F.G >> 4, cfirst = F.vcu >> 4;
#define RL_DMA(ci_, buf_) do { const int row0_ = (ci_) * 64, s0_ = seq_start(row0_), s1_ = seq_end(row0_); \
        _Pragma("unroll") for (int k_ = 0; k_ < (FINAL ? 5 : 3); ++k_) { int q_ = w + NWAVES * k_; q_ = q_ < (FINAL ? 33 : 17) ? q_ : (FINAL ? 32 : 16);     \
            const int lr_ = 4 * (q_ < 17 ? q_ : q_ - 17) + (lane >> 4); int gr_ = q_ < 17 ? row0_ - 2 + lr_ : row0_ + lr_; gr_ = gr_ < s0_ ? s0_ : (gr_ >= s1_ ? s1_ - 1 : gr_); \
            const bf16* gp_ = RXY + (size_t)gr_ * 4096 + (q_ < 17 ? 0 : 2048) + n * 128 + (lane & 15) * 8; \
            rl_glds16(gp_, (unsigned)__builtin_amdgcn_readfirstlane((int)(lds0 + RL_RAW + (buf_) * RL_RAWB + q_ * 1024))); } } while (0)
    const unsigned lds0 = (unsigned)(uintptr_t)L;
    {
#define RL_WRAP(x) ((x) >= NCHUNK ? (x) - NCHUNK : (x))
    float cnx[2] = {0.f, 0.f};
    if (cfirst < NCHUNK) { RL_DMA(cfirst, 0); if (FINAL) { cnx[0] = CARRY[(size_t)(cfirst * 2 + 0) * RW + cg]; cnx[1] = CARRY[(size_t)(cfirst * 2 + 1) * RW + cg]; } }
    int buf = 0;
    for (int cl_ = cfirst; cl_ < NCHUNK * RL_PASSES; cl_ += cstep, buf ^= 1) { const int ci = RL_WRAP(cl_);
        const int row0 = ci * 64, s0 = seq_start(row0), s1 = seq_end(row0);
        LAS unsigned char* RAW = L + RL_RAW + buf * RL_RAWB; LAS unsigned char* YR = RAW + 68 * 256;
        asm volatile("s_waitcnt vmcnt(0) lgkmcnt(0)" ::: "memory"); __builtin_amdgcn_s_barrier(); asm volatile("" ::: "memory");
        const float cin2[2] = {cnx[0], cnx[1]};
        if (cl_ + cstep < NCHUNK * RL_PASSES) { const int cn = RL_WRAP(cl_ + cstep); RL_DMA(cn, buf ^ 1);
            if (FINAL) { cnx[0] = CARRY[(size_t)(cn * 2 + 0) * RW + cg]; cnx[1] = CARRY[(size_t)(cn * 2 + 1) * RW + cg]; } }
        { float xa[16];
#pragma unroll
          for (int k = 0; k < 16; ++k) xa[k] = CW[512 + c16 + k];
#pragma unroll
          for (int j = 0; j < 4; ++j) { const int rr = row0 + t + j - 2; const float msk = (rr >= s0 && rr < s1) ? 1.f : 0.f;
              const LAS v4u* rp = (const LAS v4u*)(RAW + (t + j) * 256 + c16 * 2); const v4u q0 = rp[0], q1 = rp[1];
              const unsigned ww[8] = {q0.x, q0.y, q0.z, q0.w, q1.x, q1.y, q1.z, q1.w};
#pragma unroll
              for (int k = 0; k < 8; ++k) { xa[2 * k] += CW[j * 128 + c16 + 2 * k] * (msk * pg8::bf_lo(ww[k])); xa[2 * k + 1] += CW[j * 128 + c16 + 2 * k + 1] * (msk * pg8::bf_hi(ww[k])); } }
          LAS f32x4* xf = (LAS f32x4*)(L + RL_XF + t * 528 + c16 * 4);
#pragma unroll
          for (int k = 0; k < 4; ++k) xf[k] = (f32x4){xa[4 * k], xa[4 * k + 1], xa[4 * k + 2], xa[4 * k + 3]};
          LAS v4u* xb = (LAS v4u*)(L + RL_XB + t * 272 + c16 * 2);
          xb[0] = (v4u){pk2(xa[0], xa[1]), pk2(xa[2], xa[3]), pk2(xa[4], xa[5]), pk2(xa[6], xa[7])};
          xb[1] = (v4u){pk2(xa[8], xa[9]), pk2(xa[10], xa[11]), pk2(xa[12], xa[13]), pk2(xa[14], xa[15])}; }
        asm volatile("s_waitcnt lgkmcnt(0)" ::: "memory"); __builtin_amdgcn_s_barrier(); asm volatile("" ::: "memory");
        float hsum[4][4];
#pragma unroll
        for (int d = 0; d < 2; ++d) {
            float a[4][4], u[4][4];
#pragma unroll
            for (int mt = 0; mt < 4; ++mt) {
                f32x4 ca = (f32x4){bias[2 * d], bias[2 * d], bias[2 * d], bias[2 * d]}, cx = (f32x4){bias[2 * d + 1], bias[2 * d + 1], bias[2 * d + 1], bias[2 * d + 1]};
#pragma unroll
                for (int ks = 0; ks < 4; ++ks) { const bf16x8 af = *(const LAS bf16x8*)(L + RL_XB + (16 * mt + fr) * 272 + (32 * ks + 8 * fq) * 2);
                    ca = __builtin_amdgcn_mfma_f32_16x16x32_bf16(af, Bf[2 * d][ks], ca, 0, 0, 0); cx = __builtin_amdgcn_mfma_f32_16x16x32_bf16(af, Bf[2 * d + 1][ks], cx, 0, 0, 0); }
#pragma unroll
                for (int i = 0; i < 4; ++i) { const float ra = pg8::sigm(ca[i]), ia = pg8::sigm(cx[i]);
                    const float xv = *(const LAS float*)(L + RL_XF + (16 * mt + 4 * fq + i) * 528 + cl * 4);
                    const float av = __builtin_amdgcn_exp2f(k1[d] * ra);
                    a[mt][i] = av; u[mt][i] = __builtin_amdgcn_sqrtf(fmaxf(fmaf(-av, av, 1.f), 0.f)) * (ia * xv); } }
            float h[4][4], Atot, Hfin;
            const float cin = cin2[d];
            if (d == 0) rl_scan<false>(a, u, cin, h, Atot, Hfin, lane); else rl_scan<true>(a, u, cin, h, Atot, Hfin, lane);
            if (FINAL) {
#pragma unroll
                for (int mt = 0; mt < 4; ++mt)
#pragma unroll
                    for (int i = 0; i < 4; ++i) hsum[mt][i] = d == 0 ? h[mt][i] : hsum[mt][i] + h[mt][i]; }
            else if (fq == 0) { float2 ah; ah.x = Atot; ah.y = Hfin; *(float2*)(AGG + ((size_t)(ci * 2 + d) * RW + cg) * 2) = ah; }
        }
        if (FINAL) {
#pragma unroll
            for (int mt = 0; mt < 4; ++mt)
#pragma unroll
                for (int i = 0; i < 4; ++i) { LAS unsigned short* yp = (LAS unsigned short*)(YR + (16 * mt + 4 * fq + i) * 256 + cl * 2);
                    const float y = __uint_as_float((unsigned)(*yp) << 16); *yp = (unsigned short)f2bf(hsum[mt][i] * gelu_tanh(y)); }
            asm volatile("s_waitcnt lgkmcnt(0)" ::: "memory"); __builtin_amdgcn_s_barrier(); asm volatile("" ::: "memory");
            { const LAS v4u* yb = (const LAS v4u*)(YR + t * 256 + c16 * 2); const v4u o0 = yb[0], o1 = yb[1]; *(v4u*)((unsigned char*)RR + pg8::blk_off(row0 + t, n * 128 + c16, RW / 64)) = o0; *(v4u*)((unsigned char*)RR + pg8::blk_off(row0 + t, n * 128 + c16 + 8, RW / 64)) = o1; }
        }
    }
    asm volatile("s_waitcnt vmcnt(0) lgkmcnt(0)" ::: "memory"); __builtin_amdgcn_s_barrier(); asm volatile("" ::: "memory"); }
#undef RL_DMA
#undef RL_WRAP
}
__device__ __forceinline__ void carry_phase(Frame& F, const float* AGG, float* CARRY) {
    const int gt = F.vcu * (NWAVES * 64) + F.tid;
    if (gt >= 3 * 2 * RW) return;
    const int s = gt / (2 * RW), d = (gt / RW) & 1, c = gt % RW;
    const int c0 = s == 0 ? 0 : (s == 1 ? 64 : 128), c1 = s == 0 ? 64 : (s == 1 ? 128 : NCHUNK);
    float carry = 0.f;
    for (int b = 0; b < c1 - c0; b += 32) {
        float2 ah[32];
#pragma unroll
        for (int k = 0; k < 32; ++k) { const int ch = d == 0 ? c0 + b + k : c1 - 1 - b - k; ah[k] = *(const float2*)(AGG + ((size_t)(ch * 2 + d) * RW + c) * 2); }
#pragma unroll
        for (int k = 0; k < 32; ++k) { const int ch = d == 0 ? c0 + b + k : c1 - 1 - b - k; CARRY[(size_t)(ch * 2 + d) * RW + c] = carry; carry = ah[k].x * carry + ah[k].y; }
    }
}

#ifndef ATT_FORCE_SLOW
#define ATT_FORCE_SLOW 0
#endif
#ifndef GEMM_SP2
#define GEMM_SP2 true
#endif
#ifndef ALL_WGM
#define ALL_WGM 4
#endif
#ifndef GEMM_REV
#define GEMM_REV 0xB
#endif
#ifndef FFO_CSPLIT
#define FFO_CSPLIT 1
#endif
#ifndef FFO_WGM
#define FFO_WGM 4
#endif
#ifndef TAIL_FILL
#define TAIL_FILL 0
#endif
#ifndef SKEW_TICKS
#define SKEW_TICKS 0
#endif
#define PHASE_SKEW() do { if (SKEW_TICKS) { const unsigned long long t0_ = __builtin_amdgcn_s_memrealtime(); const unsigned long long d_ = (unsigned long long)((F.vcu * 8 / F.G) & 7) * SKEW_TICKS; \
        while (__builtin_amdgcn_s_memrealtime() - t0_ < d_) __builtin_amdgcn_s_sleep(16); } } while (0)
#define RESID_WMODE (RESID_PERM ? 2 : 1)
#ifndef RESID_ALIGN
#define RESID_ALIGN true
#endif
struct Args { const float* in[26]; float* out; unsigned char* ws; int ph_lo, ph_hi, li, pad; };
__device__ __forceinline__ double rope_rev(int j) {
    return j == 0 ? 0.15915494309189535 : j == 1 ? 0.03086376340470123 : j == 2 ? 0.005985185712713705 : j == 3 ? 0.001160663641240061 :
           j == 4 ? 0.00022507907903927653 : j == 5 ? 4.364795279280289e-05 : j == 6 ? 8.464330808241401e-06 : 1.6414262627950345e-06;
}
#define TRANSPOSE_STREAM(DESC, NIT) do { int it_ = gw; if (it_ < (NIT)) { float va_[32], vb_[32]; TItem da_ = DESC(it_), db_; titem_load(da_, va_); \
        for (;;) { int nx_ = it_ + NGW; bool hn_ = nx_ < (NIT); db_ = DESC(hn_ ? nx_ : it_); titem_load(db_, vb_); titem_finish(da_, va_, scr, F.lane); if (!hn_) break; it_ = nx_; \
                   nx_ = it_ + NGW; hn_ = nx_ < (NIT); da_ = DESC(hn_ ? nx_ : it_); titem_load(da_, va_); titem_finish(db_, vb_, scr, F.lane); if (!hn_) break; it_ = nx_; } } } while (0)
__global__ void __launch_bounds__(NWAVES * 64, 2) mk_fwd(Args args) {
    extern __shared__ __attribute__((aligned(16))) unsigned char lds[];
    Frame F;
    F.lds = (LAS unsigned char*)lds;
    F.MISC = (volatile LAS unsigned*)(F.lds + MISC_OFF);
    F.tid = threadIdx.x; F.lane = F.tid & 63; F.wave = __builtin_amdgcn_readfirstlane(F.tid >> 6);
    F.G = gridDim.x; { const int bx = blockIdx.x; F.vcu = (F.G % 8 == 0) ? (bx % 8) * (F.G / 8) + bx / 8 : bx; }
    unsigned char* ws = args.ws;
    gu32* ctl = (gu32*)(ws + WS_CTL);
    const float* x_prompt = args.in[0]; const float* x_sample = args.in[1];
    const float* ffn1_norm = args.in[2]; const float* ffn1_w_in = args.in[3]; const float* ffn1_w_out = args.in[4];
    const float* mix_norm = args.in[5]; const float* w_in = args.in[6];
    const float* lq1 = args.in[7]; const float* lk1 = args.in[8]; const float* lq2 = args.in[9]; const float* lk2 = args.in[10];
    const float* subln_gain = args.in[11]; const float* conv_w = args.in[12]; const float* conv_b = args.in[13];
    const float* rg_wa = args.in[14]; const float* rg_ba = args.in[15]; const float* rg_wx = args.in[16]; const float* rg_bx = args.in[17]; const float* rg_lambda = args.in[18];
    const float* w_attn = args.in[19]; const float* w_rnn = args.in[20]; const float* w_out = args.in[21];
    const float* ffn2_norm = args.in[22]; const float* ffn2_w_in = args.in[23]; const float* ffn2_w_out = args.in[24]; const float* final_norm = args.in[25];
    float* out = args.out;
    float* ROPE = (float*)(ws + WS_ROPE); bf16* RGW = (bf16*)(ws + WS_RGW); float* AGG = (float*)(ws + WS_AGG); float* CARRY = (float*)(ws + WS_CARRY);
    bf16* WFI = (bf16*)(ws + WS_WFI); bf16* WFO = (bf16*)(ws + WS_WFO); bf16* WIN = (bf16*)(ws + WS_WIN); bf16* WA = (bf16*)(ws + WS_WA); bf16* WR = (bf16*)(ws + WS_WR); bf16* WO = (bf16*)(ws + WS_WO);
    bf16* H = (bf16*)(ws + WS_H); bf16* OB = H; bf16* RR = (bf16*)(ws + WS_RR);
    bf16* XR = (bf16*)(ws + WS_XR); float* SSQ = (float*)(ws + WS_SSQ); float* RSTD = (float*)(ws + WS_RSTD); bf16* MID = (bf16*)(ws + WS_BIG); bf16* QKV = (bf16*)(ws + WS_QKV); bf16* RXY = (bf16*)(ws + WS_RXY); bf16* GT = (bf16*)(ws + WS_G); bf16* MG = QKV;

    for (int u = F.tid; u < (LDS_BYTES - LDSCTL_OFF) / 4; u += NWAVES * 64) ((LAS unsigned*)(F.lds + LDSCTL_OFF))[u] = 0u;
    __syncthreads();
    XcdBarrier bar; bar.bar = (unsigned*)(ctl + CW_BAR) + args.li * XCD_BAR_WORDS; bar.x = 0; bar.st = nullptr;
    if (!MK_PER_PHASE) bar = xcd_barrier_post((unsigned*)(ctl + CW_BAR) + args.li * XCD_BAR_WORDS, F.MISC + 8);
#define GRID_BAR() do { xcd_barrier(bar); } while (0)
    const int lo = args.ph_lo, hi = args.ph_hi;
#ifndef PH_MASK
#define PH_MASK 0x7fff
#endif
#define IN(k) (((PH_MASK >> (k)) & 1) && lo <= (k) && (k) < hi)
#define BOTH(k) (IN(k) && IN((k) + 1))
#ifndef PH_REP
#define PH_REP 0
#endif
#define REPS(k) ((((PH_REP) >> (k)) & 1) + 1)
    const int gw = F.vcu * NWAVES + F.wave, NGW = F.G * NWAVES;
    LAS float* scr = (LAS float*)(F.lds + RING_OFF + F.wave * 16384);

#ifndef PROBE_ALL2_LO
#define PROBE_ALL2_LO 0
#define PROBE_ALL2_HI (NPHASE - 1)
#endif
#ifndef PROBE_ALL2
#define PROBE_ALL2 0
#endif
    if (IN(0))
_Pragma("unroll")
    for (int rep = 0; rep < REPS(0); ++rep) {
        constexpr int I_FI = (DM / 64) * (2 * DFF / 32), I_FO = (DFF / 64) * (DM / 32), I_IN = (DM / 64) * (NIN / 32), I_A = (AW / 64) * (DM / 32), I_O = (DM / 64) * (DM / 32), I_RG = 512;
        constexpr int NITEMS = I_FI + I_IN + I_O + I_RG + (TAIL_FILL ? 0 : I_FO + 2 * I_A);
        auto desc0 = [&](int it) -> TItem {
            int r = it;
            if (r < I_FI) return titem_matrix(ffn1_w_in, DM, 2 * DFF, WFI, DM / 64, 2, 1, r, F.lane); r -= I_FI;
            if (r < I_IN) return titem_matrix(w_in, DM, NIN, WIN, DM / 64, 2, 0, r, F.lane, mix_norm); r -= I_IN;
            if (r < I_O) return titem_matrix(w_out, DM, DM, WO, DM / 64, RESID_WMODE, 0, r, F.lane); r -= I_O;
            if (!TAIL_FILL) {
            if (r < I_FO) return titem_matrix(ffn1_w_out, DFF, DM, WFO, DFF / 64, RESID_WMODE, 0, r, F.lane); r -= I_FO;
            if (r < I_A) return titem_matrix(w_attn, AW, DM, WA, AW / 64, 2, 0, r, F.lane); r -= I_A;
            if (r < I_A) return titem_matrix(w_rnn, RW, DM, WR, RW / 64, 2, 0, r, F.lane); r -= I_A; }
            const int blk = r >> 3, sub = r & 7, gate = blk >> 5, b = blk & 31, dir = b >> 4, n = b & 15;
            return titem_matrix((gate ? rg_wx : rg_wa) + (size_t)b * 16384, 128, 128, RGW + (size_t)((dir * 2 + gate) * 16 + n) * 16384, 128, 0, 0, sub, F.lane);
        };
        TRANSPOSE_STREAM(desc0, NITEMS);
        for (int idx = gw * 64 + F.lane; idx < 16384 * 8; idx += NGW * 64) { const int pos = idx >> 3, j = idx & 7;
            double rev = (double)pos * rope_rev(j); rev -= __builtin_floor(rev); const float rf = (float)rev;
            float2 cs; cs.x = __builtin_amdgcn_cosf(rf); cs.y = __builtin_amdgcn_sinf(rf); *(float2*)(ROPE + 2 * (size_t)idx) = cs; }
        rms_phase(F, x_prompt, x_sample, ffn1_norm, H);
        if (BOTH(0) || rep + 1 < REPS(0)) GRID_BAR();
    }
    if (IN(1))
_Pragma("unroll")
    for (int rep = 0; rep < REPS(1); ++rep) {
        pg8::Gemm g{H, WFI, TT, 2 * DFF, DM, LDH, LDH}; pg8::StaticOrder S; S.init(TT, 2 * DFF, F.G, (int)blockIdx.x, ALL_WGM); S.rev = (GEMM_REV >> 5) & 1;
        pg8::EpiSwiGLU E{MID, DFF / 64, nullptr};
        pg8::gemm_phase<pg8::EpiSwiGLU, pg8::StaticOrder, true, GEMM_SP2>(F.lds + RING_OFF, g, S, E);
        if (TAIL_FILL && rep == 0) {
            constexpr int I_FO = (DFF / 64) * (DM / 32), I_A = (AW / 64) * (DM / 32);
            const int tail = ((TT / 256) * (2 * DFF / 256)) % F.G, nidle = tail ? F.G - tail : F.G, iw = tail ? (int)blockIdx.x - tail : (int)blockIdx.x;
            if (iw >= 0) { const int gw = iw * NWAVES + F.wave, NGW = nidle * NWAVES;
                auto desc1 = [&](int it) -> TItem { int r = it;
                    if (r < I_FO) return titem_matrix(ffn1_w_out, DFF, DM, WFO, DFF / 64, RESID_WMODE, 0, r, F.lane); r -= I_FO;
                    if (r < I_A) return titem_matrix(w_attn, AW, DM, WA, AW / 64, 2, 0, r, F.lane); r -= I_A;
                    return titem_matrix(w_rnn, RW, DM, WR, RW / 64, 2, 0, r, F.lane); };
                TRANSPOSE_STREAM(desc1, I_FO + 2 * I_A); } }
        if (BOTH(1) || rep + 1 < REPS(1)) GRID_BAR();
    }
#ifdef PROBE_P2B
    if (IN(2)) {
        pg8::Gemm g{MID, WFO, TT, DM, DFF, LDMID, LDMID}; pg8::StaticOrder S; S.init(TT, DM, F.G, (int)blockIdx.x, FFO_WGM); S.csplit = FFO_CSPLIT; S.rev = (GEMM_REV >> 0) & 1;
        pg8::EpiPlainBf16 E{H, 0.5f};
        pg8::gemm_phase<pg8::EpiPlainBf16, pg8::StaticOrder, true, GEMM_SP2>(F.lds + RING_OFF, g, S, E);
        GRID_BAR();
    }
#endif
    if (IN(2))
_Pragma("unroll")
    for (int rep = 0; rep < REPS(2); ++rep) {
        pg8::Gemm g{MID, WFO, TT, DM, DFF, LDMID, LDMID}; pg8::StaticOrder S; S.init(TT, DM, F.G, (int)blockIdx.x, FFO_WGM); S.csplit = FFO_CSPLIT; S.rev = (GEMM_REV >> 0) & 1;
        pg8::EpiResidT<false, true> E{x_prompt, x_sample, 8192, XR, DM, 0.5f, SSQ};
        PHASE_SKEW();
        pg8::gemm_phase<pg8::EpiResidT<false, true>, pg8::StaticOrder, RESID_ALIGN, GEMM_SP2>(F.lds + RING_OFF, g, S, E);
        if (BOTH(2) || rep + 1 < REPS(2)) GRID_BAR();
    }
    if (IN(3))
_Pragma("unroll")
    for (int rep = 0; rep < REPS(3); ++rep) {
        rstd_phase(F, SSQ, RSTD);
        constexpr int I_FI = (DM / 64) * (2 * DFF / 32), I_FO = (DFF / 64) * (DM / 32);
        auto desc3 = [&](int it) -> TItem { return it < I_FI ? titem_matrix(ffn2_w_in, DM, 2 * DFF, WFI, DM / 64, 2, 1, it, F.lane, ffn2_norm) : titem_matrix(ffn2_w_out, DFF, DM, WFO, DFF / 64, RESID_WMODE, 0, it - I_FI, F.lane); };
        TRANSPOSE_STREAM(desc3, I_FI + (TAIL_FILL ? 0 : I_FO));
        if (BOTH(3) || rep + 1 < REPS(3)) GRID_BAR();
    }
    if (IN(4))
_Pragma("unroll")
    for (int rep = 0; rep < REPS(4); ++rep) {
        pg8::Gemm g{XR, WIN, TT, NIN, DM, LDH, LDH}; pg8::StaticOrder S; S.init(TT, NIN, F.G, (int)blockIdx.x, ALL_WGM); S.rev = (GEMM_REV >> 4) & 1;
        pg8::EpiProj E{QKV, RXY, GT, ROPE, RSTD};
        pg8::gemm_phase<pg8::EpiProj, pg8::StaticOrder, true, GEMM_SP2>(F.lds + RING_OFF, g, S, E);
        if (BOTH(4) || rep + 1 < REPS(4)) GRID_BAR();
    }
    if (IN(5))
_Pragma("unroll")
    for (int rep = 0; rep < REPS(5); ++rep) {
        rglru_phase<false>(F, RXY, RGW, conv_w, conv_b, rg_ba, rg_bx, rg_lambda, AGG, CARRY, RR);
        if (BOTH(5) || rep + 1 < REPS(5)) GRID_BAR();
    }
    if (IN(6))
_Pragma("unroll")
    for (int rep = 0; rep < REPS(6); ++rep) {
        carry_phase(F, AGG, CARRY);
        const float lam = __expf(wave_sum(lq1[F.lane] * lk1[F.lane])) - __expf(wave_sum(lq2[F.lane] * lk2[F.lane])) + 0.2f;
        const int lane = F.lane, r32 = lane & 31, hi = lane >> 5, wid = F.wave;
        char* alds = (char*)lds + RING_OFF;
        const __amdgpu_buffer_rsrc_t qkv_rs = __builtin_amdgcn_make_buffer_rsrc((void*)QKV, 0, (int)((size_t)TT * 6144 * 2), 0x00020000);
        float* li_l = (float*)(alds + att::LDS_WS) + wid * 64;
#ifndef ATT_PASSES
#define ATT_PASSES 1
#endif
        for (int L_ = F.vcu; L_ < 1536 * ATT_PASSES; L_ += F.G) { const int L = L_ >= 1536 ? L_ - 1536 : L_;
            int h, qb, row0, seqlen;
            if (L < 1024) { const int i = L >> 8, xcd = (L & 255) >> 5, loc = L & 31; h = 2 * xcd + (i >> 1); qb = 32 * (i & 1) + loc; row0 = 8192; seqlen = 16384; }
            else { const int Lp = L - 1024, j = Lp >> 8, xcd = (Lp & 255) >> 5, loc = Lp & 31, pair = 4 * xcd + 2 * j + (loc >> 4); qb = loc & 15; h = pair & 15; row0 = (pair >> 4) * 4096; seqlen = 4096; }
            for (int m = 0; m < 2; ++m) {
                const unsigned qo = (unsigned)(((row0 + qb * 256) * 2048 + h * 128 + m * 64) * 2);
                const char* kbase = (const char*)QKV + pg8::QKV_KOFF + (size_t)((((row0 >> 6) * 16 + h) * 2 + m)) * 8192;
                const char* vbase = (const char*)QKV + pg8::QKV_VOFF + (size_t)((row0 >> 6) * 16 + h) * 16384;
                att::f32x16 o[4]; float l;
                att::attn_map_body<true>(qkv_rs, qo, kbase, vbase, seqlen, alds, o, l);
                {
                    LAS unsigned* ovf = (LAS unsigned*)(F.lds + RING_OFF + att::LDS_BYTES);
                    const bool bad = ATT_FORCE_SLOW || !(l < 1e30f);
                    const bool anyb = __any(bad);
                    if (lane == 0) ovf[wid] = anyb ? 1u : 0u;
                    asm volatile("s_waitcnt lgkmcnt(0)" ::: "memory"); __syncthreads();
                    unsigned any8 = 0;
#pragma unroll
                    for (int w8 = 0; w8 < 8; ++w8) any8 |= ovf[w8];
                    __syncthreads();
                    if (any8) att::attn_map_body<false>(qkv_rs, qo, kbase, vbase, seqlen, alds, o, l);
                }
                if (hi == 0) li_l[r32] = l;
                asm volatile("s_waitcnt lgkmcnt(0)" ::: "memory");
                float rli[16];
#pragma unroll
                for (int r = 0; r < 16; ++r) rli[r] = __builtin_amdgcn_rcpf(li_l[att::crow(r, hi)]);
                float* const swb = (float*)(ws + WS_ASCR) + (size_t)blockIdx.x * (256 * 128);
                unsigned swo = (unsigned)(((wid * 32 + 4 * hi) * 128 + r32) * 4); asm volatile("" : "+v"(swo));
#define SWL(idx) (*(float*)((unsigned char*)swb + swo + (idx) * 4))
                if (m == 0) {
#pragma unroll
                    for (int r = 0; r < 16; ++r)
#pragma unroll
                        for (int d0 = 0; d0 < 4; ++d0) SWL(((r & 3) + 8 * (r >> 2)) * 128 + d0 * 32) = o[d0][r] * rli[r];
                    asm volatile("s_waitcnt vmcnt(0)" ::: "memory");
                } else {
                    const int orow0 = row0 + qb * 256 + wid * 32;
                    unsigned char* const obb = (unsigned char*)OB + pg8::blk_off(orow0, h * 128, AW / 64);
                    unsigned ob0 = (unsigned)(hi * 256 + r32 * 2); asm volatile("" : "+v"(ob0));
                    unsigned ob1 = (unsigned)(hi * 256 + ((r32 * 2) ^ 32)); asm volatile("" : "+v"(ob1));
                    float gain[4];
#pragma unroll
                    for (int d0 = 0; d0 < 4; ++d0) gain[d0] = subln_gain[d0 * 32 + r32] * 0.8f;
#pragma unroll
                    for (int r = 0; r < 16; ++r) { const int rb = (r & 3) + 8 * (r >> 2); float ss = 0.f; float v[4];
#pragma unroll
                        for (int d0 = 0; d0 < 4; ++d0) { v[d0] = SWL(rb * 128 + d0 * 32) - lam * (o[d0][r] * rli[r]); ss += v[d0] * v[d0]; }
                        ss += __shfl_xor(ss, 1); ss += __shfl_xor(ss, 2); ss += __shfl_xor(ss, 4); ss += __shfl_xor(ss, 8); ss += __shfl_xor(ss, 16);
                        const float rs = 1.f / sqrtf(ss * (1.f / 128.f) + EPS);
#pragma unroll
                        for (int d0 = 0; d0 < 4; ++d0) { const int coff = (d0 >> 1) * 32768 + ((rb >> 4) * 2 + (d0 & 1)) * 1024 + (rb & 15) * 64;
                            *(bf16*)(obb + (((rb & 8) ? ob1 : ob0) + (unsigned)coff)) = (bf16)f2bf(v[d0] * rs * gain[d0]); } }
                }
#undef SWL
                __syncthreads();
            }
        }
        if (BOTH(6) || rep + 1 < REPS(6)) GRID_BAR();
    }
    if (IN(7))
_Pragma("unroll")
    for (int rep = 0; rep < REPS(7); ++rep) {
        rglru_phase<true>(F, RXY, RGW, conv_w, conv_b, rg_ba, rg_bx, rg_lambda, AGG, CARRY, RR);
        if (BOTH(7) || rep + 1 < REPS(7)) GRID_BAR();
    }
#ifndef PROBE_P89
#define PROBE_P89 0
#endif
_Pragma("unroll")
    for (int rep2 = 0; rep2 < (PROBE_P89 ? 2 : 1); ++rep2) {
    if (IN(8)) {
        pg8::Gemm g{OB, WA, TT, DM, AW, LDO, LDO}; pg8::PairOrder S; S.S.init(TT, DM, F.G, (int)blockIdx.x, ALL_WGM);
        pg8::EpiGatePair E{MG, GT, DM / 64};
        pg8::gemm_phase<pg8::EpiGatePair, pg8::PairOrder, true, GEMM_SP2>(F.lds + RING_OFF, g, S, E);
        if (BOTH(8)) GRID_BAR();
    }
    }
#ifndef PROBE_P10
#define PROBE_P10 0
#endif
    if (IN(10))
_Pragma("unroll")
    for (int rep = 0; rep < (PROBE_P10 ? 3 : 1); ++rep) {
        pg8::Gemm g{MG, WO, TT, DM, DM, LDH, LDH}; pg8::StaticOrder S; S.init(TT, DM, F.G, (int)blockIdx.x, ALL_WGM); S.rev = (GEMM_REV >> 1) & 1;
        pg8::EpiResidT<true, true> E{XR, nullptr, TT, XR, DM, rep == 1 ? -1.0f : 1.0f, SSQ};
        PHASE_SKEW();
        pg8::gemm_phase<pg8::EpiResidT<true, true>, pg8::StaticOrder, RESID_ALIGN, GEMM_SP2>(F.lds + RING_OFF, g, S, E);
        if (BOTH(10) || rep + 1 < (PROBE_P10 ? 3 : 1)) GRID_BAR();
    }
    if (IN(11))
_Pragma("unroll")
    for (int rep = 0; rep < REPS(11); ++rep) {
        rstd_phase(F, SSQ, RSTD);
        if (BOTH(11) || rep + 1 < REPS(11)) GRID_BAR();
    }
    if (IN(12))
_Pragma("unroll")
    for (int rep = 0; rep < REPS(12); ++rep) {
        pg8::Gemm g{XR, WFI, TT, 2 * DFF, DM, LDH, LDH}; pg8::StaticOrder S; S.init(TT, 2 * DFF, F.G, (int)blockIdx.x, ALL_WGM); S.rev = (GEMM_REV >> 2) & 1;
        pg8::EpiSwiGLU E{MID, DFF / 64, RSTD};
        pg8::gemm_phase<pg8::EpiSwiGLU, pg8::StaticOrder, true, GEMM_SP2>(F.lds + RING_OFF, g, S, E);
        if (TAIL_FILL && rep == 0) {
            constexpr int I_FO = (DFF / 64) * (DM / 32);
            const int tail = ((TT / 256) * (2 * DFF / 256)) % F.G, nidle = tail ? F.G - tail : F.G, iw = tail ? (int)blockIdx.x - tail : (int)blockIdx.x;
            if (iw >= 0) { const int gw = iw * NWAVES + F.wave, NGW = nidle * NWAVES;
                auto desc12 = [&](int it) -> TItem { return titem_matrix(ffn2_w_out, DFF, DM, WFO, DFF / 64, RESID_WMODE, 0, it, F.lane); };
                TRANSPOSE_STREAM(desc12, I_FO); } }
        if (BOTH(12) || rep + 1 < REPS(12)) GRID_BAR();
    }
#ifndef PROBE_P13
#define PROBE_P13 0
#endif
    if (IN(13))
_Pragma("unroll")
    for (int rep = 0; rep < (PROBE_P13 ? 3 : 1); ++rep) {
        pg8::Gemm g{MID, WFO, TT, DM, DFF, LDMID, LDMID}; pg8::StaticOrder S; S.init(TT, DM, F.G, (int)blockIdx.x, FFO_WGM); S.csplit = FFO_CSPLIT; S.rev = (GEMM_REV >> 3) & 1;
        pg8::EpiResidT<true, true> E{XR, nullptr, TT, XR, DM, rep == 1 ? -0.5f : 0.5f, nullptr};
        PHASE_SKEW();
        pg8::gemm_phase<pg8::EpiResidT<true, true>, pg8::StaticOrder, RESID_ALIGN, GEMM_SP2>(F.lds + RING_OFF, g, S, E);
        if (BOTH(13) || rep + 1 < (PROBE_P13 ? 3 : 1)) GRID_BAR();
    }
    if (IN(14)) {
#ifdef PROBE_BARS
        for (int b_ = 0; b_ < PROBE_BARS; ++b_) GRID_BAR();
#endif
        for (int it = gw; it < TT; it += NGW) { const int m = recent_first_row(it); rms_row_bf16_to_f32(XR, m, final_norm, out + (size_t)m * DM, F.lane); }
    }
#undef IN
#undef BOTH
#undef GRID_BAR
}

extern "C" void kernel_launch(void* const* d_in, const int* in_sizes, int n_in, void* d_out, int out_size, void* d_ws, size_t ws_size, hipStream_t stream) {
    static int grid = 0;
    if (grid == 0) {
        if (n_in != 26 || in_sizes[0] != 8192 * DM || in_sizes[1] != 16384 * DM || out_size != TT * DM || ws_size < WS_END) {
            fprintf(stderr, "kernel_launch: shape mismatch (n_in %d, out %d, ws %zu, need %zu); nothing launched\n", n_in, out_size, ws_size, (size_t)WS_END); grid = -1; return; }
        int dev = 0, cus = 0;
        if (hipGetDevice(&dev) != hipSuccess || hipDeviceGetAttribute(&cus, hipDeviceAttributeMultiprocessorCount, dev) != hipSuccess) { grid = -1; return; }
        if (hipFuncSetAttribute((const void*)mk_fwd, hipFuncAttributeMaxDynamicSharedMemorySize, LDS_BYTES) != hipSuccess) { fprintf(stderr, "kernel_launch: hipFuncSetAttribute failed\n"); grid = -1; return; }
        (void)hipGetLastError();
        grid = cus > 256 ? 256 : cus - (cus % 16);
        if (grid < 16) { grid = -1; return; }
    }
    if (grid < 0) return;
    if (hipMemsetAsync((char*)d_ws + WS_CTL, 0, CTL_ZERO_BYTES, stream) != hipSuccess) return;
    Args a{};
    for (int i = 0; i < 26; ++i) a.in[i] = (const float*)d_in[i];
    a.out = (float*)d_out; a.ws = (unsigned char*)d_ws;
#if MK_PER_PHASE
    for (int k = 0; k < NPHASE; ++k) { a.ph_lo = k; a.ph_hi = k + 1; hipLaunchKernelGGL(mk_fwd, dim3(grid), dim3(NWAVES * 64), LDS_BYTES, stream, a); }
#else
#if PROBE_ALL2
    a.ph_lo = PROBE_ALL2_LO; a.ph_hi = PROBE_ALL2_HI; a.li = 1;
    hipLaunchKernelGGL(mk_fwd, dim3(grid), dim3(NWAVES * 64), LDS_BYTES, stream, a);
#endif
    a.ph_lo = 0; a.ph_hi = NPHASE; a.li = 0;
    hipLaunchKernelGGL(mk_fwd, dim3(grid), dim3(NWAVES * 64), LDS_BYTES, stream, a);
#endif
    const hipError_t le = hipPeekAtLastError();
    if (le != hipSuccess) fprintf(stderr, "kernel_launch: launch failed: %s\n", hipGetErrorName(le));
}
```

```cpp
#include <hip/hip_runtime.h>
#include <hip/hip_bf16.h>
#include <cstdio>
#include <cstdint>
#include <cmath>
#define EARLY_BAR 4
namespace pg8 {
#define PG8_LAS __attribute__((address_space(3)))
typedef unsigned short bf16_t;
typedef short bf16x8 __attribute__((ext_vector_type(8)));
typedef float f32x4 __attribute__((ext_vector_type(4)));
typedef unsigned u32x4 __attribute__((ext_vector_type(4)));
constexpr int BM = 256, BK = 64, HALF = 128, HTB = HALF * BK * 2  , STAGE_BYTES = 8 * HTB, NXCD = 8, WGM = 8;

__host__ __device__ __forceinline__ int lds_byte(int r, int c) { const int st = (r >> 4) * 2 + (c >> 5), rr = r & 15, cc = c & 31, ob = rr * 64 + cc * 2; return st * 1024 + (ob ^ (((ob >> 9) & 1) << 5)); }
__host__ __device__ __forceinline__ void stage_rc(int b, int& R, int& C) { const int st = b / 1024, sb = b % 1024, swz = sb ^ (((sb >> 9) & 1) << 5); R = (st >> 1) * 16 + swz / 64; C = (st & 1) * 32 + (swz % 64) / 2; }
__host__ __device__ __forceinline__ int perm32(int rho) { const int n = rho >> 4, i = rho & 15; return 8 * (i >> 2) + 4 * n + (i & 3); }
__host__ __device__ __forceinline__ int inv_perm32(int w) { return 16 * ((w >> 2) & 1) + 4 * (w >> 3) + (w & 3); }
__host__ __device__ __forceinline__ size_t blk_off(int row, int col, int KT) { return ((size_t)((row >> 8) * KT + (col >> 6)) * 2 + ((row >> 7) & 1)) * 16384 + (size_t)lds_byte(row & 127, col & 63); }
__host__ __device__ __forceinline__ size_t blk_off_b(int w, int col, int KT, bool perm) { const int w128 = w & 127, R = perm ? (w128 & ~31) + inv_perm32(w128 & 31) : w128;
    return ((size_t)((w >> 8) * KT + (col >> 6)) * 2 + ((w >> 7) & 1)) * 16384 + (size_t)lds_byte(R, col & 63); }

struct Unit { int pm, pn; };
struct Gemm { const bf16_t* A; const bf16_t* Bt; int M, N, K, lda, ldb; };

#ifndef SERPENTINE
#define SERPENTINE 1
#endif
struct StaticOrder {
    int rev = 0;
    int csplit = 0;
    int nM, nN, nwg, G, c, wgm, serp = SERPENTINE;
    __host__ __device__ void init(int M, int N, int G_, int c_, int wgm_ = WGM) { nM = M / BM; nN = N / BM; nwg = nM * nN; G = G_; c = c_; wgm = wgm_; }
    __host__ __device__ bool next(int i, Unit& u) const {
        const long L = (long)i * G + c; if (L >= nwg) return false;
        if (csplit && nwg % NXCD == 0 && nM % 16 == 0 && nN % 2 == 0) { const int xcd = (int)(L % NXCD), off = (int)(L / NXCD), cpg = nN / 2, rnd = off / (4 * cpg), in = off % (4 * cpg);
            u.pm = (xcd >> 1) * (nM / 4) + rnd * 4 + (in & 3); u.pn = (xcd & 1) * cpg + (in >> 2); if (rev) u.pm = nM - 1 - u.pm; return true; }
        int wgid = (int)L; { const int q = nwg / NXCD, r = nwg % NXCD, xcd = wgid % NXCD, off = wgid / NXCD; wgid = (xcd < r ? xcd * (q + 1) : r * (q + 1) + (xcd - r) * q) + off; }
        const int nig = wgm * nN, gid = wgid / nig, fm = gid * wgm, gsz = (nM - fm) < wgm ? (nM - fm) : wgm;
        u.pm = fm + ((wgid % nig) % gsz); u.pn = (wgid % nig) / gsz;
        if (serp && (nwg / NXCD) % nig == 0 && nwg % NXCD == 0 && (((wgid % (nwg / NXCD)) / nig) & 1)) u.pn = nN - 1 - u.pn;
        if (rev) u.pm = nM - 1 - u.pm;
        return true;
    }
    __device__ __forceinline__ void a_ready(const Unit&) const {}
    __device__ __forceinline__ void done(const Unit&) const {}
};

__device__ __forceinline__ unsigned cvt_pk_bf16(float lo, float hi) { unsigned r; asm volatile("v_cvt_pk_bf16_f32 %0, %1, %2" : "=v"(r) : "v"(lo), "v"(hi)); return r; }
typedef float f32x2 __attribute__((ext_vector_type(2)));
__device__ __forceinline__ float sigm(float x) { return __builtin_amdgcn_rcpf(1.f + __builtin_amdgcn_exp2f(-1.4426950408889634f * x)); }
__device__ __forceinline__ float bf_lo(unsigned w) { return __uint_as_float(w << 16); }
__device__ __forceinline__ float bf_hi(unsigned w) { return __uint_as_float(w & 0xffff0000u); }
#ifndef OUT_NT
#define OUT_NT 0
#endif
struct EpiSwiGLU {
    static constexpr bool PERM = true, AFTER_DRAIN = false;
    bf16_t* O; int KT; const float* rstd;
    __device__ __forceinline__ void operator()(const f32x4 (&acc)[2][2][4][2], const Unit& u, int wr, int wc, int fr, int fq) const {
        const int row0 = u.pm * BM + wr * 64 + fr, col0 = u.pn * HALF + wc * 32 + 8 * fq;
        float rs8[2][4];
#pragma unroll
        for (int ai = 0; ai < 2; ++ai)
#pragma unroll
            for (int m = 0; m < 4; ++m) rs8[ai][m] = rstd ? rstd[row0 + ai * HALF + m * 16] : 1.f;
        asm volatile("" ::: "memory");
#pragma unroll
        for (int ai = 0; ai < 2; ++ai)
#pragma unroll
            for (int m = 0; m < 4; ++m) {
                bf16_t* rowp = (bf16_t*)((unsigned char*)O + blk_off(row0 + ai * HALF + m * 16, col0, KT));
                float r[8]; const float rs = rs8[ai][m];
#pragma unroll
                for (int n = 0; n < 2; ++n)
#pragma unroll
                    for (int j = 0; j < 4; ++j) { const float g = acc[ai][0][m][n][j] * rs, up = acc[ai][1][m][n][j] * rs; r[4 * n + j] = g * sigm(g) * up; }
                u32x4 w; w.x = cvt_pk_bf16(r[0], r[1]); w.y = cvt_pk_bf16(r[2], r[3]); w.z = cvt_pk_bf16(r[4], r[5]); w.w = cvt_pk_bf16(r[6], r[7]);
                if (OUT_NT) __builtin_nontemporal_store(w, (u32x4*)rowp); else *(u32x4*)rowp = w;
            }
    }
};
template <bool RB16, bool OB16> struct EpiResidT {
#ifndef RESID_PERM
#define RESID_PERM 1
#endif
    static constexpr bool PERM = RESID_PERM != 0, AFTER_DRAIN = false;
    const void* res0; const void* res1; int split_row; void* out; int ldc; float alpha; float* ssq;
    __device__ __forceinline__ void operator()(const f32x4 (&acc)[2][2][4][2], const Unit& u, int wr, int wc, int fr, int fq) const {
        typedef unsigned u32x2v __attribute__((ext_vector_type(2)));
        const int rowt = u.pm * BM;
        const float* rbf = RB16 ? nullptr : (rowt < split_row ? (const float*)res0 + (size_t)rowt * ldc : (const float*)res1 + (size_t)(rowt - split_row) * ldc);
        float* obf = OB16 ? nullptr : (float*)out + (size_t)rowt * ldc;
#if RESID_PERM
        const int col0 = u.pn * BM + wc * 32 + 8 * fq;
        u32x4 rwa[2][4][2];
        if (RB16) {
#pragma unroll
            for (int ai = 0; ai < 2; ++ai)
#pragma unroll
                for (int m = 0; m < 4; ++m)
#pragma unroll
                    for (int bj = 0; bj < 2; ++bj) rwa[ai][m][bj] = *(const u32x4*)((const unsigned char*)res0 + blk_off(rowt + ai * HALF + wr * 64 + m * 16 + fr, col0 + bj * HALF, 64));
            asm volatile("" ::: "memory"); }
#pragma unroll
        for (int ai = 0; ai < 2; ++ai) {
            f32x4 rv[4][2][2]; u32x4 rw[4][2];
#pragma unroll
            for (int m = 0; m < 4; ++m) { const int rl = ai * HALF + wr * 64 + m * 16 + fr; const size_t off = (size_t)rl * ldc + col0;
#pragma unroll
                for (int bj = 0; bj < 2; ++bj) {
                    if (RB16) rw[m][bj] = rwa[ai][m][bj];
                    else { rv[m][bj][0] = *(const f32x4*)(rbf + off + bj * HALF); rv[m][bj][1] = *(const f32x4*)(rbf + off + bj * HALF + 4); } } }
#pragma unroll
            for (int m = 0; m < 4; ++m) { const int rl = ai * HALF + wr * 64 + m * 16 + fr; const size_t off = (size_t)rl * ldc + col0; float sq = 0.f;
#pragma unroll
                for (int bj = 0; bj < 2; ++bj) {
                    if (RB16) { const u32x4 w = rw[m][bj]; rv[m][bj][0] = (f32x4){bf_lo(w.x), bf_hi(w.x), bf_lo(w.y), bf_hi(w.y)}; rv[m][bj][1] = (f32x4){bf_lo(w.z), bf_hi(w.z), bf_lo(w.w), bf_hi(w.w)}; }
                    const f32x4 v0 = rv[m][bj][0] + acc[ai][bj][m][0] * alpha, v1 = rv[m][bj][1] + acc[ai][bj][m][1] * alpha;
                    sq += ((v0[0] * v0[0] + v0[1] * v0[1]) + (v0[2] * v0[2] + v0[3] * v0[3])) + ((v1[0] * v1[0] + v1[1] * v1[1]) + (v1[2] * v1[2] + v1[3] * v1[3]));
                    if (OB16) { u32x4 w; w.x = cvt_pk_bf16(v0[0], v0[1]); w.y = cvt_pk_bf16(v0[2], v0[3]); w.z = cvt_pk_bf16(v1[0], v1[1]); w.w = cvt_pk_bf16(v1[2], v1[3]);
                        *(u32x4*)((unsigned char*)out + blk_off(rowt + rl, col0 + bj * HALF, 64)) = w; }
                    else { *(f32x4*)(obf + off + bj * HALF) = v0; *(f32x4*)(obf + off + bj * HALF + 4) = v1; } }
                if (ssq) { sq += __shfl_xor(sq, 16); sq += __shfl_xor(sq, 32); if (fq == 0) ssq[(size_t)(rowt + rl) * 64 + u.pn * 4 + wc] = sq; } }
            asm volatile("" ::: "memory"); }
#else
        const int col0 = u.pn * BM + wc * 32 + 4 * fq;
#pragma unroll
        for (int ai = 0; ai < 2; ++ai) {
            f32x4 rv[4][2][2];
#pragma unroll
            for (int m = 0; m < 4; ++m) { const int rl = ai * HALF + wr * 64 + m * 16 + fr; const size_t off = (size_t)rl * ldc + col0;
#pragma unroll
                for (int bj = 0; bj < 2; ++bj)
#pragma unroll
                    for (int n = 0; n < 2; ++n) {
                        if (RB16) { const u32x2v w = *(const u32x2v*)((const unsigned char*)res0 + blk_off(rowt + rl, col0 + bj * HALF + n * 16, 64)); rv[m][bj][n] = (f32x4){bf_lo(w.x), bf_hi(w.x), bf_lo(w.y), bf_hi(w.y)}; }
                        else rv[m][bj][n] = *(const f32x4*)(rbf + off + bj * HALF + n * 16); } }
#pragma unroll
            for (int m = 0; m < 4; ++m) { const int rl = ai * HALF + wr * 64 + m * 16 + fr; const size_t off = (size_t)rl * ldc + col0; float sq = 0.f;
#pragma unroll
                for (int bj = 0; bj < 2; ++bj)
#pragma unroll
                    for (int n = 0; n < 2; ++n) { const f32x4 val = rv[m][bj][n] + acc[ai][bj][m][n] * alpha;
                        sq += (val[0] * val[0] + val[1] * val[1]) + (val[2] * val[2] + val[3] * val[3]);
                        if (OB16) { u32x2v w; w.x = cvt_pk_bf16(val[0], val[1]); w.y = cvt_pk_bf16(val[2], val[3]); *(u32x2v*)((unsigned char*)out + blk_off(rowt + rl, col0 + bj * HALF + n * 16, 64)) = w; }
                        else *(f32x4*)(obf + off + bj * HALF + n * 16) = val; }
                if (ssq) { sq += __shfl_xor(sq, 16); sq += __shfl_xor(sq, 32); if (fq == 0) ssq[(size_t)(rowt + rl) * 64 + u.pn * 4 + wc] = sq; } }
            asm volatile("" ::: "memory"); }
#endif
    }
};
constexpr size_t QKV_KOFF = (size_t)24576 * 2048 * 2, QKV_VOFF = 2 * QKV_KOFF;
__host__ __device__ __forceinline__ int kimg(int r64, int d) { return r64 * 128 + ((d * 2) ^ (((r64 >> 1) & 7) << 4)); }
__host__ __device__ __forceinline__ int vimg(int k, int c) { const int kk = k;     return ((kk >> 3) * 4 + (c >> 5)) * 512 + ((kk & 7) * 32 + (c & 31)) * 2; }
struct EpiPlainBf16 {
    static constexpr bool PERM = false, AFTER_DRAIN = false;
    bf16_t* O; float alpha;
    __device__ __forceinline__ void operator()(const f32x4 (&acc)[2][2][4][2], const Unit& u, int wr, int wc, int fr, int fq) const {
        const int col0 = u.pn * BM + wc * 32 + 4 * fq;
#pragma unroll
        for (int ai = 0; ai < 2; ++ai)
#pragma unroll
            for (int m = 0; m < 4; ++m) { const size_t off = (size_t)(u.pm * BM + ai * HALF + wr * 64 + m * 16 + fr) * 4096 + col0;
#pragma unroll
                for (int bj = 0; bj < 2; ++bj)
#pragma unroll
                    for (int n = 0; n < 2; ++n) { const f32x4 v = acc[ai][bj][m][n] * alpha; unsigned long long w = (unsigned long long)cvt_pk_bf16(v[0], v[1]) | ((unsigned long long)cvt_pk_bf16(v[2], v[3]) << 32);
                        *(unsigned long long*)(O + off + bj * HALF + n * 16) = w; } }
    }
};
struct EpiProj {
    static constexpr bool PERM = true, AFTER_DRAIN = false;
    bf16_t* QKV; bf16_t* RXY; bf16_t* G; const float* rope; const float* rstd;
    __device__ __forceinline__ void operator()(const f32x4 (&acc)[2][2][4][2], const Unit& u, int wr, int wc, int fr, int fq) const {
        const int colt = u.pn * BM, rowt = u.pm * BM;
        bf16_t* base; int ldc, cb;
        if (colt < 6144) { base = QKV; ldc = 6144; cb = colt; } else if (colt < 10240) { base = RXY; ldc = 4096; cb = colt - 6144; } else { base = G; ldc = 8192; cb = colt - 10240; }
        const bool rot = (colt < 4096) && ((wc & 1) == 0);
        const int pos0 = rowt - (rowt < 4096 ? 0 : (rowt < 8192 ? 4096 : 8192));
        const int col0 = cb + wc * 32 + 8 * fq;
        const float sgn = fq == 0 ? -1.f : 1.f;
        const float qs = colt < 2048 ? 0.125f * 1.4426950408889634f : 1.f;
        float rs8[8];
#pragma unroll
        for (int it = 0; it < 8; ++it) rs8[it] = rstd[rowt + (it >> 2) * HALF + wr * 64 + (it & 3) * 16 + fr];
        asm volatile("" ::: "memory");
        if (rot) body<true>(acc, rs8, base, ldc, colt, rowt, pos0, col0, sgn, qs, wr, fr, fq);
        else body<false>(acc, rs8, base, ldc, colt, rowt, pos0, col0, sgn, qs, wr, fr, fq);
    }
    template <bool ROT>
    __device__ __forceinline__ void body(const f32x4 (&acc)[2][2][4][2], const float (&rs8)[8], bf16_t* base, int ldc, int colt, int rowt, int pos0, int col0, float sgn, float qs, int wr, int fr, int fq) const {
        f32x4 cs[2][4];
        if (ROT) { const f32x4* tp = (const f32x4*)(rope + (size_t)(pos0 + wr * 64 + fr) * 16);
#pragma unroll
            for (int q = 0; q < 4; ++q) cs[0][q] = tp[q]; }
#pragma unroll
        for (int it = 0; it < 8; ++it) { const int ai = it >> 2, m = it & 3;
                const int rl = ai * HALF + wr * 64 + m * 16 + fr;
                const int row = rowt + rl; const float rs = rs8[it];
                if (ROT && it + 1 < 8) { const int rn = ((it + 1) >> 2) * HALF + wr * 64 + ((it + 1) & 3) * 16 + fr; const f32x4* tp = (const f32x4*)(rope + (size_t)(pos0 + rn) * 16);
#pragma unroll
                    for (int q = 0; q < 4; ++q) cs[(it + 1) & 1][q] = tp[q];
                    asm volatile("" ::: "memory"); }
#pragma unroll
                for (int bj = 0; bj < 2; ++bj) {
                    f32x4 v0 = acc[ai][bj][m][0] * (qs * rs), v1 = acc[ai][bj][m][1] * (qs * rs);
                    if (ROT) { const f32x4 (&c)[4] = cs[it & 1];
                        f32x4 p0, p1;
#pragma unroll
                        for (int j = 0; j < 4; ++j) { p0[j] = __shfl_xor(v0[j], 16); p1[j] = __shfl_xor(v1[j], 16); }
                        if (fq < 2) {
                            v0[0] = v0[0] * c[0][0] + sgn * p0[0] * c[0][1]; v0[1] = v0[1] * c[0][2] + sgn * p0[1] * c[0][3];
                            v0[2] = v0[2] * c[1][0] + sgn * p0[2] * c[1][1]; v0[3] = v0[3] * c[1][2] + sgn * p0[3] * c[1][3];
                            v1[0] = v1[0] * c[2][0] + sgn * p1[0] * c[2][1]; v1[1] = v1[1] * c[2][2] + sgn * p1[1] * c[2][3];
                            v1[2] = v1[2] * c[3][0] + sgn * p1[2] * c[3][1]; v1[3] = v1[3] * c[3][2] + sgn * p1[3] * c[3][3];
                        }
                    }
                    u32x4 w; w.x = cvt_pk_bf16(v0[0], v0[1]); w.y = cvt_pk_bf16(v0[2], v0[3]); w.z = cvt_pk_bf16(v1[0], v1[1]); w.w = cvt_pk_bf16(v1[2], v1[3]);
                    const int col = col0 + bj * HALF;
                    unsigned char* dp;
                    if (colt >= 6144) dp = (unsigned char*)(base + (size_t)row * ldc + col);
                    else if (colt < 2048) dp = (unsigned char*)(QKV + (size_t)row * 2048 + col);
                    else if (colt < 4096) { const int c2 = col - 2048; dp = (unsigned char*)QKV + QKV_KOFF + (size_t)((((row >> 6) * 16 + (c2 >> 7)) * 2 + ((c2 >> 6) & 1))) * 8192 + kimg(row & 63, c2 & 63); }
                    else { const int c2 = col - 4096; dp = (unsigned char*)QKV + QKV_VOFF + (size_t)((row >> 6) * 16 + (c2 >> 7)) * 16384 + vimg(row & 63, c2 & 127); }
                    if (OUT_NT) __builtin_nontemporal_store(w, (u32x4*)dp); else *(u32x4*)dp = w;
                }
            }
    }
};
template <bool ADD> struct EpiGate {
    static constexpr bool PERM = true, AFTER_DRAIN = false;
    bf16_t* O; const bf16_t* Gt; int goff; int KT;
    __device__ __forceinline__ void operator()(const f32x4 (&acc)[2][2][4][2], const Unit& u, int wr, int wc, int fr, int fq) const {
        const int row0 = u.pm * BM + wr * 64 + fr, col0 = u.pn * BM + wc * 32 + 8 * fq;
#pragma unroll
        for (int ai = 0; ai < 2; ++ai) {
            u32x4 gv[4][2], ov[4][2];
#pragma unroll
            for (int m = 0; m < 4; ++m) { const size_t row = (size_t)(row0 + ai * HALF + m * 16);
#pragma unroll
                for (int bj = 0; bj < 2; ++bj) { gv[m][bj] = *(const u32x4*)(Gt + row * 8192 + goff + col0 + bj * HALF); if (ADD) ov[m][bj] = *(const u32x4*)((const unsigned char*)O + blk_off((int)row, col0 + bj * HALF, KT)); } }
            asm volatile("" ::: "memory");
#pragma unroll
            for (int m = 0; m < 4; ++m) { const size_t row = (size_t)(row0 + ai * HALF + m * 16);
#pragma unroll
                for (int bj = 0; bj < 2; ++bj) { const f32x4 a0 = acc[ai][bj][m][0], a1 = acc[ai][bj][m][1]; float r[8]; const u32x4 g = gv[m][bj];
                    r[0] = sigm(bf_lo(g.x)) * a0[0]; r[1] = sigm(bf_hi(g.x)) * a0[1]; r[2] = sigm(bf_lo(g.y)) * a0[2]; r[3] = sigm(bf_hi(g.y)) * a0[3];
                    r[4] = sigm(bf_lo(g.z)) * a1[0]; r[5] = sigm(bf_hi(g.z)) * a1[1]; r[6] = sigm(bf_lo(g.w)) * a1[2]; r[7] = sigm(bf_hi(g.w)) * a1[3];
                    if (ADD) { const u32x4 o = ov[m][bj]; r[0] += bf_lo(o.x); r[1] += bf_hi(o.x); r[2] += bf_lo(o.y); r[3] += bf_hi(o.y); r[4] += bf_lo(o.z); r[5] += bf_hi(o.z); r[6] += bf_lo(o.w); r[7] += bf_hi(o.w); }
                    u32x4 w; w.x = cvt_pk_bf16(r[0], r[1]); w.y = cvt_pk_bf16(r[2], r[3]); w.z = cvt_pk_bf16(r[4], r[5]); w.w = cvt_pk_bf16(r[6], r[7]);
                    *(u32x4*)((unsigned char*)O + blk_off((int)row, col0 + bj * HALF, KT)) = w; } }
            asm volatile("" ::: "memory"); }
    }
};

struct EpiGatePair {
    static constexpr bool PERM = true, AFTER_DRAIN = false;
    bf16_t* O; const bf16_t* Gt; int KT;
    __device__ __forceinline__ void operator()(const f32x4 (&acc)[2][2][4][2], const Unit& u, int wr, int wc, int fr, int fq) const {
        if (u.pm < 96) { EpiGate<false> e{O, Gt, 0, KT}; e(acc, u, wr, wc, fr, fq); }
        else { Unit v; v.pm = u.pm - 96; v.pn = u.pn - 16; EpiGate<true> e{O, Gt, 4096, KT}; e(acc, v, wr, wc, fr, fq); }
    }
};
struct PairOrder {
    StaticOrder S;
    __device__ __forceinline__ bool next(int i, Unit& u) const { if (!S.next(i >> 1, u)) return false; if (i & 1) { u.pm += 96; u.pn += 16; } return true; }
    __device__ __forceinline__ void a_ready(const Unit&) const {}
    __device__ __forceinline__ void done(const Unit&) const {}
};

template <class Epi, class Sched, bool ALIGN_EPI = false, bool SP2 = false>
__device__ __forceinline__ void gemm_phase(PG8_LAS unsigned char* lds, const Gemm g, const Sched& S, const Epi& E) {
    const int tid = threadIdx.x, wid = __builtin_amdgcn_readfirstlane(tid >> 6), lane = tid & 63, wr = wid >> 2, wc = wid & 3, fr = lane & 15, fq = lane >> 4;
    const int K = g.K, nt = K / BK;
    unsigned voffA[2], voffB[2];
#pragma unroll
    for (int i = 0; i < 2; ++i) { voffA[i] = (unsigned)(tid * 16 + i * 8192); voffB[i] = voffA[i]; }
    const size_t kstep = 32768;
    const size_t hstepA = 16384, hstepB = 16384;
    const size_t tstepA = (size_t)nt * 32768, tstepB = tstepA;
    const unsigned ldsw = (unsigned)wid * 1024u;
    const int aoff = lds_byte(wr * 64 + fr, fq * 8), boff = lds_byte(wc * 32 + fr, fq * 8);
#define PG8_SA(b, h) (((b) * 2 + (h)) * HTB)
#define PG8_SB(b, h) ((4 + (b) * 2 + (h)) * HTB)
#define PG8_STAGE(bufoff, gbase, voff) do { _Pragma("unroll") for (int _i = 0; _i < 2; ++_i) \
        __builtin_amdgcn_global_load_lds((const unsigned*)((const char*)(gbase) + (voff)[_i]), (PG8_LAS unsigned*)(lds + (bufoff) + ldsw + _i * 8192), 16, 0, 0); } while (0)
#ifndef GEMM_B_AUX
#define GEMM_B_AUX 0
#endif
#define PG8_STAGEB(bufoff, gbase, voff) do { _Pragma("unroll") for (int _i = 0; _i < 2; ++_i) \
        __builtin_amdgcn_global_load_lds((const unsigned*)((const char*)(gbase) + (voff)[_i]), (PG8_LAS unsigned*)(lds + (bufoff) + ldsw + _i * 8192), 16, 0, GEMM_B_AUX); } while (0)
#define PG8_LDA(dst, b, h) do { _Pragma("unroll") for (int m = 0; m < 4; ++m) _Pragma("unroll") for (int k = 0; k < 2; ++k) dst[m][k] = *(const PG8_LAS bf16x8*)(lds + PG8_SA(b, h) + aoff + m * 2048 + k * 1024); } while (0)
#define PG8_LDB(dst, b, h) do { _Pragma("unroll") for (int n = 0; n < 2; ++n) _Pragma("unroll") for (int k = 0; k < 2; ++k) dst[n][k] = *(const PG8_LAS bf16x8*)(lds + PG8_SB(b, h) + boff + n * 2048 + k * 1024); } while (0)
#ifndef MMA_ORDER
#define MMA_ORDER 3
#endif
#define PG8_MFMA1(ai, bj, At, Bt, m, n, k) acc[ai][bj][m][n] = __builtin_amdgcn_mfma_f32_16x16x32_bf16(Bt[n][k], At[m][k], acc[ai][bj][m][n], 0, 0, 0)
#define PG8_MMA(ai, bj, At, Bt) do { __builtin_amdgcn_s_setprio(1); \
        if (MMA_ORDER == 1) { _Pragma("unroll") for (int n = 0; n < 2; ++n) _Pragma("unroll") for (int k = 0; k < 2; ++k) _Pragma("unroll") for (int m = 0; m < 4; ++m) PG8_MFMA1(ai, bj, At, Bt, m, n, k); } \
        else if (MMA_ORDER == 2) { _Pragma("unroll") for (int m = 0; m < 4; ++m) _Pragma("unroll") for (int k = 0; k < 2; ++k) _Pragma("unroll") for (int n = 0; n < 2; ++n) PG8_MFMA1(ai, bj, At, Bt, m, n, k); } \
        else if (MMA_ORDER == 3) { _Pragma("unroll") for (int k = 0; k < 2; ++k) _Pragma("unroll") for (int m = 0; m < 4; ++m) _Pragma("unroll") for (int nn = 0; nn < 2; ++nn) { const int n = (m & 1) ? 1 - nn : nn; PG8_MFMA1(ai, bj, At, Bt, m, n, k); } }     \
        else { _Pragma("unroll") for (int m = 0; m < 4; ++m) _Pragma("unroll") for (int n = 0; n < 2; ++n) _Pragma("unroll") for (int k = 0; k < 2; ++k) PG8_MFMA1(ai, bj, At, Bt, m, n, k); } \
        __builtin_amdgcn_s_setprio(0); } while (0)
#ifndef EARLY_BAR
#define EARLY_BAR 2
#endif
#define PG8_MMA_E(ai, bj, At, Bt) do { __builtin_amdgcn_s_setprio(1); \
        _Pragma("unroll") for (int k = 0; k < 2; ++k) _Pragma("unroll") for (int m = 0; m < 4; ++m) _Pragma("unroll") for (int nn = 0; nn < 2; ++nn) { const int n = (m & 1) ? 1 - nn : nn; \
            if ((k * 4 + m) * 2 + nn == 16 - EARLY_BAR) { __builtin_amdgcn_sched_barrier(0); __builtin_amdgcn_s_setprio(2); __builtin_amdgcn_s_barrier(); __builtin_amdgcn_sched_barrier(0); } \
            PG8_MFMA1(ai, bj, At, Bt, m, n, k); } \
        __builtin_amdgcn_s_setprio(0); } while (0)
#define PG8_WAIT_V(n) asm volatile("s_waitcnt vmcnt(" #n ")" ::: "memory")
#define PG8_WAIT_L(n) asm volatile("s_waitcnt lgkmcnt(" #n ")" ::: "memory")
#define PG8_BAR __builtin_amdgcn_s_barrier()
#define PG8_SCHED __builtin_amdgcn_sched_barrier(0)
    Unit cur, nxt; int ui = 0;
    if (!S.next(0, cur)) return;
    f32x4 acc[2][2][4][2];
#pragma unroll
    for (int a = 0; a < 2; ++a)
#pragma unroll
        for (int b = 0; b < 2; ++b)
#pragma unroll
            for (int m = 0; m < 4; ++m)
#pragma unroll
                for (int n = 0; n < 2; ++n) acc[a][b][m][n] = (f32x4){0.f, 0.f, 0.f, 0.f};
    bf16x8 At[4][2], B0[2][2], B1[2][2];
    const char* cA = (const char*)g.A + (size_t)cur.pm * tstepA; const char* cB = (const char*)g.Bt + (size_t)cur.pn * tstepB;
    S.a_ready(cur);
    if constexpr (SP2) {
        PG8_STAGEB(PG8_SB(0, 0), cB, voffB); PG8_STAGEB(PG8_SB(0, 1), cB + hstepB, voffB); PG8_STAGE(PG8_SA(0, 0), cA, voffA); PG8_STAGE(PG8_SA(0, 1), cA + hstepA, voffA);
        if (wr == 1) PG8_BAR;
        PG8_WAIT_V(2); PG8_BAR;
        PG8_STAGEB(PG8_SB(1, 0), cB + kstep, voffB); PG8_STAGE(PG8_SA(1, 0), cA + kstep, voffA); PG8_STAGEB(PG8_SB(1, 1), cB + hstepB + kstep, voffB);
        PG8_WAIT_V(6); PG8_BAR;
    } else {
        PG8_STAGEB(PG8_SB(0, 0), cB, voffB); PG8_STAGE(PG8_SA(0, 0), cA, voffA); PG8_STAGEB(PG8_SB(0, 1), cB + hstepB, voffB); PG8_STAGE(PG8_SA(0, 1), cA + hstepA, voffA);
        if (wr == 1) PG8_BAR;
        PG8_WAIT_V(4); PG8_BAR;
        PG8_STAGEB(PG8_SB(1, 0), cB + kstep, voffB); PG8_STAGE(PG8_SA(1, 0), cA + kstep, voffA); PG8_STAGEB(PG8_SB(1, 1), cB + hstepB + kstep, voffB);
        PG8_WAIT_V(6); PG8_BAR;
    }
    for (;;) {
        const bool has_next = S.next(ui + 1, nxt);
        const char* nA = has_next ? (const char*)g.A + (size_t)nxt.pm * tstepA : cA; const char* nB = has_next ? (const char*)g.Bt + (size_t)nxt.pn * tstepB : cB;
        for (int t = 0; t < nt; t += 2) {
            const bool last = (t == nt - 2);
            const char* a1 = cA + (size_t)(t + 1) * kstep;
            const char* a2 = last ? nA : cA + (size_t)(t + 2) * kstep; const char* b2 = last ? nB : cB + (size_t)(t + 2) * kstep;
            const char* a3 = a2 + kstep; const char* b3 = b2 + kstep;
            if (last && has_next) S.a_ready(nxt);
            if constexpr (SP2) {
            PG8_LDB(B0, 0, 0); PG8_LDB(B1, 0, 1); PG8_SCHED; PG8_LDA(At, 0, 0); PG8_STAGE(PG8_SA(1, 1), a1 + hstepA, voffA);
            PG8_WAIT_V(8); PG8_WAIT_L(0); PG8_BAR; PG8_MMA(0, 0, At, B0); if (EARLY_BAR) { PG8_MMA_E(0, 1, At, B1); } else { PG8_MMA(0, 1, At, B1); PG8_BAR; } PG8_SCHED;
            PG8_LDA(At, 0, 1); PG8_STAGEB(PG8_SB(0, 0), b2, voffB); PG8_STAGEB(PG8_SB(0, 1), b2 + hstepB, voffB); PG8_STAGE(PG8_SA(0, 0), a2, voffA);
            PG8_WAIT_V(8); PG8_WAIT_L(0); PG8_BAR; PG8_MMA(1, 0, At, B0); if (EARLY_BAR) { PG8_MMA_E(1, 1, At, B1); } else { PG8_MMA(1, 1, At, B1); PG8_BAR; } PG8_SCHED;
            PG8_LDB(B0, 1, 0); PG8_LDB(B1, 1, 1); PG8_SCHED; PG8_LDA(At, 1, 0); PG8_STAGE(PG8_SA(0, 1), a2 + hstepA, voffA);
            PG8_WAIT_V(8); PG8_WAIT_L(0); PG8_BAR; PG8_MMA(0, 0, At, B0); if (EARLY_BAR) { PG8_MMA_E(0, 1, At, B1); } else { PG8_MMA(0, 1, At, B1); PG8_BAR; } PG8_SCHED;
            PG8_LDA(At, 1, 1); PG8_STAGEB(PG8_SB(1, 0), b3, voffB); PG8_STAGEB(PG8_SB(1, 1), b3 + hstepB, voffB); PG8_STAGE(PG8_SA(1, 0), a3, voffA);
            PG8_WAIT_V(8); PG8_WAIT_L(0); PG8_BAR; PG8_MMA(1, 0, At, B0); if (EARLY_BAR) { PG8_MMA_E(1, 1, At, B1); } else { PG8_MMA(1, 1, At, B1); PG8_BAR; } PG8_SCHED;
            } else {
            PG8_LDB(B0, 0, 0); PG8_SCHED; PG8_LDA(At, 0, 0); PG8_STAGE(PG8_SA(1, 1), a1 + hstepA, voffA);
            PG8_WAIT_L(8); PG8_BAR; PG8_WAIT_L(0); PG8_MMA(0, 0, At, B0); PG8_BAR; PG8_SCHED;
            PG8_LDB(B1, 0, 1); PG8_STAGEB(PG8_SB(0, 0), b2, voffB);
            PG8_BAR; PG8_WAIT_L(0); PG8_MMA(0, 1, At, B1); PG8_BAR;
            PG8_LDA(At, 0, 1); PG8_STAGE(PG8_SA(0, 0), a2, voffA);
            PG8_BAR; PG8_WAIT_L(0); PG8_MMA(1, 0, At, B0); PG8_BAR; PG8_SCHED;
            PG8_STAGEB(PG8_SB(0, 1), b2 + hstepB, voffB);
            PG8_WAIT_V(6); PG8_BAR; PG8_MMA(1, 1, At, B1); PG8_BAR;
            PG8_LDB(B0, 1, 0); PG8_SCHED; PG8_LDA(At, 1, 0); PG8_STAGE(PG8_SA(0, 1), a2 + hstepA, voffA);
            PG8_WAIT_L(8); PG8_BAR; PG8_WAIT_L(0); PG8_MMA(0, 0, At, B0); PG8_BAR; PG8_SCHED;
            PG8_LDB(B1, 1, 1); PG8_STAGEB(PG8_SB(1, 0), b3, voffB);
            PG8_BAR; PG8_WAIT_L(0); PG8_MMA(0, 1, At, B1); PG8_BAR;
            PG8_LDA(At, 1, 1); PG8_STAGE(PG8_SA(1, 0), a3, voffA);
            PG8_BAR; PG8_WAIT_L(0); PG8_MMA(1, 0, At, B0); PG8_BAR; PG8_SCHED;
            PG8_STAGEB(PG8_SB(1, 1), b3 + hstepB, voffB);
            PG8_WAIT_V(6); PG8_BAR; PG8_MMA(1, 1, At, B1); PG8_BAR;
            }
        }
        if constexpr (ALIGN_EPI) { if (wr == 0) PG8_BAR; }
        if constexpr (!Epi::AFTER_DRAIN) { E(acc, cur, wr, wc, fr, fq); S.done(cur); }
        if (!has_next) break;
#pragma unroll
        for (int a = 0; a < 2; ++a)
#pragma unroll
            for (int b = 0; b < 2; ++b)
#pragma unroll
                for (int m = 0; m < 4; ++m)
#pragma unroll
                    for (int n = 0; n < 2; ++n) acc[a][b][m][n] = (f32x4){0.f, 0.f, 0.f, 0.f};
        cur = nxt; cA = nA; cB = nB; ++ui;
        if constexpr (ALIGN_EPI) { if (wr == 1) PG8_BAR; }
    }
    PG8_WAIT_V(0);
    if constexpr (!ALIGN_EPI) { if (wr == 0) PG8_BAR; }
    PG8_BAR;
    if constexpr (Epi::AFTER_DRAIN) { E.fused(acc, cur, wr, wc, fr, fq, lds, wid, lane); S.done(cur); }
#undef PG8_SA
#undef PG8_SB
#undef PG8_STAGE
#undef PG8_STAGEB
#undef PG8_LDA
#undef PG8_LDB
#undef PG8_MMA
#undef PG8_MMA_E
#undef PG8_MFMA1
#undef PG8_WAIT_V
#undef PG8_WAIT_L
#undef PG8_BAR
#undef PG8_SCHED
}
}
#ifndef ATT_SETPRIO
#define ATT_SETPRIO 0
#endif
namespace att {
typedef unsigned short bf16;
using bf16x8 = __attribute__((ext_vector_type(8))) short;
using s16x4  = __attribute__((ext_vector_type(4))) short;
using f32x16 = __attribute__((ext_vector_type(16))) float;
using u32x4  = __attribute__((ext_vector_type(4))) unsigned;
constexpr int NW = 8, QBLK = 32, KVBLK = 64, LDQ = 6144;
constexpr float SCALE = 0.125f;
constexpr float THR = 8.f;
constexpr int SHM_V = KVBLK * 128 * 2, SHM_K = KVBLK * 64 * 2;
constexpr int LDS_K = 0, LDS_V = 3 * SHM_K, LDS_WS = 3 * SHM_K + 4 * SHM_V, LDS_BYTES = LDS_WS + NW * 64 * 4;
#define KSWZ64(row, colB) ((row) * 128 + ((colB) ^ ((((row) >> 1) & 7) << 4)))
#define SBAR() __builtin_amdgcn_sched_barrier(0)
__device__ __forceinline__ int crow(int r, int hi) { return (r & 3) + 8 * (r >> 2) + 4 * hi; }
__device__ __forceinline__ unsigned cvtpk(float lo, float hi) { unsigned r; asm volatile("v_cvt_pk_bf16_f32 %0, %1, %2" : "=v"(r) : "v"(lo), "v"(hi)); return r; }

template <bool FIRST>
__device__ __forceinline__ void partialSM(f32x16& p0, f32x16& p1, float& mhat, f32x16& negm, float& alpha) {
  constexpr float THRL = THR * 1.4426950408889634f;
  float pmax = p0[0];
#pragma unroll
  for (int r = 1; r < 16; ++r) pmax = fmaxf(pmax, p0[r]);
#pragma unroll
  for (int r = 0; r < 16; ++r) pmax = fmaxf(pmax, p1[r]);
  { auto rr = __builtin_amdgcn_permlane32_swap(__float_as_uint(pmax), __float_as_uint(pmax), false, false);
    pmax = fmaxf(__uint_as_float(rr[0]), __uint_as_float(rr[1])); }
  if (!FIRST && __builtin_expect(__all(pmax <= THRL), 1)) { alpha = 1.f; }
  else { const float dl = FIRST ? pmax : fmaxf(pmax, 0.f); mhat += dl; alpha = FIRST ? 1.f : __builtin_amdgcn_exp2f(-dl);
#pragma unroll
    for (int r = 0; r < 16; ++r) { p0[r] -= dl; p1[r] -= dl; }
#pragma unroll
    for (int r = 0; r < 16; ++r) negm[r] = -mhat; }
#pragma unroll
  for (int r = 0; r < 16; ++r) p0[r] = __builtin_amdgcn_exp2f(p0[r]);
}
__device__ __forceinline__ void finishSM(f32x16& p0, f32x16& p1, float alpha, float& l_reg, bf16x8& pa0, bf16x8& pa1, bf16x8& pa2, bf16x8& pa3) {
#pragma unroll
  for (int r = 0; r < 16; ++r) p1[r] = __builtin_amdgcn_exp2f(p1[r]);
  float ps = 0;
#pragma unroll
  for (int r = 0; r < 16; ++r) ps += p0[r];
#pragma unroll
  for (int r = 0; r < 16; ++r) ps += p1[r];
  { auto rr = __builtin_amdgcn_permlane32_swap(__float_as_uint(ps), __float_as_uint(ps), false, false);
    ps = __uint_as_float(rr[0]) + __uint_as_float(rr[1]); }
  l_reg = l_reg * alpha + ps;
#define PK8(P, BASE, OUT) do { u32x4 w = {cvtpk(P[BASE + 0], P[BASE + 1]), cvtpk(P[BASE + 2], P[BASE + 3]), cvtpk(P[BASE + 4], P[BASE + 5]), cvtpk(P[BASE + 6], P[BASE + 7])}; \
    OUT = *reinterpret_cast<bf16x8*>(&w); } while (0)
  PK8(p0, 0, pa0); PK8(p0, 8, pa1); PK8(p1, 0, pa2); PK8(p1, 8, pa3);
#undef PK8
}
__device__ __forceinline__ void qkt(f32x16& p0, f32x16& p1, const char* Ks, const bf16x8* qr, const f32x16& negm, int r32, int hi) {
#pragma unroll
  for (int d0 = 0; d0 < 4; ++d0) { const int cb = (d0 * 16 + hi * 8) * 2;
    bf16x8 b0 = *reinterpret_cast<const bf16x8*>(Ks + KSWZ64(r32, cb));
    bf16x8 b1 = *reinterpret_cast<const bf16x8*>(Ks + KSWZ64(32 + r32, cb));
    if (d0 == 0) { p0 = __builtin_amdgcn_mfma_f32_32x32x16_bf16(b0, qr[0], negm, 0, 0, 0); p1 = __builtin_amdgcn_mfma_f32_32x32x16_bf16(b1, qr[0], negm, 0, 0, 0); }
    else { p0 = __builtin_amdgcn_mfma_f32_32x32x16_bf16(b0, qr[d0], p0, 0, 0, 0); p1 = __builtin_amdgcn_mfma_f32_32x32x16_bf16(b1, qr[d0], p1, 0, 0, 0); } }
}
__device__ __forceinline__ int v_st(int k, int c) { const int kk = (k & ~0xC) | ((k & 4) << 1) | ((k & 8) >> 1); return ((kk >> 3) * 4 + (c >> 5)) * 512 + ((kk & 7) * 32 + (c & 31)) * 2; }
__device__ __forceinline__ int v_rd_base(int lane) { return ((lane & 3) << 3) | (((lane >> 2) & 3) << 6) | (((lane >> 4) & 1) << 5) | (((lane >> 5) & 1) << 8); }
constexpr int v_rd_off(int d0, int ks, int half) { return d0 * 512 + ks * 4096 + half * 2048; }
template <int OFF> __device__ __forceinline__ s16x4 tr_read(int vb) {
  s16x4 r; asm volatile("ds_read_b64_tr_b16 %0, %1 offset:%2" : "=&v"(r) : "v"(vb), "i"(OFF) : "memory"); return r;
}
template <int D0> __device__ __forceinline__ void pv_one(f32x16& od, int vb, bf16x8 pa0, bf16x8 pa1, bf16x8 pa2, bf16x8 pa3) {
  const s16x4 l0 = tr_read<v_rd_off(D0, 0, 0)>(vb), h0 = tr_read<v_rd_off(D0, 0, 1)>(vb), l1 = tr_read<v_rd_off(D0, 1, 0)>(vb), h1 = tr_read<v_rd_off(D0, 1, 1)>(vb);
  const s16x4 l2 = tr_read<v_rd_off(D0, 2, 0)>(vb), h2 = tr_read<v_rd_off(D0, 2, 1)>(vb), l3 = tr_read<v_rd_off(D0, 3, 0)>(vb), h3 = tr_read<v_rd_off(D0, 3, 1)>(vb);
  asm volatile("s_waitcnt lgkmcnt(0)" ::: "memory"); SBAR();
#define PK(L, H) (bf16x8){L[0], L[1], L[2], L[3], H[0], H[1], H[2], H[3]}
#if ATT_SETPRIO
  __builtin_amdgcn_s_setprio(1);
#endif
  od = __builtin_amdgcn_mfma_f32_32x32x16_bf16(pa0, PK(l0, h0), od, 0, 0, 0);
  od = __builtin_amdgcn_mfma_f32_32x32x16_bf16(pa1, PK(l1, h1), od, 0, 0, 0);
  od = __builtin_amdgcn_mfma_f32_32x32x16_bf16(pa2, PK(l2, h2), od, 0, 0, 0);
  od = __builtin_amdgcn_mfma_f32_32x32x16_bf16(pa3, PK(l3, h3), od, 0, 0, 0);
#if ATT_SETPRIO
  __builtin_amdgcn_s_setprio(0);
#endif
#undef PK
}
__device__ __forceinline__ void pv_d0(f32x16* o, int vb, bf16x8 pa0, bf16x8 pa1, bf16x8 pa2, bf16x8 pa3) {
  pv_one<0>(o[0], vb, pa0, pa1, pa2, pa3); pv_one<1>(o[1], vb, pa0, pa1, pa2, pa3); pv_one<2>(o[2], vb, pa0, pa1, pa2, pa3); pv_one<3>(o[3], vb, pa0, pa1, pa2, pa3);
}

__device__ __forceinline__ bf16x8 bload(__amdgpu_buffer_rsrc_t rs, unsigned voff, unsigned soff) { return __builtin_bit_cast(bf16x8, __builtin_amdgcn_raw_buffer_load_b128(rs, voff, soff, 0)); }
__device__ __forceinline__ void glds16s(const char* sbase, unsigned voff, unsigned lds_dst) { unsigned keep;
  asm volatile("s_mov_b32 %0, m0\n\ts_mov_b32 m0, %3\n\ts_nop 0\n\tglobal_load_lds_dwordx4 %1, %2\n\ts_mov_b32 m0, %0" : "=&s"(keep) : "v"(voff), "s"(sbase), "s"(lds_dst) : "memory"); }
#define WAIT_BAR(N) asm volatile("s_waitcnt vmcnt(" #N ") lgkmcnt(0)\n\ts_barrier" ::: "memory")
template <bool FAST>
__device__ __forceinline__ void attn_map_body(__amdgpu_buffer_rsrc_t rs, unsigned qo, const char* kbase, const char* vbase, int seq, char* lds, f32x16 (&o)[4], float& l_out) {
  const int tid = threadIdx.x, wid = __builtin_amdgcn_readfirstlane(tid >> 6), lane = tid & 63, r32 = lane & 31, hi = lane >> 5;
  char* V_lds = lds + LDS_V; char* K_lds = lds + LDS_K;
  float* ws = (float*)(lds + LDS_WS) + wid * 64; float* al_l = ws + 32;
  float mhat = 0.f, l_reg = 0; bf16x8 qr[4]; f32x16 negm = f32x16{};
#pragma unroll
  for (int d = 0; d < 4; ++d) o[d] = f32x16{};
  const unsigned qvo = (unsigned)(((wid * QBLK + r32) * 2048 + hi * 8) * 2);
#pragma unroll
  for (int d0 = 0; d0 < 4; ++d0) qr[d0] = bload(rs, qvo + d0 * 32, qo);
  const unsigned lds0 = (unsigned)(uintptr_t)lds;
  const unsigned kvo = (unsigned)(wid * 1024 + lane * 16);
  unsigned vvo[2];
#pragma unroll
  for (int i = 0; i < 2; ++i) vvo[i] = (unsigned)((wid + 8 * i) * 1024 + lane * 16);
  const unsigned kdst = lds0 + LDS_K + wid * 1024, vdst = lds0 + LDS_V + wid * 1024;
#define DMA_K(t, slot) glds16s(kbase + (size_t)(t) * 262144, kvo, (unsigned)__builtin_amdgcn_readfirstlane((int)(kdst + (slot) * SHM_K)))
#define DMA_V(t, slot) do { const char* vb_ = vbase + (size_t)(t) * 262144; const unsigned vd_ = (unsigned)__builtin_amdgcn_readfirstlane((int)(vdst + (slot) * SHM_V)); \
    glds16s(vb_, vvo[0], vd_); glds16s(vb_, vvo[1], vd_ + 8192); } while (0)
  const int vb0 = (int)(uintptr_t)V_lds + v_rd_base(lane);
#define RESC(a) do { if (__any((a) < 1.f)) { if (hi == 0) al_l[r32] = (a); asm volatile("s_waitcnt lgkmcnt(0)" ::: "memory"); \
    _Pragma("unroll") for (int d = 0; d < 4; ++d) _Pragma("unroll") for (int r = 0; r < 16; ++r) o[d][r] *= al_l[crow(r, hi)]; } } while (0)
  f32x16 pA0, pA1, pB0, pB1; float alA, alB; bf16x8 pa0, pa1, pa2, pa3; const int NT = seq / KVBLK;
  int k3 = 0;
#define K3NEXT() do { k3 = (k3 == 2) ? 0 : k3 + 1; } while (0)
#define SM_STEP(PX0, PX1, alX) do { if (FAST) { alX = 1.f; _Pragma("unroll") for (int r_ = 0; r_ < 16; ++r_) PX0[r_] = __builtin_amdgcn_exp2f(PX0[r_]); } \
    else { partialSM<false>(PX0, PX1, mhat, negm, alX); RESC(alX); } } while (0)
#define A_PART(PX0, PX1, PY0, PY1, alY, j, GK, GV, FIN) do { \
    if (GK) DMA_K((j) + 2, (k3 == 0 ? 2 : k3 - 1)); if (GV) DMA_V((j) + 1, ((j) + 1) & 3); \
    SBAR(); qkt(PX0, PX1, K_lds + k3 * SHM_K, qr, negm, r32, hi); \
    if (FIN) finishSM(PY0, PY1, alY, l_reg, pa0, pa1, pa2, pa3); SBAR(); } while (0)
#ifndef ATT_EXP_IN_PV
#define ATT_EXP_IN_PV 1
#endif
#define B_PART(PX0, PX1, alX, j) do { \
    if (FAST && ATT_EXP_IN_PV) { const int vb_ = vb0 + (((j) + 3) & 3) * SHM_V; alX = 1.f; \
        pv_one<0>(o[0], vb_, pa0, pa1, pa2, pa3); _Pragma("unroll") for (int r_ = 0; r_ < 4; ++r_) PX0[r_] = __builtin_amdgcn_exp2f(PX0[r_]); \
        pv_one<1>(o[1], vb_, pa0, pa1, pa2, pa3); _Pragma("unroll") for (int r_ = 4; r_ < 8; ++r_) PX0[r_] = __builtin_amdgcn_exp2f(PX0[r_]); \
        pv_one<2>(o[2], vb_, pa0, pa1, pa2, pa3); _Pragma("unroll") for (int r_ = 8; r_ < 12; ++r_) PX0[r_] = __builtin_amdgcn_exp2f(PX0[r_]); \
        pv_one<3>(o[3], vb_, pa0, pa1, pa2, pa3); _Pragma("unroll") for (int r_ = 12; r_ < 16; ++r_) PX0[r_] = __builtin_amdgcn_exp2f(PX0[r_]); } \
    else { pv_d0(o, vb0 + (((j) + 3) & 3) * SHM_V, pa0, pa1, pa2, pa3); SM_STEP(PX0, PX1, alX); } } while (0)
#ifndef ATT_LATE_SPLIT
#define ATT_LATE_SPLIT 0
#endif
#define B1_PART(j) do { const int vb_ = vb0 + (((j) + 3) & 3) * SHM_V; if (ATT_LATE_SPLIT) { pv_one<0>(o[0], vb_, pa0, pa1, pa2, pa3); pv_one<1>(o[1], vb_, pa0, pa1, pa2, pa3); } } while (0)
#define B2_PART(PX0, PX1, alX, j) do { const int vb_ = vb0 + (((j) + 3) & 3) * SHM_V; \
    if (ATT_LATE_SPLIT) { pv_one<2>(o[2], vb_, pa0, pa1, pa2, pa3); pv_one<3>(o[3], vb_, pa0, pa1, pa2, pa3); } else pv_d0(o, vb_, pa0, pa1, pa2, pa3); \
    SM_STEP(PX0, PX1, alX); } while (0)
  DMA_K(0, 0); DMA_V(0, 0); DMA_K(1, 1);
  WAIT_BAR(0);
  int j = 1;
  if (wid < 4) {
    A_PART(pA0, pA1, pB0, pB1, alB, 0, true, true, false); partialSM<true>(pA0, pA1, mhat, negm, alA); WAIT_BAR(3); K3NEXT();
    for (; j + 3 < NT; j += 2) {
      A_PART(pB0, pB1, pA0, pA1, alA, j, true, true, true); B_PART(pB0, pB1, alB, j); WAIT_BAR(3); K3NEXT();
      A_PART(pA0, pA1, pB0, pB1, alB, j + 1, true, true, true); B_PART(pA0, pA1, alA, j + 1); WAIT_BAR(3); K3NEXT();
    }
    A_PART(pB0, pB1, pA0, pA1, alA, j, true, true, true); B_PART(pB0, pB1, alB, j); WAIT_BAR(3); K3NEXT();
    A_PART(pA0, pA1, pB0, pB1, alB, j + 1, false, true, true); B_PART(pA0, pA1, alA, j + 1); WAIT_BAR(2); K3NEXT();
    A_PART(pB0, pB1, pA0, pA1, alA, j + 2, false, false, true); B_PART(pB0, pB1, alB, j + 2); WAIT_BAR(0); K3NEXT();
  } else {
    A_PART(pA0, pA1, pB0, pB1, alB, 0, true, true, false); WAIT_BAR(3); K3NEXT();
    partialSM<true>(pA0, pA1, mhat, negm, alA);
    for (; j + 3 < NT; j += 2) {
      A_PART(pB0, pB1, pA0, pA1, alA, j, true, true, true); B1_PART(j); WAIT_BAR(3); K3NEXT(); B2_PART(pB0, pB1, alB, j);
      A_PART(pA0, pA1, pB0, pB1, alB, j + 1, true, true, true); B1_PART(j + 1); WAIT_BAR(3); K3NEXT(); B2_PART(pA0, pA1, alA, j + 1);
    }
    A_PART(pB0, pB1, pA0, pA1, alA, j, true, true, true); B1_PART(j); WAIT_BAR(3); K3NEXT(); B2_PART(pB0, pB1, alB, j);
    A_PART(pA0, pA1, pB0, pB1, alB, j + 1, false, true, true); B1_PART(j + 1); WAIT_BAR(2); K3NEXT(); B2_PART(pA0, pA1, alA, j + 1);
    A_PART(pB0, pB1, pA0, pA1, alA, j + 2, false, false, true); B1_PART(j + 2); WAIT_BAR(0); K3NEXT(); B2_PART(pB0, pB1, alB, j + 2);
  }
  finishSM(pB0, pB1, alB, l_reg, pa0, pa1, pa2, pa3); SBAR();
  pv_d0(o, vb0 + ((NT - 1) & 3) * SHM_V, pa0, pa1, pa2, pa3);
  WAIT_BAR(0);
  l_out = l_reg;
#undef A_PART
#undef SM_STEP
#undef B_PART
#undef B1_PART
#undef B2_PART
#undef K3NEXT
#undef DMA_K
#undef DMA_V
#undef RESC
}
#undef WAIT_BAR
#undef SBAR
}

#define GAS __attribute__((address_space(1)))
#define LAS __attribute__((address_space(3)))
typedef unsigned short bf16;
typedef unsigned v4u __attribute__((ext_vector_type(4)));
typedef float f32x4 __attribute__((ext_vector_type(4)));
typedef short bf16x8 __attribute__((ext_vector_type(8)));
typedef GAS unsigned gu32;
typedef GAS unsigned long long gu64;
#define RLX_AGENT __ATOMIC_RELAXED, __HIP_MEMORY_SCOPE_AGENT
#define LDS_WAIT() asm volatile("s_waitcnt lgkmcnt(0)" ::: "memory")
#define VM_WAIT() asm volatile("s_waitcnt vmcnt(0)" ::: "memory")
__device__ __forceinline__ unsigned long long rt() { return __builtin_amdgcn_s_memrealtime(); }
__device__ __forceinline__ unsigned f2bf(float f) { unsigned u = __builtin_bit_cast(unsigned, f); return (u + 0x7fffu + ((u >> 16) & 1u)) >> 16; }
__device__ __forceinline__ unsigned pk2(float lo, float hi) { return f2bf(lo) | (f2bf(hi) << 16); }
#define XB_TMO      128
#define XB_XCNT(j)  (256  + 64 * (j))
#define XB_XSUB(j)  (1280 + 64 * (j))
#define XB_XGEN(j)  (2304 + 64 * (j))
#define XB_TOP      3328
#define XB_TOPGEN   3392
#define XCD_BAR_WORDS 3456
#define XB_SPIN_CAP (1u << 18)

__device__ __forceinline__ unsigned xb_ld(unsigned* p)              { return __hip_atomic_load(p, __ATOMIC_RELAXED, __HIP_MEMORY_SCOPE_AGENT); }
__device__ __forceinline__ unsigned xb_add(unsigned* p, unsigned v) { return __hip_atomic_fetch_add(p, v, __ATOMIC_RELAXED, __HIP_MEMORY_SCOPE_AGENT); }
__device__ __forceinline__ unsigned xb_xcc_id() { return (unsigned)__builtin_amdgcn_s_getreg((3 << 11) | 20) & 0xFu; }
#define XB_SPIN(cond, bar) do { unsigned _sp = 0; while (cond) { __builtin_amdgcn_s_sleep(1); \
    if ((++_sp & 255u) == 0u) { if (xb_ld(&(bar)[XB_TMO])) break; if (_sp > XB_SPIN_CAP) { atomicAdd(&(bar)[XB_TMO], 1u); break; } } } } while (0)

struct XcdBarrier {
    unsigned* bar; unsigned x;
    volatile LAS unsigned* st;
};

__device__ __forceinline__ XcdBarrier xcd_barrier_post(unsigned* bar, volatile LAS unsigned* st) {
    XcdBarrier b; b.bar = bar; b.x = xb_xcc_id(); b.st = st;
    if (threadIdx.x == 0) (void)xb_add(&bar[XB_XCNT(b.x)], 1u);
    return b;
}
__device__ __forceinline__ void xcd_barrier_complete(unsigned* bar, unsigned x, unsigned& nloc, unsigned& nx) {
    const unsigned G = gridDim.x * gridDim.y * gridDim.z;
    unsigned sum, cnt, mine, sp = 0u;
    for (;;) {
        sum = 0u; cnt = 0u; mine = 0u;
#pragma unroll
        for (unsigned j = 0; j < 16; ++j) { const unsigned c = xb_ld(&bar[XB_XCNT(j)]); sum += c; cnt += (c > 0u) ? 1u : 0u; mine = (j == x) ? c : mine; }
        if (sum == G) break;
        __builtin_amdgcn_s_sleep(1);
        if ((++sp & 255u) == 0u) { if (xb_ld(&bar[XB_TMO])) break; if (sp > XB_SPIN_CAP) { atomicAdd(&bar[XB_TMO], 1u); break; } }
    }
    nloc = mine > 0u ? mine : 1u; nx = cnt > 0u ? cnt : 1u;
}

__device__ __forceinline__ void xcd_barrier(const XcdBarrier& b) {
    asm volatile("s_waitcnt vmcnt(0)" ::: "memory");
    __syncthreads();
    if (threadIdx.x == 0) {
        unsigned* bar = b.bar;
        __builtin_amdgcn_s_waitcnt(0);
        unsigned nloc = b.st[0], nx = b.st[1];
        if (nloc == 0u) { xcd_barrier_complete(bar, b.x, nloc, nx); b.st[0] = nloc; b.st[1] = nx; }
        const unsigned old = xb_add(&bar[XB_XSUB(b.x)], 1u);
        const unsigned gen = old / nloc;
        if (old + 1u == (gen + 1u) * nloc) {
            __builtin_amdgcn_fence(__ATOMIC_RELEASE, "agent");
            asm volatile("s_waitcnt vmcnt(0)" ::: "memory");
            const unsigned og = xb_add(&bar[XB_TOP], 1u);
            const unsigned tg = og / nx;
            if (og + 1u == (tg + 1u) * nx) xb_add(&bar[XB_TOPGEN], 1u);
            else XB_SPIN(xb_ld(&bar[XB_TOPGEN]) == tg, bar);
            __builtin_amdgcn_fence(__ATOMIC_ACQUIRE, "agent");
            xb_add(&bar[XB_XGEN(b.x)], 1u);
            asm volatile("s_waitcnt vmcnt(0)" ::: "memory");
        } else {
            XB_SPIN(xb_ld(&bar[XB_XGEN(b.x)]) == gen, bar);
            __builtin_amdgcn_fence(__ATOMIC_ACQUIRE, "agent");
            asm volatile("s_waitcnt vmcnt(0)" ::: "memory");
        }
    }
    __syncthreads();
}
constexpr int NWAVES = 8;
constexpr int TT = 24576, DM = 4096, DFF = 11008, NIN = 18432;
constexpr int NH = 16, AW = 2048, RW = 2048;
constexpr int NCHUNK = TT / 64;
constexpr float EPS = 1e-6f;
constexpr int NPHASE = 15;
#ifndef MK_PER_PHASE
#define MK_PER_PHASE 0
#endif

constexpr size_t MiB = 1u << 20;
constexpr size_t WS_CTL = 0, CTL_ZERO_BYTES = 1 * MiB;
constexpr size_t WS_ROPE = 1 * MiB;
constexpr size_t WS_RGW = 2 * MiB;
constexpr size_t WS_AGG = 4 * MiB;
constexpr size_t WS_CARRY = 16 * MiB;
constexpr size_t WS_ASCR = 22 * MiB;
constexpr int PADE = 128, LDH = DM + PADE, LDMID = DFF + PADE, LDO = AW + PADE;
constexpr size_t WS_WFI = 54 * MiB, WS_WFO = 232 * MiB;
constexpr size_t WS_WIN = 319 * MiB, WS_WA = 468 * MiB, WS_WR = WS_WA + (size_t)DM * AW * 2  , WS_WO = 502 * MiB;
constexpr size_t WS_H = 535 * MiB;
constexpr size_t WS_RR = WS_H + (size_t)TT * AW * 2;
constexpr size_t WS_BIG = 739 * MiB;
constexpr size_t WS_QKV = WS_BIG, WS_RXY = WS_BIG + 288 * MiB, WS_G = WS_BIG + 480 * MiB, WS_XR = WS_BIG + 864 * MiB, WS_END = WS_XR + 192 * MiB;
static_assert(WS_WFI + (size_t)2 * DFF * LDH * 2 <= WS_WFO && WS_WFO + (size_t)DM * LDMID * 2 <= WS_WIN && WS_WIN + (size_t)NIN * LDH * 2 <= WS_WA && WS_WA + (size_t)DM * AW * 2 <= WS_WR &&
              WS_WR + (size_t)DM * RW * 2 <= WS_WO && WS_WO + (size_t)DM * LDH * 2 <= WS_H && WS_H + (size_t)TT * LDH * 2 <= WS_BIG && WS_H + (size_t)TT * AW * 2 <= WS_RR && WS_RR + (size_t)TT * RW * 2 <= WS_BIG, "ws map");
static_assert(WS_QKV + (size_t)TT * 6144 * 2 <= WS_RXY && WS_RXY + (size_t)TT * 4096 * 2 <= WS_G && WS_G + (size_t)TT * 8192 * 2 <= WS_END && WS_BIG + (size_t)TT * LDMID * 2 <= WS_END && (size_t)TT * LDH * 2 <= 288 * MiB, "ws map 2");
constexpr int CW_BAR = 4096;
constexpr size_t WS_SSQ = WS_ASCR;
constexpr size_t WS_RSTD = WS_CTL + 512 * 1024;

constexpr int RING_OFF = 0, RING_BYTES = 131072;
constexpr int LDSCTL_OFF = RING_BYTES, MISC_OFF = LDSCTL_OFF + 320;
constexpr int LDS_BYTES = 147456;

struct Frame {
    LAS unsigned char* lds;
    volatile LAS unsigned* MISC;
    int tid, lane, wave;
    int vcu, G;
};
__device__ __forceinline__ float wave_sum(float v) {
#pragma unroll
    for (int o = 1; o < 64; o <<= 1) v += __shfl_xor(v, o);
    return v;
}
__device__ __forceinline__ int seq_start(int row) { return row < 4096 ? 0 : (row < 8192 ? 4096 : 8192); }
__device__ __forceinline__ int seq_end(int row) { return row < 4096 ? 4096 : (row < 8192 ? 8192 : TT); }

struct TItem { const float* src; bf16* WT; const float* gk; int N, drow0, k0, KT, mode; };
__device__ __forceinline__ void titem_load(const TItem& d, float (&v)[32]) {
#pragma unroll
    for (int i = 0; i < 32; ++i) v[i] = d.src[(size_t)(2 * i) * d.N];
}
__device__ __forceinline__ void titem_finish(const TItem& d, const float (&v)[32], LAS float* scr, int lane) {
#pragma unroll
    for (int i = 0; i < 32; ++i) scr[(2 * i + (lane >> 5)) * 33 + (lane & 31)] = v[i];
    LDS_WAIT(); asm volatile("" ::: "memory");
    const int c = lane & 7;
    f32x4 g0 = (f32x4){1.f, 1.f, 1.f, 1.f}, g1 = g0;
    if (d.gk) { g0 = *(const GAS f32x4*)(d.gk + d.k0 + 8 * c); g1 = *(const GAS f32x4*)(d.gk + d.k0 + 8 * c + 4); }
#pragma unroll
    for (int j = 0; j < 4; ++j) { const int n = (lane >> 3) + 8 * j; const LAS float* s = scr + (8 * c) * 33 + n;
        v4u o; o.x = pk2(s[0 * 33] * g0.x, s[1 * 33] * g0.y); o.y = pk2(s[2 * 33] * g0.z, s[3 * 33] * g0.w); o.z = pk2(s[4 * 33] * g1.x, s[5 * 33] * g1.y); o.w = pk2(s[6 * 33] * g1.z, s[7 * 33] * g1.w);
        GAS v4u* dp = d.mode == 0 ? (GAS v4u*)(d.WT + (size_t)(d.drow0 + n) * d.KT + d.k0 + 8 * c)
                                  : (GAS v4u*)((unsigned char*)d.WT + pg8::blk_off_b(d.drow0 + n, d.k0 + 8 * c, d.KT, d.mode == 2));
        *dp = o; }
    LDS_WAIT(); asm volatile("" ::: "memory");
}
__device__ __forceinline__ int ffn_in_row(int n) { return n < DFF ? (n >> 7) * 256 + (n & 127) : ((n - DFF) >> 7) * 256 + 128 + ((n - DFF) & 127); }
__device__ __forceinline__ TItem titem_matrix(const float* W, int K, int N, bf16* WT, int KT, int mode, int ffn, int item, int lane, const float* gk = nullptr) {
    const int nblk = N / 32, kb = item / nblk, nb = item % nblk, n0 = 32 * nb, k0 = 64 * kb;
    TItem d; d.src = W + (size_t)(k0 + (lane >> 5)) * N + n0 + (lane & 31); d.WT = WT; d.gk = gk; d.N = N; d.drow0 = ffn ? ffn_in_row(n0) : n0; d.k0 = k0; d.KT = KT; d.mode = mode; return d;
}
__device__ __forceinline__ void rms_row_to_bf16(const float* xrow, const float* g, bf16* Hb, int m, int lane) {
    const GAS f32x4* xr = (const GAS f32x4*)xrow + lane; const GAS f32x4* gr = (const GAS f32x4*)g + lane;
    f32x4 v[16]; float s = 0.f;
#pragma unroll
    for (int j = 0; j < 16; ++j) { v[j] = xr[64 * j]; s += (v[j].x * v[j].x + v[j].y * v[j].y) + (v[j].z * v[j].z + v[j].w * v[j].w); }
    const float rstd = 1.f / sqrtf(wave_sum(s) * (1.f / DM) + EPS);
#pragma unroll
    for (int j = 0; j < 16; ++j) { const f32x4 gg = gr[64 * j];
        *(GAS unsigned long long*)((unsigned char*)Hb + pg8::blk_off(m, 4 * lane + 256 * j, DM / 64)) =
            (unsigned long long)pk2(v[j].x * rstd * gg.x, v[j].y * rstd * gg.y) | ((unsigned long long)pk2(v[j].z * rstd * gg.z, v[j].w * rstd * gg.w) << 32); }
}
__device__ __forceinline__ void rms_row_bf16_to_bf16(const bf16* xrow, const float* g, bf16* Hb, int m, int lane) {
    const GAS v4u* xr = (const GAS v4u*)xrow + lane;
    v4u v[8]; float s = 0.f;
#pragma unroll
    for (int j = 0; j < 8; ++j) { v[j] = xr[64 * j]; const unsigned w[4] = {v[j].x, v[j].y, v[j].z, v[j].w};
#pragma unroll
        for (int k = 0; k < 4; ++k) { const float a = pg8::bf_lo(w[k]), b = pg8::bf_hi(w[k]); s += a * a + b * b; } }
    const float rstd = 1.f / sqrtf(wave_sum(s) * (1.f / DM) + EPS);
#pragma unroll
    for (int j = 0; j < 8; ++j) { const int col = 8 * lane + 512 * j; const f32x4 g0 = *(const GAS f32x4*)(g + col), g1 = *(const GAS f32x4*)(g + col + 4);
        v4u o; o.x = pk2(pg8::bf_lo(v[j].x) * rstd * g0.x, pg8::bf_hi(v[j].x) * rstd * g0.y); o.y = pk2(pg8::bf_lo(v[j].y) * rstd * g0.z, pg8::bf_hi(v[j].y) * rstd * g0.w);
        o.z = pk2(pg8::bf_lo(v[j].z) * rstd * g1.x, pg8::bf_hi(v[j].z) * rstd * g1.y); o.w = pk2(pg8::bf_lo(v[j].w) * rstd * g1.z, pg8::bf_hi(v[j].w) * rstd * g1.w);
        *(GAS v4u*)((unsigned char*)Hb + pg8::blk_off(m, col, DM / 64)) = o; }
}
__device__ __forceinline__ void rms_row_f32_inplace(float* xrow, const float* g, int lane) {
    GAS f32x4* xr = (GAS f32x4*)xrow + lane; const GAS f32x4* gr = (const GAS f32x4*)g + lane;
    f32x4 v[16]; float s = 0.f;
#pragma unroll
    for (int j = 0; j < 16; ++j) { v[j] = xr[64 * j]; s += (v[j].x * v[j].x + v[j].y * v[j].y) + (v[j].z * v[j].z + v[j].w * v[j].w); }
    const float rstd = 1.f / sqrtf(wave_sum(s) * (1.f / DM) + EPS);
#pragma unroll
    for (int j = 0; j < 16; ++j) { const f32x4 gg = gr[64 * j]; xr[64 * j] = v[j] * rstd * gg; }
}
__device__ __forceinline__ int recent_first_row(int it) { const int pp = it >> 8, s = pp >> 5, idx = pp & 31; return ((12 * (idx >> 2) + 4 * (2 - s) + (idx & 3)) << 8) + (it & 255); }
__device__ __forceinline__ void rms_row_bf16_to_f32(const bf16* Xb, int m, const float* g, float* orow, int lane) {
    v4u v[8]; float s = 0.f;
#pragma unroll
    for (int j = 0; j < 8; ++j) { v[j] = *(const GAS v4u*)((const unsigned char*)Xb + pg8::blk_off(m, 8 * lane + 512 * j, DM / 64)); const unsigned w[4] = {v[j].x, v[j].y, v[j].z, v[j].w};
#pragma unroll
        for (int k = 0; k < 4; ++k) { const float a = pg8::bf_lo(w[k]), b = pg8::bf_hi(w[k]); s += a * a + b * b; } }
    const float rstd = 1.f / sqrtf(wave_sum(s) * (1.f / DM) + EPS);
#pragma unroll
    for (int j = 0; j < 8; ++j) { const int col = 8 * lane + 512 * j; const f32x4 g0 = *(const GAS f32x4*)(g + col), g1 = *(const GAS f32x4*)(g + col + 4);
        *(GAS f32x4*)(orow + col) = (f32x4){pg8::bf_lo(v[j].x) * rstd * g0.x, pg8::bf_hi(v[j].x) * rstd * g0.y, pg8::bf_lo(v[j].y) * rstd * g0.z, pg8::bf_hi(v[j].y) * rstd * g0.w};
        *(GAS f32x4*)(orow + col + 4) = (f32x4){pg8::bf_lo(v[j].z) * rstd * g1.x, pg8::bf_hi(v[j].z) * rstd * g1.y, pg8::bf_lo(v[j].w) * rstd * g1.z, pg8::bf_hi(v[j].w) * rstd * g1.w}; }
}
__device__ __forceinline__ void rstd_phase(Frame& F, const float* ssq, float* rstd) {
    for (int m = F.vcu * (NWAVES * 64) + F.tid; m < TT; m += F.G * NWAVES * 64) { const GAS f32x4* p = (const GAS f32x4*)(ssq + (size_t)m * 64); float s = 0.f;
#pragma unroll
        for (int j = 0; j < 16; ++j) { const f32x4 v = p[j]; s += (v.x + v.y) + (v.z + v.w); }
        rstd[m] = 1.f / sqrtf(s * (1.f / DM) + EPS); }
}
__device__ __forceinline__ void rms_phase(Frame& F, const float* xa, const float* xb, const float* g, bf16* H) {
    const int gw = F.vcu * NWAVES + F.wave, NGW = F.G * NWAVES;
    for (int it = gw; it < TT; it += NGW) { const int m = recent_first_row(it); const float* xr = m < 8192 ? xa + (size_t)m * DM : xb + (size_t)(m - 8192) * DM; rms_row_to_bf16(xr, g, H, m, F.lane); }
}

constexpr int RL_XB = 0, RL_XF = 17408, RL_CW = 51200, RL_RAW = 53760, RL_RAWB = 33792;
static_assert(RL_RAW + 2 * RL_RAWB <= RING_BYTES, "rglru LDS");
template <bool REV> __device__ __forceinline__ void rl_scan(const float (&a)[4][4], const float (&u)[4][4], float cin, float (&h)[4][4], float& Atot, float& Hfin, int lane) {
    const int fq = lane >> 4, fr = lane & 15;
    const int src1 = (REV ? lane + 16 : lane - 16) & 63, src2 = (REV ? lane + 32 : lane - 32) & 63, srct = REV ? fr : fr + 48;
    const bool v1 = REV ? fq <= 2 : fq >= 1, v2 = REV ? fq <= 1 : fq >= 2;
    float C = cin; Atot = 1.f;
#pragma unroll
    for (int mtt = 0; mtt < 4; ++mtt) { const int mt = REV ? 3 - mtt : mtt;
        float P[4], Hl[4];
        if (!REV) { P[0] = a[mt][0]; Hl[0] = u[mt][0];
#pragma unroll
            for (int i = 1; i < 4; ++i) { P[i] = a[mt][i] * P[i - 1]; Hl[i] = a[mt][i] * Hl[i - 1] + u[mt][i]; } }
        else { P[3] = a[mt][3]; Hl[3] = u[mt][3];
#pragma unroll
            for (int i = 2; i >= 0; --i) { P[i] = a[mt][i] * P[i + 1]; Hl[i] = a[mt][i] * Hl[i + 1] + u[mt][i]; } }
        float As = REV ? P[0] : P[3], Hs = REV ? Hl[0] : Hl[3];
        { const float Ap = __shfl(As, src1), Hp = __shfl(Hs, src1); if (v1) { Hs = As * Hp + Hs; As = As * Ap; } }
        { const float Ap = __shfl(As, src2), Hp = __shfl(Hs, src2); if (v2) { Hs = As * Hp + Hs; As = As * Ap; } }
        float Ae = __shfl(As, src1), He = __shfl(Hs, src1); if (!v1) { Ae = 1.f; He = 0.f; }
        const float At = __shfl(As, srct), Ht = __shfl(Hs, srct);
        const float E = Ae * C + He;
#pragma unroll
        for (int i = 0; i < 4; ++i) h[mt][i] = P[i] * E + Hl[i];
        C = At * C + Ht; Atot *= At; }
    Hfin = C;
}
__device__ __forceinline__ float gelu_tanh(float x) {
    const float z = 0.7978845608028654f * (x + 0.044715f * x * x * x);
    const float e = __builtin_amdgcn_exp2f(2.f * 1.4426950408889634f * z);
    const float th = 1.f - 2.f * __builtin_amdgcn_rcpf(e + 1.f);
    return 0.5f * x * (1.f + th);
}
__device__ __forceinline__ void rl_glds16(const void* gsrc, unsigned lds_dst) { unsigned keep;
    asm volatile("s_mov_b32 %0, m0\n\ts_mov_b32 m0, %2\n\ts_nop 0\n\tglobal_load_lds_dwordx4 %1, off\n\ts_mov_b32 m0, %0" : "=&s"(keep) : "v"(gsrc), "s"(lds_dst) : "memory"); }
template <bool FINAL>
__device__ __forceinline__ void rglru_phase(Frame& F, const bf16* RXY, const bf16* RGW, const float* conv_w, const float* conv_b, const float* rg_ba, const float* rg_bx,
                                            const float* rg_lambda, float* AGG, const float* CARRY, bf16* RR) {
    typedef short bf16x8 __attribute__((ext_vector_type(8)));
    const int tid = F.tid, lane = F.lane, w = F.wave, fr = lane & 15, fq = lane >> 4;
    const int n = F.vcu & 15, cl = 16 * w + fr, cg = n * 128 + cl;
    LAS unsigned char* L = F.lds + RING_OFF;
    LAS float* CW = (LAS float*)(L + RL_CW);
    for (int i = tid; i < 640; i += NWAVES * 64) CW[i] = i < 512 ? conv_w[(i >> 7) * RW + n * 128 + (i & 127)] : conv_b[n * 128 + (i - 512)];
    bf16x8 Bf[4][4]; float bias[4], sp[2];
#pragma unroll
    for (int g = 0; g < 4; ++g) {
#pragma unroll
        for (int ks = 0; ks < 4; ++ks) Bf[g][ks] = *(const bf16x8*)(RGW + ((size_t)(g * 16 + n) * 128 + cl) * 128 + 32 * ks + 8 * fq);
        bias[g] = (g & 1) ? rg_bx[((g >> 1) * 16 + n) * 128 + cl] : rg_ba[((g >> 1) * 16 + n) * 128 + cl]; }
#pragma unroll
    for (int d = 0; d < 2; ++d) sp[d] = log1pf(__expf(-rg_lambda[d * RW + cg]));
    __syncthreads();
    const int t = tid >> 3, c16 = (tid & 7) * 16;
    float k1[2];
#pragma unroll
    for (int d = 0; d < 2; ++d) k1[d] = -8.f * 1.4426950408889634f * sp[d];
#ifndef RL_PASSES
#define RL_PASSES 1
#endif
    const int cstep = F.G >> 4, cfirst = F.vcu >> 4;
#define RL_DMA(ci_, buf_) do { const int row0_ = (ci_) * 64, s0_ = seq_start(row0_), s1_ = seq_end(row0_); \
        _Pragma("unroll") for (int k_ = 0; k_ < (FINAL ? 5 : 3); ++k_) { int q_ = w + NWAVES * k_; q_ = q_ < (FINAL ? 33 : 17) ? q_ : (FINAL ? 32 : 16);     \
            const int lr_ = 4 * (q_ < 17 ? q_ : q_ - 17) + (lane >> 4); int gr_ = q_ < 17 ? row0_ - 2 + lr_ : row0_ + lr_; gr_ = gr_ < s0_ ? s0_ : (gr_ >= s1_ ? s1_ - 1 : gr_); \
            const bf16* gp_ = RXY + (size_t)gr_ * 4096 + (q_ < 17 ? 0 : 2048) + n * 128 + (lane & 15) * 8; \
            rl_glds16(gp_, (unsigned)__builtin_amdgcn_readfirstlane((int)(lds0 + RL_RAW + (buf_) * RL_RAWB + q_ * 1024))); } } while (0)
    const unsigned lds0 = (unsigned)(uintptr_t)L;
    {
#define RL_WRAP(x) ((x) >= NCHUNK ? (x) - NCHUNK : (x))
    float cnx[2] = {0.f, 0.f};
    if (cfirst < NCHUNK) { RL_DMA(cfirst, 0); if (FINAL) { cnx[0] = CARRY[(size_t)(cfirst * 2 + 0) * RW + cg]; cnx[1] = CARRY[(size_t)(cfirst * 2 + 1) * RW + cg]; } }
    int buf = 0;
    for (int cl_ = cfirst; cl_ < NCHUNK * RL_PASSES; cl_ += cstep, buf ^= 1) { const int ci = RL_WRAP(cl_);
        const int row0 = ci * 64, s0 = seq_start(row0), s1 = seq_end(row0);
        LAS unsigned char* RAW = L + RL_RAW + buf * RL_RAWB; LAS unsigned char* YR = RAW + 68 * 256;
        asm volatile("s_waitcnt vmcnt(0) lgkmcnt(0)" ::: "memory"); __builtin_amdgcn_s_barrier(); asm volatile("" ::: "memory");
        const float cin2[2] = {cnx[0], cnx[1]};
        if (cl_ + cstep < NCHUNK * RL_PASSES) { const int cn = RL_WRAP(cl_ + cstep); RL_DMA(cn, buf ^ 1);
            if (FINAL) { cnx[0] = CARRY[(size_t)(cn * 2 + 0) * RW + cg]; cnx[1] = CARRY[(size_t)(cn * 2 + 1) * RW + cg]; } }
        { float xa[16];
#pragma unroll
          for (int k = 0; k < 16; ++k) xa[k] = CW[512 + c16 + k];
#pragma unroll
          for (int j = 0; j < 4; ++j) { const int rr = row0 + t + j - 2; const float msk = (rr >= s0 && rr < s1) ? 1.f : 0.f;
              const LAS v4u* rp = (const LAS v4u*)(RAW + (t + j) * 256 + c16 * 2); const v4u q0 = rp[0], q1 = rp[1];
              const unsigned ww[8] = {q0.x, q0.y, q0.z, q0.w, q1.x, q1.y, q1.z, q1.w};
#pragma unroll
              for (int k = 0; k < 8; ++k) { xa[2 * k] += CW[j * 128 + c16 + 2 * k] * (msk * pg8::bf_lo(ww[k])); xa[2 * k + 1] += CW[j * 128 + c16 + 2 * k + 1] * (msk * pg8::bf_hi(ww[k])); } }
          LAS f32x4* xf = (LAS f32x4*)(L + RL_XF + t * 528 + c16 * 4);
#pragma unroll
          for (int k = 0; k < 4; ++k) xf[k] = (f32x4){xa[4 * k], xa[4 * k + 1], xa[4 * k + 2], xa[4 * k + 3]};
          LAS v4u* xb = (LAS v4u*)(L + RL_XB + t * 272 + c16 * 2);
          xb[0] = (v4u){pk2(xa[0], xa[1]), pk2(xa[2], xa[3]), pk2(xa[4], xa[5]), pk2(xa[6], xa[7])};
          xb[1] = (v4u){pk2(xa[8], xa[9]), pk2(xa[10], xa[11]), pk2(xa[12], xa[13]), pk2(xa[14], xa[15])}; }
        asm volatile("s_waitcnt lgkmcnt(0)" ::: "memory"); __builtin_amdgcn_s_barrier(); asm volatile("" ::: "memory");
        float hsum[4][4];
#pragma unroll
        for (int d = 0; d < 2; ++d) {
            float a[4][4], u[4][4];
#pragma unroll
            for (int mt = 0; mt < 4; ++mt) {
                f32x4 ca = (f32x4){bias[2 * d], bias[2 * d], bias[2 * d], bias[2 * d]}, cx = (f32x4){bias[2 * d + 1], bias[2 * d + 1], bias[2 * d + 1], bias[2 * d + 1]};
#pragma unroll
                for (int ks = 0; ks < 4; ++ks) { const bf16x8 af = *(const LAS bf16x8*)(L + RL_XB + (16 * mt + fr) * 272 + (32 * ks + 8 * fq) * 2);
                    ca = __builtin_amdgcn_mfma_f32_16x16x32_bf16(af, Bf[2 * d][ks], ca, 0, 0, 0); cx = __builtin_amdgcn_mfma_f32_16x16x32_bf16(af, Bf[2 * d + 1][ks], cx, 0, 0, 0); }
#pragma unroll
                for (int i = 0; i < 4; ++i) { const float ra = pg8::sigm(ca[i]), ia = pg8::sigm(cx[i]);
                    const float xv = *(const LAS float*)(L + RL_XF + (16 * mt + 4 * fq + i) * 528 + cl * 4);
                    const float av = __builtin_amdgcn_exp2f(k1[d] * ra);
                    a[mt][i] = av; u[mt][i] = __builtin_amdgcn_sqrtf(fmaxf(fmaf(-av, av, 1.f), 0.f)) * (ia * xv); } }
            float h[4][4], Atot, Hfin;
            const float cin = cin2[d];
            if (d == 0) rl_scan<false>(a, u, cin, h, Atot, Hfin, lane); else rl_scan<true>(a, u, cin, h, Atot, Hfin, lane);
            if (FINAL) {
#pragma unroll
                for (int mt = 0; mt < 4; ++mt)
#pragma unroll
                    for (int i = 0; i < 4; ++i) hsum[mt][i] = d == 0 ? h[mt][i] : hsum[mt][i] + h[mt][i]; }
            else if (fq == 0) { float2 ah; ah.x = Atot; ah.y = Hfin; *(float2*)(AGG + ((size_t)(ci * 2 + d) * RW + cg) * 2) = ah; }
        }
        if (FINAL) {
#pragma unroll
            for (int mt = 0; mt < 4; ++mt)
#pragma unroll
                for (int i = 0; i < 4; ++i) { LAS unsigned short* yp = (LAS unsigned short*)(YR + (16 * mt + 4 * fq + i) * 256 + cl * 2);
                    const float y = __uint_as_float((unsigned)(*yp) << 16); *yp = (unsigned short)f2bf(hsum[mt][i] * gelu_tanh(y)); }
            asm volatile("s_waitcnt lgkmcnt(0)" ::: "memory"); __builtin_amdgcn_s_barrier(); asm volatile("" ::: "memory");
            { const LAS v4u* yb = (const LAS v4u*)(YR + t * 256 + c16 * 2); const v4u o0 = yb[0], o1 = yb[1]; *(v4u*)((unsigned char*)RR + pg8::blk_off(row0 + t, n * 128 + c16, RW / 64)) = o0; *(v4u*)((unsigned char*)RR + pg8::blk_off(row0 + t, n * 128 + c16 + 8, RW / 64)) = o1; }
        }
    }
    asm volatile("s_waitcnt vmcnt(0) lgkmcnt(0)" ::: "memory"); __builtin_amdgcn_s_barrier(); asm volatile("" ::: "memory"); }
#undef RL_DMA
#undef RL_WRAP
}
__device__ __forceinline__ void carry_phase(Frame& F, const float* AGG, float* CARRY) {
    const int gt = F.vcu * (NWAVES * 64) + F.tid;
    if (gt >= 3 * 2 * RW) return;
    const int s = gt / (2 * RW), d = (gt / RW) & 1, c = gt % RW;
    const int c0 = s == 0 ? 0 : (s == 1 ? 64 : 128), c1 = s == 0 ? 64 : (s == 1 ? 128 : NCHUNK);
    float carry = 0.f;
    for (int b = 0; b < c1 - c0; b += 32) {
        float2 ah[32];
#pragma unroll
        for (int k = 0; k < 32; ++k) { const int ch = d == 0 ? c0 + b + k : c1 - 1 - b - k; ah[k] = *(const float2*)(AGG + ((size_t)(ch * 2 + d) * RW + c) * 2); }
#pragma unroll
        for (int k = 0; k < 32; ++k) { const int ch = d == 0 ? c0 + b + k : c1 - 1 - b - k; CARRY[(size_t)(ch * 2 + d) * RW + c] = carry; carry = ah[k].x * carry + ah[k].y; }
    }
}

#ifndef ATT_FORCE_SLOW
#define ATT_FORCE_SLOW 0
#endif
#ifndef GEMM_SP2
#define GEMM_SP2 true
#endif
#ifndef ALL_WGM
#define ALL_WGM 4
#endif
#ifndef GEMM_REV
#define GEMM_REV 0xB
#endif
#ifndef FFO_CSPLIT
#define FFO_CSPLIT 1
#endif
#ifndef FFO_WGM
#define FFO_WGM 4
#endif
#ifndef TAIL_FILL
#define TAIL_FILL 0
#endif
#ifndef SKEW_TICKS
#define SKEW_TICKS 0
#endif
#define PHASE_SKEW() do { if (SKEW_TICKS) { const unsigned long long t0_ = __builtin_amdgcn_s_memrealtime(); const unsigned long long d_ = (unsigned long long)((F.vcu * 8 / F.G) & 7) * SKEW_TICKS; \
        while (__builtin_amdgcn_s_memrealtime() - t0_ < d_) __builtin_amdgcn_s_sleep(16); } } while (0)
#define RESID_WMODE (RESID_PERM ? 2 : 1)
#ifndef RESID_ALIGN
#define RESID_ALIGN true
#endif
struct Args { const float* in[26]; float* out; unsigned char* ws; int ph_lo, ph_hi, li, pad; };
__device__ __forceinline__ double rope_rev(int j) {
    return j == 0 ? 0.15915494309189535 : j == 1 ? 0.03086376340470123 : j == 2 ? 0.005985185712713705 : j == 3 ? 0.001160663641240061 :
           j == 4 ? 0.00022507907903927653 : j == 5 ? 4.364795279280289e-05 : j == 6 ? 8.464330808241401e-06 : 1.6414262627950345e-06;
}
#define TRANSPOSE_STREAM(DESC, NIT) do { int it_ = gw; if (it_ < (NIT)) { float va_[32], vb_[32]; TItem da_ = DESC(it_), db_; titem_load(da_, va_); \
        for (;;) { int nx_ = it_ + NGW; bool hn_ = nx_ < (NIT); db_ = DESC(hn_ ? nx_ : it_); titem_load(db_, vb_); titem_finish(da_, va_, scr, F.lane); if (!hn_) break; it_ = nx_; \
                   nx_ = it_ + NGW; hn_ = nx_ < (NIT); da_ = DESC(hn_ ? nx_ : it_); titem_load(da_, va_); titem_finish(db_, vb_, scr, F.lane); if (!hn_) break; it_ = nx_; } } } while (0)
__global__ void __launch_bounds__(NWAVES * 64, 2) mk_fwd(Args args) {
    extern __shared__ __attribute__((aligned(16))) unsigned char lds[];
    Frame F;
    F.lds = (LAS unsigned char*)lds;
    F.MISC = (volatile LAS unsigned*)(F.lds + MISC_OFF);
    F.tid = threadIdx.x; F.lane = F.tid & 63; F.wave = __builtin_amdgcn_readfirstlane(F.tid >> 6);
    F.G = gridDim.x; { const int bx = blockIdx.x; F.vcu = (F.G % 8 == 0) ? (bx % 8) * (F.G / 8) + bx / 8 : bx; }
    unsigned char* ws = args.ws;
    gu32* ctl = (gu32*)(ws + WS_CTL);
    const float* x_prompt = args.in[0]; const float* x_sample = args.in[1];
    const float* ffn1_norm = args.in[2]; const float* ffn1_w_in = args.in[3]; const float* ffn1_w_out = args.in[4];
    const float* mix_norm = args.in[5]; const float* w_in = args.in[6];
    const float* lq1 = args.in[7]; const float* lk1 = args.in[8]; const float* lq2 = args.in[9]; const float* lk2 = args.in[10];
    const float* subln_gain = args.in[11]; const float* conv_w = args.in[12]; const float* conv_b = args.in[13];
    const float* rg_wa = args.in[14]; const float* rg_ba = args.in[15]; const float* rg_wx = args.in[16]; const float* rg_bx = args.in[17]; const float* rg_lambda = args.in[18];
    const float* w_attn = args.in[19]; const float* w_rnn = args.in[20]; const float* w_out = args.in[21];
    const float* ffn2_norm = args.in[22]; const float* ffn2_w_in = args.in[23]; const float* ffn2_w_out = args.in[24]; const float* final_norm = args.in[25];
    float* out = args.out;
    float* ROPE = (float*)(ws + WS_ROPE); bf16* RGW = (bf16*)(ws + WS_RGW); float* AGG = (float*)(ws + WS_AGG); float* CARRY = (float*)(ws + WS_CARRY);
    bf16* WFI = (bf16*)(ws + WS_WFI); bf16* WFO = (bf16*)(ws + WS_WFO); bf16* WIN = (bf16*)(ws + WS_WIN); bf16* WA = (bf16*)(ws + WS_WA); bf16* WR = (bf16*)(ws + WS_WR); bf16* WO = (bf16*)(ws + WS_WO);
    bf16* H = (bf16*)(ws + WS_H); bf16* OB = H; bf16* RR = (bf16*)(ws + WS_RR);
    bf16* XR = (bf16*)(ws + WS_XR); float* SSQ = (float*)(ws + WS_SSQ); float* RSTD = (float*)(ws + WS_RSTD); bf16* MID = (bf16*)(ws + WS_BIG); bf16* QKV = (bf16*)(ws + WS_QKV); bf16* RXY = (bf16*)(ws + WS_RXY); bf16* GT = (bf16*)(ws + WS_G); bf16* MG = QKV;

    for (int u = F.tid; u < (LDS_BYTES - LDSCTL_OFF) / 4; u += NWAVES * 64) ((LAS unsigned*)(F.lds + LDSCTL_OFF))[u] = 0u;
    __syncthreads();
    XcdBarrier bar; bar.bar = (unsigned*)(ctl + CW_BAR) + args.li * XCD_BAR_WORDS; bar.x = 0; bar.st = nullptr;
    if (!MK_PER_PHASE) bar = xcd_barrier_post((unsigned*)(ctl + CW_BAR) + args.li * XCD_BAR_WORDS, F.MISC + 8);
#define GRID_BAR() do { xcd_barrier(bar); } while (0)
    const int lo = args.ph_lo, hi = args.ph_hi;
#ifndef PH_MASK
#define PH_MASK 0x7fff
#endif
#define IN(k) (((PH_MASK >> (k)) & 1) && lo <= (k) && (k) < hi)
#define BOTH(k) (IN(k) && IN((k) + 1))
#ifndef PH_REP
#define PH_REP 0
#endif
#define REPS(k) ((((PH_REP) >> (k)) & 1) + 1)
    const int gw = F.vcu * NWAVES + F.wave, NGW = F.G * NWAVES;
    LAS float* scr = (LAS float*)(F.lds + RING_OFF + F.wave * 16384);

#ifndef PROBE_ALL2_LO
#define PROBE_ALL2_LO 0
#define PROBE_ALL2_HI (NPHASE - 1)
#endif
#ifndef PROBE_ALL2
#define PROBE_ALL2 0
#endif
    if (IN(0))
_Pragma("unroll")
    for (int rep = 0; rep < REPS(0); ++rep) {
        constexpr int I_FI = (DM / 64) * (2 * DFF / 32), I_FO = (DFF / 64) * (DM / 32), I_IN = (DM / 64) * (NIN / 32), I_A = (AW / 64) * (DM / 32), I_O = (DM / 64) * (DM / 32), I_RG = 512;
        constexpr int NITEMS = I_FI + I_IN + I_O + I_RG + (TAIL_FILL ? 0 : I_FO + 2 * I_A);
        auto desc0 = [&](int it) -> TItem {
            int r = it;
            if (r < I_FI) return titem_matrix(ffn1_w_in, DM, 2 * DFF, WFI, DM / 64, 2, 1, r, F.lane); r -= I_FI;
            if (r < I_IN) return titem_matrix(w_in, DM, NIN, WIN, DM / 64, 2, 0, r, F.lane, mix_norm); r -= I_IN;
            if (r < I_O) return titem_matrix(w_out, DM, DM, WO, DM / 64, RESID_WMODE, 0, r, F.lane); r -= I_O;
            if (!TAIL_FILL) {
            if (r < I_FO) return titem_matrix(ffn1_w_out, DFF, DM, WFO, DFF / 64, RESID_WMODE, 0, r, F.lane); r -= I_FO;
            if (r < I_A) return titem_matrix(w_attn, AW, DM, WA, AW / 64, 2, 0, r, F.lane); r -= I_A;
            if (r < I_A) return titem_matrix(w_rnn, RW, DM, WR, RW / 64, 2, 0, r, F.lane); r -= I_A; }
            const int blk = r >> 3, sub = r & 7, gate = blk >> 5, b = blk & 31, dir = b >> 4, n = b & 15;
            return titem_matrix((gate ? rg_wx : rg_wa) + (size_t)b * 16384, 128, 128, RGW + (size_t)((dir * 2 + gate) * 16 + n) * 16384, 128, 0, 0, sub, F.lane);
        };
        TRANSPOSE_STREAM(desc0, NITEMS);
        for (int idx = gw * 64 + F.lane; idx < 16384 * 8; idx += NGW * 64) { const int pos = idx >> 3, j = idx & 7;
            double rev = (double)pos * rope_rev(j); rev -= __builtin_floor(rev); const float rf = (float)rev;
            float2 cs; cs.x = __builtin_amdgcn_cosf(rf); cs.y = __builtin_amdgcn_sinf(rf); *(float2*)(ROPE + 2 * (size_t)idx) = cs; }
        rms_phase(F, x_prompt, x_sample, ffn1_norm, H);
        if (BOTH(0) || rep + 1 < REPS(0)) GRID_BAR();
    }
    if (IN(1))
_Pragma("unroll")
    for (int rep = 0; rep < REPS(1); ++rep) {
        pg8::Gemm g{H, WFI, TT, 2 * DFF, DM, LDH, LDH}; pg8::StaticOrder S; S.init(TT, 2 * DFF, F.G, (int)blockIdx.x, ALL_WGM); S.rev = (GEMM_REV >> 5) & 1;
        pg8::EpiSwiGLU E{MID, DFF / 64, nullptr};
        pg8::gemm_phase<pg8::EpiSwiGLU, pg8::StaticOrder, true, GEMM_SP2>(F.lds + RING_OFF, g, S, E);
        if (TAIL_FILL && rep == 0) {
            constexpr int I_FO = (DFF / 64) * (DM / 32), I_A = (AW / 64) * (DM / 32);
            const int tail = ((TT / 256) * (2 * DFF / 256)) % F.G, nidle = tail ? F.G - tail : F.G, iw = tail ? (int)blockIdx.x - tail : (int)blockIdx.x;
            if (iw >= 0) { const int gw = iw * NWAVES + F.wave, NGW = nidle * NWAVES;
                auto desc1 = [&](int it) -> TItem { int r = it;
                    if (r < I_FO) return titem_matrix(ffn1_w_out, DFF, DM, WFO, DFF / 64, RESID_WMODE, 0, r, F.lane); r -= I_FO;
                    if (r < I_A) return titem_matrix(w_attn, AW, DM, WA, AW / 64, 2, 0, r, F.lane); r -= I_A;
                    return titem_matrix(w_rnn, RW, DM, WR, RW / 64, 2, 0, r, F.lane); };
                TRANSPOSE_STREAM(desc1, I_FO + 2 * I_A); } }
        if (BOTH(1) || rep + 1 < REPS(1)) GRID_BAR();
    }
#ifdef PROBE_P2B
    if (IN(2)) {
        pg8::Gemm g{MID, WFO, TT, DM, DFF, LDMID, LDMID}; pg8::StaticOrder S; S.init(TT, DM, F.G, (int)blockIdx.x, FFO_WGM); S.csplit = FFO_CSPLIT; S.rev = (GEMM_REV >> 0) & 1;
        pg8::EpiPlainBf16 E{H, 0.5f};
        pg8::gemm_phase<pg8::EpiPlainBf16, pg8::StaticOrder, true, GEMM_SP2>(F.lds + RING_OFF, g, S, E);
        GRID_BAR();
    }
#endif
    if (IN(2))
_Pragma("unroll")
    for (int rep = 0; rep < REPS(2); ++rep) {
        pg8::Gemm g{MID, WFO, TT, DM, DFF, LDMID, LDMID}; pg8::StaticOrder S; S.init(TT, DM, F.G, (int)blockIdx.x, FFO_WGM); S.csplit = FFO_CSPLIT; S.rev = (GEMM_REV >> 0) & 1;
        pg8::EpiResidT<false, true> E{x_prompt, x_sample, 8192, XR, DM, 0.5f, SSQ};
        PHASE_SKEW();
        pg8::gemm_phase<pg8::EpiResidT<false, true>, pg8::StaticOrder, RESID_ALIGN, GEMM_SP2>(F.lds + RING_OFF, g, S, E);
        if (BOTH(2) || rep + 1 < REPS(2)) GRID_BAR();
    }
    if (IN(3))
_Pragma("unroll")
    for (int rep = 0; rep < REPS(3); ++rep) {
        rstd_phase(F, SSQ, RSTD);
        constexpr int I_FI = (DM / 64) * (2 * DFF / 32), I_FO = (DFF / 64) * (DM / 32);
        auto desc3 = [&](int it) -> TItem { return it < I_FI ? titem_matrix(ffn2_w_in, DM, 2 * DFF, WFI, DM / 64, 2, 1, it, F.lane, ffn2_norm) : titem_matrix(ffn2_w_out, DFF, DM, WFO, DFF / 64, RESID_WMODE, 0, it - I_FI, F.lane); };
        TRANSPOSE_STREAM(desc3, I_FI + (TAIL_FILL ? 0 : I_FO));
        if (BOTH(3) || rep + 1 < REPS(3)) GRID_BAR();
    }
    if (IN(4))
_Pragma("unroll")
    for (int rep = 0; rep < REPS(4); ++rep) {
        pg8::Gemm g{XR, WIN, TT, NIN, DM, LDH, LDH}; pg8::StaticOrder S; S.init(TT, NIN, F.G, (int)blockIdx.x, ALL_WGM); S.rev = (GEMM_REV >> 4) & 1;
        pg8::EpiProj E{QKV, RXY, GT, ROPE, RSTD};
        pg8::gemm_phase<pg8::EpiProj, pg8::StaticOrder, true, GEMM_SP2>(F.lds + RING_OFF, g, S, E);
        if (BOTH(4) || rep + 1 < REPS(4)) GRID_BAR();
    }
    if (IN(5))
_Pragma("unroll")
    for (int rep = 0; rep < REPS(5); ++rep) {
        rglru_phase<false>(F, RXY, RGW, conv_w, conv_b, rg_ba, rg_bx, rg_lambda, AGG, CARRY, RR);
        if (BOTH(5) || rep + 1 < REPS(5)) GRID_BAR();
    }
    if (IN(6))
_Pragma("unroll")
    for (int rep = 0; rep < REPS(6); ++rep) {
        carry_phase(F, AGG, CARRY);
        const float lam = __expf(wave_sum(lq1[F.lane] * lk1[F.lane])) - __expf(wave_sum(lq2[F.lane] * lk2[F.lane])) + 0.2f;
        const int lane = F.lane, r32 = lane & 31, hi = lane >> 5, wid = F.wave;
        char* alds = (char*)lds + RING_OFF;
        const __amdgpu_buffer_rsrc_t qkv_rs = __builtin_amdgcn_make_buffer_rsrc((void*)QKV, 0, (int)((size_t)TT * 6144 * 2), 0x00020000);
        float* li_l = (float*)(alds + att::LDS_WS) + wid * 64;
#ifndef ATT_PASSES
#define ATT_PASSES 1
#endif
        for (int L_ = F.vcu; L_ < 1536 * ATT_PASSES; L_ += F.G) { const int L = L_ >= 1536 ? L_ - 1536 : L_;
            int h, qb, row0, seqlen;
            if (L < 1024) { const int i = L >> 8, xcd = (L & 255) >> 5, loc = L & 31; h = 2 * xcd + (i >> 1); qb = 32 * (i & 1) + loc; row0 = 8192; seqlen = 16384; }
            else { const int Lp = L - 1024, j = Lp >> 8, xcd = (Lp & 255) >> 5, loc = Lp & 31, pair = 4 * xcd + 2 * j + (loc >> 4); qb = loc & 15; h = pair & 15; row0 = (pair >> 4) * 4096; seqlen = 4096; }
            for (int m = 0; m < 2; ++m) {
                const unsigned qo = (unsigned)(((row0 + qb * 256) * 2048 + h * 128 + m * 64) * 2);
                const char* kbase = (const char*)QKV + pg8::QKV_KOFF + (size_t)((((row0 >> 6) * 16 + h) * 2 + m)) * 8192;
                const char* vbase = (const char*)QKV + pg8::QKV_VOFF + (size_t)((row0 >> 6) * 16 + h) * 16384;
                att::f32x16 o[4]; float l;
                att::attn_map_body<true>(qkv_rs, qo, kbase, vbase, seqlen, alds, o, l);
                {
                    LAS unsigned* ovf = (LAS unsigned*)(F.lds + RING_OFF + att::LDS_BYTES);
                    const bool bad = ATT_FORCE_SLOW || !(l < 1e30f);
                    const bool anyb = __any(bad);
                    if (lane == 0) ovf[wid] = anyb ? 1u : 0u;
                    asm volatile("s_waitcnt lgkmcnt(0)" ::: "memory"); __syncthreads();
                    unsigned any8 = 0;
#pragma unroll
                    for (int w8 = 0; w8 < 8; ++w8) any8 |= ovf[w8];
                    __syncthreads();
                    if (any8) att::attn_map_body<false>(qkv_rs, qo, kbase, vbase, seqlen, alds, o, l);
                }
                if (hi == 0) li_l[r32] = l;
                asm volatile("s_waitcnt lgkmcnt(0)" ::: "memory");
                float rli[16];
#pragma unroll
                for (int r = 0; r < 16; ++r) rli[r] = __builtin_amdgcn_rcpf(li_l[att::crow(r, hi)]);
                float* const swb = (float*)(ws + WS_ASCR) + (size_t)blockIdx.x * (256 * 128);
                unsigned swo = (unsigned)(((wid * 32 + 4 * hi) * 128 + r32) * 4); asm volatile("" : "+v"(swo));
#define SWL(idx) (*(float*)((unsigned char*)swb + swo + (idx) * 4))
                if (m == 0) {
#pragma unroll
                    for (int r = 0; r < 16; ++r)
#pragma unroll
                        for (int d0 = 0; d0 < 4; ++d0) SWL(((r & 3) + 8 * (r >> 2)) * 128 + d0 * 32) = o[d0][r] * rli[r];
                    asm volatile("s_waitcnt vmcnt(0)" ::: "memory");
                } else {
                    const int orow0 = row0 + qb * 256 + wid * 32;
                    unsigned char* const obb = (unsigned char*)OB + pg8::blk_off(orow0, h * 128, AW / 64);
                    unsigned ob0 = (unsigned)(hi * 256 + r32 * 2); asm volatile("" : "+v"(ob0));
                    unsigned ob1 = (unsigned)(hi * 256 + ((r32 * 2) ^ 32)); asm volatile("" : "+v"(ob1));
                    float gain[4];
#pragma unroll
                    for (int d0 = 0; d0 < 4; ++d0) gain[d0] = subln_gain[d0 * 32 + r32] * 0.8f;
#pragma unroll
                    for (int r = 0; r < 16; ++r) { const int rb = (r & 3) + 8 * (r >> 2); float ss = 0.f; float v[4];
#pragma unroll
                        for (int d0 = 0; d0 < 4; ++d0) { v[d0] = SWL(rb * 128 + d0 * 32) - lam * (o[d0][r] * rli[r]); ss += v[d0] * v[d0]; }
                        ss += __shfl_xor(ss, 1); ss += __shfl_xor(ss, 2); ss += __shfl_xor(ss, 4); ss += __shfl_xor(ss, 8); ss += __shfl_xor(ss, 16);
                        const float rs = 1.f / sqrtf(ss * (1.f / 128.f) + EPS);
#pragma unroll
                        for (int d0 = 0; d0 < 4; ++d0) { const int coff = (d0 >> 1) * 32768 + ((rb >> 4) * 2 + (d0 & 1)) * 1024 + (rb & 15) * 64;
                            *(bf16*)(obb + (((rb & 8) ? ob1 : ob0) + (unsigned)coff)) = (bf16)f2bf(v[d0] * rs * gain[d0]); } }
                }
#undef SWL
                __syncthreads();
            }
        }
        if (BOTH(6) || rep + 1 < REPS(6)) GRID_BAR();
    }
    if (IN(7))
_Pragma("unroll")
    for (int rep = 0; rep < REPS(7); ++rep) {
        rglru_phase<true>(F, RXY, RGW, conv_w, conv_b, rg_ba, rg_bx, rg_lambda, AGG, CARRY, RR);
        if (BOTH(7) || rep + 1 < REPS(7)) GRID_BAR();
    }
#ifndef PROBE_P89
#define PROBE_P89 0
#endif
_Pragma("unroll")
    for (int rep2 = 0; rep2 < (PROBE_P89 ? 2 : 1); ++rep2) {
    if (IN(8)) {
        pg8::Gemm g{OB, WA, TT, DM, AW, LDO, LDO}; pg8::PairOrder S; S.S.init(TT, DM, F.G, (int)blockIdx.x, ALL_WGM);
        pg8::EpiGatePair E{MG, GT, DM / 64};
        pg8::gemm_phase<pg8::EpiGatePair, pg8::PairOrder, true, GEMM_SP2>(F.lds + RING_OFF, g, S, E);
        if (BOTH(8)) GRID_BAR();
    }
    }
#ifndef PROBE_P10
#define PROBE_P10 0
#endif
    if (IN(10))
_Pragma("unroll")
    for (int rep = 0; rep < (PROBE_P10 ? 3 : 1); ++rep) {
        pg8::Gemm g{MG, WO, TT, DM, DM, LDH, LDH}; pg8::StaticOrder S; S.init(TT, DM, F.G, (int)blockIdx.x, ALL_WGM); S.rev = (GEMM_REV >> 1) & 1;
        pg8::EpiResidT<true, true> E{XR, nullptr, TT, XR, DM, rep == 1 ? -1.0f : 1.0f, SSQ};
        PHASE_SKEW();
        pg8::gemm_phase<pg8::EpiResidT<true, true>, pg8::StaticOrder, RESID_ALIGN, GEMM_SP2>(F.lds + RING_OFF, g, S, E);
        if (BOTH(10) || rep + 1 < (PROBE_P10 ? 3 : 1)) GRID_BAR();
    }
    if (IN(11))
_Pragma("unroll")
    for (int rep = 0; rep < REPS(11); ++rep) {
        rstd_phase(F, SSQ, RSTD);
        if (BOTH(11) || rep + 1 < REPS(11)) GRID_BAR();
    }
    if (IN(12))
_Pragma("unroll")
    for (int rep = 0; rep < REPS(12); ++rep) {
        pg8::Gemm g{XR, WFI, TT, 2 * DFF, DM, LDH, LDH}; pg8::StaticOrder S; S.init(TT, 2 * DFF, F.G, (int)blockIdx.x, ALL_WGM); S.rev = (GEMM_REV >> 2) & 1;
        pg8::EpiSwiGLU E{MID, DFF / 64, RSTD};
        pg8::gemm_phase<pg8::EpiSwiGLU, pg8::StaticOrder, true, GEMM_SP2>(F.lds + RING_OFF, g, S, E);
        if (TAIL_FILL && rep == 0) {
            constexpr int I_FO = (DFF / 64) * (DM / 32);
            const int tail = ((TT / 256) * (2 * DFF / 256)) % F.G, nidle = tail ? F.G - tail : F.G, iw = tail ? (int)blockIdx.x - tail : (int)blockIdx.x;
            if (iw >= 0) { const int gw = iw * NWAVES + F.wave, NGW = nidle * NWAVES;
                auto desc12 = [&](int it) -> TItem { return titem_matrix(ffn2_w_out, DFF, DM, WFO, DFF / 64, RESID_WMODE, 0, it, F.lane); };
                TRANSPOSE_STREAM(desc12, I_FO); } }
        if (BOTH(12) || rep + 1 < REPS(12)) GRID_BAR();
    }
#ifndef PROBE_P13
#define PROBE_P13 0
#endif
    if (IN(13))
_Pragma("unroll")
    for (int rep = 0; rep < (PROBE_P13 ? 3 : 1); ++rep) {
        pg8::Gemm g{MID, WFO, TT, DM, DFF, LDMID, LDMID}; pg8::StaticOrder S; S.init(TT, DM, F.G, (int)blockIdx.x, FFO_WGM); S.csplit = FFO_CSPLIT; S.rev = (GEMM_REV >> 3) & 1;
        pg8::EpiResidT<true, true> E{XR, nullptr, TT, XR, DM, rep == 1 ? -0.5f : 0.5f, nullptr};
        PHASE_SKEW();
        pg8::gemm_phase<pg8::EpiResidT<true, true>, pg8::StaticOrder, RESID_ALIGN, GEMM_SP2>(F.lds + RING_OFF, g, S, E);
        if (BOTH(13) || rep + 1 < (PROBE_P13 ? 3 : 1)) GRID_BAR();
    }
    if (IN(14)) {
#ifdef PROBE_BARS
        for (int b_ = 0; b_ < PROBE_BARS; ++b_) GRID_BAR();
#endif
        for (int it = gw; it < TT; it += NGW) { const int m = recent_first_row(it); rms_row_bf16_to_f32(XR, m, final_norm, out + (size_t)m * DM, F.lane); }
    }
#undef IN
#undef BOTH
#undef GRID_BAR
}

extern "C" void kernel_launch(void* const* d_in, const int* in_sizes, int n_in, void* d_out, int out_size, void* d_ws, size_t ws_size, hipStream_t stream) {
    static int grid = 0;
    if (grid == 0) {
        if (n_in != 26 || in_sizes[0] != 8192 * DM || in_sizes[1] != 16384 * DM || out_size != TT * DM || ws_size < WS_END) {
            fprintf(stderr, "kernel_launch: shape mismatch (n_in %d, out %d, ws %zu, need %zu); nothing launched\n", n_in, out_size, ws_size, (size_t)WS_END); grid = -1; return; }
        int dev = 0, cus = 0;
        if (hipGetDevice(&dev) != hipSuccess || hipDeviceGetAttribute(&cus, hipDeviceAttributeMultiprocessorCount, dev) != hipSuccess) { grid = -1; return; }
        if (hipFuncSetAttribute((const void*)mk_fwd, hipFuncAttributeMaxDynamicSharedMemorySize, LDS_BYTES) != hipSuccess) { fprintf(stderr, "kernel_launch: hipFuncSetAttribute failed\n"); grid = -1; return; }
        (void)hipGetLastError();
        grid = cus > 256 ? 256 : cus - (cus % 16);
        if (grid < 16) { grid = -1; return; }
    }
    if (grid < 0) return;
    if (hipMemsetAsync((char*)d_ws + WS_CTL, 0, CTL_ZERO_BYTES, stream) != hipSuccess) return;
    Args a{};
    for (int i = 0; i < 26; ++i) a.in[i] = (const float*)d_in[i];
    a.out = (float*)d_out; a.ws = (unsigned char*)d_ws;
#if MK_PER_PHASE
    for (int k = 0; k < NPHASE; ++k) { a.ph_lo = k; a.ph_hi = k + 1; hipLaunchKernelGGL(mk_fwd, dim3(grid), dim3(NWAVES * 64), LDS_BYTES, stream, a); }
#else
#if PROBE_ALL2
    a.ph_lo = PROBE_ALL2_LO; a.ph_hi = PROBE_ALL2_HI; a.li = 1;
    hipLaunchKernelGGL(mk_fwd, dim3(grid), dim3(NWAVES * 64), LDS_BYTES, stream, a);
#endif
    a.ph_lo = 0; a.ph_hi = NPHASE; a.li = 0;
    hipLaunchKernelGGL(mk_fwd, dim3(grid), dim3(NWAVES * 64), LDS_BYTES, stream, a);
#endif
    const hipError_t le = hipPeekAtLastError();
    if (le != hipSuccess) fprintf(stderr, "kernel_launch: launch failed: %s\n", hipGetErrorName(le));
}
```
